# Optimizing an MI355X kernel written in HIP

```python
import math
import jax, jax.numpy as jnp
from jax import lax
import numpy as np

D_MODEL = 2048
BATCH = 4
SEQ = 4096
DEPTH = 2

CTX_LEN = 256
GRID_W = 64
HEAD_DIM = 128
A_HEADS = 8
A_KV_HEADS = 2
GQA_GROUP = A_HEADS // A_KV_HEADS
B_HEADS = 4
B_QK_DIM = 64
B_V_DIM = 2 * B_QK_DIM
POOL_WINDOWS = (2, 4, 8, 16)
POOL_GROUP = 128
C_WIDTH = len(POOL_WINDOWS) * POOL_GROUP
A_Q = A_HEADS * HEAD_DIM
A_KV = A_KV_HEADS * HEAD_DIM
B_QK = B_HEADS * 2 * B_QK_DIM
B_V = B_HEADS * B_V_DIM
IN_SIZES = (A_Q, A_KV, A_KV, B_QK, B_QK, B_V, C_WIDTH)
IN_SPLITS = tuple(int(v) for v in np.cumsum(IN_SIZES)[:-1])
IN_WIDTH = sum(IN_SIZES)
MIX_WIDTH = A_Q + B_V + C_WIDTH
N_EXPERTS = 32
TOP_K = 4
D_EXPERT = 1024
SWIGLU_LIMIT = 7.0
SWIGLU_ALPHA = 1.702
ROPE_THETA = 10000.0
Q_BLOCK = 128
EPS = 1e-6

kernel_name = 'hybrid_parallel_heads_prefix_ctx_moe'


def rms_norm(x, g):
    xf = x.astype(jnp.float32)
    y = xf * lax.rsqrt(jnp.mean(xf * xf, axis=-1, keepdims=True) + EPS)
    return (y * g.astype(jnp.float32)).astype(x.dtype)


def rope_tables(pos, dim):
    inv = ROPE_THETA ** (-jnp.arange(0, dim, 2, dtype=jnp.float32) / dim)
    ang = pos.astype(jnp.float32)[:, None] * inv[None, :]
    return jnp.cos(ang), jnp.sin(ang)


def rope_1d(x, cos, sin):
    n2 = x.shape[-1] // 2
    x1, x2 = x[..., :n2], x[..., n2:]
    cs = cos[None, :, None, :].astype(x.dtype)
    sn = sin[None, :, None, :].astype(x.dtype)
    return jnp.concatenate([x1 * cs - x2 * sn, x1 * sn + x2 * cs], axis=-1)


def axial_rope(x, tabs):
    cr, sr, cc, sc = tabs
    h = x.shape[-1] // 2
    return jnp.concatenate([rope_1d(x[..., :h], cr, sr), rope_1d(x[..., h:], cc, sc)], axis=-1)


def axial_tables(row, col, head_dim):
    cr, sr = rope_tables(row, head_dim // 2)
    cc, sc = rope_tables(col, head_dim // 2)
    return (cr, sr, cc, sc)


def sweep_query_blocks(q, fn):
    b, s = q.shape[:2]
    nb = s // Q_BLOCK
    qb = jnp.moveaxis(q.reshape((b, nb, Q_BLOCK) + q.shape[2:]), 1, 0)
    out = jnp.moveaxis(lax.map(fn, qb), 0, 1)
    return out.reshape((b, s) + out.shape[3:])


def gqa_attend(q, k, v):
    s = jnp.einsum('bqkgd,btkd->bkgqt', q, k).astype(jnp.float32) * (1.0 / math.sqrt(HEAD_DIM))
    p = jax.nn.softmax(s, axis=-1).astype(v.dtype)
    return jnp.einsum('bkgqt,btkd->bqkgd', p, v)


def diff_attend(q, k, v, lam):
    s = jnp.einsum('bqchd,btchd->bchqt', q, k).astype(jnp.float32) * (1.0 / math.sqrt(B_QK_DIM))
    p = jax.nn.softmax(s, axis=-1)
    a = (p[:, 0] - lam * p[:, 1]).astype(v.dtype)
    return jnp.einsum('bhqt,bthe->bqhe', a, v)


def multiscale_pool(u, w_pool, pool_scale):
    b, L, cw = u.shape
    uf = u.astype(jnp.float32)
    cs = jnp.concatenate([jnp.zeros((b, 1, cw), jnp.float32), jnp.cumsum(uf, axis=1)], axis=1)
    t = jnp.arange(L)
    groups = []
    for gi, w in enumerate(POOL_WINDOWS):
        lo = jnp.clip(t - w // 2, 0, L)
        hi = jnp.clip(t + w // 2, 0, L)
        seg = cs[:, :, gi * POOL_GROUP:(gi + 1) * POOL_GROUP]
        mean = (seg[:, hi] - seg[:, lo]) / (hi - lo).astype(jnp.float32)[None, :, None]
        groups.append(mean - uf[..., gi * POOL_GROUP:(gi + 1) * POOL_GROUP])
    p = jnp.stack(groups, axis=2).astype(u.dtype)
    y = jnp.einsum('blgc,gcd->blgd', p, w_pool).reshape(b, L, cw)
    return y * pool_scale


def project(h, w_in, g_q, g_k):
    b, L, _ = h.shape
    p = jnp.einsum('bld,de->ble', h, w_in)
    qa, ka, va, qb, kb, vb, uc = jnp.split(p, IN_SPLITS, axis=-1)
    qa = rms_norm(qa.reshape(b, L, A_HEADS, HEAD_DIM), g_q)
    ka = rms_norm(ka.reshape(b, L, A_KV_HEADS, HEAD_DIM), g_k)
    va = va.reshape(b, L, A_KV_HEADS, HEAD_DIM)
    qb = qb.reshape(b, L, 2 * B_HEADS, B_QK_DIM)
    kb = kb.reshape(b, L, 2 * B_HEADS, B_QK_DIM)
    vb = vb.reshape(b, L, B_HEADS, B_V_DIM)
    return qa, ka, va, qb, kb, vb, uc


def mix_layer(h_ctx, h_lat, rope_a, rope_b, w_in, g_q, g_k, lam, lam_init, g_sub, w_pool, pool_scale, w_out, need_ctx):
    b, S, _ = h_lat.shape
    C = h_ctx.shape[1]
    T = C + S
    qa_c, ka_c, va_c, qb_c, kb_c, vb_c, uc_c = project(h_ctx, w_in, g_q, g_k)
    qa_l, ka_l, va_l, qb_l, kb_l, vb_l, uc_l = project(h_lat, w_in, g_q, g_k)
    qa_l, ka_l = axial_rope(qa_l, rope_a), axial_rope(ka_l, rope_a)
    qb_l, kb_l = axial_rope(qb_l, rope_b), axial_rope(kb_l, rope_b)
    ka_all = jnp.concatenate([ka_c, ka_l], axis=1)
    va_all = jnp.concatenate([va_c, va_l], axis=1)
    qa5 = qa_l.reshape(b, S, A_KV_HEADS, GQA_GROUP, HEAD_DIM)
    oa = sweep_query_blocks(qa5, lambda qblk: gqa_attend(qblk, ka_all, va_all)).reshape(b, S, A_Q)
    kb_all = jnp.concatenate([kb_c, kb_l], axis=1).reshape(b, T, 2, B_HEADS, B_QK_DIM)
    vb_all = jnp.concatenate([vb_c, vb_l], axis=1)
    qb5 = qb_l.reshape(b, S, 2, B_HEADS, B_QK_DIM)
    ob = sweep_query_blocks(qb5, lambda qblk: diff_attend(qblk, kb_all, vb_all, lam))
    ob = (rms_norm(ob, g_sub) * (1.0 - lam_init)).reshape(b, S, B_V)
    oc = multiscale_pool(uc_l, w_pool, pool_scale)
    out_lat = jnp.einsum('ble,ed->bld', jnp.concatenate([oa, ob, oc], axis=-1), w_out)
    if not need_ctx:
        return None, out_lat
    oa_c = gqa_attend(qa_c.reshape(b, C, A_KV_HEADS, GQA_GROUP, HEAD_DIM), ka_c, va_c).reshape(b, C, A_Q)
    ob_c = diff_attend(qb_c.reshape(b, C, 2, B_HEADS, B_QK_DIM), kb_c.reshape(b, C, 2, B_HEADS, B_QK_DIM), vb_c, lam)
    ob_c = (rms_norm(ob_c, g_sub) * (1.0 - lam_init)).reshape(b, C, B_V)
    oc_c = multiscale_pool(uc_c, w_pool, pool_scale)
    out_ctx = jnp.einsum('ble,ed->bld', jnp.concatenate([oa_c, ob_c, oc_c], axis=-1), w_out)
    return out_ctx, out_lat


def moe(h, w_router, b_router, w1, b1, w2, b2):
    logits = jnp.einsum('nd,de->ne', h, w_router).astype(jnp.float32) + b_router.astype(jnp.float32)
    top_v, top_i = lax.top_k(logits, TOP_K)
    wts = jax.nn.softmax(top_v, axis=-1)
    gates = jnp.einsum('nk,nke->ne', wts, jax.nn.one_hot(top_i, N_EXPERTS, dtype=jnp.float32))
    out = jnp.zeros(h.shape, jnp.float32)
    for e in range(N_EXPERTS):
        u = jnp.einsum('nd,df->nf', h, w1[e]) + b1[e]
        glu = jnp.minimum(u[..., ::2], SWIGLU_LIMIT)
        lin = jnp.clip(u[..., 1::2], -SWIGLU_LIMIT, SWIGLU_LIMIT)
        a = glu * jax.nn.sigmoid(SWIGLU_ALPHA * glu) * (lin + 1.0)
        y = jnp.einsum('nf,fd->nd', a, w2[e]) + b2[e]
        out = out + gates[:, e:e + 1] * y.astype(jnp.float32)
    return out.astype(h.dtype)


def setup_inputs(seed: int = 0) -> dict:
    key = jax.random.key(seed)
    ks = iter(jax.random.split(key, 32))
    f32 = jnp.float32

    def nrm(shape, scale):
        return jax.random.normal(next(ks), shape, f32) * scale

    L, D, E, F = DEPTH, D_MODEL, N_EXPERTS, D_EXPERT
    return {
        'x': nrm((BATCH, SEQ, D), 1.0),
        'c': nrm((BATCH, D), 1.0),
        'ctx': nrm((BATCH, CTX_LEN, D), 1.0),
        'c_ctx': nrm((D,), 1.0),
        'w_mod': nrm((L, D, 6 * D), 0.5 * D ** -0.5),
        'b_mod': nrm((L, 6 * D), 0.01),
        'g_norm1': 1.0 + nrm((L, D), 0.05),
        'g_norm2': 1.0 + nrm((L, D), 0.05),
        'w_in': nrm((L, D, IN_WIDTH), D ** -0.5),
        'g_qnorm': 1.0 + nrm((L, HEAD_DIM), 0.05),
        'g_knorm': 1.0 + nrm((L, HEAD_DIM), 0.05),
        'lambda_q1': nrm((L, B_QK_DIM), 0.1),
        'lambda_k1': nrm((L, B_QK_DIM), 0.1),
        'lambda_q2': nrm((L, B_QK_DIM), 0.1),
        'lambda_k2': nrm((L, B_QK_DIM), 0.1),
        'g_subln': 1.0 + nrm((L, B_V_DIM), 0.05),
        'w_pool': nrm((L, len(POOL_WINDOWS), POOL_GROUP, POOL_GROUP), POOL_GROUP ** -0.5),
        'pool_scale': 1.0 + nrm((L, C_WIDTH), 0.05),
        'w_out': nrm((L, MIX_WIDTH, D), MIX_WIDTH ** -0.5),
        'w_router': nrm((L, D, E), D ** -0.5),
        'b_router': nrm((L, E), 0.01),
        'w_expert_in': nrm((L, E, D, 2 * F), D ** -0.5),
        'b_expert_in': nrm((L, E, 2 * F), 0.01),
        'w_expert_out': nrm((L, E, F, D), F ** -0.5),
        'b_expert_out': nrm((L, E, D), 0.01),
        'g_final': 1.0 + nrm((D,), 0.05),
    }


def reference(x, c, ctx, c_ctx, w_mod, b_mod, g_norm1, g_norm2, w_in, g_qnorm, g_knorm, lambda_q1, lambda_k1, lambda_q2, lambda_k2, g_subln, w_pool, pool_scale, w_out, w_router, b_router, w_expert_in, b_expert_in, w_expert_out, b_expert_out, g_final):
    b, S, D = x.shape
    C = ctx.shape[1]
    rows = S // GRID_W
    row = jnp.repeat(jnp.arange(rows), GRID_W)
    col = jnp.tile(jnp.arange(GRID_W), rows)
    rope_a = axial_tables(row, col, HEAD_DIM)
    rope_b = axial_tables(row, col, B_QK_DIM)
    for l in range(DEPTH):
        need_ctx = l < DEPTH - 1
        lam_init = 0.8 - 0.6 * math.exp(-0.3 * l)
        lam = (jnp.exp(jnp.sum(lambda_q1[l].astype(jnp.float32) * lambda_k1[l].astype(jnp.float32)))
               - jnp.exp(jnp.sum(lambda_q2[l].astype(jnp.float32) * lambda_k2[l].astype(jnp.float32)))
               + lam_init)
        mod_l = (jnp.einsum('bd,de->be', jax.nn.silu(c), w_mod[l]) + b_mod[l])[:, None, :]
        mod_c = (jnp.einsum('d,de->e', jax.nn.silu(c_ctx), w_mod[l]) + b_mod[l])[None, None, :]
        sh1, sc1, gt1, sh2, sc2, gt2 = jnp.split(mod_l, 6, axis=-1)
        csh1, csc1, cgt1, csh2, csc2, cgt2 = jnp.split(mod_c, 6, axis=-1)
        n_lat = rms_norm(x, g_norm1[l]) * (1.0 + sc1) + sh1
        n_ctx = rms_norm(ctx, g_norm1[l]) * (1.0 + csc1) + csh1
        m_ctx, m_lat = mix_layer(n_ctx, n_lat, rope_a, rope_b, w_in[l], g_qnorm[l], g_knorm[l], lam, lam_init,
                                 g_subln[l], w_pool[l], pool_scale[l], w_out[l], need_ctx)
        x = x + gt1 * m_lat
        f_lat = rms_norm(x, g_norm2[l]) * (1.0 + sc2) + sh2
        if need_ctx:
            ctx = ctx + cgt1 * m_ctx
            f_ctx = rms_norm(ctx, g_norm2[l]) * (1.0 + csc2) + csh2
            tokens = jnp.concatenate([f_lat.reshape(-1, D), f_ctx.reshape(-1, D)], axis=0)
        else:
            tokens = f_lat.reshape(-1, D)
        y = moe(tokens, w_router[l], b_router[l], w_expert_in[l], b_expert_in[l], w_expert_out[l], b_expert_out[l])
        x = x + gt2 * y[:b * S].reshape(b, S, D)
        if need_ctx:
            ctx = ctx + cgt2 * y[b * S:].reshape(b, C, D)
    return rms_norm(x, g_final)
```

```cpp
#include <hip/hip_runtime.h>
#include <cstdio>
#include <cstdint>

#ifndef MK_PER_PHASE_LAUNCH
#define MK_PER_PHASE_LAUNCH 0
#endif

#ifndef MK_REPEAT
#define MK_REPEAT 0
#endif
#define REP(k) for (int _rep = 0; _rep < 1 + ((MK_REPEAT >> (k)) & 1); ++_rep)
#define GAS __attribute__((address_space(1)))
#define LAS __attribute__((address_space(3)))
typedef unsigned short bf16_t;
typedef short bf16x8 __attribute__((ext_vector_type(8)));
typedef short s16x4 __attribute__((ext_vector_type(4)));
typedef float f32x4 __attribute__((ext_vector_type(4)));
typedef float f32x2 __attribute__((ext_vector_type(2)));
typedef float f32x16 __attribute__((ext_vector_type(16)));
typedef unsigned u32x4 __attribute__((ext_vector_type(4)));
typedef unsigned u32x2 __attribute__((ext_vector_type(2)));
typedef int v8i __attribute__((ext_vector_type(8)));

constexpr int D = 2048, NB = 4, SEQ = 4096, CTX = 256, TK = CTX + SEQ  , DEPTH = 2;
constexpr int ML = NB * SEQ  , MC = NB * CTX  , MT = ML + MC  ;
constexpr int INW = 3584, NE = 32, DE = 1024;
constexpr int OFF_QA = 0, OFF_KA = 1024, OFF_VA = 1280, OFF_QB = 1536, OFF_KB = 2048, OFF_VB = 2560, OFF_UC = 3072;
constexpr float EPS = 1e-6f;
constexpr int MAXROWS = 77824;
constexpr int NWAVES = 8, NTHREADS = 512;

constexpr size_t MiB = 1u << 20;
constexpr size_t WS_CTL = 0, CTL_ZERO_BYTES = 2 * MiB;
constexpr size_t WS_MOD = 1 * MiB;
constexpr size_t WS_ROPE = 2 * MiB;
constexpr size_t WS_ROUT = 3 * MiB;
constexpr size_t WS_XR = 8 * MiB;
constexpr size_t WS_N = 144 * MiB;
constexpr size_t WS_P = 212 * MiB;
constexpr size_t WS_QA = 332 * MiB;
constexpr size_t WS_KA = 366 * MiB;
constexpr size_t WS_VA = 375 * MiB;
constexpr size_t WS_QB = 384 * MiB;
constexpr size_t WS_KB = 401 * MiB;
constexpr size_t WS_VB = 418 * MiB;
constexpr size_t WS_CAT = 435 * MiB;
constexpr size_t WS_OB = 503 * MiB;
constexpr size_t WS_ACT = 571 * MiB;
constexpr size_t WS_Y = 723 * MiB;
constexpr size_t WS_WIN = 1027 * MiB;
constexpr size_t WS_WOUT = 1055 * MiB;
constexpr size_t WS_W1 = 1071 * MiB;
constexpr size_t WS_W2 = 1583 * MiB;
constexpr size_t WS_MODP = 1839 * MiB;
constexpr size_t WS_NF8 = 1871 * MiB;
constexpr size_t WS_END = 1907 * MiB;
static_assert(WS_XR + (size_t)MT * D * 4 <= WS_N && WS_N + (size_t)MT * D * 2 <= WS_P && WS_P + (size_t)MT * INW * 2 <= WS_QA, "ws map 1");
static_assert(WS_QA + (size_t)MT * 1024 * 2 <= WS_KA && WS_KA + (size_t)MT * 256 * 2 <= WS_VA && WS_VA + (size_t)MT * 256 * 2 <= WS_QB, "ws map 2");
static_assert(WS_QB + (size_t)MT * 512 * 2 <= WS_KB && WS_KB + (size_t)MT * 512 * 2 <= WS_VB && WS_VB + (size_t)MT * 512 * 2 <= WS_CAT, "ws map 3");
static_assert(WS_CAT + (size_t)MT * D * 2 <= WS_OB && WS_OB + (size_t)MT * 1024 * 4 <= WS_ACT && WS_ACT + (size_t)MAXROWS * 1024 * 2 <= WS_Y, "ws map 4");
static_assert(WS_Y + (size_t)MAXROWS * 2048 * 2 <= WS_WIN && WS_WIN + (size_t)2 * INW * D * 2 <= WS_WOUT && WS_WOUT + (size_t)2 * D * D * 2 <= WS_W1, "ws map 5");
static_assert(WS_W1 + (size_t)2 * 32 * 2048 * 2048 * 2 <= WS_W2 && WS_W2 + (size_t)2 * 32 * 2048 * 1024 * 2 <= WS_MODP && WS_MODP + (size_t)64 * 10 * 12288 * 4 <= WS_NF8 && WS_NF8 + (size_t)MT * D <= WS_END, "ws map 6");
static_assert(NB * TK == MT, "K/V row count");
constexpr size_t ROUT_EID = 0, ROUT_GATE = (size_t)MT * 16, ROUT_POS = (size_t)MT * 32, ROUT_LIST = (size_t)MT * 48;
static_assert(WS_ROUT + ROUT_LIST + (size_t)32 * MT * 4 <= WS_XR, "router map");
constexpr int CW_BAR = 4096;
constexpr int CW_CNT = 8192;
constexpr int CW_Q = 12288;
static_assert((CW_Q + 512) * 4 <= (int)WS_MOD && CW_CNT + 64 * 64 <= CW_Q, "ctl map");

constexpr int RING_BYTES = 131072;
constexpr int MISC_OFF = RING_BYTES + 1024;
constexpr int LDS_BYTES = 147456;
constexpr int FLS = 2052;

#define VM_WAIT() asm volatile("s_waitcnt vmcnt(0)" ::: "memory")
#define LDS_WAIT() asm volatile("s_waitcnt lgkmcnt(0)" ::: "memory")
__device__ __forceinline__ unsigned cvt_pk_bf16(float lo, float hi) { unsigned r; asm volatile("v_cvt_pk_bf16_f32 %0, %1, %2" : "=v"(r) : "v"(lo), "v"(hi)); return r; }
__device__ __forceinline__ bf16_t f2bf(float f) { return (bf16_t)(cvt_pk_bf16(f, 0.f) & 0xffffu); }
__device__ __forceinline__ float bf2f(bf16_t b) { return __uint_as_float(((unsigned)b) << 16); }
__device__ __forceinline__ int tid_local() { int t = threadIdx.x; asm volatile("" : "+v"(t)); return t; }
template <class T> __device__ __forceinline__ T* uniform_ptr(T* p) {
    const unsigned long long v = (unsigned long long)p;
    const unsigned lo = __builtin_amdgcn_readfirstlane((unsigned)v), hi = __builtin_amdgcn_readfirstlane((unsigned)(v >> 32));
    return (T*)(GAS T*)(((unsigned long long)hi << 32) | lo);
}
__device__ __forceinline__ float wave_sum(float v) {
    v += __builtin_bit_cast(float, __builtin_amdgcn_update_dpp(0, __builtin_bit_cast(int, v), 0xB1, 0xF, 0xF, true));
    v += __builtin_bit_cast(float, __builtin_amdgcn_update_dpp(0, __builtin_bit_cast(int, v), 0x4E, 0xF, 0xF, true));
    v += __builtin_bit_cast(float, __builtin_amdgcn_update_dpp(0, __builtin_bit_cast(int, v), 0x141, 0xF, 0xF, true));
    v += __builtin_bit_cast(float, __builtin_amdgcn_update_dpp(0, __builtin_bit_cast(int, v), 0x140, 0xF, 0xF, true));
    const float a = __builtin_bit_cast(float, __builtin_amdgcn_readlane(__builtin_bit_cast(int, v), 0)), b = __builtin_bit_cast(float, __builtin_amdgcn_readlane(__builtin_bit_cast(int, v), 16));
    const float c = __builtin_bit_cast(float, __builtin_amdgcn_readlane(__builtin_bit_cast(int, v), 32)), d = __builtin_bit_cast(float, __builtin_amdgcn_readlane(__builtin_bit_cast(int, v), 48));
    return (a + b) + (c + d);
}

constexpr int PT_OFF = 131072 + 1024 + 3072;
constexpr int PT_OUT = 26, PT_WS = 27;
__device__ __forceinline__ unsigned long long ldp_raw(LAS unsigned char* lds, int i) {
    const u32x2 v = *(const LAS u32x2*)(lds + PT_OFF + 8 * i);
    const unsigned lo = __builtin_amdgcn_readfirstlane(v.x), hi = __builtin_amdgcn_readfirstlane(v.y);
    return ((unsigned long long)hi << 32) | lo;
}
#define INP(i) ((const float*)(const GAS float*)ldp_raw(lds, (i)))
#define WSP() ((unsigned char*)(GAS unsigned char*)ldp_raw(lds, PT_WS))
#define OUTP() ((float*)(GAS float*)ldp_raw(lds, PT_OUT))
#define PHASE_FN __device__ __forceinline__ void

#define XB_TMO      128
#define XB_XCNT(j)  (256  + 64 * (j))
#define XB_XSUB(j)  (1280 + 64 * (j))
#define XB_XGEN(j)  (2304 + 64 * (j))
#define XB_TOP      3328
#define XB_TOPGEN   3392
#define XCD_BAR_WORDS 3456
#define XB_SPIN_CAP (1u << 18)
__device__ __forceinline__ unsigned xb_ld(unsigned* p)              { return __hip_atomic_load(p, __ATOMIC_RELAXED, __HIP_MEMORY_SCOPE_AGENT); }
__device__ __forceinline__ unsigned xb_add(unsigned* p, unsigned v) { return __hip_atomic_fetch_add(p, v, __ATOMIC_RELAXED, __HIP_MEMORY_SCOPE_AGENT); }
__device__ __forceinline__ unsigned xb_xcc_id() { return (unsigned)__builtin_amdgcn_s_getreg((3 << 11) | 20) & 0xFu; }
#define XB_SPIN(cond, bar) do { unsigned _sp = 0; while (cond) { __builtin_amdgcn_s_sleep(1); \
    if ((++_sp & 255u) == 0u) { if (xb_ld(&(bar)[XB_TMO])) break; if (_sp > XB_SPIN_CAP) { atomicAdd(&(bar)[XB_TMO], 1u); break; } } } } while (0)
struct XcdBarrier { unsigned* bar; unsigned x; volatile LAS unsigned* st; };
__device__ __forceinline__ XcdBarrier xcd_barrier_post(unsigned* bar, volatile LAS unsigned* st) {
    XcdBarrier b; b.bar = bar; b.x = xb_xcc_id(); b.st = st;
    if (threadIdx.x == 0) (void)xb_add(&bar[XB_XCNT(b.x)], 1u);
    return b;
}
__device__ __forceinline__ void xcd_barrier_complete(unsigned* bar, unsigned x, unsigned& nloc, unsigned& nx) {
    const unsigned G = gridDim.x * gridDim.y * gridDim.z;
    unsigned sum, cnt, mine, sp = 0u;
    for (;;) {
        sum = 0u; cnt = 0u; mine = 0u;
#pragma unroll
        for (unsigned j = 0; j < 16; ++j) { const unsigned c = xb_ld(&bar[XB_XCNT(j)]); sum += c; cnt += (c > 0u) ? 1u : 0u; mine = (j == x) ? c : mine; }
        if (sum == G) break;
        __builtin_amdgcn_s_sleep(1);
        if ((++sp & 255u) == 0u) { if (xb_ld(&bar[XB_TMO])) break; if (sp > XB_SPIN_CAP) { atomicAdd(&bar[XB_TMO], 1u); break; } }
    }
    nloc = mine > 0u ? mine : 1u; nx = cnt > 0u ? cnt : 1u;
}
__device__ __forceinline__ void xcd_barrier(const XcdBarrier& b) {
    asm volatile("s_waitcnt vmcnt(0)" ::: "memory");
    __syncthreads();
    if (threadIdx.x == 0) {
        unsigned* bar = b.bar;
        __builtin_amdgcn_s_waitcnt(0);
        unsigned nloc = b.st[0], nx = b.st[1];
        if (nloc == 0u) { xcd_barrier_complete(bar, b.x, nloc, nx); b.st[0] = nloc; b.st[1] = nx; }
        const unsigned old = xb_add(&bar[XB_XSUB(b.x)], 1u);
        const unsigned gen = old / nloc;
        if (old + 1u == (gen + 1u) * nloc) {
            __builtin_amdgcn_fence(__ATOMIC_RELEASE, "agent");
            asm volatile("s_waitcnt vmcnt(0)" ::: "memory");
            const unsigned og = xb_add(&bar[XB_TOP], 1u);
            const unsigned tg = og / nx;
            if (og + 1u == (tg + 1u) * nx) xb_add(&bar[XB_TOPGEN], 1u);
            else XB_SPIN(xb_ld(&bar[XB_TOPGEN]) == tg, bar);
            __builtin_amdgcn_fence(__ATOMIC_ACQUIRE, "agent");
            xb_add(&bar[XB_XGEN(b.x)], 1u);
            asm volatile("s_waitcnt vmcnt(0)" ::: "memory");
        } else {
            XB_SPIN(xb_ld(&bar[XB_XGEN(b.x)]) == gen, bar);
            __builtin_amdgcn_fence(__ATOMIC_ACQUIRE, "agent");
            asm volatile("s_waitcnt vmcnt(0)" ::: "memory");
        }
    }
    __syncthreads();
}

namespace pg8 {
constexpr int BM = 256, BK = 64, HALF = 128, HTB = HALF * BK * 2, STAGE_BYTES = 8 * HTB, NXCD = 8, WGM = 8;
__host__ __device__ __forceinline__ int lds_byte(int r, int c) { const int st = (r >> 4) * 2 + (c >> 5), rr = r & 15, cc = c & 31, ob = rr * 64 + cc * 2; return st * 1024 + (ob ^ (((ob >> 9) & 1) << 5)); }
__host__ __device__ __forceinline__ void stage_rc(int b, int& R, int& C) { const int st = b / 1024, sb = b % 1024, swz = sb ^ (((sb >> 9) & 1) << 5); R = (st >> 1) * 16 + swz / 64; C = (st & 1) * 32 + (swz % 64) / 2; }
__host__ __device__ __forceinline__ int perm32(int rho) { const int n = rho >> 4, i = rho & 15; return 8 * (i >> 2) + 4 * n + (i & 3); }

__host__ __device__ __forceinline__ int f8_f(int rr) { return (0x9C >> (2 * (rr >> 2))) & 3; }
__host__ __device__ __forceinline__ int lds_byte8(int r, int b) { const int st = (r >> 4) * 2 + (b >> 6), rr = r & 15, q = (b >> 4) & 3; return st * 1024 + rr * 64 + ((q ^ f8_f(rr)) << 4) + (b & 15); }
__host__ __device__ __forceinline__ void stage_rc8(int o, int& R, int& Cb) { const int st = o / 1024, w = o % 1024, rr = w / 64, slot = (w % 64) / 16; R = (st >> 1) * 16 + rr; Cb = (st & 1) * 64 + ((slot ^ f8_f(rr)) << 4); }
template <int ESZ> __host__ __device__ __forceinline__ void stage_rcb(int o, int& R, int& Cb) { if constexpr (ESZ == 2) { int C; stage_rc(o, R, C); Cb = 2 * C; } else stage_rc8(o, R, Cb); }
struct Unit { int pm, pn, e; };

template <int K_, int ESZ_> struct DenseSched {
    static constexpr int K = K_, ESZ = ESZ_, SCALE_B = (ESZ_ == 1) ? 121 : 127;
    static constexpr bool GATHER_A = false;
    int nM, nN, nwg, G, c; const char* A; const char* Bt;
    __device__ void init(const void* A_, const void* Bt_, int M, int N, int G_, int c_) { A = (const char*)A_; Bt = (const char*)Bt_; nM = M / BM; nN = N / BM; nwg = nM * nN; G = G_; c = c_; }
    __device__ __forceinline__ bool next(int i, Unit& u) const {
        const long L = (long)i * G + c; if (L >= nwg) return false;
        int wgid = (int)L; { const int q = nwg / NXCD, r = nwg % NXCD, xcd = wgid % NXCD, off = wgid / NXCD; wgid = (xcd < r ? xcd * (q + 1) : r * (q + 1) + (xcd - r) * q) + off; }
        const int nig = WGM * nN, gid = wgid / nig, fm = gid * WGM, gsz = (nM - fm) < WGM ? (nM - fm) : WGM;
        u.pm = fm + ((wgid % nig) % gsz); u.pn = (wgid % nig) / gsz; u.e = 0; return true;
    }
    __device__ __forceinline__ int row0(const Unit& u) const { return u.pm * BM; }
    __device__ __forceinline__ const char* a_base() const { return A; }
    __device__ __forceinline__ const char* b_base(const Unit& u) const { return Bt + (size_t)u.pn * BM * K * ESZ; }
    __device__ __forceinline__ void a_voff(const Unit& u, int tid, unsigned (&v)[2][2]) const {
#pragma unroll
        for (int i = 0; i < 2; ++i) { int R, Cb; stage_rcb<ESZ>(tid * 16 + i * 8192, R, Cb);
#pragma unroll
            for (int h = 0; h < 2; ++h) v[h][i] = (unsigned)((u.pm * BM + h * HALF + R) * (K * ESZ) + Cb); }
    }
};
template <bool GATHER, int K_, int ESZ_> struct MoeSched {
    static constexpr int K = K_, ESZ = ESZ_, SCALE_B = (K_ == 2048) ? 121 : 122;
    static constexpr size_t BSTRIDE = (size_t)2048 * K * ESZ;
    static constexpr bool GATHER_A = GATHER;
    const LAS int* tp; const LAS int* cnt; int start, end, j, stride; const char* A; const char* Bt; const int* list;
    __device__ void init(const LAS int* tp_, const LAS int* cnt_, const void* A_, const void* Bt_, const int* list_, int G, int c) {
        tp = tp_; cnt = cnt_; A = (const char*)A_; Bt = (const char*)Bt_; list = list_;
        const int U = 8 * tp[NE];
        if (G == 256) { const int x = c & 7; j = c >> 3; stride = 32; start = (int)(((long)x * U) / 8); end = (int)(((long)(x + 1) * U) / 8); }
        else { start = 0; end = U; j = c; stride = G; }
    }
    __device__ __forceinline__ bool next(int i, Unit& u) const {
        const int idx = start + i * stride + j; if (idx >= end) return false;
        int e = 0;
        for (int q = 1; q < NE; ++q) e += (8 * tp[q] <= idx) ? 1 : 0;
        e = __builtin_amdgcn_readfirstlane(e);
        const int tiles = tp[e + 1] - tp[e], r = idx - 8 * tp[e];
        const int gi = r >> 5, fm = gi * 4, gsz = (tiles - fm) < 4 ? (tiles - fm) : 4, w = r - 32 * gi;
        u.e = e; u.pm = __builtin_amdgcn_readfirstlane(fm + (w % gsz)); u.pn = __builtin_amdgcn_readfirstlane(w / gsz); return true;
    }
    __device__ __forceinline__ int row0(const Unit& u) const { return __builtin_amdgcn_readfirstlane((tp[u.e] + u.pm) * BM); }
    __device__ __forceinline__ const char* a_base() const { return A; }
    __device__ __forceinline__ const char* b_base(const Unit& u) const { return Bt + (size_t)u.e * BSTRIDE + (size_t)u.pn * BM * K * ESZ; }
    __device__ __forceinline__ void a_voff(const Unit& u, int tid, unsigned (&v)[2][2]) const {
        if constexpr (GATHER) {
            const int* lp = list + (size_t)u.e * MT + u.pm * BM;
            const int nv = cnt[u.e] - u.pm * BM;
            int tok[2][2], Cc[2];
#pragma unroll
            for (int i = 0; i < 2; ++i) { int R; stage_rcb<ESZ>(tid * 16 + i * 8192, R, Cc[i]);
#pragma unroll
                for (int h = 0; h < 2; ++h) { const int lr = h * HALF + R; tok[h][i] = lp[lr < nv ? lr : 0]; } }
            asm volatile("s_waitcnt vmcnt(0)" ::: "memory");
#pragma unroll
            for (int h = 0; h < 2; ++h)
#pragma unroll
                for (int i = 0; i < 2; ++i) v[h][i] = (unsigned)(tok[h][i] * (K * ESZ) + Cc[i]);
        } else {
            const int r0 = row0(u);
#pragma unroll
            for (int i = 0; i < 2; ++i) { int R, Cb; stage_rcb<ESZ>(tid * 16 + i * 8192, R, Cb);
#pragma unroll
                for (int h = 0; h < 2; ++h) v[h][i] = (unsigned)((r0 + h * HALF + R) * (K * ESZ) + Cb); }
        }
    }
};

struct EpiBf16 {
    static constexpr bool PERM = true;
    bf16_t* O; int ldc; const float* bias; int bias_estride;
    __device__ __forceinline__ void operator()(const f32x4 (&acc)[2][2][4][2], const Unit& u, int urow0, int wr, int wc, int fr, int fq) const {
        const int row0 = urow0 + wr * 64 + fr; const int col0 = u.pn * BM + wc * 32 + 8 * fq;
        const float* bp = bias ? bias + (size_t)u.e * bias_estride + col0 : nullptr;
        f32x4 bv[2][2];
#pragma unroll
        for (int bj = 0; bj < 2; ++bj)
#pragma unroll
            for (int n = 0; n < 2; ++n) bv[bj][n] = bp ? *(const f32x4*)(bp + bj * HALF + 4 * n) : (f32x4){0.f, 0.f, 0.f, 0.f};
#pragma unroll
        for (int ai = 0; ai < 2; ++ai)
#pragma unroll
            for (int m = 0; m < 4; ++m) { bf16_t* rowp = O + (size_t)(row0 + ai * HALF + m * 16) * ldc + col0;
#pragma unroll
                for (int bj = 0; bj < 2; ++bj) { const f32x4 v0 = acc[ai][bj][m][0] + bv[bj][0], v1 = acc[ai][bj][m][1] + bv[bj][1];
                    u32x4 w; w.x = cvt_pk_bf16(v0[0], v0[1]); w.y = cvt_pk_bf16(v0[2], v0[3]); w.z = cvt_pk_bf16(v1[0], v1[1]); w.w = cvt_pk_bf16(v1[2], v1[3]);
                    *(u32x4*)(rowp + bj * HALF) = w; } }
    }
};
struct EpiF8 {
    static constexpr bool PERM = true;
    unsigned char* O; int ldc; const float* bias; int bias_estride;
    __device__ __forceinline__ void operator()(const f32x4 (&acc)[2][2][4][2], const Unit& u, int urow0, int wr, int wc, int fr, int fq) const {
        const int row0 = urow0 + wr * 64 + fr; const int col0 = u.pn * BM + wc * 32 + 8 * fq;
        const float* bp = bias + (size_t)u.e * bias_estride + col0;
        f32x4 bv[2][2];
#pragma unroll
        for (int bj = 0; bj < 2; ++bj)
#pragma unroll
            for (int n = 0; n < 2; ++n) bv[bj][n] = *(const f32x4*)(bp + bj * HALF + 4 * n);
#pragma unroll
        for (int ai = 0; ai < 2; ++ai)
#pragma unroll
            for (int m = 0; m < 4; ++m) { unsigned char* rowp = O + (size_t)(row0 + ai * HALF + m * 16) * ldc + col0;
#pragma unroll
                for (int bj = 0; bj < 2; ++bj) { const f32x4 v0 = acc[ai][bj][m][0] + bv[bj][0], v1 = acc[ai][bj][m][1] + bv[bj][1];
                    int w0 = 0, w1 = 0; w0 = __builtin_amdgcn_cvt_pk_fp8_f32(v0[0], v0[1], w0, false); w0 = __builtin_amdgcn_cvt_pk_fp8_f32(v0[2], v0[3], w0, true);
                    w1 = __builtin_amdgcn_cvt_pk_fp8_f32(v1[0], v1[1], w1, false); w1 = __builtin_amdgcn_cvt_pk_fp8_f32(v1[2], v1[3], w1, true);
                    *(u32x2*)(rowp + bj * HALF) = (u32x2){(unsigned)w0, (unsigned)w1}; } }
    }
};
__device__ __forceinline__ float swiglu1(float g, float l) {
    g = fminf(g, 7.0f); l = fminf(fmaxf(l, -7.0f), 7.0f);
    const float sg = __builtin_amdgcn_rcpf(1.0f + __builtin_amdgcn_exp2f(-1.702f * 1.4426950408889634f * g));
    return g * sg * (l + 1.0f);
}
struct EpiSwiglu {
    static constexpr bool PERM = true;
    unsigned char* O; const float* bias;
    __device__ __forceinline__ void operator()(const f32x4 (&acc)[2][2][4][2], const Unit& u, int urow0, int wr, int wc, int fr, int fq) const {
        const int row0 = urow0 + wr * 64 + fr; const int col0 = u.pn * BM + wc * 32 + 8 * fq;
        const float* bp = bias + (size_t)u.e * 2048 + col0;
        f32x4 bv[2][2];
#pragma unroll
        for (int bj = 0; bj < 2; ++bj)
#pragma unroll
            for (int n = 0; n < 2; ++n) bv[bj][n] = *(const f32x4*)(bp + bj * HALF + 4 * n);
#pragma unroll
        for (int ai = 0; ai < 2; ++ai)
#pragma unroll
            for (int m = 0; m < 4; ++m) { unsigned char* rowp = O + (size_t)(row0 + ai * HALF + m * 16) * DE + (col0 >> 1);
#pragma unroll
                for (int bj = 0; bj < 2; ++bj) { const f32x4 v0 = acc[ai][bj][m][0] + bv[bj][0], v1 = acc[ai][bj][m][1] + bv[bj][1];
                    int w = 0; w = __builtin_amdgcn_cvt_pk_fp8_f32(swiglu1(v0[0], v0[1]), swiglu1(v0[2], v0[3]), w, false); w = __builtin_amdgcn_cvt_pk_fp8_f32(swiglu1(v1[0], v1[1]), swiglu1(v1[2], v1[3]), w, true);
                    *(int*)(rowp + bj * (HALF / 2)) = w; } }
    }
};
struct EpiResid {
    static constexpr bool PERM = false;
    const float* xin; const float* cin; const float* xr_in; float* xr_out; const float* mod; int layer;
    __device__ __forceinline__ void operator()(const f32x4 (&acc)[2][2][4][2], const Unit& u, int urow0, int wr, int wc, int fr, int fq) const {
        const int row0 = urow0 + wr * 64 + fr, col0 = u.pn * BM + wc * 32 + 4 * fq;
        const int bidx = urow0 < ML ? (urow0 >> 12) : 4;
        const float* gp = mod + (size_t)bidx * 12288 + 2 * 2048 + col0;
        f32x4 g[2][2];
#pragma unroll
        for (int bj = 0; bj < 2; ++bj)
#pragma unroll
            for (int n = 0; n < 2; ++n) g[bj][n] = *(const f32x4*)(gp + bj * HALF + n * 16);
        const float* bbase = (layer == 0) ? (urow0 < ML ? xin : cin - (size_t)ML * D) : xr_in;
#pragma unroll
        for (int ai = 0; ai < 2; ++ai)
#pragma unroll
            for (int mp = 0; mp < 2; ++mp) {
                f32x4 bs[2][2][2];
#pragma unroll
                for (int mq = 0; mq < 2; ++mq) { const int row = row0 + ai * HALF + (2 * mp + mq) * 16; const float* bp = bbase + (size_t)row * D + col0;
#pragma unroll
                    for (int bj = 0; bj < 2; ++bj)
#pragma unroll
                        for (int n = 0; n < 2; ++n) bs[mq][bj][n] = *(const f32x4*)(bp + bj * HALF + n * 16); }
#pragma unroll
                for (int mq = 0; mq < 2; ++mq) { const int m = 2 * mp + mq; const int row = row0 + ai * HALF + m * 16; float* op = xr_out + (size_t)row * D + col0;
#pragma unroll
                    for (int bj = 0; bj < 2; ++bj)
#pragma unroll
                        for (int n = 0; n < 2; ++n) *(f32x4*)(op + bj * HALF + n * 16) = bs[mq][bj][n] + g[bj][n] * acc[ai][bj][m][n]; }
                asm volatile("" ::: "memory"); }
    }
};

template <class Epi, class Sched>
__device__ __forceinline__ void gemm_phase(LAS unsigned char* lds, const Sched& S, const Epi& E) {
    constexpr int K = Sched::K, ESZ = Sched::ESZ;
    const int tid = tid_local(), wid = __builtin_amdgcn_readfirstlane(tid >> 6), lane = tid & 63, wr = wid >> 2, wc = wid & 3, fr = lane & 15, fq = lane >> 4;
    constexpr int nt = K * ESZ / 128;
    constexpr int SCALE_A = 127, SCALE_B = Sched::SCALE_B;
    unsigned voffB[2], voffA[2][2];
#pragma unroll
    for (int i = 0; i < 2; ++i) { int R, Cb; stage_rcb<ESZ>(tid * 16 + i * 8192, R, Cb); const int Rb = Epi::PERM ? ((R & ~31) + perm32(R & 31)) : R; voffB[i] = (unsigned)(Rb * (K * ESZ) + Cb); }
    constexpr size_t kstep = 128;
    constexpr size_t hstep = (size_t)HALF * K * ESZ;
    const unsigned ldsw = (unsigned)wid * 1024u;
    const int aoff = ESZ == 2 ? lds_byte(wr * 64 + fr, fq * 8) : lds_byte8(wr * 64 + fr, fq * 32), boff = ESZ == 2 ? lds_byte(wc * 32 + fr, fq * 8) : lds_byte8(wc * 32 + fr, fq * 32);
    const int aoff2 = aoff ^ 16, boff2 = boff ^ 16;
#define PG8_SA(b, h) (((b) * 2 + (h)) * HTB)
#define PG8_SB(b, h) ((4 + (b) * 2 + (h)) * HTB)
#define PG8_STAGE(bufoff, gbase, voff) do { _Pragma("unroll") for (int _i = 0; _i < 2; ++_i) \
        __builtin_amdgcn_global_load_lds((const unsigned*)((const char*)(gbase) + (voff)[_i]), (LAS unsigned*)(lds + (bufoff) + ldsw + _i * 8192), 16, 0, 0); } while (0)
#define PG8_LDA(dst, b, h) do { if constexpr (ESZ == 2) { _Pragma("unroll") for (int m = 0; m < 4; ++m) _Pragma("unroll") for (int k = 0; k < 2; ++k) dst[m][k] = *(const LAS bf16x8*)(lds + PG8_SA(b, h) + aoff + m * 2048 + k * 1024); } \
        else { _Pragma("unroll") for (int m = 0; m < 4; ++m) { const u32x4 _lo = *(const LAS u32x4*)(lds + PG8_SA(b, h) + aoff + m * 2048), _hi = *(const LAS u32x4*)(lds + PG8_SA(b, h) + aoff2 + m * 2048); \
            dst##8[m] = (v8i){(int)_lo.x, (int)_lo.y, (int)_lo.z, (int)_lo.w, (int)_hi.x, (int)_hi.y, (int)_hi.z, (int)_hi.w}; } } } while (0)
#define PG8_LDB(dst, b, h) do { if constexpr (ESZ == 2) { _Pragma("unroll") for (int n = 0; n < 2; ++n) _Pragma("unroll") for (int k = 0; k < 2; ++k) dst[n][k] = *(const LAS bf16x8*)(lds + PG8_SB(b, h) + boff + n * 2048 + k * 1024); } \
        else { _Pragma("unroll") for (int n = 0; n < 2; ++n) { const u32x4 _lo = *(const LAS u32x4*)(lds + PG8_SB(b, h) + boff + n * 2048), _hi = *(const LAS u32x4*)(lds + PG8_SB(b, h) + boff2 + n * 2048); \
            dst##8[n] = (v8i){(int)_lo.x, (int)_lo.y, (int)_lo.z, (int)_lo.w, (int)_hi.x, (int)_hi.y, (int)_hi.z, (int)_hi.w}; } } } while (0)
#define PG8_MMA(ai, bj, At, Bt) do { __builtin_amdgcn_s_setprio(1); if constexpr (ESZ == 2) { _Pragma("unroll") for (int m = 0; m < 4; ++m) _Pragma("unroll") for (int n = 0; n < 2; ++n) _Pragma("unroll") for (int k = 0; k < 2; ++k) \
        acc[ai][bj][m][n] = __builtin_amdgcn_mfma_f32_16x16x32_bf16(Bt[n][k], At[m][k], acc[ai][bj][m][n], 0, 0, 0); } \
        else { _Pragma("unroll") for (int m = 0; m < 4; ++m) _Pragma("unroll") for (int n = 0; n < 2; ++n) \
        acc[ai][bj][m][n] = __builtin_amdgcn_mfma_scale_f32_16x16x128_f8f6f4(Bt##8[n], At##8[m], acc[ai][bj][m][n], 0, 0, 0, SCALE_B, 0, SCALE_A); } __builtin_amdgcn_s_setprio(0); } while (0)
#define PG8_WAIT_V(n) asm volatile("s_waitcnt vmcnt(" #n ")" ::: "memory")
#define PG8_WAIT_L(n) asm volatile("s_waitcnt lgkmcnt(" #n ")" ::: "memory")
#define PG8_BAR __builtin_amdgcn_s_barrier()
#define PG8_SCHED __builtin_amdgcn_sched_barrier(0)
    Unit cur, nxt; int ui = 0;
    if (!S.next(0, cur)) return;
    f32x4 acc[2][2][4][2];
#pragma unroll
    for (int a = 0; a < 2; ++a)
#pragma unroll
        for (int b = 0; b < 2; ++b)
#pragma unroll
            for (int m = 0; m < 4; ++m)
#pragma unroll
                for (int n = 0; n < 2; ++n) acc[a][b][m][n] = (f32x4){0.f, 0.f, 0.f, 0.f};
    bf16x8 At[4][2], B0[2][2], B1[2][2];
    v8i At8[4], B08[2], B18[2];
    const char* const Ab = S.a_base();
    const char* cB = S.b_base(cur);
    S.a_voff(cur, tid, voffA);
    PG8_STAGE(PG8_SB(0, 0), cB, voffB); PG8_STAGE(PG8_SB(0, 1), cB + hstep, voffB); PG8_STAGE(PG8_SA(0, 0), Ab, voffA[0]); PG8_STAGE(PG8_SA(0, 1), Ab, voffA[1]);
    if (wr == 1) PG8_BAR;
    PG8_WAIT_V(2); PG8_BAR;
    PG8_STAGE(PG8_SB(1, 0), cB + kstep, voffB); PG8_STAGE(PG8_SA(1, 0), Ab + kstep, voffA[0]); PG8_STAGE(PG8_SB(1, 1), cB + hstep + kstep, voffB);
    PG8_WAIT_V(6); PG8_BAR;
    for (;;) {
        const bool has_next = S.next(ui + 1, nxt);
        const char* nB = has_next ? S.b_base(nxt) : cB;
        unsigned voffN[2][2];
        if constexpr (Sched::GATHER_A) { if (has_next) S.a_voff(nxt, tid, voffN); }
#pragma unroll 1
        for (int t = 0; t < nt; t += 2) {
            const bool last = (t == nt - 2);
            const char* a1 = Ab + (size_t)(t + 1) * kstep;
            const char* a2 = last ? Ab : Ab + (size_t)(t + 2) * kstep; const char* b2 = last ? nB : cB + (size_t)(t + 2) * kstep;
            const char* a3 = a2 + kstep; const char* b3 = b2 + kstep;
            PG8_LDB(B0, 0, 0); PG8_LDB(B1, 0, 1); PG8_SCHED; PG8_LDA(At, 0, 0); PG8_STAGE(PG8_SA(1, 1), a1, voffA[1]);
            if (last && has_next) {
                if constexpr (Sched::GATHER_A) { voffA[0][0] = voffN[0][0]; voffA[0][1] = voffN[0][1]; voffA[1][0] = voffN[1][0]; voffA[1][1] = voffN[1][1]; }
                else S.a_voff(nxt, tid, voffA); }
            PG8_WAIT_V(8); PG8_WAIT_L(0); PG8_BAR; PG8_MMA(0, 0, At, B0); PG8_MMA(0, 1, At, B1); PG8_BAR; PG8_SCHED;
            PG8_LDA(At, 0, 1); PG8_STAGE(PG8_SB(0, 0), b2, voffB); PG8_STAGE(PG8_SB(0, 1), b2 + hstep, voffB); PG8_STAGE(PG8_SA(0, 0), a2, voffA[0]);
            PG8_WAIT_V(8); PG8_WAIT_L(0); PG8_BAR; PG8_MMA(1, 0, At, B0); PG8_MMA(1, 1, At, B1); PG8_BAR; PG8_SCHED;
            PG8_LDB(B0, 1, 0); PG8_LDB(B1, 1, 1); PG8_SCHED; PG8_LDA(At, 1, 0); PG8_STAGE(PG8_SA(0, 1), a2, voffA[1]);
            PG8_WAIT_V(8); PG8_WAIT_L(0); PG8_BAR; PG8_MMA(0, 0, At, B0); PG8_MMA(0, 1, At, B1); PG8_BAR; PG8_SCHED;
            PG8_LDA(At, 1, 1); PG8_STAGE(PG8_SB(1, 0), b3, voffB); PG8_STAGE(PG8_SB(1, 1), b3 + hstep, voffB); PG8_STAGE(PG8_SA(1, 0), a3, voffA[0]);
            PG8_WAIT_V(8); PG8_WAIT_L(0); PG8_BAR; PG8_MMA(1, 0, At, B0); PG8_MMA(1, 1, At, B1); PG8_BAR; PG8_SCHED;
        }
        if (wr == 0) PG8_BAR;
        E(acc, cur, S.row0(cur), wr, wc, fr, fq);
        if constexpr (Epi::PERM) { if ((MK_REPEAT >> 12) & 1) E(acc, cur, S.row0(cur), wr, wc, fr, fq); }
        if (!has_next) break;
#pragma unroll
        for (int a = 0; a < 2; ++a)
#pragma unroll
            for (int b = 0; b < 2; ++b)
#pragma unroll
                for (int m = 0; m < 4; ++m)
#pragma unroll
                    for (int n = 0; n < 2; ++n) acc[a][b][m][n] = (f32x4){0.f, 0.f, 0.f, 0.f};
        cur = nxt; cB = nB; ++ui;
        if (wr == 1) PG8_BAR;
    }
    PG8_WAIT_V(0);
    PG8_BAR;
#undef PG8_SA
#undef PG8_SB
#undef PG8_STAGE
#undef PG8_LDA
#undef PG8_LDB
#undef PG8_MMA
#undef PG8_WAIT_V
#undef PG8_WAIT_L
#undef PG8_BAR
#undef PG8_SCHED
}
}

namespace att {
constexpr int NW = 8, QBLK = 32, KVBLK = 64, DV = 128;
constexpr float THR = 8.f;
constexpr int SHM_V = KVBLK * DV * 2, SHM_K = KVBLK * 128 * 2, SHM_ATTN = 2 * SHM_V + 2 * SHM_K + NW * 64 * 4;
#define SBAR() __builtin_amdgcn_sched_barrier(0)
__device__ __forceinline__ int crow(int r, int hi) { return (r & 3) + 8 * (r >> 2) + 4 * hi; }
template <int DQK> __device__ __forceinline__ int kswz(int row, int colB) {
    if constexpr (DQK == 128) return row * 256 + (colB ^ ((row & 15) << 4));
    else return row * 128 + (colB ^ (((row >> 1) & 7) << 4));
}
template <int DQK> __device__ __forceinline__ void partialSM(f32x16& p0, f32x16& p1, float& m_reg, float& mn, float& alpha) {
    constexpr float SCALE = (DQK == 128) ? 0.088388347648318440f : 0.125f;
    constexpr float Cc = SCALE * 1.4426950408889634f;
    float pmax = p0[0];
#pragma unroll
    for (int r = 1; r < 16; ++r) pmax = fmaxf(pmax, p0[r]);
#pragma unroll
    for (int r = 0; r < 16; ++r) pmax = fmaxf(pmax, p1[r]);
    { auto rr = __builtin_amdgcn_permlane32_swap(__float_as_uint(pmax), __float_as_uint(pmax), false, false);
      pmax = fmaxf(__uint_as_float(rr[0]), __uint_as_float(rr[1])); }
    if (__builtin_expect(__all(pmax - m_reg <= THR / SCALE), 1)) { mn = m_reg; alpha = 1.f; }
    else { mn = fmaxf(m_reg, pmax); alpha = __builtin_amdgcn_exp2f((m_reg - mn) * Cc); m_reg = mn; }
    const float mnC = -mn * Cc;
#pragma unroll
    for (int r = 0; r < 16; ++r) p0[r] = fmaf(p0[r], Cc, mnC);
#pragma unroll
    for (int r = 0; r < 16; ++r) p1[r] = fmaf(p1[r], Cc, mnC);
#pragma unroll
    for (int r = 0; r < 16; ++r) p0[r] = __builtin_amdgcn_exp2f(p0[r]);
}
__device__ __forceinline__ void finishSM(f32x16& p0, f32x16& p1, float alpha, float& l_reg, bf16x8& pa0, bf16x8& pa1, bf16x8& pa2, bf16x8& pa3) {
#pragma unroll
    for (int r = 0; r < 16; ++r) p1[r] = __builtin_amdgcn_exp2f(p1[r]);
    float ps = 0;
#pragma unroll
    for (int r = 0; r < 16; ++r) ps += p0[r];
#pragma unroll
    for (int r = 0; r < 16; ++r) ps += p1[r];
    { auto rr = __builtin_amdgcn_permlane32_swap(__float_as_uint(ps), __float_as_uint(ps), false, false);
      ps = __uint_as_float(rr[0]) + __uint_as_float(rr[1]); }
    l_reg = l_reg * alpha + ps;
#define PK4(P, BASE, OUT) do { unsigned a0 = cvt_pk_bf16(P[BASE + 0], P[BASE + 1]), a1 = cvt_pk_bf16(P[BASE + 2], P[BASE + 3]);   \
    unsigned b0 = cvt_pk_bf16(P[BASE + 4], P[BASE + 5]), b1 = cvt_pk_bf16(P[BASE + 6], P[BASE + 7]);                              \
    auto r0 = __builtin_amdgcn_permlane32_swap(a0, b0, false, false); auto r1 = __builtin_amdgcn_permlane32_swap(a1, b1, false, false); \
    u32x4 w = {r0[0], r1[0], r0[1], r1[1]}; OUT = *reinterpret_cast<bf16x8*>(&w); } while (0)
    PK4(p0, 0, pa0); PK4(p0, 8, pa1); PK4(p1, 0, pa2); PK4(p1, 8, pa3);
#undef PK4
}
template <int DQK> __device__ __forceinline__ void qkt(f32x16& p0, f32x16& p1, const char* Ks, const bf16x8* qr, int r32, int hi) {
    p0 = f32x16{}; p1 = f32x16{};
#pragma unroll
    for (int d0 = 0; d0 < DQK / 16; ++d0) { const int cb = (d0 * 16 + hi * 8) * 2;
        const bf16x8 b0 = *reinterpret_cast<const bf16x8*>(Ks + kswz<DQK>(r32, cb));
        const bf16x8 b1 = *reinterpret_cast<const bf16x8*>(Ks + kswz<DQK>(32 + r32, cb));
        p0 = __builtin_amdgcn_mfma_f32_32x32x16_bf16(b0, qr[d0], p0, 0, 0, 0);
        p1 = __builtin_amdgcn_mfma_f32_32x32x16_bf16(b1, qr[d0], p1, 0, 0, 0); }
}
__device__ __forceinline__ int v_st(int k, int c) { const int kk = (k & ~0xC) | ((k & 4) << 1) | ((k & 8) >> 1); return ((kk >> 3) * 4 + (c >> 5)) * 512 + ((kk & 7) * 32 + (c & 31)) * 2; }
__device__ __forceinline__ int v_rd_base(int lane) { return ((lane & 3) << 3) | (((lane >> 2) & 3) << 6) | (((lane >> 4) & 1) << 5) | (((lane >> 5) & 1) << 8); }
constexpr int v_rd_off(int d0, int ks, int half) { return d0 * 512 + ks * 4096 + half * 2048; }
template <int OFF> __device__ __forceinline__ s16x4 tr_read(int vb) {
    s16x4 r; asm volatile("ds_read_b64_tr_b16 %0, %1 offset:%2" : "=&v"(r) : "v"(vb), "i"(OFF) : "memory"); return r;
}
template <int KS> __device__ __forceinline__ void pv_step(f32x16* o, int vb, bf16x8 pa) {
    const s16x4 l0 = tr_read<v_rd_off(0, KS, 0)>(vb), h0 = tr_read<v_rd_off(0, KS, 1)>(vb), l1 = tr_read<v_rd_off(1, KS, 0)>(vb), h1 = tr_read<v_rd_off(1, KS, 1)>(vb);
    const s16x4 l2 = tr_read<v_rd_off(2, KS, 0)>(vb), h2 = tr_read<v_rd_off(2, KS, 1)>(vb), l3 = tr_read<v_rd_off(3, KS, 0)>(vb), h3 = tr_read<v_rd_off(3, KS, 1)>(vb);
    asm volatile("s_waitcnt lgkmcnt(0)" ::: "memory"); SBAR();
#define PK(L, H) (bf16x8){L[0], L[1], L[2], L[3], H[0], H[1], H[2], H[3]}
    o[0] = __builtin_amdgcn_mfma_f32_32x32x16_bf16(pa, PK(l0, h0), o[0], 0, 0, 0);
    o[1] = __builtin_amdgcn_mfma_f32_32x32x16_bf16(pa, PK(l1, h1), o[1], 0, 0, 0);
    o[2] = __builtin_amdgcn_mfma_f32_32x32x16_bf16(pa, PK(l2, h2), o[2], 0, 0, 0);
    o[3] = __builtin_amdgcn_mfma_f32_32x32x16_bf16(pa, PK(l3, h3), o[3], 0, 0, 0);
#undef PK
}
__device__ __forceinline__ void pv_d0(f32x16* o, int vb, bf16x8 pa0, bf16x8 pa1, bf16x8 pa2, bf16x8 pa3) {
    pv_step<0>(o, vb, pa0); pv_step<1>(o, vb, pa1); pv_step<2>(o, vb, pa2); pv_step<3>(o, vb, pa3);
}
template <int DQK, int LDQ, int LDK, int LDV, int LDO, bool OUT_BF16>
__device__ __forceinline__ void attn_body(const bf16_t* __restrict__ Qb, const bf16_t* __restrict__ Kh, const bf16_t* __restrict__ Vh, void* __restrict__ Ob, int seq, char* lds) {
    const int tid = tid_local(), wid = tid >> 6, lane = tid & 63, r32 = lane & 31, hi = lane >> 5;
    Qb = uniform_ptr(Qb); Kh = uniform_ptr(Kh); Vh = uniform_ptr(Vh); Ob = uniform_ptr(Ob);
    char* V_lds = lds; char* K_lds = lds + 2 * SHM_V;
    float* ws = (float*)(lds + 2 * SHM_V + 2 * SHM_K) + wid * 64; float* li_l = ws; float* al_l = ws + 32;
    float m_reg = -1e30f, l_reg = 0; f32x16 o[4] = {}; bf16x8 qr[DQK / 16];
    const unsigned qoff = (unsigned)((wid * QBLK + r32) * LDQ + hi * 8) * 2u;
#pragma unroll
    for (int d0 = 0; d0 < DQK / 16; ++d0) qr[d0] = *reinterpret_cast<const bf16x8*>((const char*)Qb + qoff + d0 * 32);
    const int sr = tid >> 4, sc = (tid & 15) * 8, vst0 = v_st(sr, sc), vst1 = v_st(32 + sr, sc);
    const int kr = (DQK == 128) ? sr : (tid >> 3), kc = (DQK == 128) ? sc : (tid & 7) * 8;
    const unsigned voffV = (unsigned)(sr * LDV + sc) * 2u, voffK = (unsigned)(kr * LDK + kc) * 2u;
    const int vb0 = (int)(uintptr_t)V_lds + v_rd_base(lane);
    struct { bf16x8 vs0, vs1, ks0, ks1; } sr_[2];
#define SLOAD(i, k0) do { const char* _vb = (const char*)Vh + (size_t)(k0) * (LDV * 2); const char* _kb = (const char*)Kh + (size_t)(k0) * (LDK * 2); \
    sr_[i].vs0 = *reinterpret_cast<const bf16x8*>(_vb + voffV); sr_[i].vs1 = *reinterpret_cast<const bf16x8*>(_vb + voffV + 32 * LDV * 2); \
    sr_[i].ks0 = *reinterpret_cast<const bf16x8*>(_kb + voffK); if constexpr (DQK == 128) sr_[i].ks1 = *reinterpret_cast<const bf16x8*>(_kb + voffK + 32 * LDK * 2); } while (0)
#define SWRITE(b, i) do { *(bf16x8*)(V_lds + (b) * SHM_V + vst0) = sr_[i].vs0;          \
    *(bf16x8*)(V_lds + (b) * SHM_V + vst1) = sr_[i].vs1;               \
    *(bf16x8*)(K_lds + (b) * SHM_K + kswz<DQK>(kr, kc * 2)) = sr_[i].ks0;                       \
    if constexpr (DQK == 128) *(bf16x8*)(K_lds + (b) * SHM_K + kswz<DQK>(32 + kr, kc * 2)) = sr_[i].ks1; } while (0)
#define SWAIT() do { if constexpr (DQK == 128) asm volatile("s_waitcnt vmcnt(4)" ::: "memory"); else asm volatile("s_waitcnt vmcnt(3)" ::: "memory"); } while (0)
#define RESC(a) do { if (__any((a) < 1.f)) { if (hi == 0) al_l[r32] = (a); asm volatile("s_waitcnt lgkmcnt(0)" ::: "memory"); \
    _Pragma("unroll") for (int d = 0; d < 4; ++d) _Pragma("unroll") for (int r = 0; r < 16; ++r) o[d][r] *= al_l[crow(r, hi)]; } } while (0)
    f32x16 pA0, pA1, pB0, pB1; float mnA, mnB, alA, alB; bf16x8 pa0, pa1, pa2, pa3; const int NT = seq / KVBLK;
    constexpr int SE = 0, SO = 1;
    SLOAD(SE, 0); asm volatile("s_waitcnt vmcnt(0)" ::: "memory"); SWRITE(0, SE); __syncthreads();
    qkt<DQK>(pA0, pA1, K_lds, qr, r32, hi); partialSM<DQK>(pA0, pA1, m_reg, mnA, alA);
    SLOAD(SO, KVBLK); if (2 < NT) SLOAD(SE, 2 * KVBLK);
    SWAIT(); SWRITE(1, SO); __syncthreads();
    for (int j = 1; j + 1 < NT; j += 2) {
        SBAR(); qkt<DQK>(pB0, pB1, K_lds + SHM_K, qr, r32, hi);
        finishSM(pA0, pA1, alA, l_reg, pa0, pa1, pa2, pa3); SBAR();
        SLOAD(SO, (j + 2) * KVBLK); SBAR();
        pv_d0(o, vb0, pa0, pa1, pa2, pa3); partialSM<DQK>(pB0, pB1, m_reg, mnB, alB);
        __syncthreads(); SWAIT(); SWRITE(0, SE);
        RESC(alB); __syncthreads();
        SBAR(); qkt<DQK>(pA0, pA1, K_lds, qr, r32, hi);
        finishSM(pB0, pB1, alB, l_reg, pa0, pa1, pa2, pa3); SBAR();
        if (j + 3 < NT) SLOAD(SE, (j + 3) * KVBLK); SBAR();
        pv_d0(o, vb0 + (int)SHM_V, pa0, pa1, pa2, pa3); partialSM<DQK>(pA0, pA1, m_reg, mnA, alA);
        __syncthreads(); SWAIT(); SWRITE(1, SO);
        RESC(alA); __syncthreads();
    }
    SBAR(); qkt<DQK>(pB0, pB1, K_lds + SHM_K, qr, r32, hi);
    finishSM(pA0, pA1, alA, l_reg, pa0, pa1, pa2, pa3); SBAR();
    pv_d0(o, vb0, pa0, pa1, pa2, pa3); partialSM<DQK>(pB0, pB1, m_reg, mnB, alB);
    __syncthreads(); RESC(alB);
    finishSM(pB0, pB1, alB, l_reg, pa0, pa1, pa2, pa3); SBAR();
    pv_d0(o, vb0 + (int)SHM_V, pa0, pa1, pa2, pa3);
    if (hi == 0) li_l[r32] = l_reg; asm volatile("s_waitcnt lgkmcnt(0)" ::: "memory");
    float rli[16];
#pragma unroll
    for (int r = 0; r < 16; ++r) rli[r] = __builtin_amdgcn_rcpf(li_l[crow(r, hi)]);
    if constexpr (OUT_BF16) {
#pragma unroll
        for (int r = 0; r < 16; ++r) { const unsigned ob = (unsigned)((wid * QBLK + crow(r, hi)) * LDO + r32); const float sc16 = rli[r] * 16.0f;
#pragma unroll
            for (int d0 = 0; d0 < 4; ++d0) *((unsigned char*)Ob + ob + d0 * 32) = (unsigned char)(__builtin_amdgcn_cvt_pk_fp8_f32(o[d0][r] * sc16, 0.f, 0, false) & 0xff); }
    } else {
#pragma unroll
        for (int r = 0; r < 16; ++r) { const unsigned ob = (unsigned)((wid * QBLK + crow(r, hi)) * LDO + r32) * 4u;
#pragma unroll
            for (int d0 = 0; d0 < 4; ++d0) *(float*)((char*)Ob + ob + d0 * 128) = o[d0][r] * rli[r]; }
    }
#undef SLOAD
#undef SWRITE
#undef SWAIT
#undef RESC
}
}

struct Args { const float* in[26]; float* out; unsigned char* ws; int ph_lo, ph_hi; };
enum { I_X = 0, I_C, I_CTX, I_CCTX, I_WMOD, I_BMOD, I_G1, I_G2, I_WIN, I_GQ, I_GK, I_LQ1, I_LK1, I_LQ2, I_LK2, I_GSUB, I_WPOOL, I_PSCALE, I_WOUT, I_WR, I_BR, I_W1, I_B1, I_W2, I_B2, I_GF };
constexpr int NPHASE = 22;

struct TItem { const float* src; unsigned char* dst; int N, ldb; float scale; };
__device__ __forceinline__ TItem titem(int it, const float* win, const float* wout, const float* w1, const float* w2, unsigned char* ws, int lane) {
    constexpr int I_IN = 32 * (INW / 64), I_OUT = 24 * (D / 64), I_E1 = 32 * 32, I_E2 = 16 * 32;
    constexpr int T_IN = 2 * I_IN, T_OUT = 2 * I_OUT, T_E1 = 64 * I_E1;
    const float* W; unsigned char* WT; int N, ldb, item; float scale; int r = it;
    if (r < T_IN) { const int l = r / I_IN; W = win + (size_t)l * D * INW; N = INW; WT = ws + WS_WIN + (size_t)l * INW * D; ldb = D; item = r % I_IN; scale = 64.0f; }
    else if ((r -= T_IN) < T_OUT) { const int l = r / I_OUT; W = wout + (size_t)l * D * D; N = D; WT = ws + WS_WOUT + (size_t)l * D * D; ldb = D; item = r % I_OUT; scale = (item / (D / 64) < 16) ? 4.0f : 64.0f; }
    else if ((r -= T_OUT) < T_E1) { const int le = r / I_E1; W = w1 + (size_t)le * D * 2048; N = 2048; WT = ws + WS_W1 + (size_t)le * 2048 * D; ldb = D; item = r % I_E1; scale = 64.0f; }
    else { r -= T_E1; const int le = r / I_E2; W = w2 + (size_t)le * DE * D; N = D; WT = ws + WS_W2 + (size_t)le * D * DE; ldb = DE; item = r % I_E2; scale = 32.0f; }
    const int nblk = N / 64, kb = item / nblk, nb = item % nblk, k0 = 64 * kb + 16 * (lane >> 4), n0 = 64 * nb + 4 * (lane & 15);
    TItem t; t.src = W + (size_t)k0 * N + n0; t.dst = WT + (size_t)n0 * ldb + k0; t.N = N; t.ldb = ldb; t.scale = scale; return t;
}
#define TI_LOAD(v, t) do { _Pragma("unroll") for (int _i = 0; _i < 16; ++_i) v[_i] = *(const f32x4*)((t).src + (size_t)_i * (t).N); } while (0)
#define TI_STORE(v, t) do { const float _sc = (t).scale; _Pragma("unroll") for (int _c = 0; _c < 4; ++_c) { int _w[4]; \
        _Pragma("unroll") for (int _q = 0; _q < 4; ++_q) { int _x = 0; _x = __builtin_amdgcn_cvt_pk_fp8_f32(v[4 * _q][_c] * _sc, v[4 * _q + 1][_c] * _sc, _x, false); \
            _x = __builtin_amdgcn_cvt_pk_fp8_f32(v[4 * _q + 2][_c] * _sc, v[4 * _q + 3][_c] * _sc, _x, true); _w[_q] = _x; } \
        *(u32x4*)((t).dst + (size_t)_c * (t).ldb) = (u32x4){(unsigned)_w[0], (unsigned)_w[1], (unsigned)_w[2], (unsigned)_w[3]}; } } while (0)
__device__ __forceinline__ float silu_f(float x) { return x / (1.0f + __expf(-x)); }

__device__ __forceinline__ void fold_item(int it, const float* wpool, const float* pscale, const float* wout, unsigned char* WOUT) {
    const int n = it & 2047, cc = (it >> 11) & 15, g = (it >> 15) & 3, l = it >> 17;
    const float* wp = wpool + (((size_t)l * 4 + g) * 128 + cc * 8) * 128;
    const float* ps = pscale + (size_t)l * 512 + g * 128;
    const float* wo = wout + ((size_t)l * D + 1536 + g * 128) * D + n;
    float acc[8];
#pragma unroll
    for (int q = 0; q < 8; ++q) acc[q] = 0.f;
#pragma unroll 1
    for (int d0 = 0; d0 < 128; d0 += 32) { float av[32];
#pragma unroll
        for (int dd = 0; dd < 32; ++dd) av[dd] = wo[(size_t)(d0 + dd) * D];
#pragma unroll
        for (int dd = 0; dd < 32; ++dd) { const float x = ps[d0 + dd] * av[dd];
#pragma unroll
            for (int q = 0; q < 8; ++q) acc[q] = fmaf(wp[q * 128 + d0 + dd], x, acc[q]); } }
    int o0 = 0, o1 = 0; o0 = __builtin_amdgcn_cvt_pk_fp8_f32(acc[0] * 64.f, acc[1] * 64.f, o0, false); o0 = __builtin_amdgcn_cvt_pk_fp8_f32(acc[2] * 64.f, acc[3] * 64.f, o0, true);
    o1 = __builtin_amdgcn_cvt_pk_fp8_f32(acc[4] * 64.f, acc[5] * 64.f, o1, false); o1 = __builtin_amdgcn_cvt_pk_fp8_f32(acc[6] * 64.f, acc[7] * 64.f, o1, true);
    *(u32x2*)(WOUT + ((size_t)l * D + n) * D + 1536 + g * 128 + cc * 8) = (u32x2){(unsigned)o0, (unsigned)o1};
}

PHASE_FN phase_prologue(LAS unsigned char* lds, int l_unused, int G) {
    lds = (LAS unsigned char*)__builtin_amdgcn_readfirstlane((int)(uintptr_t)lds); G = __builtin_amdgcn_readfirstlane(G);
    const int tid = tid_local(), lane = tid & 63, wave = __builtin_amdgcn_readfirstlane(tid >> 6);
    unsigned char* ws = WSP();
    const int gw = blockIdx.x * NWAVES + wave, NGW = G * NWAVES;
    {
        float* MODP = (float*)(ws + WS_MODP);
        const float* cvec = INP(I_C); const float* cctx = INP(I_CCTX); const float* wmod = INP(I_WMOD);
        LAS float* st = (LAS float*)lds;
        for (int i = tid; i < 5 * D; i += NTHREADS) st[i] = silu_f(i < 4 * D ? cvec[i] : cctx[i - 4 * D]);
        __syncthreads();
        for (int u = gw; u < 2 * 64 * 48; u += NGW) {
            const int l = u / (64 * 48), r = u % (64 * 48), kc = r / 48, cg = r % 48;
            const int col = cg * 256 + lane * 4;
            const float* W = wmod + (size_t)l * D * 12288 + (size_t)(kc * 32) * 12288 + col;
            f32x4 acc[5];
#pragma unroll
            for (int v = 0; v < 5; ++v) acc[v] = (f32x4){0.f, 0.f, 0.f, 0.f};
#pragma unroll 1
            for (int k8 = 0; k8 < 32; k8 += 16) {
                f32x4 w[16];
#pragma unroll
                for (int kk = 0; kk < 16; ++kk) w[kk] = *(const f32x4*)(W + (size_t)(k8 + kk) * 12288);
#pragma unroll
                for (int kk = 0; kk < 16; ++kk) { const int k = kc * 32 + k8 + kk;
#pragma unroll
                    for (int v = 0; v < 5; ++v) acc[v] += st[v * D + k] * w[kk]; } }
#pragma unroll
            for (int v = 0; v < 5; ++v) *(f32x4*)(MODP + ((size_t)kc * 10 + l * 5 + v) * 12288 + col) = acc[v];
        }
        __syncthreads();
    }
    {
        f32x2* tabA = (f32x2*)(ws + WS_ROPE); f32x2* tabB = tabA + 64 * 32;
        for (int i = blockIdx.x * NTHREADS + tid; i < 64 * 32 + 64 * 16; i += G * NTHREADS) {
            if (i < 64 * 32) { const int pos = i >> 5, f = i & 31; const float inv = powf(10000.0f, -(float)f / 32.0f); const float ang = (float)pos * inv; tabA[i] = (f32x2){cosf(ang), sinf(ang)}; }
            else { const int q = i - 64 * 32; const int pos = q >> 4, f = q & 15; const float inv = powf(10000.0f, -(float)f / 16.0f); const float ang = (float)pos * inv; tabB[q] = (f32x2){cosf(ang), sinf(ang)}; }
        }
    }
    {
        const float* win = INP(I_WIN); const float* wout = INP(I_WOUT); const float* w1 = INP(I_W1); const float* w2 = INP(I_W2);
        constexpr int TOT = 2 * 32 * (INW / 64);
        f32x4 va[16], vb[16]; TItem ta, tb;
        int it = gw;
        if (it < TOT) { ta = titem(it, win, wout, w1, w2, ws, lane); TI_LOAD(va, ta); }
        while (it < TOT) {
            const int i1 = it + NGW;
            if (i1 < TOT) { tb = titem(i1, win, wout, w1, w2, ws, lane); TI_LOAD(vb, tb); }
            TI_STORE(va, ta);
            if (i1 >= TOT) break;
            const int i2 = i1 + NGW;
            if (i2 < TOT) { ta = titem(i2, win, wout, w1, w2, ws, lane); TI_LOAD(va, ta); }
            TI_STORE(vb, tb);
            it = i2;
        }
    }
}

PHASE_FN phase_modreduce(LAS unsigned char* lds, int l_unused, int G) {
    lds = (LAS unsigned char*)__builtin_amdgcn_readfirstlane((int)(uintptr_t)lds); G = __builtin_amdgcn_readfirstlane(G);
    const int tid = tid_local();
    unsigned char* ws = WSP();
    const float* MODP = (const float*)(ws + WS_MODP); float* MOD = (float*)(ws + WS_MOD); const float* bmod = INP(I_BMOD);
    for (int i = blockIdx.x * NTHREADS + tid; i < 10 * 12288 / 4; i += G * NTHREADS) {
        const int lv = i / 3072, col = (i % 3072) * 4, l = lv / 5;
        f32x4 s = *(const f32x4*)(bmod + (size_t)l * 12288 + col);
#pragma unroll 16
        for (int kc = 0; kc < 64; ++kc) s += *(const f32x4*)(MODP + ((size_t)kc * 10 + lv) * 12288 + col);
        *(f32x4*)(MOD + (size_t)lv * 12288 + col) = s;
    }
}

__device__ __forceinline__ void norm_mod_store(const f32x4 (&v)[8], const f32x4 (&gg)[8], const f32x4 (&sh)[8], const f32x4 (&sc)[8], unsigned char* orow, int lane) {
    float ss = 0.f;
#pragma unroll
    for (int j = 0; j < 8; ++j) ss += (v[j].x * v[j].x + v[j].y * v[j].y) + (v[j].z * v[j].z + v[j].w * v[j].w);
    const float rs = rsqrtf(wave_sum(ss) * (1.0f / D) + EPS);
#pragma unroll
    for (int j = 0; j < 8; ++j) { const int col = 4 * (lane + 64 * j);
        const f32x4 y = (v[j] * rs) * gg[j]; const f32x4 n = y * (sc[j] + 1.0f) + sh[j];
        int w = 0; w = __builtin_amdgcn_cvt_pk_fp8_f32(n.x, n.y, w, false); w = __builtin_amdgcn_cvt_pk_fp8_f32(n.z, n.w, w, true);
        *(int*)(orow + col) = w; }
}

PHASE_FN phase_norm1_l0(LAS unsigned char* lds, int l_unused, int G) {
    lds = (LAS unsigned char*)__builtin_amdgcn_readfirstlane((int)(uintptr_t)lds); G = __builtin_amdgcn_readfirstlane(G);
    const int tid = tid_local(), lane = tid & 63, wave = __builtin_amdgcn_readfirstlane(tid >> 6);
    unsigned char* ws = WSP();
    const float* MOD = (const float*)(ws + WS_MOD);
    unsigned char* N = ws + WS_N;
    const float* x = INP(I_X); const float* ctx = INP(I_CTX); const float* g1 = INP(I_G1);
    f32x4 gg[8];
#pragma unroll
    for (int j = 0; j < 8; ++j) gg[j] = *(const f32x4*)(g1 + 4 * (lane + 64 * j));
    for (int row = blockIdx.x * NWAVES + wave; row < MT; row += G * NWAVES) {
        const float* src = row < ML ? x + (size_t)row * D : ctx + (size_t)(row - ML) * D;
        const int bidx = row < ML ? (row >> 12) : 4;
        const float* m = MOD + (size_t)bidx * 12288;
        f32x4 v[8], sh[8], sc[8];
#pragma unroll
        for (int j = 0; j < 8; ++j) { v[j] = *(const f32x4*)(src + 4 * (lane + 64 * j)); sh[j] = *(const f32x4*)(m + 4 * (lane + 64 * j)); sc[j] = *(const f32x4*)(m + 2048 + 4 * (lane + 64 * j)); }
        norm_mod_store(v, gg, sh, sc, N + (size_t)row * D, lane);
    }
}

PHASE_FN phase_inproj(LAS unsigned char* lds, int l, int G) {
    lds = (LAS unsigned char*)__builtin_amdgcn_readfirstlane((int)(uintptr_t)lds); l = __builtin_amdgcn_readfirstlane(l); G = __builtin_amdgcn_readfirstlane(G);
    unsigned char* ws = WSP();
    pg8::DenseSched<D, 1> S; S.init(ws + WS_N, ws + WS_WIN + (size_t)l * INW * D, MT, INW, G, (int)blockIdx.x);
    pg8::EpiBf16 E{(bf16_t*)(ws + WS_P), INW, nullptr, 0};
    pg8::gemm_phase(lds, S, E);
}

PHASE_FN phase_prep(LAS unsigned char* lds, int l, int G) {
    lds = (LAS unsigned char*)__builtin_amdgcn_readfirstlane((int)(uintptr_t)lds); l = __builtin_amdgcn_readfirstlane(l); G = __builtin_amdgcn_readfirstlane(G);
    const int tid = tid_local(), lane = tid & 63, wave = __builtin_amdgcn_readfirstlane(tid >> 6);
    unsigned char* ws = WSP();
    const bf16_t* P = (const bf16_t*)(ws + WS_P);
    unsigned* QA = (unsigned*)(ws + WS_QA); unsigned* KA = (unsigned*)(ws + WS_KA); unsigned* VA = (unsigned*)(ws + WS_VA);
    unsigned* QB = (unsigned*)(ws + WS_QB); unsigned* KB = (unsigned*)(ws + WS_KB); unsigned* VB = (unsigned*)(ws + WS_VB); unsigned char* CAT = ws + WS_CAT;
    const f32x2* tabA = (const f32x2*)(ws + WS_ROPE); const f32x2* tabB = tabA + 64 * 32;
    const f32x2 gq2 = *(const f32x2*)(INP(I_GQ) + l * 128 + 2 * lane), gk2 = *(const f32x2*)(INP(I_GK) + l * 128 + 2 * lane);
    const bool firstA = (lane & 16) == 0, firstB = (lane & 8) == 0;
    for (int unit = blockIdx.x; unit < MT / 8; unit += G) {
        const int ch = tid, hw = 1 << (ch >> 7);
        const int row0 = unit * 8; int base, s0, L;
        if (row0 < ML) { base = row0 & ~4095; s0 = row0 & 4095; L = SEQ; } else { const int r2 = row0 - ML; base = ML + (r2 & ~255); s0 = r2 & 255; L = CTX; }
        float pv_[23];
        { const bf16_t* pc = P + (size_t)base * INW + OFF_UC + ch;
#pragma unroll
            for (int j = 0; j < 23; ++j) { int sj = s0 - 8 + j; sj = sj < 0 ? 0 : (sj >= L ? L - 1 : sj);
                pv_[j] = bf2f(pc[(size_t)sj * INW]); } }
        {
            const int row = unit * 8 + wave;
            const bool lat = row < ML; int b, sq, trow;
            if (lat) { b = row >> 12; sq = row & 4095; trow = b * TK + CTX + sq; } else { const int r2 = row - ML; b = r2 >> 8; sq = r2 & 255; trow = b * TK + sq; }
            const unsigned* p = (const unsigned*)(P + (size_t)row * INW);
            unsigned ha[10], hb[8];
#pragma unroll
            for (int hh = 0; hh < 10; ++hh) ha[hh] = p[(hh < 8 ? hh * 64 : OFF_KA / 2 + (hh - 8) * 64) + lane];
#pragma unroll
            for (int jp = 0; jp < 8; ++jp) hb[jp] = p[(jp < 4 ? OFF_QB / 2 + jp * 64 : OFF_KB / 2 + (jp - 4) * 64) + lane];
            const u32x2 vva = *(const u32x2*)(p + OFF_VA / 2 + 2 * lane);
            const u32x4 vvb = *(const u32x4*)(p + OFF_VB / 2 + 4 * lane);
            const int prow = sq >> 6, pcol = sq & 63;
            const f32x4 csA = *(const f32x4*)(tabA + (lane < 32 ? prow : pcol) * 32 + 2 * (lane & 15));
            const f32x4 csB = *(const f32x4*)(tabB + ((lane & 16) == 0 ? prow : pcol) * 16 + 2 * (lane & 7));
#pragma unroll
            for (int hh = 0; hh < 10; ++hh) {
                float e0 = __uint_as_float(ha[hh] << 16), e1 = __uint_as_float(ha[hh] & 0xffff0000u);
                const float ss = wave_sum(e0 * e0 + e1 * e1); const float r = rsqrtf(ss * (1.0f / 128.0f) + EPS);
                const f32x2 g = hh < 8 ? gq2 : gk2;
                e0 = e0 * r * g.x; e1 = e1 * r * g.y;
                if (lat) {
                    const float o0 = __shfl_xor(e0, 16), o1 = __shfl_xor(e1, 16);
                    e0 = firstA ? (e0 * csA.x - o0 * csA.y) : (o0 * csA.y + e0 * csA.x);
                    e1 = firstA ? (e1 * csA.z - o1 * csA.w) : (o1 * csA.w + e1 * csA.z);
                }
                unsigned* dst = hh < 8 ? QA + (size_t)row * 512 + hh * 64 : KA + (size_t)trow * 128 + (hh - 8) * 64;
                dst[lane] = cvt_pk_bf16(e0, e1);
            }
            *(u32x2*)(VA + (size_t)trow * 128 + 2 * lane) = vva;
#pragma unroll
            for (int jp = 0; jp < 8; ++jp) {
                float e0 = __uint_as_float(hb[jp] << 16), e1 = __uint_as_float(hb[jp] & 0xffff0000u);
                if (lat) {
                    const float o0 = __shfl_xor(e0, 8), o1 = __shfl_xor(e1, 8);
                    e0 = firstB ? (e0 * csB.x - o0 * csB.y) : (o0 * csB.y + e0 * csB.x);
                    e1 = firstB ? (e1 * csB.z - o1 * csB.w) : (o1 * csB.w + e1 * csB.z);
                }
                unsigned* dst = jp < 4 ? QB + (size_t)row * 256 + jp * 64 : KB + (size_t)trow * 256 + (jp - 4) * 64;
                dst[lane] = cvt_pk_bf16(e0, e1);
            }
            *(u32x4*)(VB + (size_t)trow * 256 + 4 * lane) = vvb;
        }
        {
#pragma unroll
            for (int tk = 0; tk < 8; ++tk) { const int sq = s0 + tk;
                const int lo = (sq - hw) < 0 ? 0 : (sq - hw), hi = (sq + hw) > L ? L : (sq + hw);
                float sum = 0.f;
#pragma unroll
                for (int j = tk; j < tk + 16; ++j) { const int sj = s0 - 8 + j; sum += (sj >= lo && sj < hi) ? pv_[j] : 0.f; }
                CAT[(size_t)(row0 + tk) * D + 1536 + ch] = (unsigned char)(__builtin_amdgcn_cvt_pk_fp8_f32(sum / (float)(hi - lo) - pv_[tk + 8], 0.f, 0, false) & 0xff); }
        }
    }
}

constexpr int CONV_BATCH = 64, CONV_E1 = 32 * 32 * 32, CONV_E2 = 32 * 16 * 32, CONV_ITEMS = CONV_E1 + CONV_E2  , CONV_FIRST = 2 * 32 * (INW / 64) + 2 * 24 * (D / 64);
constexpr int CONV_OUT0 = 2 * 32 * (INW / 64), CONV_OUT = 24 * (D / 64)  , NB_FOLD = 4 * 16 * 2048 / NTHREADS  , NB_OUT = CONV_OUT / CONV_BATCH, NB_EXP = CONV_ITEMS / CONV_BATCH;
static_assert(CONV_OUT % CONV_BATCH == 0 && CONV_E1 % CONV_BATCH == 0, "conversion batches");
__device__ __forceinline__ void conv_batch(int bt, int l, unsigned char* ws, const float* wpool, const float* pscale, const float* win, const float* wout, const float* w1, const float* w2, int tid) {
    if (bt < NB_FOLD) { fold_item(l * (4 * 16 * 2048) + bt * NTHREADS + tid, wpool, pscale, wout, ws + WS_WOUT); return; }
    const int lane = tid & 63, wave = __builtin_amdgcn_readfirstlane(tid >> 6);
    int base;
    if (bt < NB_FOLD + NB_OUT) base = CONV_OUT0 + l * CONV_OUT + (bt - NB_FOLD) * CONV_BATCH + wave * (CONV_BATCH / NWAVES);
    else { const int li = (bt - NB_FOLD - NB_OUT) * CONV_BATCH + wave * (CONV_BATCH / NWAVES);
        base = li < CONV_E1 ? CONV_FIRST + l * CONV_E1 + li : CONV_FIRST + 2 * CONV_E1 + l * CONV_E2 + (li - CONV_E1); }
    f32x4 va[16], vb[16]; TItem ta, tb;
    ta = titem(base, win, wout, w1, w2, ws, lane); TI_LOAD(va, ta);
#pragma unroll 1
    for (int i = 0; i < CONV_BATCH / NWAVES; i += 2) {
        tb = titem(base + i + 1, win, wout, w1, w2, ws, lane); TI_LOAD(vb, tb);
        TI_STORE(va, ta);
        if (i + 2 < CONV_BATCH / NWAVES) { ta = titem(base + i + 2, win, wout, w1, w2, ws, lane); TI_LOAD(va, ta); }
        TI_STORE(vb, tb);
    }
}
PHASE_FN phase_attention(LAS unsigned char* lds_, int l, int G) {
    lds_ = (LAS unsigned char*)__builtin_amdgcn_readfirstlane((int)(uintptr_t)lds_); l = __builtin_amdgcn_readfirstlane(l); G = __builtin_amdgcn_readfirstlane(G);
    LAS unsigned char* lds = lds_;
    unsigned char* ws = WSP();
    char* ldsg = (char*)lds_;
    const int tid = tid_local();
    const int c = (int)blockIdx.x;
    const bf16_t* QA = (const bf16_t*)(ws + WS_QA); const bf16_t* KA = (const bf16_t*)(ws + WS_KA); const bf16_t* VA = (const bf16_t*)(ws + WS_VA);
    const bf16_t* QB = (const bf16_t*)(ws + WS_QB); const bf16_t* KB = (const bf16_t*)(ws + WS_KB); const bf16_t* VB = (const bf16_t*)(ws + WS_VB);
    unsigned char* CAT = ws + WS_CAT; float* OB = (float*)(ws + WS_OB);
    const int nctx = (l == 0) ? 32 : 0;
    const int pos = (G == 256) ? ((c >> 3) % 5) : 4;
#define CONV_SHARE() do { const float* wpool = INP(I_WPOOL); const float* pscale = INP(I_PSCALE); const float* win = INP(I_WIN); const float* wout = INP(I_WOUT); const float* w1 = INP(I_W1); const float* w2 = INP(I_W2); \
        for (int _bt = c; _bt < NB_FOLD + NB_OUT + NB_EXP; _bt += G) conv_batch(_bt, l, ws, wpool, pscale, win, wout, w1, w2, tid); } while (0)
    int slot_i = 0;
    for (int id = c; id < 512 + nctx; id += G, ++slot_i) {
        if (slot_i == pos && slot_i < 2) CONV_SHARE();
        const bf16_t *q, *k, *v; unsigned char* o; int seq;
        if (id < 512) { const int x = id & 7, i = id >> 8, j = (id >> 3) & 31; const int b = x >> 1, kvh = x & 1, h = kvh * 4 + 2 * i + (j >> 4), qb = j & 15;
            const size_t r0 = (size_t)b * SEQ + qb * 256;
            q = QA + r0 * 1024 + h * 128; k = KA + (size_t)b * TK * 256 + kvh * 128; v = VA + (size_t)b * TK * 256 + kvh * 128; o = CAT + r0 * D + h * 128; seq = TK; }
        else { const int cc = id - 512, b = cc >> 3, h = cc & 7; const size_t r0 = (size_t)ML + b * CTX;
            q = QA + r0 * 1024 + h * 128; k = KA + (size_t)b * TK * 256 + (h >> 2) * 128; v = VA + (size_t)b * TK * 256 + (h >> 2) * 128; o = CAT + r0 * D + h * 128; seq = CTX; }
        __syncthreads();
        att::attn_body<128, 1024, 256, 256, D, true>(q, k, v, o, seq, ldsg);
    }
    if (G == 256) slot_i = 2;
    for (int it = 0;; ++it, ++slot_i) {
        int id = c + it * G;
        if (G == 256 && it == 2) id = (c >= 32 && c < 32 + nctx) ? 512 + (c - 32) : 1 << 30;
        if (id >= 512 + nctx) break;
        if (slot_i == pos && slot_i < 4 && G == 256) CONV_SHARE();
        const bf16_t *q, *k, *v; float* o; int seq;
        if (id < 512) { const int x = id & 7, i = id >> 8, j = (id >> 3) & 31; const int combo = 2 * x + i, b = combo >> 2, h = combo & 3, comp = j >> 4, qb = j & 15;
            const int jj = comp * 4 + h; const size_t r0 = (size_t)b * SEQ + qb * 256;
            q = QB + r0 * 512 + jj * 64; k = KB + (size_t)b * TK * 512 + jj * 64; v = VB + (size_t)b * TK * 512 + h * 128; o = OB + r0 * 1024 + jj * 128; seq = TK; }
        else { const int cc = id - 512, b = cc >> 3, jj = cc & 7, h = jj & 3; const size_t r0 = (size_t)ML + b * CTX;
            q = QB + r0 * 512 + jj * 64; k = KB + (size_t)b * TK * 512 + jj * 64; v = VB + (size_t)b * TK * 512 + h * 128; o = OB + r0 * 1024 + jj * 128; seq = CTX; }
        __syncthreads();
        att::attn_body<64, 512, 512, 512, 1024, false>(q, k, v, o, seq, ldsg);
    }
    if (pos >= 4) CONV_SHARE();
#undef CONV_SHARE
}

PHASE_FN phase_fixup(LAS unsigned char* lds, int l, int G) {
    lds = (LAS unsigned char*)__builtin_amdgcn_readfirstlane((int)(uintptr_t)lds); l = __builtin_amdgcn_readfirstlane(l); G = __builtin_amdgcn_readfirstlane(G);
    const int tid = tid_local(), lane = tid & 63, wave = __builtin_amdgcn_readfirstlane(tid >> 6);
    unsigned char* ws = WSP();
    const float lam_init = 0.8f - 0.6f * expf(-0.3f * (float)l);
    float s1 = 0.f, s2 = 0.f;
    { const float* lq1 = INP(I_LQ1) + l * 64; const float* lk1 = INP(I_LK1) + l * 64; const float* lq2 = INP(I_LQ2) + l * 64; const float* lk2 = INP(I_LK2) + l * 64;
      s1 = wave_sum(lq1[lane] * lk1[lane]); s2 = wave_sum(lq2[lane] * lk2[lane]); }
    const float lam = expf(s1) - expf(s2) + lam_init;
    const float* OB = (const float*)(ws + WS_OB); unsigned char* CAT = ws + WS_CAT;
    const float* gs = INP(I_GSUB) + l * 128;
    const int nrows = (l == 0) ? MT : ML;
    const f32x2 g2 = *(const f32x2*)(gs + 2 * lane);
    for (int row = blockIdx.x * NWAVES + wave; row < nrows; row += G * NWAVES) {
        f32x2 o1[4], o2[4];
#pragma unroll
        for (int h = 0; h < 4; ++h) { o1[h] = *(const f32x2*)(OB + (size_t)row * 1024 + h * 128 + 2 * lane); o2[h] = *(const f32x2*)(OB + (size_t)row * 1024 + (4 + h) * 128 + 2 * lane); }
#pragma unroll
        for (int h = 0; h < 4; ++h) {
            const f32x2 d = o1[h] - lam * o2[h];
            const float ss = wave_sum(d.x * d.x + d.y * d.y); const float r = rsqrtf(ss * (1.0f / 128.0f) + EPS) * (1.0f - lam_init);
            *(unsigned short*)(CAT + (size_t)row * D + 1024 + h * 128 + 2 * lane) = (unsigned short)(__builtin_amdgcn_cvt_pk_fp8_f32(d.x * r * g2.x, d.y * r * g2.y, 0, false) & 0xffff);
        }
    }
}

PHASE_FN phase_outproj(LAS unsigned char* lds, int l, int G) {
    lds = (LAS unsigned char*)__builtin_amdgcn_readfirstlane((int)(uintptr_t)lds); l = __builtin_amdgcn_readfirstlane(l); G = __builtin_amdgcn_readfirstlane(G);
    unsigned char* ws = WSP();
    pg8::DenseSched<D, 1> S; S.init(ws + WS_CAT, ws + WS_WOUT + (size_t)l * D * D, (l == 0) ? MT : ML, D, G, (int)blockIdx.x);
    pg8::EpiResid E{INP(I_X), INP(I_CTX), (const float*)(ws + WS_XR), (float*)(ws + WS_XR), (const float*)(ws + WS_MOD) + (size_t)l * 5 * 12288, l};
    pg8::gemm_phase(lds, S, E);
}

PHASE_FN phase_router(LAS unsigned char* lds, int l, int G) {
    lds = (LAS unsigned char*)__builtin_amdgcn_readfirstlane((int)(uintptr_t)lds); l = __builtin_amdgcn_readfirstlane(l); G = __builtin_amdgcn_readfirstlane(G);
    const int tid = tid_local(), lane = tid & 63, wave = __builtin_amdgcn_readfirstlane(tid >> 6);
    unsigned char* ws = WSP();
    const float* XR = (const float*)(ws + WS_XR); unsigned char* NF8 = ws + WS_NF8;
    const float* MOD = (const float*)(ws + WS_MOD) + (size_t)l * 5 * 12288;
    int* eid = (int*)(ws + WS_ROUT + ROUT_EID); float* gate = (float*)(ws + WS_ROUT + ROUT_GATE); int* posb = (int*)(ws + WS_ROUT + ROUT_POS); int* list = (int*)(ws + WS_ROUT + ROUT_LIST);
    unsigned* cnt = (unsigned*)(ws + WS_CTL) + CW_CNT + l * 32 * 64;
    const float* wr_ = INP(I_WR) + (size_t)l * D * NE; const float* br = INP(I_BR) + l * NE; const float* g2 = INP(I_G2) + (size_t)l * D;
    LAS float* fl = (LAS float*)lds;
    LAS float* lg = (LAS float*)(lds + MISC_OFF + 512);
    LAS int* selall = (LAS int*)(lds + MISC_OFF + 4096);
    const int ntok = (l == 0) ? MT : ML;
    int ui = 0;
    f32x4 g2v[8];
#pragma unroll
    for (int j = 0; j < 8; ++j) g2v[j] = *(const f32x4*)(g2 + 4 * (lane + 64 * j));
    for (int unit = blockIdx.x; unit < ntok / 16; unit += G) {
        LAS int* sel = selall + ui * 64;
        { const int tl = wave * 2, row = unit * 16 + tl;
            const int bidx = row < ML ? (row >> 12) : 4; const float* m = MOD + (size_t)bidx * 12288;
            f32x4 va[8], vb[8], shv[8], scv[8]; float ssa = 0.f, ssb = 0.f;
#pragma unroll
            for (int j = 0; j < 8; ++j) { va[j] = *(const f32x4*)(XR + (size_t)row * D + 4 * (lane + 64 * j)); vb[j] = *(const f32x4*)(XR + (size_t)(row + 1) * D + 4 * (lane + 64 * j));
                shv[j] = *(const f32x4*)(m + 3 * 2048 + 4 * (lane + 64 * j)); scv[j] = *(const f32x4*)(m + 4 * 2048 + 4 * (lane + 64 * j)); }
#pragma unroll
            for (int j = 0; j < 8; ++j) { ssa += (va[j].x * va[j].x + va[j].y * va[j].y) + (va[j].z * va[j].z + va[j].w * va[j].w); ssb += (vb[j].x * vb[j].x + vb[j].y * vb[j].y) + (vb[j].z * vb[j].z + vb[j].w * vb[j].w); }
            const float rsa = rsqrtf(wave_sum(ssa) * (1.0f / D) + EPS), rsb = rsqrtf(wave_sum(ssb) * (1.0f / D) + EPS);
#pragma unroll
            for (int j = 0; j < 8; ++j) { const int col = 4 * (lane + 64 * j);
                const f32x4 gg = g2v[j], sh = shv[j], sc = scv[j];
                const f32x4 na = ((va[j] * rsa) * gg) * (sc + 1.0f) + sh, nb = ((vb[j] * rsb) * gg) * (sc + 1.0f) + sh;
                int wa = 0, wb = 0; wa = __builtin_amdgcn_cvt_pk_fp8_f32(na.x, na.y, wa, false); wa = __builtin_amdgcn_cvt_pk_fp8_f32(na.z, na.w, wa, true);
                wb = __builtin_amdgcn_cvt_pk_fp8_f32(nb.x, nb.y, wb, false); wb = __builtin_amdgcn_cvt_pk_fp8_f32(nb.z, nb.w, wb, true);
                *(int*)(NF8 + (size_t)row * D + col) = wa; *(int*)(NF8 + (size_t)(row + 1) * D + col) = wb;
                *(LAS f32x4*)(fl + tl * FLS + col) = na; *(LAS f32x4*)(fl + (tl + 1) * FLS + col) = nb; }
        }
        __syncthreads();
        f32x4 acc0 = (f32x4){0.f, 0.f, 0.f, 0.f}, acc1 = (f32x4){0.f, 0.f, 0.f, 0.f};
        { const int trow = lane & 15, g4 = lane >> 4;
#pragma unroll 4
            for (int kq = 0; kq < 16; ++kq) { const int kb = wave * 256 + kq * 16 + 4 * g4;
                const f32x4 av = *(const LAS f32x4*)(fl + trow * FLS + kb);
                const float* wp = wr_ + (size_t)kb * NE + trow;
                float b0[4], b1[4];
#pragma unroll
                for (int kk = 0; kk < 4; ++kk) { b0[kk] = wp[kk * NE]; b1[kk] = wp[kk * NE + 16]; }
#pragma unroll
                for (int kk = 0; kk < 4; ++kk) { acc0 = __builtin_amdgcn_mfma_f32_16x16x4f32(av[kk], b0[kk], acc0, 0, 0, 0); acc1 = __builtin_amdgcn_mfma_f32_16x16x4f32(av[kk], b1[kk], acc1, 0, 0, 0); } }
        }
        __syncthreads();
        { const int ecol = lane & 15, g4 = lane >> 4; LAS float* pw = fl + wave * 512;
#pragma unroll
            for (int r = 0; r < 4; ++r) { pw[(g4 * 4 + r) * 32 + ecol] = acc0[r]; pw[(g4 * 4 + r) * 32 + 16 + ecol] = acc1[r]; } }
        __syncthreads();
        { float sacc = br[tid & 31];
#pragma unroll
            for (int w = 0; w < 8; ++w) sacc += fl[w * 512 + tid];
            lg[tid] = sacc; }
        __syncthreads();
        if (tid < 16) { const int row = unit * 16 + tid; float v[4]; int id[4]; unsigned used = 0u;
#pragma unroll
            for (int k = 0; k < 4; ++k) { float best = -3.0e38f; int bi = 0;
                for (int e = 0; e < NE; ++e) { const float x = lg[tid * 32 + e]; if (!((used >> e) & 1u) && x > best) { best = x; bi = e; } }
                used |= 1u << bi; v[k] = best; id[k] = bi; }
            const float e1 = __expf(v[1] - v[0]), e2 = __expf(v[2] - v[0]), e3 = __expf(v[3] - v[0]); const float inv = 1.0f / (1.0f + e1 + e2 + e3);
            sel[tid * 4 + 0] = id[0]; sel[tid * 4 + 1] = id[1]; sel[tid * 4 + 2] = id[2]; sel[tid * 4 + 3] = id[3];
            *(int4*)(eid + (size_t)row * 4) = make_int4(id[0], id[1], id[2], id[3]);
            *(f32x4*)(gate + (size_t)row * 4) = (f32x4){inv, e1 * inv, e2 * inv, e3 * inv}; }
        __syncthreads();
        ++ui;
    }
    __syncthreads();
    if (tid < NE) { int c = 0; const int nent = ui * 64;
        for (int i = 0; i < nent; ++i) c += (selall[i] == tid) ? 1 : 0;
        if (c > 0) { const int base = (int)atomicAdd(cnt + tid * 64, (unsigned)c); int r = 0;
            for (int i = 0; i < nent; ++i) if (selall[i] == tid) { const int row = ((int)blockIdx.x + (i >> 6) * G) * 16 + ((i & 63) >> 2); list[(size_t)tid * MT + base + r] = row; posb[(size_t)row * 4 + (i & 3)] = base + r; ++r; } } }
    __syncthreads();
}

__device__ __forceinline__ void moe_tables(unsigned char* ws, int l, LAS unsigned char* lds) {
    LAS int* tp = (LAS int*)(lds + MISC_OFF + 64); LAS int* cn = (LAS int*)(lds + MISC_OFF + 256);
    const unsigned* cnt = (const unsigned*)(ws + WS_CTL) + CW_CNT + l * 32 * 64;
    __syncthreads();
    if (threadIdx.x < 64) { const int ln = threadIdx.x;
        const int c = (ln < NE) ? (int)__hip_atomic_load(cnt + ln * 64, __ATOMIC_RELAXED, __HIP_MEMORY_SCOPE_AGENT) : 0;
        const int t = (c + 255) >> 8; int incl = t;
#pragma unroll
        for (int o = 1; o < 32; o <<= 1) { const int u = __shfl_up(incl, o); if (ln >= o) incl += u; }
        if (ln < NE) { tp[ln] = incl - t; cn[ln] = c; }
        if (ln == NE - 1) tp[NE] = incl; }
    __syncthreads();
}

PHASE_FN phase_moe_up(LAS unsigned char* lds, int l, int G) {
    lds = (LAS unsigned char*)__builtin_amdgcn_readfirstlane((int)(uintptr_t)lds); l = __builtin_amdgcn_readfirstlane(l); G = __builtin_amdgcn_readfirstlane(G);
    unsigned char* ws = WSP();
    moe_tables(ws, l, lds);
    pg8::MoeSched<true, D, 1> S; S.init((const LAS int*)(lds + MISC_OFF + 64), (const LAS int*)(lds + MISC_OFF + 256), ws + WS_NF8, ws + WS_W1 + (size_t)l * 32 * 2048 * D,
                                  (const int*)(ws + WS_ROUT + ROUT_LIST), G, (int)blockIdx.x);
    pg8::EpiSwiglu E{ws + WS_ACT, INP(I_B1) + (size_t)l * 32 * 2048};
    pg8::gemm_phase(lds, S, E);
}

PHASE_FN phase_moe_down(LAS unsigned char* lds, int l, int G) {
    lds = (LAS unsigned char*)__builtin_amdgcn_readfirstlane((int)(uintptr_t)lds); l = __builtin_amdgcn_readfirstlane(l); G = __builtin_amdgcn_readfirstlane(G);
    unsigned char* ws = WSP();
    moe_tables(ws, l, lds);
    pg8::MoeSched<false, DE, 1> S; S.init((const LAS int*)(lds + MISC_OFF + 64), (const LAS int*)(lds + MISC_OFF + 256), ws + WS_ACT, ws + WS_W2 + (size_t)l * 32 * D * DE,
                                   nullptr, G, (int)blockIdx.x);
    pg8::EpiF8 E{ws + WS_Y, D, INP(I_B2) + (size_t)l * 32 * D, D};
    pg8::gemm_phase(lds, S, E);
}

PHASE_FN phase_combine(LAS unsigned char* lds, int l, int G) {
    lds = (LAS unsigned char*)__builtin_amdgcn_readfirstlane((int)(uintptr_t)lds); l = __builtin_amdgcn_readfirstlane(l); G = __builtin_amdgcn_readfirstlane(G);
    const int tid = tid_local(), lane = tid & 63, wave = __builtin_amdgcn_readfirstlane(tid >> 6);
    unsigned char* ws = WSP();
    moe_tables(ws, l, lds);
    float* XR = (float*)(ws + WS_XR); unsigned char* N = ws + WS_N; const unsigned char* Y = ws + WS_Y;
    const float* MOD = (const float*)(ws + WS_MOD);
    const int* eid = (const int*)(ws + WS_ROUT + ROUT_EID); const float* gate = (const float*)(ws + WS_ROUT + ROUT_GATE); const int* posb = (const int*)(ws + WS_ROUT + ROUT_POS);
    const LAS int* tp = (const LAS int*)(lds + MISC_OFF + 64);
    const float* g1n = INP(I_G1) + D; const float* gf = INP(I_GF); float* out = OUTP();
    const int ntok = (l == 0) ? MT : ML;
    for (int row = blockIdx.x * NWAVES + wave; row < ntok; row += G * NWAVES) {
        const int bidx = row < ML ? (row >> 12) : 4; const float* m = MOD + ((size_t)l * 5 + bidx) * 12288;
        const int4 ev = *(const int4*)(eid + (size_t)row * 4), pv = *(const int4*)(posb + (size_t)row * 4); const f32x4 gv = *(const f32x4*)(gate + (size_t)row * 4);
        const unsigned char* yr[4];
        yr[0] = Y + ((size_t)tp[ev.x] * 256 + pv.x) * D; yr[1] = Y + ((size_t)tp[ev.y] * 256 + pv.y) * D; yr[2] = Y + ((size_t)tp[ev.z] * 256 + pv.z) * D; yr[3] = Y + ((size_t)tp[ev.w] * 256 + pv.w) * D;
        u32x2 yv[4][4]; f32x4 xv[4][2];
#pragma unroll
        for (int j = 0; j < 4; ++j) { const int col = 8 * (lane + 64 * j);
#pragma unroll
            for (int k = 0; k < 4; ++k) yv[j][k] = *(const u32x2*)(yr[k] + col);
            xv[j][0] = *(const f32x4*)(XR + (size_t)row * D + col); xv[j][1] = *(const f32x4*)(XR + (size_t)row * D + col + 4); }
        float ss = 0.f;
#pragma unroll
        for (int j = 0; j < 4; ++j) { const int col = 8 * (lane + 64 * j);
            f32x4 s0 = (f32x4){0.f, 0.f, 0.f, 0.f}, s1 = s0;
#pragma unroll
            for (int k = 0; k < 4; ++k) { const u32x2 w = yv[j][k];
                const f32x2 a0 = __builtin_amdgcn_cvt_pk_f32_fp8((int)w.x, false), a1 = __builtin_amdgcn_cvt_pk_f32_fp8((int)w.x, true), a2 = __builtin_amdgcn_cvt_pk_f32_fp8((int)w.y, false), a3 = __builtin_amdgcn_cvt_pk_f32_fp8((int)w.y, true);
                s0 += gv[k] * (f32x4){a0.x, a0.y, a1.x, a1.y};
                s1 += gv[k] * (f32x4){a2.x, a2.y, a3.x, a3.y}; }
            const f32x4 gt0 = *(const f32x4*)(m + 5 * 2048 + col), gt1 = *(const f32x4*)(m + 5 * 2048 + col + 4);
            xv[j][0] += gt0 * s0; xv[j][1] += gt1 * s1;
            ss += (xv[j][0].x * xv[j][0].x + xv[j][0].y * xv[j][0].y) + (xv[j][0].z * xv[j][0].z + xv[j][0].w * xv[j][0].w);
            ss += (xv[j][1].x * xv[j][1].x + xv[j][1].y * xv[j][1].y) + (xv[j][1].z * xv[j][1].z + xv[j][1].w * xv[j][1].w); }
        const float rs = rsqrtf(wave_sum(ss) * (1.0f / D) + EPS);
        if (l == 0) {
            const float* m1 = MOD + ((size_t)5 + bidx) * 12288;
#pragma unroll
            for (int j = 0; j < 4; ++j) { const int col = 8 * (lane + 64 * j);
                *(f32x4*)(XR + (size_t)row * D + col) = xv[j][0]; *(f32x4*)(XR + (size_t)row * D + col + 4) = xv[j][1];
                int w0 = 0, w1 = 0;
#pragma unroll
                for (int q = 0; q < 2; ++q) { const f32x4 gg = *(const f32x4*)(g1n + col + 4 * q), sh = *(const f32x4*)(m1 + col + 4 * q), sc = *(const f32x4*)(m1 + 2048 + col + 4 * q);
                    const f32x4 n = ((xv[j][q] * rs) * gg) * (sc + 1.0f) + sh;
                    if (q == 0) { w0 = __builtin_amdgcn_cvt_pk_fp8_f32(n.x, n.y, w0, false); w0 = __builtin_amdgcn_cvt_pk_fp8_f32(n.z, n.w, w0, true); }
                    else { w1 = __builtin_amdgcn_cvt_pk_fp8_f32(n.x, n.y, w1, false); w1 = __builtin_amdgcn_cvt_pk_fp8_f32(n.z, n.w, w1, true); } }
                *(u32x2*)(N + (size_t)row * D + col) = (u32x2){(unsigned)w0, (unsigned)w1}; }
        } else {
            f32x4 gfv[4][2];
#pragma unroll
            for (int j = 0; j < 4; ++j)
#pragma unroll
                for (int q = 0; q < 2; ++q) gfv[j][q] = *(const f32x4*)(gf + 8 * (lane + 64 * j) + 4 * q);
            asm volatile("" ::: "memory");
#pragma unroll
            for (int j = 0; j < 4; ++j) { const int col = 8 * (lane + 64 * j);
                *(f32x4*)(out + (size_t)row * D + col) = (xv[j][0] * rs) * gfv[j][0];
                *(f32x4*)(out + (size_t)row * D + col + 4) = (xv[j][1] * rs) * gfv[j][1]; }
        }
    }
}

__global__ void __launch_bounds__(NTHREADS, 2) mk_fwd(Args a) {
    extern __shared__ __attribute__((aligned(16))) unsigned char lds_raw[];
    LAS unsigned char* lds = (LAS unsigned char*)lds_raw;
    const int tid = threadIdx.x; const int G = gridDim.x;
    if (tid < 16) ((LAS unsigned*)(lds + MISC_OFF))[tid] = 0u;
    if (tid == 64) { LAS unsigned long long* pt = (LAS unsigned long long*)(lds + PT_OFF);
#pragma unroll
        for (int i = 0; i < 26; ++i) pt[i] = (unsigned long long)a.in[i];
        pt[PT_OUT] = (unsigned long long)a.out; pt[PT_WS] = (unsigned long long)a.ws; }
    __syncthreads();
    const bool multi = (a.ph_hi - a.ph_lo) > 1;
    if (multi) (void)xcd_barrier_post((unsigned*)(a.ws + WS_CTL) + CW_BAR, (volatile LAS unsigned*)(lds + MISC_OFF));
    const int lo = a.ph_lo, hi = a.ph_hi;
#define IN(k) (lo <= (k) && (k) < hi)
#define SEAM(k) do { if (IN((k) + 1)) { XcdBarrier _b; _b.bar = (unsigned*)(a.ws + WS_CTL) + CW_BAR; _b.x = xb_xcc_id(); _b.st = (volatile LAS unsigned*)(lds + MISC_OFF); xcd_barrier(_b); if ((MK_REPEAT >> 11) & 1) xcd_barrier(_b); } } while (0)

    if (IN(0)) { REP(0) phase_prologue(lds, 0, G); SEAM(0); }
    if (IN(1)) { phase_modreduce(lds, 0, G); SEAM(1); }
#define LAYER_BODY(l) { \
        const int pb = 2 + 10 * l; \
        if (l == 0 && IN(pb + 0)) { phase_norm1_l0(lds, 0, G); SEAM(pb + 0); } \
        if (IN(pb + 1)) { REP(2) phase_inproj(lds, l, G); SEAM(pb + 1); } \
        if (IN(pb + 2)) { REP(3) phase_prep(lds, l, G); SEAM(pb + 2); } \
        if (IN(pb + 3)) { REP(4) phase_attention(lds, l, G); SEAM(pb + 3); } \
        if (IN(pb + 4)) { REP(5) phase_fixup(lds, l, G); SEAM(pb + 4); } \
        if (IN(pb + 5)) { if (l == 0) { REP(6) phase_outproj(lds, l, G); } else phase_outproj(lds, l, G); SEAM(pb + 5); } \
        if (IN(pb + 6)) { phase_router(lds, l, G); SEAM(pb + 6); } \
        if (IN(pb + 7)) { REP(8) phase_moe_up(lds, l, G); SEAM(pb + 7); } \
        if (IN(pb + 8)) { REP(9) phase_moe_down(lds, l, G); SEAM(pb + 8); } \
        if (IN(pb + 9)) { if (l == 1) { REP(10) phase_combine(lds, l, G); } else phase_combine(lds, l, G); if (l == 0) SEAM(pb + 9); } \
    }
    LAYER_BODY(0)
    LAYER_BODY(1)
#undef LAYER_BODY
#undef IN
#undef SEAM
}

extern "C" void kernel_launch(void* const* d_in, const int* in_sizes, int n_in, void* d_out, int out_size, void* d_ws, size_t ws_size, hipStream_t stream) {
    static int grid = 0;
    if (grid == 0) {
        if (n_in != 26 || in_sizes[0] != ML * D || out_size != ML * D || ws_size < WS_END) {
            fprintf(stderr, "kernel_launch: shape mismatch (n_in %d, in0 %d, out %d, ws %zu need %zu); nothing launched\n", n_in, n_in > 0 ? in_sizes[0] : -1, out_size, ws_size, (size_t)WS_END); grid = -1; return; }
        int dev = 0, cus = 0, per_cu = 0;
        if (hipGetDevice(&dev) != hipSuccess || hipDeviceGetAttribute(&cus, hipDeviceAttributeMultiprocessorCount, dev) != hipSuccess) { grid = -1; return; }
        if (hipFuncSetAttribute((const void*)mk_fwd, hipFuncAttributeMaxDynamicSharedMemorySize, LDS_BYTES) != hipSuccess) { fprintf(stderr, "kernel_launch: hipFuncSetAttribute failed\n"); grid = -1; return; }
        if (hipOccupancyMaxActiveBlocksPerMultiprocessor(&per_cu, (const void*)mk_fwd, NTHREADS, LDS_BYTES) != hipSuccess || per_cu < 1)
            fprintf(stderr, "kernel_launch: note: occupancy query reports %d workgroups per CU\n", per_cu);
        (void)hipGetLastError();
        grid = cus;
    }
    if (grid < 0) return;
    if (hipMemsetAsync((char*)d_ws + WS_CTL, 0, CTL_ZERO_BYTES, stream) != hipSuccess) { fprintf(stderr, "kernel_launch: memset failed\n"); return; }
    Args a{};
    for (int i = 0; i < 26; ++i) a.in[i] = (const float*)d_in[i];
    a.out = (float*)d_out; a.ws = (unsigned char*)d_ws;
#if MK_PER_PHASE_LAUNCH
    for (int p = 0; p < NPHASE; ++p) {
        if (p == 12) continue;
        a.ph_lo = p; a.ph_hi = p + 1;
        hipLaunchKernelGGL(mk_fwd, dim3(grid), dim3(NTHREADS), LDS_BYTES, stream, a);
    }
#else
    a.ph_lo = 0; a.ph_hi = NPHASE;
    hipLaunchKernelGGL(mk_fwd, dim3(grid), dim3(NTHREADS), LDS_BYTES, stream, a);
#endif
    const hipError_t le = hipPeekAtLastError();
    if (le != hipSuccess) fprintf(stderr, "kernel_launch: launch failed: %s\n", hipGetErrorName(le));
}
```

```cpp
#include <hip/hip_runtime.h>
#include <cstdio>
#include <cstdint>

#ifndef MK_PER_PHASE_LAUNCH
#define MK_PER_PHASE_LAUNCH 0
#endif

#ifndef MK_REPEAT
#define MK_REPEAT 0
#endif
#define REP(k) for (int _rep = 0; _rep < 1 + ((MK_REPEAT >> (k)) & 1); ++_rep)
#define GAS __attribute__((address_space(1)))
#define LAS __attribute__((address_space(3)))
typedef unsigned short bf16_t;
typedef short bf16x8 __attribute__((ext_vector_type(8)));
typedef short s16x4 __attribute__((ext_vector_type(4)));
typedef float f32x4 __attribute__((ext_vector_type(4)));
typedef float f32x2 __attribute__((ext_vector_type(2)));
typedef float f32x16 __attribute__((ext_vector_type(16)));
typedef unsigned u32x4 __attribute__((ext_vector_type(4)));
typedef unsigned u32x2 __attribute__((ext_vector_type(2)));
typedef int v8i __attribute__((ext_vector_type(8)));

constexpr int D = 2048, NB = 4, SEQ = 4096, CTX = 256, TK = CTX + SEQ  , DEPTH = 2;
constexpr int ML = NB * SEQ  , MC = NB * CTX  , MT = ML + MC  ;
constexpr int INW = 3584, NE = 32, DE = 1024;
constexpr int OFF_QA = 0, OFF_KA = 1024, OFF_VA = 1280, OFF_QB = 1536, OFF_KB = 2048, OFF_VB = 2560, OFF_UC = 3072;
constexpr float EPS = 1e-6f;
constexpr int MAXROWS = 77824;
constexpr int NWAVES = 8, NTHREADS = 512;

constexpr size_t MiB = 1u << 20;
constexpr size_t WS_CTL = 0, CTL_ZERO_BYTES = 2 * MiB;
constexpr size_t WS_MOD = 1 * MiB;
constexpr size_t WS_ROPE = 2 * MiB;
constexpr size_t WS_ROUT = 3 * MiB;
constexpr size_t WS_XR = 8 * MiB;
constexpr size_t WS_N = 144 * MiB;
constexpr size_t WS_P = 212 * MiB;
constexpr size_t WS_QA = 332 * MiB;
constexpr size_t WS_KA = 366 * MiB;
constexpr size_t WS_VA = 375 * MiB;
constexpr size_t WS_QB = 384 * MiB;
constexpr size_t WS_KB = 401 * MiB;
constexpr size_t WS_VB = 418 * MiB;
constexpr size_t WS_CAT = 435 * MiB;
constexpr size_t WS_OB = 503 * MiB;
constexpr size_t WS_ACT = 571 * MiB;
constexpr size_t WS_Y = 723 * MiB;
constexpr size_t WS_WIN = 1027 * MiB;
constexpr size_t WS_WOUT = 1055 * MiB;
constexpr size_t WS_W1 = 1071 * MiB;
constexpr size_t WS_W2 = 1583 * MiB;
constexpr size_t WS_MODP = 1839 * MiB;
constexpr size_t WS_NF8 = 1871 * MiB;
constexpr size_t WS_END = 1907 * MiB;
static_assert(WS_XR + (size_t)MT * D * 4 <= WS_N && WS_N + (size_t)MT * D * 2 <= WS_P && WS_P + (size_t)MT * INW * 2 <= WS_QA, "ws map 1");
static_assert(WS_QA + (size_t)MT * 1024 * 2 <= WS_KA && WS_KA + (size_t)MT * 256 * 2 <= WS_VA && WS_VA + (size_t)MT * 256 * 2 <= WS_QB, "ws map 2");
static_assert(WS_QB + (size_t)MT * 512 * 2 <= WS_KB && WS_KB + (size_t)MT * 512 * 2 <= WS_VB && WS_VB + (size_t)MT * 512 * 2 <= WS_CAT, "ws map 3");
static_assert(WS_CAT + (size_t)MT * D * 2 <= WS_OB && WS_OB + (size_t)MT * 1024 * 4 <= WS_ACT && WS_ACT + (size_t)MAXROWS * 1024 * 2 <= WS_Y, "ws map 4");
static_assert(WS_Y + (size_t)MAXROWS * 2048 * 2 <= WS_WIN && WS_WIN + (size_t)2 * INW * D * 2 <= WS_WOUT && WS_WOUT + (size_t)2 * D * D * 2 <= WS_W1, "ws map 5");
static_assert(WS_W1 + (size_t)2 * 32 * 2048 * 2048 * 2 <= WS_W2 && WS_W2 + (size_t)2 * 32 * 2048 * 1024 * 2 <= WS_MODP && WS_MODP + (size_t)64 * 10 * 12288 * 4 <= WS_NF8 && WS_NF8 + (size_t)MT * D <= WS_END, "ws map 6");
static_assert(NB * TK == MT, "K/V row count");
constexpr size_t ROUT_EID = 0, ROUT_GATE = (size_t)MT * 16, ROUT_POS = (size_t)MT * 32, ROUT_LIST = (size_t)MT * 48;
static_assert(WS_ROUT + ROUT_LIST + (size_t)32 * MT * 4 <= WS_XR, "router map");
constexpr int CW_BAR = 4096;
constexpr int CW_CNT = 8192;
constexpr int CW_Q = 12288;
static_assert((CW_Q + 512) * 4 <= (int)WS_MOD && CW_CNT + 64 * 64 <= CW_Q, "ctl map");

constexpr int RING_BYTES = 131072;
constexpr int MISC_OFF = RING_BYTES + 1024;
constexpr int LDS_BYTES = 147456;
constexpr int FLS = 2052;

#define VM_WAIT() asm volatile("s_waitcnt vmcnt(0)" ::: "memory")
#define LDS_WAIT() asm volatile("s_waitcnt lgkmcnt(0)" ::: "memory")
__device__ __forceinline__ unsigned cvt_pk_bf16(float lo, float hi) { unsigned r; asm volatile("v_cvt_pk_bf16_f32 %0, %1, %2" : "=v"(r) : "v"(lo), "v"(hi)); return r; }
__device__ __forceinline__ bf16_t f2bf(float f) { return (bf16_t)(cvt_pk_bf16(f, 0.f) & 0xffffu); }
__device__ __forceinline__ float bf2f(bf16_t b) { return __uint_as_float(((unsigned)b) << 16); }
__device__ __forceinline__ int tid_local() { int t = threadIdx.x; asm volatile("" : "+v"(t)); return t; }
template <class T> __device__ __forceinline__ T* uniform_ptr(T* p) {
    const unsigned long long v = (unsigned long long)p;
    const unsigned lo = __builtin_amdgcn_readfirstlane((unsigned)v), hi = __builtin_amdgcn_readfirstlane((unsigned)(v >> 32));
    return (T*)(GAS T*)(((unsigned long long)hi << 32) | lo);
}
__device__ __forceinline__ float wave_sum(float v) {
    v += __builtin_bit_cast(float, __builtin_amdgcn_update_dpp(0, __builtin_bit_cast(int, v), 0xB1, 0xF, 0xF, true));
    v += __builtin_bit_cast(float, __builtin_amdgcn_update_dpp(0, __builtin_bit_cast(int, v), 0x4E, 0xF, 0xF, true));
    v += __builtin_bit_cast(float, __builtin_amdgcn_update_dpp(0, __builtin_bit_cast(int, v), 0x141, 0xF, 0xF, true));
    v += __builtin_bit_cast(float, __builtin_amdgcn_update_dpp(0, __builtin_bit_cast(int, v), 0x140, 0xF, 0xF, true));
    const float a = __builtin_bit_cast(float, __builtin_amdgcn_readlane(__builtin_bit_cast(int, v), 0)), b = __builtin_bit_cast(float, __builtin_amdgcn_readlane(__builtin_bit_cast(int, v), 16));
    const float c = __builtin_bit_cast(float, __builtin_amdgcn_readlane(__builtin_bit_cast(int, v), 32)), d = __builtin_bit_cast(float, __builtin_amdgcn_readlane(__builtin_bit_cast(int, v), 48));
    return (a + b) + (c + d);
}

constexpr int PT_OFF = 131072 + 1024 + 3072;
constexpr int PT_OUT = 26, PT_WS = 27;
__device__ __forceinline__ unsigned long long ldp_raw(LAS unsigned char* lds, int i) {
    const u32x2 v = *(const LAS u32x2*)(lds + PT_OFF + 8 * i);
    const unsigned lo = __builtin_amdgcn_readfirstlane(v.x), hi = __builtin_amdgcn_readfirstlane(v.y);
    return ((unsigned long long)hi << 32) | lo;
}
#define INP(i) ((const float*)(const GAS float*)ldp_raw(lds, (i)))
#define WSP() ((unsigned char*)(GAS unsigned char*)ldp_raw(lds, PT_WS))
#define OUTP() ((float*)(GAS float*)ldp_raw(lds, PT_OUT))
#define PHASE_FN __device__ __forceinline__ void

#define XB_TMO      128
#define XB_XCNT(j)  (256  + 64 * (j))
#define XB_XSUB(j)  (1280 + 64 * (j))
#define XB_XGEN(j)  (2304 + 64 * (j))
#define XB_TOP      3328
#define XB_TOPGEN   3392
#define XCD_BAR_WORDS 3456
#define XB_SPIN_CAP (1u << 18)
__device__ __forceinline__ unsigned xb_ld(unsigned* p)              { return __hip_atomic_load(p, __ATOMIC_RELAXED, __HIP_MEMORY_SCOPE_AGENT); }
__device__ __forceinline__ unsigned xb_add(unsigned* p, unsigned v) { return __hip_atomic_fetch_add(p, v, __ATOMIC_RELAXED, __HIP_MEMORY_SCOPE_AGENT); }
__device__ __forceinline__ unsigned xb_xcc_id() { return (unsigned)__builtin_amdgcn_s_getreg((3 << 11) | 20) & 0xFu; }
#define XB_SPIN(cond, bar) do { unsigned _sp = 0; while (cond) { __builtin_amdgcn_s_sleep(1); \
    if ((++_sp & 255u) == 0u) { if (xb_ld(&(bar)[XB_TMO])) break; if (_sp > XB_SPIN_CAP) { atomicAdd(&(bar)[XB_TMO], 1u); break; } } } } while (0)
struct XcdBarrier { unsigned* bar; unsigned x; volatile LAS unsigned* st; };
__device__ __forceinline__ XcdBarrier xcd_barrier_post(unsigned* bar, volatile LAS unsigned* st) {
    XcdBarrier b; b.bar = bar; b.x = xb_xcc_id(); b.st = st;
    if (threadIdx.x == 0) (void)xb_add(&bar[XB_XCNT(b.x)], 1u);
    return b;
}
__device__ __forceinline__ void xcd_barrier_complete(unsigned* bar, unsigned x, unsigned& nloc, unsigned& nx) {
    const unsigned G = gridDim.x * gridDim.y * gridDim.z;
    unsigned sum, cnt, mine, sp = 0u;
    for (;;) {
        sum = 0u; cnt = 0u; mine = 0u;
#pragma unroll
        for (unsigned j = 0; j < 16; ++j) { const unsigned c = xb_ld(&bar[XB_XCNT(j)]); sum += c; cnt += (c > 0u) ? 1u : 0u; mine = (j == x) ? c : mine; }
        if (sum == G) break;
        __builtin_amdgcn_s_sleep(1);
        if ((++sp & 255u) == 0u) { if (xb_ld(&bar[XB_TMO])) break; if (sp > XB_SPIN_CAP) { atomicAdd(&bar[XB_TMO], 1u); break; } }
    }
    nloc = mine > 0u ? mine : 1u; nx = cnt > 0u ? cnt : 1u;
}
__device__ __forceinline__ void xcd_barrier(const XcdBarrier& b) {
    asm volatile("s_waitcnt vmcnt(0)" ::: "memory");
    __syncthreads();
    if (threadIdx.x == 0) {
        unsigned* bar = b.bar;
        __builtin_amdgcn_s_waitcnt(0);
        unsigned nloc = b.st[0], nx = b.st[1];
        if (nloc == 0u) { xcd_barrier_complete(bar, b.x, nloc, nx); b.st[0] = nloc; b.st[1] = nx; }
        const unsigned old = xb_add(&bar[XB_XSUB(b.x)], 1u);
        const unsigned gen = old / nloc;
        if (old + 1u == (gen + 1u) * nloc) {
            __builtin_amdgcn_fence(__ATOMIC_RELEASE, "agent");
            asm volatile("s_waitcnt vmcnt(0)" ::: "memory");
            const unsigned og = xb_add(&bar[XB_TOP], 1u);
            const unsigned tg = og / nx;
            if (og + 1u == (tg + 1u) * nx) xb_add(&bar[XB_TOPGEN], 1u);
            else XB_SPIN(xb_ld(&bar[XB_TOPGEN]) == tg, bar);
            __builtin_amdgcn_fence(__ATOMIC_ACQUIRE, "agent");
            xb_add(&bar[XB_XGEN(b.x)], 1u);
            asm volatile("s_waitcnt vmcnt(0)" ::: "memory");
        } else {
            XB_SPIN(xb_ld(&bar[XB_XGEN(b.x)]) == gen, bar);
            __builtin_amdgcn_fence(__ATOMIC_ACQUIRE, "agent");
            asm volatile("s_waitcnt vmcnt(0)" ::: "memory");
        }
    }
    __syncthreads();
}

namespace pg8 {
constexpr int BM = 256, BK = 64, HALF = 128, HTB = HALF * BK * 2, STAGE_BYTES = 8 * HTB, NXCD = 8, WGM = 8;
__host__ __device__ __forceinline__ int lds_byte(int r, int c) { const int st = (r >> 4) * 2 + (c >> 5), rr = r & 15, cc = c & 31, ob = rr * 64 + cc * 2; return st * 1024 + (ob ^ (((ob >> 9) & 1) << 5)); }
__host__ __device__ __forceinline__ void stage_rc(int b, int& R, int& C) { const int st = b / 1024, sb = b % 1024, swz = sb ^ (((sb >> 9) & 1) << 5); R = (st >> 1) * 16 + swz / 64; C = (st & 1) * 32 + (swz % 64) / 2; }
__host__ __device__ __forceinline__ int perm32(int rho) { const int n = rho >> 4, i = rho & 15; return 8 * (i >> 2) + 4 * n + (i & 3); }

__host__ __device__ __forceinline__ int f8_f(int rr) { return (0x9C >> (2 * (rr >> 2))) & 3; }
__host__ __device__ __forceinline__ int lds_byte8(int r, int b) { const int st = (r >> 4) * 2 + (b >> 6), rr = r & 15, q = (b >> 4) & 3; return st * 1024 + rr * 64 + ((q ^ f8_f(rr)) << 4) + (b & 15); }
__host__ __device__ __forceinline__ void stage_rc8(int o, int& R, int& Cb) { const int st = o / 1024, w = o % 1024, rr = w / 64, slot = (w % 64) / 16; R = (st >> 1) * 16 + rr; Cb = (st & 1) * 64 + ((slot ^ f8_f(rr)) << 4); }
template <int ESZ> __host__ __device__ __forceinline__ void stage_rcb(int o, int& R, int& Cb) { if constexpr (ESZ == 2) { int C; stage_rc(o, R, C); Cb = 2 * C; } else stage_rc8(o, R, Cb); }
struct Unit { int pm, pn, e; };

template <int K_, int ESZ_> struct DenseSched {
    static constexpr int K = K_, ESZ = ESZ_, SCALE_B = (ESZ_ == 1) ? 121 : 127;
    static constexpr bool GATHER_A = false;
    int nM, nN, nwg, G, c; const char* A; const char* Bt;
    __device__ void init(const void* A_, const void* Bt_, int M, int N, int G_, int c_) { A = (const char*)A_; Bt = (const char*)Bt_; nM = M / BM; nN = N / BM; nwg = nM * nN; G = G_; c = c_; }
    __device__ __forceinline__ bool next(int i, Unit& u) const {
        const long L = (long)i * G + c; if (L >= nwg) return false;
        int wgid = (int)L; { const int q = nwg / NXCD, r = nwg % NXCD, xcd = wgid % NXCD, off = wgid / NXCD; wgid = (xcd < r ? xcd * (q + 1) : r * (q + 1) + (xcd - r) * q) + off; }
        const int nig = WGM * nN, gid = wgid / nig, fm = gid * WGM, gsz = (nM - fm) < WGM ? (nM - fm) : WGM;
        u.pm = fm + ((wgid % nig) % gsz); u.pn = (wgid % nig) / gsz; u.e = 0; return true;
    }
    __device__ __forceinline__ int row0(const Unit& u) const { return u.pm * BM; }
    __device__ __forceinline__ const char* a_base() const { return A; }
    __device__ __forceinline__ const char* b_base(const Unit& u) const { return Bt + (size_t)u.pn * BM * K * ESZ; }
    __device__ __forceinline__ void a_voff(const Unit& u, int tid, unsigned (&v)[2][2]) const {
#pragma unroll
        for (int i = 0; i < 2; ++i) { int R, Cb; stage_rcb<ESZ>(tid * 16 + i * 8192, R, Cb);
#pragma unroll
            for (int h = 0; h < 2; ++h) v[h][i] = (unsigned)((u.pm * BM + h * HALF + R) * (K * ESZ) + Cb); }
    }
};
template <bool GATHER, int K_, int ESZ_> struct MoeSched {
    static constexpr int K = K_, ESZ = ESZ_, SCALE_B = (K_ == 2048) ? 121 : 122;
    static constexpr size_t BSTRIDE = (size_t)2048 * K * ESZ;
    static constexpr bool GATHER_A = GATHER;
    const LAS int* tp; const LAS int* cnt; int start, end, j, stride; const char* A; const char* Bt; const int* list;
    __device__ void init(const LAS int* tp_, const LAS int* cnt_, const void* A_, const void* Bt_, const int* list_, int G, int c) {
        tp = tp_; cnt = cnt_; A = (const char*)A_; Bt = (const char*)Bt_; list = list_;
        const int U = 8 * tp[NE];
        if (G == 256) { const int x = c & 7; j = c >> 3; stride = 32; start = (int)(((long)x * U) / 8); end = (int)(((long)(x + 1) * U) / 8); }
        else { start = 0; end = U; j = c; stride = G; }
    }
    __device__ __forceinline__ bool next(int i, Unit& u) const {
        const int idx = start + i * stride + j; if (idx >= end) return false;
        int e = 0;
        for (int q = 1; q < NE; ++q) e += (8 * tp[q] <= idx) ? 1 : 0;
        e = __builtin_amdgcn_readfirstlane(e);
        const int tiles = tp[e + 1] - tp[e], r = idx - 8 * tp[e];
        const int gi = r >> 5, fm = gi * 4, gsz = (tiles - fm) < 4 ? (tiles - fm) : 4, w = r - 32 * gi;
        u.e = e; u.pm = __builtin_amdgcn_readfirstlane(fm + (w % gsz)); u.pn = __builtin_amdgcn_readfirstlane(w / gsz); return true;
    }
    __device__ __forceinline__ int row0(const Unit& u) const { return __builtin_amdgcn_readfirstlane((tp[u.e] + u.pm) * BM); }
    __device__ __forceinline__ const char* a_base() const { return A; }
    __device__ __forceinline__ const char* b_base(const Unit& u) const { return Bt + (size_t)u.e * BSTRIDE + (size_t)u.pn * BM * K * ESZ; }
    __device__ __forceinline__ void a_voff(const Unit& u, int tid, unsigned (&v)[2][2]) const {
        if constexpr (GATHER) {
            const int* lp = list + (size_t)u.e * MT + u.pm * BM;
            const int nv = cnt[u.e] - u.pm * BM;
            int tok[2][2], Cc[2];
#pragma unroll
            for (int i = 0; i < 2; ++i) { int R; stage_rcb<ESZ>(tid * 16 + i * 8192, R, Cc[i]);
#pragma unroll
                for (int h = 0; h < 2; ++h) { const int lr = h * HALF + R; tok[h][i] = lp[lr < nv ? lr : 0]; } }
            asm volatile("s_waitcnt vmcnt(0)" ::: "memory");
#pragma unroll
            for (int h = 0; h < 2; ++h)
#pragma unroll
                for (int i = 0; i < 2; ++i) v[h][i] = (unsigned)(tok[h][i] * (K * ESZ) + Cc[i]);
        } else {
            const int r0 = row0(u);
#pragma unroll
            for (int i = 0; i < 2; ++i) { int R, Cb; stage_rcb<ESZ>(tid * 16 + i * 8192, R, Cb);
#pragma unroll
                for (int h = 0; h < 2; ++h) v[h][i] = (unsigned)((r0 + h * HALF + R) * (K * ESZ) + Cb); }
        }
    }
};

struct EpiBf16 {
    static constexpr bool PERM = true;
    bf16_t* O; int ldc; const float* bias; int bias_estride;
    __device__ __forceinline__ void operator()(const f32x4 (&acc)[2][2][4][2], const Unit& u, int urow0, int wr, int wc, int fr, int fq) const {
        const int row0 = urow0 + wr * 64 + fr; const int col0 = u.pn * BM + wc * 32 + 8 * fq;
        const float* bp = bias ? bias + (size_t)u.e * bias_estride + col0 : nullptr;
        f32x4 bv[2][2];
#pragma unroll
        for (int bj = 0; bj < 2; ++bj)
#pragma unroll
            for (int n = 0; n < 2; ++n) bv[bj][n] = bp ? *(const f32x4*)(bp + bj * HALF + 4 * n) : (f32x4){0.f, 0.f, 0.f, 0.f};
#pragma unroll
        for (int ai = 0; ai < 2; ++ai)
#pragma unroll
            for (int m = 0; m < 4; ++m) { bf16_t* rowp = O + (size_t)(row0 + ai * HALF + m * 16) * ldc + col0;
#pragma unroll
                for (int bj = 0; bj < 2; ++bj) { const f32x4 v0 = acc[ai][bj][m][0] + bv[bj][0], v1 = acc[ai][bj][m][1] + bv[bj][1];
                    u32x4 w; w.x = cvt_pk_bf16(v0[0], v0[1]); w.y = cvt_pk_bf16(v0[2], v0[3]); w.z = cvt_pk_bf16(v1[0], v1[1]); w.w = cvt_pk_bf16(v1[2], v1[3]);
                    *(u32x4*)(rowp + bj * HALF) = w; } }
    }
};
struct EpiF8 {
    static constexpr bool PERM = true;
    unsigned char* O; int ldc; const float* bias; int bias_estride;
    __device__ __forceinline__ void operator()(const f32x4 (&acc)[2][2][4][2], const Unit& u, int urow0, int wr, int wc, int fr, int fq) const {
        const int row0 = urow0 + wr * 64 + fr; const int col0 = u.pn * BM + wc * 32 + 8 * fq;
        const float* bp = bias + (size_t)u.e * bias_estride + col0;
        f32x4 bv[2][2];
#pragma unroll
        for (int bj = 0; bj < 2; ++bj)
#pragma unroll
            for (int n = 0; n < 2; ++n) bv[bj][n] = *(const f32x4*)(bp + bj * HALF + 4 * n);
#pragma unroll
        for (int ai = 0; ai < 2; ++ai)
#pragma unroll
            for (int m = 0; m < 4; ++m) { unsigned char* rowp = O + (size_t)(row0 + ai * HALF + m * 16) * ldc + col0;
#pragma unroll
                for (int bj = 0; bj < 2; ++bj) { const f32x4 v0 = acc[ai][bj][m][0] + bv[bj][0], v1 = acc[ai][bj][m][1] + bv[bj][1];
                    int w0 = 0, w1 = 0; w0 = __builtin_amdgcn_cvt_pk_fp8_f32(v0[0], v0[1], w0, false); w0 = __builtin_amdgcn_cvt_pk_fp8_f32(v0[2], v0[3], w0, true);
                    w1 = __builtin_amdgcn_cvt_pk_fp8_f32(v1[0], v1[1], w1, false); w1 = __builtin_amdgcn_cvt_pk_fp8_f32(v1[2], v1[3], w1, true);
                    *(u32x2*)(rowp + bj * HALF) = (u32x2){(unsigned)w0, (unsigned)w1}; } }
    }
};
__device__ __forceinline__ float swiglu1(float g, float l) {
    g = fminf(g, 7.0f); l = fminf(fmaxf(l, -7.0f), 7.0f);
    const float sg = __builtin_amdgcn_rcpf(1.0f + __builtin_amdgcn_exp2f(-1.702f * 1.4426950408889634f * g));
    return g * sg * (l + 1.0f);
}
struct EpiSwiglu {
    static constexpr bool PERM = true;
    unsigned char* O; const float* bias;
    __device__ __forceinline__ void operator()(const f32x4 (&acc)[2][2][4][2], const Unit& u, int urow0, int wr, int wc, int fr, int fq) const {
        const int row0 = urow0 + wr * 64 + fr; const int col0 = u.pn * BM + wc * 32 + 8 * fq;
        const float* bp = bias + (size_t)u.e * 2048 + col0;
        f32x4 bv[2][2];
#pragma unroll
        for (int bj = 0; bj < 2; ++bj)
#pragma unroll
            for (int n = 0; n < 2; ++n) bv[bj][n] = *(const f32x4*)(bp + bj * HALF + 4 * n);
#pragma unroll
        for (int ai = 0; ai < 2; ++ai)
#pragma unroll
            for (int m = 0; m < 4; ++m) { unsigned char* rowp = O + (size_t)(row0 + ai * HALF + m * 16) * DE + (col0 >> 1);
#pragma unroll
                for (int bj = 0; bj < 2; ++bj) { const f32x4 v0 = acc[ai][bj][m][0] + bv[bj][0], v1 = acc[ai][bj][m][1] + bv[bj][1];
                    int w = 0; w = __builtin_amdgcn_cvt_pk_fp8_f32(swiglu1(v0[0], v0[1]), swiglu1(v0[2], v0[3]), w, false); w = __builtin_amdgcn_cvt_pk_fp8_f32(swiglu1(v1[0], v1[1]), swiglu1(v1[2], v1[3]), w, true);
                    *(int*)(rowp + bj * (HALF / 2)) = w; } }
    }
};
__device__ __forceinline__ void unpack_bf16x8(const u32x4 w, f32x4& lo, f32x4& hi) {
    lo = (f32x4){__uint_as_float(w.x << 16), __uint_as_float(w.x & 0xffff0000u), __uint_as_float(w.y << 16), __uint_as_float(w.y & 0xffff0000u)};
    hi = (f32x4){__uint_as_float(w.z << 16), __uint_as_float(w.z & 0xffff0000u), __uint_as_float(w.w << 16), __uint_as_float(w.w & 0xffff0000u)};
}
__device__ __forceinline__ u32x4 pack_bf16x8(const f32x4 lo, const f32x4 hi) {
    u32x4 w; w.x = cvt_pk_bf16(lo[0], lo[1]); w.y = cvt_pk_bf16(lo[2], lo[3]); w.z = cvt_pk_bf16(hi[0], hi[1]); w.w = cvt_pk_bf16(hi[2], hi[3]); return w;
}
struct EpiResid {
    static constexpr bool PERM = true;
    const float* xin; const float* cin; const bf16_t* xr_in; bf16_t* xr_out; const float* mod; int layer;
    __device__ __forceinline__ void operator()(const f32x4 (&acc)[2][2][4][2], const Unit& u, int urow0, int wr, int wc, int fr, int fq) const {
        const int row0 = urow0 + wr * 64 + fr, col0 = u.pn * BM + wc * 32 + 8 * fq;
        const int bidx = urow0 < ML ? (urow0 >> 12) : 4;
        const float* gp = mod + (size_t)bidx * 12288 + 2 * 2048 + col0;
        f32x4 g[2][2];
#pragma unroll
        for (int bj = 0; bj < 2; ++bj)
#pragma unroll
            for (int n = 0; n < 2; ++n) g[bj][n] = *(const f32x4*)(gp + bj * HALF + 4 * n);
        if (layer == 0) {
            const float* bbase = urow0 < ML ? xin : cin - (size_t)ML * D;
#pragma unroll
            for (int ai = 0; ai < 2; ++ai)
#pragma unroll
                for (int mp = 0; mp < 2; ++mp) {
                    f32x4 bs[2][2][2];
#pragma unroll
                    for (int mq = 0; mq < 2; ++mq) { const int row = row0 + ai * HALF + (2 * mp + mq) * 16; const float* bp = bbase + (size_t)row * D + col0;
#pragma unroll
                        for (int bj = 0; bj < 2; ++bj)
#pragma unroll
                            for (int n = 0; n < 2; ++n) bs[mq][bj][n] = *(const f32x4*)(bp + bj * HALF + 4 * n); }
#pragma unroll
                    for (int mq = 0; mq < 2; ++mq) { const int m = 2 * mp + mq; const int row = row0 + ai * HALF + m * 16; bf16_t* op = xr_out + (size_t)row * D + col0;
#pragma unroll
                        for (int bj = 0; bj < 2; ++bj) *(u32x4*)(op + bj * HALF) = pack_bf16x8(bs[mq][bj][0] + g[bj][0] * acc[ai][bj][m][0], bs[mq][bj][1] + g[bj][1] * acc[ai][bj][m][1]); }
                    asm volatile("" ::: "memory"); }
        } else {
#pragma unroll
            for (int ai = 0; ai < 2; ++ai) {
                u32x4 bw[4][2];
#pragma unroll
                for (int m = 0; m < 4; ++m) { const int row = row0 + ai * HALF + m * 16; const bf16_t* bp = xr_in + (size_t)row * D + col0;
#pragma unroll
                    for (int bj = 0; bj < 2; ++bj) bw[m][bj] = *(const u32x4*)(bp + bj * HALF); }
#pragma unroll
                for (int m = 0; m < 4; ++m) { const int row = row0 + ai * HALF + m * 16; bf16_t* op = xr_out + (size_t)row * D + col0;
#pragma unroll
                    for (int bj = 0; bj < 2; ++bj) { f32x4 b0, b1; unpack_bf16x8(bw[m][bj], b0, b1);
                        *(u32x4*)(op + bj * HALF) = pack_bf16x8(b0 + g[bj][0] * acc[ai][bj][m][0], b1 + g[bj][1] * acc[ai][bj][m][1]); } }
                asm volatile("" ::: "memory"); }
        }
    }
};

template <class Epi, class Sched>
__device__ __forceinline__ void gemm_phase(LAS unsigned char* lds, const Sched& S, const Epi& E) {
    constexpr int K = Sched::K, ESZ = Sched::ESZ;
    const int tid = tid_local(), wid = __builtin_amdgcn_readfirstlane(tid >> 6), lane = tid & 63, wr = wid >> 2, wc = wid & 3, fr = lane & 15, fq = lane >> 4;
    constexpr int nt = K * ESZ / 128;
    constexpr int SCALE_A = 127, SCALE_B = Sched::SCALE_B;
    unsigned voffB[2], voffA[2][2];
#pragma unroll
    for (int i = 0; i < 2; ++i) { int R, Cb; stage_rcb<ESZ>(tid * 16 + i * 8192, R, Cb); const int Rb = Epi::PERM ? ((R & ~31) + perm32(R & 31)) : R; voffB[i] = (unsigned)(Rb * (K * ESZ) + Cb); }
    constexpr size_t kstep = 128;
    constexpr size_t hstep = (size_t)HALF * K * ESZ;
    const unsigned ldsw = (unsigned)wid * 1024u;
    const int aoff = ESZ == 2 ? lds_byte(wr * 64 + fr, fq * 8) : lds_byte8(wr * 64 + fr, fq * 32), boff = ESZ == 2 ? lds_byte(wc * 32 + fr, fq * 8) : lds_byte8(wc * 32 + fr, fq * 32);
    const int aoff2 = aoff ^ 16, boff2 = boff ^ 16;
#define PG8_SA(b, h) (((b) * 2 + (h)) * HTB)
#define PG8_SB(b, h) ((4 + (b) * 2 + (h)) * HTB)
#define PG8_STAGE(bufoff, gbase, voff) do { _Pragma("unroll") for (int _i = 0; _i < 2; ++_i) \
        __builtin_amdgcn_global_load_lds((const unsigned*)((const char*)(gbase) + (voff)[_i]), (LAS unsigned*)(lds + (bufoff) + ldsw + _i * 8192), 16, 0, 0); } while (0)
#define PG8_LDA(dst, b, h) do { if constexpr (ESZ == 2) { _Pragma("unroll") for (int m = 0; m < 4; ++m) _Pragma("unroll") for (int k = 0; k < 2; ++k) dst[m][k] = *(const LAS bf16x8*)(lds + PG8_SA(b, h) + aoff + m * 2048 + k * 1024); } \
        else { _Pragma("unroll") for (int m = 0; m < 4; ++m) { const u32x4 _lo = *(const LAS u32x4*)(lds + PG8_SA(b, h) + aoff + m * 2048), _hi = *(const LAS u32x4*)(lds + PG8_SA(b, h) + aoff2 + m * 2048); \
            dst##8[m] = (v8i){(int)_lo.x, (int)_lo.y, (int)_lo.z, (int)_lo.w, (int)_hi.x, (int)_hi.y, (int)_hi.z, (int)_hi.w}; } } } while (0)
#define PG8_LDB(dst, b, h) do { if constexpr (ESZ == 2) { _Pragma("unroll") for (int n = 0; n < 2; ++n) _Pragma("unroll") for (int k = 0; k < 2; ++k) dst[n][k] = *(const LAS bf16x8*)(lds + PG8_SB(b, h) + boff + n * 2048 + k * 1024); } \
        else { _Pragma("unroll") for (int n = 0; n < 2; ++n) { const u32x4 _lo = *(const LAS u32x4*)(lds + PG8_SB(b, h) + boff + n * 2048), _hi = *(const LAS u32x4*)(lds + PG8_SB(b, h) + boff2 + n * 2048); \
            dst##8[n] = (v8i){(int)_lo.x, (int)_lo.y, (int)_lo.z, (int)_lo.w, (int)_hi.x, (int)_hi.y, (int)_hi.z, (int)_hi.w}; } } } while (0)
#define PG8_MMA(ai, bj, At, Bt) do { __builtin_amdgcn_s_setprio(1); if constexpr (ESZ == 2) { _Pragma("unroll") for (int m = 0; m < 4; ++m) _Pragma("unroll") for (int n = 0; n < 2; ++n) _Pragma("unroll") for (int k = 0; k < 2; ++k) \
        acc[ai][bj][m][n] = __builtin_amdgcn_mfma_f32_16x16x32_bf16(Bt[n][k], At[m][k], acc[ai][bj][m][n], 0, 0, 0); } \
        else { _Pragma("unroll") for (int m = 0; m < 4; ++m) _Pragma("unroll") for (int n = 0; n < 2; ++n) \
        acc[ai][bj][m][n] = __builtin_amdgcn_mfma_scale_f32_16x16x128_f8f6f4(Bt##8[n], At##8[m], acc[ai][bj][m][n], 0, 0, 0, SCALE_B, 0, SCALE_A); } __builtin_amdgcn_s_setprio(0); } while (0)
#define PG8_WAIT_V(n) asm volatile("s_waitcnt vmcnt(" #n ")" ::: "memory")
#define PG8_WAIT_L(n) asm volatile("s_waitcnt lgkmcnt(" #n ")" ::: "memory")
#define PG8_BAR __builtin_amdgcn_s_barrier()
#define PG8_SCHED __builtin_amdgcn_sched_barrier(0)
    Unit cur, nxt; int ui = 0;
    if (!S.next(0, cur)) return;
    f32x4 acc[2][2][4][2];
#pragma unroll
    for (int a = 0; a < 2; ++a)
#pragma unroll
        for (int b = 0; b < 2; ++b)
#pragma unroll
            for (int m = 0; m < 4; ++m)
#pragma unroll
                for (int n = 0; n < 2; ++n) acc[a][b][m][n] = (f32x4){0.f, 0.f, 0.f, 0.f};
    bf16x8 At[4][2], B0[2][2], B1[2][2];
    v8i At8[4], B08[2], B18[2];
    const char* const Ab = S.a_base();
    const char* cB = S.b_base(cur);
    S.a_voff(cur, tid, voffA);
    PG8_STAGE(PG8_SB(0, 0), cB, voffB); PG8_STAGE(PG8_SB(0, 1), cB + hstep, voffB); PG8_STAGE(PG8_SA(0, 0), Ab, voffA[0]); PG8_STAGE(PG8_SA(0, 1), Ab, voffA[1]);
    if (wr == 1) PG8_BAR;
    PG8_WAIT_V(2); PG8_BAR;
    PG8_STAGE(PG8_SB(1, 0), cB + kstep, voffB); PG8_STAGE(PG8_SA(1, 0), Ab + kstep, voffA[0]); PG8_STAGE(PG8_SB(1, 1), cB + hstep + kstep, voffB);
    PG8_WAIT_V(6); PG8_BAR;
    for (;;) {
        const bool has_next = S.next(ui + 1, nxt);
        const char* nB = has_next ? S.b_base(nxt) : cB;
        unsigned voffN[2][2];
        if constexpr (Sched::GATHER_A) { if (has_next) S.a_voff(nxt, tid, voffN); }
#pragma unroll 1
        for (int t = 0; t < nt; t += 2) {
            const bool last = (t == nt - 2);
            const char* a1 = Ab + (size_t)(t + 1) * kstep;
            const char* a2 = last ? Ab : Ab + (size_t)(t + 2) * kstep; const char* b2 = last ? nB : cB + (size_t)(t + 2) * kstep;
            const char* a3 = a2 + kstep; const char* b3 = b2 + kstep;
            PG8_LDB(B0, 0, 0); PG8_LDB(B1, 0, 1); PG8_SCHED; PG8_LDA(At, 0, 0); PG8_STAGE(PG8_SA(1, 1), a1, voffA[1]);
            if (last && has_next) {
                if constexpr (Sched::GATHER_A) { voffA[0][0] = voffN[0][0]; voffA[0][1] = voffN[0][1]; voffA[1][0] = voffN[1][0]; voffA[1][1] = voffN[1][1]; }
                else S.a_voff(nxt, tid, voffA); }
            PG8_WAIT_V(8); PG8_WAIT_L(0); PG8_BAR; PG8_MMA(0, 0, At, B0); PG8_MMA(0, 1, At, B1); PG8_BAR; PG8_SCHED;
            PG8_LDA(At, 0, 1); PG8_STAGE(PG8_SB(0, 0), b2, voffB); PG8_STAGE(PG8_SB(0, 1), b2 + hstep, voffB); PG8_STAGE(PG8_SA(0, 0), a2, voffA[0]);
            PG8_WAIT_V(8); PG8_WAIT_L(0); PG8_BAR; PG8_MMA(1, 0, At, B0); PG8_MMA(1, 1, At, B1); PG8_BAR; PG8_SCHED;
            PG8_LDB(B0, 1, 0); PG8_LDB(B1, 1, 1); PG8_SCHED; PG8_LDA(At, 1, 0); PG8_STAGE(PG8_SA(0, 1), a2, voffA[1]);
            PG8_WAIT_V(8); PG8_WAIT_L(0); PG8_BAR; PG8_MMA(0, 0, At, B0); PG8_MMA(0, 1, At, B1); PG8_BAR; PG8_SCHED;
            PG8_LDA(At, 1, 1); PG8_STAGE(PG8_SB(1, 0), b3, voffB); PG8_STAGE(PG8_SB(1, 1), b3 + hstep, voffB); PG8_STAGE(PG8_SA(1, 0), a3, voffA[0]);
            PG8_WAIT_V(8); PG8_WAIT_L(0); PG8_BAR; PG8_MMA(1, 0, At, B0); PG8_MMA(1, 1, At, B1); PG8_BAR; PG8_SCHED;
        }
        if (wr == 0) PG8_BAR;
        E(acc, cur, S.row0(cur), wr, wc, fr, fq);
        if constexpr (Epi::PERM) { if ((MK_REPEAT >> 12) & 1) E(acc, cur, S.row0(cur), wr, wc, fr, fq); }
        if (!has_next) break;
#pragma unroll
        for (int a = 0; a < 2; ++a)
#pragma unroll
            for (int b = 0; b < 2; ++b)
#pragma unroll
                for (int m = 0; m < 4; ++m)
#pragma unroll
                    for (int n = 0; n < 2; ++n) acc[a][b][m][n] = (f32x4){0.f, 0.f, 0.f, 0.f};
        cur = nxt; cB = nB; ++ui;
        if (wr == 1) PG8_BAR;
    }
    PG8_WAIT_V(0);
    PG8_BAR;
#undef PG8_SA
#undef PG8_SB
#undef PG8_STAGE
#undef PG8_LDA
#undef PG8_LDB
#undef PG8_MMA
#undef PG8_WAIT_V
#undef PG8_WAIT_L
#undef PG8_BAR
#undef PG8_SCHED
}
}

namespace att {
constexpr int NW = 8, QBLK = 32, KVBLK = 64, DV = 128;
constexpr float THR = 8.f;
constexpr int SHM_V = KVBLK * DV * 2, SHM_K = KVBLK * 128 * 2, SHM_ATTN = 2 * SHM_V + 2 * SHM_K + NW * 64 * 4;
#define SBAR() __builtin_amdgcn_sched_barrier(0)
__device__ __forceinline__ int crow(int r, int hi) { return (r & 3) + 8 * (r >> 2) + 4 * hi; }
template <int DQK> __device__ __forceinline__ int kswz(int row, int colB) {
    if constexpr (DQK == 128) return row * 256 + (colB ^ ((row & 15) << 4));
    else return row * 128 + (colB ^ (((row >> 1) & 7) << 4));
}
template <int DQK> __device__ __forceinline__ void partialSM(f32x16& p0, f32x16& p1, float& m_reg, float& mn, float& alpha) {
    constexpr float SCALE = (DQK == 128) ? 0.088388347648318440f : 0.125f;
    constexpr float Cc = SCALE * 1.4426950408889634f;
    float pmax = p0[0];
#pragma unroll
    for (int r = 1; r < 16; ++r) pmax = fmaxf(pmax, p0[r]);
#pragma unroll
    for (int r = 0; r < 16; ++r) pmax = fmaxf(pmax, p1[r]);
    { auto rr = __builtin_amdgcn_permlane32_swap(__float_as_uint(pmax), __float_as_uint(pmax), false, false);
      pmax = fmaxf(__uint_as_float(rr[0]), __uint_as_float(rr[1])); }
    if (__builtin_expect(__all(pmax - m_reg <= THR / SCALE), 1)) { mn = m_reg; alpha = 1.f; }
    else { mn = fmaxf(m_reg, pmax); alpha = __builtin_amdgcn_exp2f((m_reg - mn) * Cc); m_reg = mn; }
    const float mnC = -mn * Cc;
#pragma unroll
    for (int r = 0; r < 16; ++r) p0[r] = fmaf(p0[r], Cc, mnC);
#pragma unroll
    for (int r = 0; r < 16; ++r) p1[r] = fmaf(p1[r], Cc, mnC);
#pragma unroll
    for (int r = 0; r < 16; ++r) p0[r] = __builtin_amdgcn_exp2f(p0[r]);
}
__device__ __forceinline__ void finishSM(f32x16& p0, f32x16& p1, float alpha, float& l_reg, bf16x8& pa0, bf16x8& pa1, bf16x8& pa2, bf16x8& pa3) {
#pragma unroll
    for (int r = 0; r < 16; ++r) p1[r] = __builtin_amdgcn_exp2f(p1[r]);
    float ps = 0;
#pragma unroll
    for (int r = 0; r < 16; ++r) ps += p0[r];
#pragma unroll
    for (int r = 0; r < 16; ++r) ps += p1[r];
    { auto rr = __builtin_amdgcn_permlane32_swap(__float_as_uint(ps), __float_as_uint(ps), false, false);
      ps = __uint_as_float(rr[0]) + __uint_as_float(rr[1]); }
    l_reg = l_reg * alpha + ps;
#define PK4(P, BASE, OUT) do { unsigned a0 = cvt_pk_bf16(P[BASE + 0], P[BASE + 1]), a1 = cvt_pk_bf16(P[BASE + 2], P[BASE + 3]);   \
    unsigned b0 = cvt_pk_bf16(P[BASE + 4], P[BASE + 5]), b1 = cvt_pk_bf16(P[BASE + 6], P[BASE + 7]);                              \
    auto r0 = __builtin_amdgcn_permlane32_swap(a0, b0, false, false); auto r1 = __builtin_amdgcn_permlane32_swap(a1, b1, false, false); \
    u32x4 w = {r0[0], r1[0], r0[1], r1[1]}; OUT = *reinterpret_cast<bf16x8*>(&w); } while (0)
    PK4(p0, 0, pa0); PK4(p0, 8, pa1); PK4(p1, 0, pa2); PK4(p1, 8, pa3);
#undef PK4
}
template <int DQK> __device__ __forceinline__ void qkt(f32x16& p0, f32x16& p1, const char* Ks, const bf16x8* qr, int r32, int hi) {
    p0 = f32x16{}; p1 = f32x16{};
#pragma unroll
    for (int d0 = 0; d0 < DQK / 16; ++d0) { const int cb = (d0 * 16 + hi * 8) * 2;
        const bf16x8 b0 = *reinterpret_cast<const bf16x8*>(Ks + kswz<DQK>(r32, cb));
        const bf16x8 b1 = *reinterpret_cast<const bf16x8*>(Ks + kswz<DQK>(32 + r32, cb));
        p0 = __builtin_amdgcn_mfma_f32_32x32x16_bf16(b0, qr[d0], p0, 0, 0, 0);
        p1 = __builtin_amdgcn_mfma_f32_32x32x16_bf16(b1, qr[d0], p1, 0, 0, 0); }
}
__device__ __forceinline__ int v_st(int k, int c) { const int kk = (k & ~0xC) | ((k & 4) << 1) | ((k & 8) >> 1); return ((kk >> 3) * 4 + (c >> 5)) * 512 + ((kk & 7) * 32 + (c & 31)) * 2; }
__device__ __forceinline__ int v_rd_base(int lane) { return ((lane & 3) << 3) | (((lane >> 2) & 3) << 6) | (((lane >> 4) & 1) << 5) | (((lane >> 5) & 1) << 8); }
constexpr int v_rd_off(int d0, int ks, int half) { return d0 * 512 + ks * 4096 + half * 2048; }
template <int OFF> __device__ __forceinline__ s16x4 tr_read(int vb) {
    s16x4 r; asm volatile("ds_read_b64_tr_b16 %0, %1 offset:%2" : "=&v"(r) : "v"(vb), "i"(OFF) : "memory"); return r;
}
template <int KS> __device__ __forceinline__ void pv_step(f32x16* o, int vb, bf16x8 pa) {
    const s16x4 l0 = tr_read<v_rd_off(0, KS, 0)>(vb), h0 = tr_read<v_rd_off(0, KS, 1)>(vb), l1 = tr_read<v_rd_off(1, KS, 0)>(vb), h1 = tr_read<v_rd_off(1, KS, 1)>(vb);
    const s16x4 l2 = tr_read<v_rd_off(2, KS, 0)>(vb), h2 = tr_read<v_rd_off(2, KS, 1)>(vb), l3 = tr_read<v_rd_off(3, KS, 0)>(vb), h3 = tr_read<v_rd_off(3, KS, 1)>(vb);
    asm volatile("s_waitcnt lgkmcnt(0)" ::: "memory"); SBAR();
#define PK(L, H) (bf16x8){L[0], L[1], L[2], L[3], H[0], H[1], H[2], H[3]}
    o[0] = __builtin_amdgcn_mfma_f32_32x32x16_bf16(pa, PK(l0, h0), o[0], 0, 0, 0);
    o[1] = __builtin_amdgcn_mfma_f32_32x32x16_bf16(pa, PK(l1, h1), o[1], 0, 0, 0);
    o[2] = __builtin_amdgcn_mfma_f32_32x32x16_bf16(pa, PK(l2, h2), o[2], 0, 0, 0);
    o[3] = __builtin_amdgcn_mfma_f32_32x32x16_bf16(pa, PK(l3, h3), o[3], 0, 0, 0);
#undef PK
}
__device__ __forceinline__ void pv_d0(f32x16* o, int vb, bf16x8 pa0, bf16x8 pa1, bf16x8 pa2, bf16x8 pa3) {
    pv_step<0>(o, vb, pa0); pv_step<1>(o, vb, pa1); pv_step<2>(o, vb, pa2); pv_step<3>(o, vb, pa3);
}
template <int DQK, int LDQ, int LDK, int LDV, int LDO, bool OUT_BF16>
__device__ __forceinline__ void attn_body(const bf16_t* __restrict__ Qb, const bf16_t* __restrict__ Kh, const bf16_t* __restrict__ Vh, void* __restrict__ Ob, int seq, char* lds) {
    const int tid = tid_local(), wid = tid >> 6, lane = tid & 63, r32 = lane & 31, hi = lane >> 5;
    Qb = uniform_ptr(Qb); Kh = uniform_ptr(Kh); Vh = uniform_ptr(Vh); Ob = uniform_ptr(Ob);
    char* V_lds = lds; char* K_lds = lds + 2 * SHM_V;
    float* ws = (float*)(lds + 2 * SHM_V + 2 * SHM_K) + wid * 64; float* li_l = ws; float* al_l = ws + 32;
    float m_reg = -1e30f, l_reg = 0; f32x16 o[4] = {}; bf16x8 qr[DQK / 16];
    const unsigned qoff = (unsigned)((wid * QBLK + r32) * LDQ + hi * 8) * 2u;
#pragma unroll
    for (int d0 = 0; d0 < DQK / 16; ++d0) qr[d0] = *reinterpret_cast<const bf16x8*>((const char*)Qb + qoff + d0 * 32);
    const int sr = tid >> 4, sc = (tid & 15) * 8, vst0 = v_st(sr, sc), vst1 = v_st(32 + sr, sc);
    const int kr = (DQK == 128) ? sr : (tid >> 3), kc = (DQK == 128) ? sc : (tid & 7) * 8;
    const unsigned voffV = (unsigned)(sr * LDV + sc) * 2u, voffK = (unsigned)(kr * LDK + kc) * 2u;
    const int vb0 = (int)(uintptr_t)V_lds + v_rd_base(lane);
    struct { bf16x8 vs0, vs1, ks0, ks1; } sr_[2];
#define SLOAD(i, k0) do { const char* _vb = (const char*)Vh + (size_t)(k0) * (LDV * 2); const char* _kb = (const char*)Kh + (size_t)(k0) * (LDK * 2); \
    sr_[i].vs0 = *reinterpret_cast<const bf16x8*>(_vb + voffV); sr_[i].vs1 = *reinterpret_cast<const bf16x8*>(_vb + voffV + 32 * LDV * 2); \
    sr_[i].ks0 = *reinterpret_cast<const bf16x8*>(_kb + voffK); if constexpr (DQK == 128) sr_[i].ks1 = *reinterpret_cast<const bf16x8*>(_kb + voffK + 32 * LDK * 2); } while (0)
#define SWRITE(b, i) do { *(bf16x8*)(V_lds + (b) * SHM_V + vst0) = sr_[i].vs0;          \
    *(bf16x8*)(V_lds + (b) * SHM_V + vst1) = sr_[i].vs1;               \
    *(bf16x8*)(K_lds + (b) * SHM_K + kswz<DQK>(kr, kc * 2)) = sr_[i].ks0;                       \
    if constexpr (DQK == 128) *(bf16x8*)(K_lds + (b) * SHM_K + kswz<DQK>(32 + kr, kc * 2)) = sr_[i].ks1; } while (0)
#define SWAIT() do { if constexpr (DQK == 128) asm volatile("s_waitcnt vmcnt(4)" ::: "memory"); else asm volatile("s_waitcnt vmcnt(3)" ::: "memory"); } while (0)
#define RESC(a) do { if (__any((a) < 1.f)) { if (hi == 0) al_l[r32] = (a); asm volatile("s_waitcnt lgkmcnt(0)" ::: "memory"); \
    _Pragma("unroll") for (int d = 0; d < 4; ++d) _Pragma("unroll") for (int r = 0; r < 16; ++r) o[d][r] *= al_l[crow(r, hi)]; } } while (0)
    f32x16 pA0, pA1, pB0, pB1; float mnA, mnB, alA, alB; bf16x8 pa0, pa1, pa2, pa3; const int NT = seq / KVBLK;
    constexpr int SE = 0, SO = 1;
    SLOAD(SE, 0); asm volatile("s_waitcnt vmcnt(0)" ::: "memory"); SWRITE(0, SE); __syncthreads();
    qkt<DQK>(pA0, pA1, K_lds, qr, r32, hi); partialSM<DQK>(pA0, pA1, m_reg, mnA, alA);
    SLOAD(SO, KVBLK); if (2 < NT) SLOAD(SE, 2 * KVBLK);
    SWAIT(); SWRITE(1, SO); __syncthreads();
    for (int j = 1; j + 1 < NT; j += 2) {
        SBAR(); qkt<DQK>(pB0, pB1, K_lds + SHM_K, qr, r32, hi);
        finishSM(pA0, pA1, alA, l_reg, pa0, pa1, pa2, pa3); SBAR();
        SLOAD(SO, (j + 2) * KVBLK); SBAR();
        pv_d0(o, vb0, pa0, pa1, pa2, pa3); partialSM<DQK>(pB0, pB1, m_reg, mnB, alB);
        __syncthreads(); SWAIT(); SWRITE(0, SE);
        RESC(alB); __syncthreads();
        SBAR(); qkt<DQK>(pA0, pA1, K_lds, qr, r32, hi);
        finishSM(pB0, pB1, alB, l_reg, pa0, pa1, pa2, pa3); SBAR();
        if (j + 3 < NT) SLOAD(SE, (j + 3) * KVBLK); SBAR();
        pv_d0(o, vb0 + (int)SHM_V, pa0, pa1, pa2, pa3); partialSM<DQK>(pA0, pA1, m_reg, mnA, alA);
        __syncthreads(); SWAIT(); SWRITE(1, SO);
        RESC(alA); __syncthreads();
    }
    SBAR(); qkt<DQK>(pB0, pB1, K_lds + SHM_K, qr, r32, hi);
    finishSM(pA0, pA1, alA, l_reg, pa0, pa1, pa2, pa3); SBAR();
    pv_d0(o, vb0, pa0, pa1, pa2, pa3); partialSM<DQK>(pB0, pB1, m_reg, mnB, alB);
    __syncthreads(); RESC(alB);
    finishSM(pB0, pB1, alB, l_reg, pa0, pa1, pa2, pa3); SBAR();
    pv_d0(o, vb0 + (int)SHM_V, pa0, pa1, pa2, pa3);
    if (hi == 0) li_l[r32] = l_reg; asm volatile("s_waitcnt lgkmcnt(0)" ::: "memory");
    float rli[16];
#pragma unroll
    for (int r = 0; r < 16; ++r) rli[r] = __builtin_amdgcn_rcpf(li_l[crow(r, hi)]);
    if constexpr (OUT_BF16) {
#pragma unroll
        for (int r = 0; r < 16; ++r) { const unsigned ob = (unsigned)((wid * QBLK + crow(r, hi)) * LDO + r32); const float sc16 = rli[r] * 16.0f;
#pragma unroll
            for (int d0 = 0; d0 < 4; ++d0) *((unsigned char*)Ob + ob + d0 * 32) = (unsigned char)(__builtin_amdgcn_cvt_pk_fp8_f32(o[d0][r] * sc16, 0.f, 0, false) & 0xff); }
    } else {
#pragma unroll
        for (int r = 0; r < 16; ++r) { const unsigned ob = (unsigned)((wid * QBLK + crow(r, hi)) * LDO + r32) * 4u;
#pragma unroll
            for (int d0 = 0; d0 < 4; ++d0) *(float*)((char*)Ob + ob + d0 * 128) = o[d0][r] * rli[r]; }
    }
#undef SLOAD
#undef SWRITE
#undef SWAIT
#undef RESC
}
}

struct Args { const float* in[26]; float* out; unsigned char* ws; int ph_lo, ph_hi; };
enum { I_X = 0, I_C, I_CTX, I_CCTX, I_WMOD, I_BMOD, I_G1, I_G2, I_WIN, I_GQ, I_GK, I_LQ1, I_LK1, I_LQ2, I_LK2, I_GSUB, I_WPOOL, I_PSCALE, I_WOUT, I_WR, I_BR, I_W1, I_B1, I_W2, I_B2, I_GF };
constexpr int NPHASE = 22;

struct TItem { const float* src; unsigned char* dst; int N, ldb; float scale; };
__device__ __forceinline__ TItem titem(int it, const float* win, const float* wout, const float* w1, const float* w2, unsigned char* ws, int lane) {
    constexpr int I_IN = 32 * (INW / 64), I_OUT = 24 * (D / 64), I_E1 = 32 * 32, I_E2 = 16 * 32;
    constexpr int T_IN = 2 * I_IN, T_OUT = 2 * I_OUT, T_E1 = 64 * I_E1;
    const float* W; unsigned char* WT; int N, ldb, item; float scale; int r = it;
    if (r < T_IN) { const int l = r / I_IN; W = win + (size_t)l * D * INW; N = INW; WT = ws + WS_WIN + (size_t)l * INW * D; ldb = D; item = r % I_IN; scale = 64.0f; }
    else if ((r -= T_IN) < T_OUT) { const int l = r / I_OUT; W = wout + (size_t)l * D * D; N = D; WT = ws + WS_WOUT + (size_t)l * D * D; ldb = D; item = r % I_OUT; scale = (item / (D / 64) < 16) ? 4.0f : 64.0f; }
    else if ((r -= T_OUT) < T_E1) { const int le = r / I_E1; W = w1 + (size_t)le * D * 2048; N = 2048; WT = ws + WS_W1 + (size_t)le * 2048 * D; ldb = D; item = r % I_E1; scale = 64.0f; }
    else { r -= T_E1; const int le = r / I_E2; W = w2 + (size_t)le * DE * D; N = D; WT = ws + WS_W2 + (size_t)le * D * DE; ldb = DE; item = r % I_E2; scale = 32.0f; }
    const int nblk = N / 64, kb = item / nblk, nb = item % nblk, k0 = 64 * kb + 16 * (lane >> 4), n0 = 64 * nb + 4 * (lane & 15);
    TItem t; t.src = W + (size_t)k0 * N + n0; t.dst = WT + (size_t)n0 * ldb + k0; t.N = N; t.ldb = ldb; t.scale = scale; return t;
}
#define TI_LOAD(v, t) do { _Pragma("unroll") for (int _i = 0; _i < 16; ++_i) v[_i] = *(const f32x4*)((t).src + (size_t)_i * (t).N); } while (0)
#define TI_STORE(v, t) do { const float _sc = (t).scale; _Pragma("unroll") for (int _c = 0; _c < 4; ++_c) { int _w[4]; \
        _Pragma("unroll") for (int _q = 0; _q < 4; ++_q) { int _x = 0; _x = __builtin_amdgcn_cvt_pk_fp8_f32(v[4 * _q][_c] * _sc, v[4 * _q + 1][_c] * _sc, _x, false); \
            _x = __builtin_amdgcn_cvt_pk_fp8_f32(v[4 * _q + 2][_c] * _sc, v[4 * _q + 3][_c] * _sc, _x, true); _w[_q] = _x; } \
        *(u32x4*)((t).dst + (size_t)_c * (t).ldb) = (u32x4){(unsigned)_w[0], (unsigned)_w[1], (unsigned)_w[2], (unsigned)_w[3]}; } } while (0)
__device__ __forceinline__ float silu_f(float x) { return x / (1.0f + __expf(-x)); }

__device__ __forceinline__ void fold_item(int it, const float* wpool, const float* pscale, const float* wout, unsigned char* WOUT) {
    const int n = it & 2047, cc = (it >> 11) & 15, g = (it >> 15) & 3, l = it >> 17;
    const float* wp = wpool + (((size_t)l * 4 + g) * 128 + cc * 8) * 128;
    const float* ps = pscale + (size_t)l * 512 + g * 128;
    const float* wo = wout + ((size_t)l * D + 1536 + g * 128) * D + n;
    float acc[8];
#pragma unroll
    for (int q = 0; q < 8; ++q) acc[q] = 0.f;
#pragma unroll 1
    for (int d0 = 0; d0 < 128; d0 += 32) { float av[32];
#pragma unroll
        for (int dd = 0; dd < 32; ++dd) av[dd] = wo[(size_t)(d0 + dd) * D];
#pragma unroll
        for (int dd = 0; dd < 32; ++dd) { const float x = ps[d0 + dd] * av[dd];
#pragma unroll
            for (int q = 0; q < 8; ++q) acc[q] = fmaf(wp[q * 128 + d0 + dd], x, acc[q]); } }
    int o0 = 0, o1 = 0; o0 = __builtin_amdgcn_cvt_pk_fp8_f32(acc[0] * 64.f, acc[1] * 64.f, o0, false); o0 = __builtin_amdgcn_cvt_pk_fp8_f32(acc[2] * 64.f, acc[3] * 64.f, o0, true);
    o1 = __builtin_amdgcn_cvt_pk_fp8_f32(acc[4] * 64.f, acc[5] * 64.f, o1, false); o1 = __builtin_amdgcn_cvt_pk_fp8_f32(acc[6] * 64.f, acc[7] * 64.f, o1, true);
    *(u32x2*)(WOUT + ((size_t)l * D + n) * D + 1536 + g * 128 + cc * 8) = (u32x2){(unsigned)o0, (unsigned)o1};
}

PHASE_FN phase_prologue(LAS unsigned char* lds, int l_unused, int G) {
    lds = (LAS unsigned char*)__builtin_amdgcn_readfirstlane((int)(uintptr_t)lds); G = __builtin_amdgcn_readfirstlane(G);
    const int tid = tid_local(), lane = tid & 63, wave = __builtin_amdgcn_readfirstlane(tid >> 6);
    unsigned char* ws = WSP();
    const int gw = blockIdx.x * NWAVES + wave, NGW = G * NWAVES;
    {
        float* MODP = (float*)(ws + WS_MODP);
        const float* cvec = INP(I_C); const float* cctx = INP(I_CCTX); const float* wmod = INP(I_WMOD);
        LAS float* st = (LAS float*)lds;
        for (int i = tid; i < 5 * D; i += NTHREADS) st[i] = silu_f(i < 4 * D ? cvec[i] : cctx[i - 4 * D]);
        __syncthreads();
        for (int u = gw; u < 2 * 64 * 48; u += NGW) {
            const int l = u / (64 * 48), r = u % (64 * 48), kc = r / 48, cg = r % 48;
            const int col = cg * 256 + lane * 4;
            const float* W = wmod + (size_t)l * D * 12288 + (size_t)(kc * 32) * 12288 + col;
            f32x4 acc[5];
#pragma unroll
            for (int v = 0; v < 5; ++v) acc[v] = (f32x4){0.f, 0.f, 0.f, 0.f};
#pragma unroll 1
            for (int k8 = 0; k8 < 32; k8 += 16) {
                f32x4 w[16];
#pragma unroll
                for (int kk = 0; kk < 16; ++kk) w[kk] = *(const f32x4*)(W + (size_t)(k8 + kk) * 12288);
#pragma unroll
                for (int kk = 0; kk < 16; ++kk) { const int k = kc * 32 + k8 + kk;
#pragma unroll
                    for (int v = 0; v < 5; ++v) acc[v] += st[v * D + k] * w[kk]; } }
#pragma unroll
            for (int v = 0; v < 5; ++v) *(f32x4*)(MODP + ((size_t)kc * 10 + l * 5 + v) * 12288 + col) = acc[v];
        }
        __syncthreads();
    }
    {
        f32x2* tabA = (f32x2*)(ws + WS_ROPE); f32x2* tabB = tabA + 64 * 32;
        for (int i = blockIdx.x * NTHREADS + tid; i < 64 * 32 + 64 * 16; i += G * NTHREADS) {
            if (i < 64 * 32) { const int pos = i >> 5, f = i & 31; const float inv = powf(10000.0f, -(float)f / 32.0f); const float ang = (float)pos * inv; tabA[i] = (f32x2){cosf(ang), sinf(ang)}; }
            else { const int q = i - 64 * 32; const int pos = q >> 4, f = q & 15; const float inv = powf(10000.0f, -(float)f / 16.0f); const float ang = (float)pos * inv; tabB[q] = (f32x2){cosf(ang), sinf(ang)}; }
        }
    }
    {
        const float* win = INP(I_WIN); const float* wout = INP(I_WOUT); const float* w1 = INP(I_W1); const float* w2 = INP(I_W2);
        constexpr int TOT = 2 * 32 * (INW / 64);
        f32x4 va[16], vb[16]; TItem ta, tb;
        int it = gw;
        if (it < TOT) { ta = titem(it, win, wout, w1, w2, ws, lane); TI_LOAD(va, ta); }
        while (it < TOT) {
            const int i1 = it + NGW;
            if (i1 < TOT) { tb = titem(i1, win, wout, w1, w2, ws, lane); TI_LOAD(vb, tb); }
            TI_STORE(va, ta);
            if (i1 >= TOT) break;
            const int i2 = i1 + NGW;
            if (i2 < TOT) { ta = titem(i2, win, wout, w1, w2, ws, lane); TI_LOAD(va, ta); }
            TI_STORE(vb, tb);
            it = i2;
        }
    }
}

PHASE_FN phase_modreduce(LAS unsigned char* lds, int l_unused, int G) {
    lds = (LAS unsigned char*)__builtin_amdgcn_readfirstlane((int)(uintptr_t)lds); G = __builtin_amdgcn_readfirstlane(G);
    const int tid = tid_local();
    unsigned char* ws = WSP();
    const float* MODP = (const float*)(ws + WS_MODP); float* MOD = (float*)(ws + WS_MOD); const float* bmod = INP(I_BMOD);
    for (int i = blockIdx.x * NTHREADS + tid; i < 10 * 12288 / 4; i += G * NTHREADS) {
        const int lv = i / 3072, col = (i % 3072) * 4, l = lv / 5;
        f32x4 s = *(const f32x4*)(bmod + (size_t)l * 12288 + col);
#pragma unroll 16
        for (int kc = 0; kc < 64; ++kc) s += *(const f32x4*)(MODP + ((size_t)kc * 10 + lv) * 12288 + col);
        *(f32x4*)(MOD + (size_t)lv * 12288 + col) = s;
    }
}

__device__ __forceinline__ void norm_mod_store(const f32x4 (&v)[8], const f32x4 (&gg)[8], const f32x4 (&sh)[8], const f32x4 (&sc)[8], unsigned char* orow, int lane) {
    float ss = 0.f;
#pragma unroll
    for (int j = 0; j < 8; ++j) ss += (v[j].x * v[j].x + v[j].y * v[j].y) + (v[j].z * v[j].z + v[j].w * v[j].w);
    const float rs = rsqrtf(wave_sum(ss) * (1.0f / D) + EPS);
#pragma unroll
    for (int j = 0; j < 8; ++j) { const int col = 4 * (lane + 64 * j);
        const f32x4 y = (v[j] * rs) * gg[j]; const f32x4 n = y * (sc[j] + 1.0f) + sh[j];
        int w = 0; w = __builtin_amdgcn_cvt_pk_fp8_f32(n.x, n.y, w, false); w = __builtin_amdgcn_cvt_pk_fp8_f32(n.z, n.w, w, true);
        *(int*)(orow + col) = w; }
}

PHASE_FN phase_norm1_l0(LAS unsigned char* lds, int l_unused, int G) {
    lds = (LAS unsigned char*)__builtin_amdgcn_readfirstlane((int)(uintptr_t)lds); G = __builtin_amdgcn_readfirstlane(G);
    const int tid = tid_local(), lane = tid & 63, wave = __builtin_amdgcn_readfirstlane(tid >> 6);
    unsigned char* ws = WSP();
    const float* MOD = (const float*)(ws + WS_MOD);
    unsigned char* N = ws + WS_N;
    const float* x = INP(I_X); const float* ctx = INP(I_CTX); const float* g1 = INP(I_G1);
    f32x4 gg[8];
#pragma unroll
    for (int j = 0; j < 8; ++j) gg[j] = *(const f32x4*)(g1 + 4 * (lane + 64 * j));
    for (int row = blockIdx.x * NWAVES + wave; row < MT; row += G * NWAVES) {
        const float* src = row < ML ? x + (size_t)row * D : ctx + (size_t)(row - ML) * D;
        const int bidx = row < ML ? (row >> 12) : 4;
        const float* m = MOD + (size_t)bidx * 12288;
        f32x4 v[8], sh[8], sc[8];
#pragma unroll
        for (int j = 0; j < 8; ++j) { v[j] = *(const f32x4*)(src + 4 * (lane + 64 * j)); sh[j] = *(const f32x4*)(m + 4 * (lane + 64 * j)); sc[j] = *(const f32x4*)(m + 2048 + 4 * (lane + 64 * j)); }
        norm_mod_store(v, gg, sh, sc, N + (size_t)row * D, lane);
    }
}

PHASE_FN phase_inproj(LAS unsigned char* lds, int l, int G) {
    lds = (LAS unsigned char*)__builtin_amdgcn_readfirstlane((int)(uintptr_t)lds); l = __builtin_amdgcn_readfirstlane(l); G = __builtin_amdgcn_readfirstlane(G);
    unsigned char* ws = WSP();
    pg8::DenseSched<D, 1> S; S.init(ws + WS_N, ws + WS_WIN + (size_t)l * INW * D, MT, INW, G, (int)blockIdx.x);
    pg8::EpiBf16 E{(bf16_t*)(ws + WS_P), INW, nullptr, 0};
    pg8::gemm_phase(lds, S, E);
}

PHASE_FN phase_prep(LAS unsigned char* lds, int l, int G) {
    lds = (LAS unsigned char*)__builtin_amdgcn_readfirstlane((int)(uintptr_t)lds); l = __builtin_amdgcn_readfirstlane(l); G = __builtin_amdgcn_readfirstlane(G);
    const int tid = tid_local(), lane = tid & 63, wave = __builtin_amdgcn_readfirstlane(tid >> 6);
    unsigned char* ws = WSP();
    const bf16_t* P = (const bf16_t*)(ws + WS_P);
    unsigned* QA = (unsigned*)(ws + WS_QA); unsigned* KA = (unsigned*)(ws + WS_KA); unsigned* VA = (unsigned*)(ws + WS_VA);
    unsigned* QB = (unsigned*)(ws + WS_QB); unsigned* KB = (unsigned*)(ws + WS_KB); unsigned* VB = (unsigned*)(ws + WS_VB); unsigned char* CAT = ws + WS_CAT;
    const f32x2* tabA = (const f32x2*)(ws + WS_ROPE); const f32x2* tabB = tabA + 64 * 32;
    const f32x2 gq2 = *(const f32x2*)(INP(I_GQ) + l * 128 + 2 * lane), gk2 = *(const f32x2*)(INP(I_GK) + l * 128 + 2 * lane);
    const bool firstA = (lane & 16) == 0, firstB = (lane & 8) == 0;
    for (int unit = blockIdx.x; unit < MT / 8; unit += G) {
        const int ch = tid, hw = 1 << (ch >> 7);
        const int row0 = unit * 8; int base, s0, L;
        if (row0 < ML) { base = row0 & ~4095; s0 = row0 & 4095; L = SEQ; } else { const int r2 = row0 - ML; base = ML + (r2 & ~255); s0 = r2 & 255; L = CTX; }
        float pv_[23];
        { const bf16_t* pc = P + (size_t)base * INW + OFF_UC + ch;
#pragma unroll
            for (int j = 0; j < 23; ++j) { int sj = s0 - 8 + j; sj = sj < 0 ? 0 : (sj >= L ? L - 1 : sj);
                pv_[j] = bf2f(pc[(size_t)sj * INW]); } }
        {
            const int row = unit * 8 + wave;
            const bool lat = row < ML; int b, sq, trow;
            if (lat) { b = row >> 12; sq = row & 4095; trow = b * TK + CTX + sq; } else { const int r2 = row - ML; b = r2 >> 8; sq = r2 & 255; trow = b * TK + sq; }
            const unsigned* p = (const unsigned*)(P + (size_t)row * INW);
            unsigned ha[10], hb[8];
#pragma unroll
            for (int hh = 0; hh < 10; ++hh) ha[hh] = p[(hh < 8 ? hh * 64 : OFF_KA / 2 + (hh - 8) * 64) + lane];
#pragma unroll
            for (int jp = 0; jp < 8; ++jp) hb[jp] = p[(jp < 4 ? OFF_QB / 2 + jp * 64 : OFF_KB / 2 + (jp - 4) * 64) + lane];
            const u32x2 vva = *(const u32x2*)(p + OFF_VA / 2 + 2 * lane);
            const u32x4 vvb = *(const u32x4*)(p + OFF_VB / 2 + 4 * lane);
            const int prow = sq >> 6, pcol = sq & 63;
            const f32x4 csA = *(const f32x4*)(tabA + (lane < 32 ? prow : pcol) * 32 + 2 * (lane & 15));
            const f32x4 csB = *(const f32x4*)(tabB + ((lane & 16) == 0 ? prow : pcol) * 16 + 2 * (lane & 7));
#pragma unroll
            for (int hh = 0; hh < 10; ++hh) {
                float e0 = __uint_as_float(ha[hh] << 16), e1 = __uint_as_float(ha[hh] & 0xffff0000u);
                const float ss = wave_sum(e0 * e0 + e1 * e1); const float r = rsqrtf(ss * (1.0f / 128.0f) + EPS);
                const f32x2 g = hh < 8 ? gq2 : gk2;
                e0 = e0 * r * g.x; e1 = e1 * r * g.y;
                if (lat) {
                    const float o0 = __shfl_xor(e0, 16), o1 = __shfl_xor(e1, 16);
                    e0 = firstA ? (e0 * csA.x - o0 * csA.y) : (o0 * csA.y + e0 * csA.x);
                    e1 = firstA ? (e1 * csA.z - o1 * csA.w) : (o1 * csA.w + e1 * csA.z);
                }
                unsigned* dst = hh < 8 ? QA + (size_t)row * 512 + hh * 64 : KA + (size_t)trow * 128 + (hh - 8) * 64;
                dst[lane] = cvt_pk_bf16(e0, e1);
            }
            *(u32x2*)(VA + (size_t)trow * 128 + 2 * lane) = vva;
#pragma unroll
            for (int jp = 0; jp < 8; ++jp) {
                float e0 = __uint_as_float(hb[jp] << 16), e1 = __uint_as_float(hb[jp] & 0xffff0000u);
                if (lat) {
                    const float o0 = __shfl_xor(e0, 8), o1 = __shfl_xor(e1, 8);
                    e0 = firstB ? (e0 * csB.x - o0 * csB.y) : (o0 * csB.y + e0 * csB.x);
                    e1 = firstB ? (e1 * csB.z - o1 * csB.w) : (o1 * csB.w + e1 * csB.z);
                }
                unsigned* dst = jp < 4 ? QB + (size_t)row * 256 + jp * 64 : KB + (size_t)trow * 256 + (jp - 4) * 64;
                dst[lane] = cvt_pk_bf16(e0, e1);
            }
            *(u32x4*)(VB + (size_t)trow * 256 + 4 * lane) = vvb;
        }
        {
#pragma unroll
            for (int tk = 0; tk < 8; ++tk) { const int sq = s0 + tk;
                const int lo = (sq - hw) < 0 ? 0 : (sq - hw), hi = (sq + hw) > L ? L : (sq + hw);
                float sum = 0.f;
#pragma unroll
                for (int j = tk; j < tk + 16; ++j) { const int sj = s0 - 8 + j; sum += (sj >= lo && sj < hi) ? pv_[j] : 0.f; }
                CAT[(size_t)(row0 + tk) * D + 1536 + ch] = (unsigned char)(__builtin_amdgcn_cvt_pk_fp8_f32(sum / (float)(hi - lo) - pv_[tk + 8], 0.f, 0, false) & 0xff); }
        }
    }
}

constexpr int NCONV_WG = 32;
constexpr int CONV_BATCH = 128, CONV_E1 = 32 * 32 * 32, CONV_E2 = 32 * 16 * 32, CONV_ITEMS = CONV_E1 + CONV_E2  , CONV_FIRST = 2 * 32 * (INW / 64) + 2 * 24 * (D / 64);
constexpr int CONV_OUT0 = 2 * 32 * (INW / 64), CONV_OUT = 24 * (D / 64)  , NB_FOLD = 4 * 16 * 2048 / NTHREADS  , NB_OUT = CONV_OUT / CONV_BATCH, NB_EXP = CONV_ITEMS / CONV_BATCH;
static_assert(CONV_OUT % CONV_BATCH == 0, "w_out batches");
PHASE_FN phase_attention(LAS unsigned char* lds_, int l, int G) {
    lds_ = (LAS unsigned char*)__builtin_amdgcn_readfirstlane((int)(uintptr_t)lds_); l = __builtin_amdgcn_readfirstlane(l); G = __builtin_amdgcn_readfirstlane(G);
    LAS unsigned char* lds = lds_;
    unsigned char* ws = WSP();
    char* ldsg = (char*)lds_;
    const int tid = tid_local();
    const bf16_t* QA = (const bf16_t*)(ws + WS_QA); const bf16_t* KA = (const bf16_t*)(ws + WS_KA); const bf16_t* VA = (const bf16_t*)(ws + WS_VA);
    const bf16_t* QB = (const bf16_t*)(ws + WS_QB); const bf16_t* KB = (const bf16_t*)(ws + WS_KB); const bf16_t* VB = (const bf16_t*)(ws + WS_VB);
    unsigned char* CAT = ws + WS_CAT; float* OB = (float*)(ws + WS_OB);
    const int nA = 512 + (l == 0 ? 32 : 0), nB = 512 + (l == 0 ? 32 : 0);
    const bool dyn = (G > NCONV_WG);
    unsigned* qh = (unsigned*)(ws + WS_CTL) + CW_Q + l * 192;
    volatile LAS int* slot = (volatile LAS int*)(lds + MISC_OFF + 32);
    if (!dyn || (int)blockIdx.x < G - NCONV_WG) {
    for (int it = 0;; ++it) {
        int id;
        __syncthreads();
        if (dyn) { if (tid == 0) *slot = (int)atomicAdd(qh, 1u); __syncthreads(); id = __builtin_amdgcn_readfirstlane(*slot); } else id = (int)blockIdx.x + it * G;
        if (id >= nA) break;
        const bf16_t *q, *k, *v; unsigned char* o; int seq;
        if (id < 512) { int b, kvh, h, qb;
            if (dyn) { b = id >> 7; kvh = (id >> 6) & 1; h = kvh * 4 + ((id >> 4) & 3); qb = id & 15; }
            else { const int x = id & 7, i = id >> 8, j = (id >> 3) & 31; b = x >> 1; kvh = x & 1; h = kvh * 4 + 2 * i + (j >> 4); qb = j & 15; }
            const size_t r0 = (size_t)b * SEQ + qb * 256;
            q = QA + r0 * 1024 + h * 128; k = KA + (size_t)b * TK * 256 + kvh * 128; v = VA + (size_t)b * TK * 256 + kvh * 128; o = CAT + r0 * D + h * 128; seq = TK; }
        else { const int c = id - 512, b = c >> 3, h = c & 7; const size_t r0 = (size_t)ML + b * CTX;
            q = QA + r0 * 1024 + h * 128; k = KA + (size_t)b * TK * 256 + (h >> 2) * 128; v = VA + (size_t)b * TK * 256 + (h >> 2) * 128; o = CAT + r0 * D + h * 128; seq = CTX; }
        att::attn_body<128, 1024, 256, 256, D, true>(q, k, v, o, seq, ldsg);
    }
    for (int it = 0;; ++it) {
        int id;
        __syncthreads();
        if (dyn) { if (tid == 0) *slot = (int)atomicAdd(qh + 64, 1u); __syncthreads(); id = __builtin_amdgcn_readfirstlane(*slot); } else id = (int)blockIdx.x + it * G;
        if (id >= nB) break;
        const bf16_t *q, *k, *v; float* o; int seq;
        if (id < 512) { int b, h, comp, qb;
            if (dyn) { b = id >> 7; h = (id >> 5) & 3; comp = (id >> 4) & 1; qb = id & 15; }
            else { const int x = id & 7, i = id >> 8, j = (id >> 3) & 31; const int combo = 2 * x + i; b = combo >> 2; h = combo & 3; comp = j >> 4; qb = j & 15; }
            const int jj = comp * 4 + h; const size_t r0 = (size_t)b * SEQ + qb * 256;
            q = QB + r0 * 512 + jj * 64; k = KB + (size_t)b * TK * 512 + jj * 64; v = VB + (size_t)b * TK * 512 + h * 128; o = OB + r0 * 1024 + jj * 128; seq = TK; }
        else { const int c = id - 512, b = c >> 3, jj = c & 7, h = jj & 3; const size_t r0 = (size_t)ML + b * CTX;
            q = QB + r0 * 512 + jj * 64; k = KB + (size_t)b * TK * 512 + jj * 64; v = VB + (size_t)b * TK * 512 + h * 128; o = OB + r0 * 1024 + jj * 128; seq = CTX; }
        att::attn_body<64, 512, 512, 512, 1024, false>(q, k, v, o, seq, ldsg);
    }
    }
    {
        const int lane = tid & 63, wave = __builtin_amdgcn_readfirstlane(tid >> 6);
        const float* win = INP(I_WIN); const float* wout = INP(I_WOUT); const float* w1 = INP(I_W1); const float* w2 = INP(I_W2);
        for (;;) {
            __syncthreads();
            if (tid == 0) *slot = (int)atomicAdd(qh + 128, 1u);
            __syncthreads();
            const int bt = __builtin_amdgcn_readfirstlane(*slot);
            if (bt >= NB_FOLD + NB_OUT + NB_EXP) break;
            if (bt < NB_FOLD) { fold_item(l * (4 * 16 * 2048) + bt * NTHREADS + tid, INP(I_WPOOL), INP(I_PSCALE), wout, ws + WS_WOUT); continue; }
            int base;
            if (bt < NB_FOLD + NB_OUT) base = CONV_OUT0 + l * CONV_OUT + (bt - NB_FOLD) * CONV_BATCH + wave * (CONV_BATCH / NWAVES);
            else { const int li = (bt - NB_FOLD - NB_OUT) * CONV_BATCH + wave * (CONV_BATCH / NWAVES);
                base = li < CONV_E1 ? CONV_FIRST + l * CONV_E1 + li : CONV_FIRST + 2 * CONV_E1 + l * CONV_E2 + (li - CONV_E1); }
            f32x4 va[16], vb[16]; TItem ta, tb;
            ta = titem(base, win, wout, w1, w2, ws, lane); TI_LOAD(va, ta);
#pragma unroll 1
            for (int i = 0; i < CONV_BATCH / NWAVES; i += 2) {
                tb = titem(base + i + 1, win, wout, w1, w2, ws, lane); TI_LOAD(vb, tb);
                TI_STORE(va, ta);
                if (i + 2 < CONV_BATCH / NWAVES) { ta = titem(base + i + 2, win, wout, w1, w2, ws, lane); TI_LOAD(va, ta); }
                TI_STORE(vb, tb);
            }
        }
    }
}

PHASE_FN phase_fixup(LAS unsigned char* lds, int l, int G) {
    lds = (LAS unsigned char*)__builtin_amdgcn_readfirstlane((int)(uintptr_t)lds); l = __builtin_amdgcn_readfirstlane(l); G = __builtin_amdgcn_readfirstlane(G);
    const int tid = tid_local(), lane = tid & 63, wave = __builtin_amdgcn_readfirstlane(tid >> 6);
    unsigned char* ws = WSP();
    const float lam_init = 0.8f - 0.6f * expf(-0.3f * (float)l);
    float s1 = 0.f, s2 = 0.f;
    { const float* lq1 = INP(I_LQ1) + l * 64; const float* lk1 = INP(I_LK1) + l * 64; const float* lq2 = INP(I_LQ2) + l * 64; const float* lk2 = INP(I_LK2) + l * 64;
      s1 = wave_sum(lq1[lane] * lk1[lane]); s2 = wave_sum(lq2[lane] * lk2[lane]); }
    const float lam = expf(s1) - expf(s2) + lam_init;
    const float* OB = (const float*)(ws + WS_OB); unsigned char* CAT = ws + WS_CAT;
    const float* gs = INP(I_GSUB) + l * 128;
    const int nrows = (l == 0) ? MT : ML;
    const f32x2 g2 = *(const f32x2*)(gs + 2 * lane);
    for (int row = blockIdx.x * NWAVES + wave; row < nrows; row += G * NWAVES) {
        f32x2 o1[4], o2[4];
#pragma unroll
        for (int h = 0; h < 4; ++h) { o1[h] = *(const f32x2*)(OB + (size_t)row * 1024 + h * 128 + 2 * lane); o2[h] = *(const f32x2*)(OB + (size_t)row * 1024 + (4 + h) * 128 + 2 * lane); }
#pragma unroll
        for (int h = 0; h < 4; ++h) {
            const f32x2 d = o1[h] - lam * o2[h];
            const float ss = wave_sum(d.x * d.x + d.y * d.y); const float r = rsqrtf(ss * (1.0f / 128.0f) + EPS) * (1.0f - lam_init);
            *(unsigned short*)(CAT + (size_t)row * D + 1024 + h * 128 + 2 * lane) = (unsigned short)(__builtin_amdgcn_cvt_pk_fp8_f32(d.x * r * g2.x, d.y * r * g2.y, 0, false) & 0xffff);
        }
    }
}

PHASE_FN phase_outproj(LAS unsigned char* lds, int l, int G) {
    lds = (LAS unsigned char*)__builtin_amdgcn_readfirstlane((int)(uintptr_t)lds); l = __builtin_amdgcn_readfirstlane(l); G = __builtin_amdgcn_readfirstlane(G);
    unsigned char* ws = WSP();
    pg8::DenseSched<D, 1> S; S.init(ws + WS_CAT, ws + WS_WOUT + (size_t)l * D * D, (l == 0) ? MT : ML, D, G, (int)blockIdx.x);
    pg8::EpiResid E{INP(I_X), INP(I_CTX), (const bf16_t*)(ws + WS_XR), (bf16_t*)(ws + WS_XR), (const float*)(ws + WS_MOD) + (size_t)l * 5 * 12288, l};
    pg8::gemm_phase(lds, S, E);
}

PHASE_FN phase_router(LAS unsigned char* lds, int l, int G) {
    lds = (LAS unsigned char*)__builtin_amdgcn_readfirstlane((int)(uintptr_t)lds); l = __builtin_amdgcn_readfirstlane(l); G = __builtin_amdgcn_readfirstlane(G);
    const int tid = tid_local(), lane = tid & 63, wave = __builtin_amdgcn_readfirstlane(tid >> 6);
    unsigned char* ws = WSP();
    const bf16_t* XR = (const bf16_t*)(ws + WS_XR); unsigned char* NF8 = ws + WS_NF8;
    const float* MOD = (const float*)(ws + WS_MOD) + (size_t)l * 5 * 12288;
    int* eid = (int*)(ws + WS_ROUT + ROUT_EID); float* gate = (float*)(ws + WS_ROUT + ROUT_GATE); int* posb = (int*)(ws + WS_ROUT + ROUT_POS); int* list = (int*)(ws + WS_ROUT + ROUT_LIST);
    unsigned* cnt = (unsigned*)(ws + WS_CTL) + CW_CNT + l * 32 * 64;
    const float* wr_ = INP(I_WR) + (size_t)l * D * NE; const float* br = INP(I_BR) + l * NE; const float* g2 = INP(I_G2) + (size_t)l * D;
    LAS float* fl = (LAS float*)lds;
    LAS float* lg = (LAS float*)(lds + MISC_OFF + 512);
    LAS int* selall = (LAS int*)(lds + MISC_OFF + 4096);
    const int ntok = (l == 0) ? MT : ML;
    int ui = 0;
    f32x4 g2v[8];
#pragma unroll
    for (int j = 0; j < 8; ++j) g2v[j] = *(const f32x4*)(g2 + 4 * (lane + 64 * j));
    for (int unit = blockIdx.x; unit < ntok / 16; unit += G) {
        LAS int* sel = selall + ui * 64;
        { const int tl = wave * 2, row = unit * 16 + tl;
            const int bidx = row < ML ? (row >> 12) : 4; const float* m = MOD + (size_t)bidx * 12288;
            f32x4 va[8], vb[8], shv[8], scv[8]; float ssa = 0.f, ssb = 0.f;
#pragma unroll
            for (int j = 0; j < 8; ++j) { const u32x2 wa_ = *(const u32x2*)(XR + (size_t)row * D + 4 * (lane + 64 * j)), wb_ = *(const u32x2*)(XR + (size_t)(row + 1) * D + 4 * (lane + 64 * j));
                va[j] = (f32x4){__uint_as_float(wa_.x << 16), __uint_as_float(wa_.x & 0xffff0000u), __uint_as_float(wa_.y << 16), __uint_as_float(wa_.y & 0xffff0000u)};
                vb[j] = (f32x4){__uint_as_float(wb_.x << 16), __uint_as_float(wb_.x & 0xffff0000u), __uint_as_float(wb_.y << 16), __uint_as_float(wb_.y & 0xffff0000u)};
                shv[j] = *(const f32x4*)(m + 3 * 2048 + 4 * (lane + 64 * j)); scv[j] = *(const f32x4*)(m + 4 * 2048 + 4 * (lane + 64 * j)); }
#pragma unroll
            for (int j = 0; j < 8; ++j) { ssa += (va[j].x * va[j].x + va[j].y * va[j].y) + (va[j].z * va[j].z + va[j].w * va[j].w); ssb += (vb[j].x * vb[j].x + vb[j].y * vb[j].y) + (vb[j].z * vb[j].z + vb[j].w * vb[j].w); }
            const float rsa = rsqrtf(wave_sum(ssa) * (1.0f / D) + EPS), rsb = rsqrtf(wave_sum(ssb) * (1.0f / D) + EPS);
#pragma unroll
            for (int j = 0; j < 8; ++j) { const int col = 4 * (lane + 64 * j);
                const f32x4 gg = g2v[j], sh = shv[j], sc = scv[j];
                const f32x4 na = ((va[j] * rsa) * gg) * (sc + 1.0f) + sh, nb = ((vb[j] * rsb) * gg) * (sc + 1.0f) + sh;
                int wa = 0, wb = 0; wa = __builtin_amdgcn_cvt_pk_fp8_f32(na.x, na.y, wa, false); wa = __builtin_amdgcn_cvt_pk_fp8_f32(na.z, na.w, wa, true);
                wb = __builtin_amdgcn_cvt_pk_fp8_f32(nb.x, nb.y, wb, false); wb = __builtin_amdgcn_cvt_pk_fp8_f32(nb.z, nb.w, wb, true);
                *(int*)(NF8 + (size_t)row * D + col) = wa; *(int*)(NF8 + (size_t)(row + 1) * D + col) = wb;
                *(LAS f32x4*)(fl + tl * FLS + col) = na; *(LAS f32x4*)(fl + (tl + 1) * FLS + col) = nb; }
        }
        __syncthreads();
        f32x4 acc0 = (f32x4){0.f, 0.f, 0.f, 0.f}, acc1 = (f32x4){0.f, 0.f, 0.f, 0.f};
        { const int trow = lane & 15, g4 = lane >> 4;
#pragma unroll 4
            for (int kq = 0; kq < 16; ++kq) { const int kb = wave * 256 + kq * 16 + 4 * g4;
                const f32x4 av = *(const LAS f32x4*)(fl + trow * FLS + kb);
                const float* wp = wr_ + (size_t)kb * NE + trow;
                float b0[4], b1[4];
#pragma unroll
                for (int kk = 0; kk < 4; ++kk) { b0[kk] = wp[kk * NE]; b1[kk] = wp[kk * NE + 16]; }
#pragma unroll
                for (int kk = 0; kk < 4; ++kk) { acc0 = __builtin_amdgcn_mfma_f32_16x16x4f32(av[kk], b0[kk], acc0, 0, 0, 0); acc1 = __builtin_amdgcn_mfma_f32_16x16x4f32(av[kk], b1[kk], acc1, 0, 0, 0); } }
        }
        __syncthreads();
        { const int ecol = lane & 15, g4 = lane >> 4; LAS float* pw = fl + wave * 512;
#pragma unroll
            for (int r = 0; r < 4; ++r) { pw[(g4 * 4 + r) * 32 + ecol] = acc0[r]; pw[(g4 * 4 + r) * 32 + 16 + ecol] = acc1[r]; } }
        __syncthreads();
        { float sacc = br[tid & 31];
#pragma unroll
            for (int w = 0; w < 8; ++w) sacc += fl[w * 512 + tid];
            lg[tid] = sacc; }
        __syncthreads();
        if (tid < 16) { const int row = unit * 16 + tid; float v[4]; int id[4]; unsigned used = 0u;
#pragma unroll
            for (int k = 0; k < 4; ++k) { float best = -3.0e38f; int bi = 0;
                for (int e = 0; e < NE; ++e) { const float x = lg[tid * 32 + e]; if (!((used >> e) & 1u) && x > best) { best = x; bi = e; } }
                used |= 1u << bi; v[k] = best; id[k] = bi; }
            const float e1 = __expf(v[1] - v[0]), e2 = __expf(v[2] - v[0]), e3 = __expf(v[3] - v[0]); const float inv = 1.0f / (1.0f + e1 + e2 + e3);
            sel[tid * 4 + 0] = id[0]; sel[tid * 4 + 1] = id[1]; sel[tid * 4 + 2] = id[2]; sel[tid * 4 + 3] = id[3];
            *(int4*)(eid + (size_t)row * 4) = make_int4(id[0], id[1], id[2], id[3]);
            *(f32x4*)(gate + (size_t)row * 4) = (f32x4){inv, e1 * inv, e2 * inv, e3 * inv}; }
        __syncthreads();
        ++ui;
    }
    __syncthreads();
    if (tid < NE) { int c = 0; const int nent = ui * 64;
        for (int i = 0; i < nent; ++i) c += (selall[i] == tid) ? 1 : 0;
        if (c > 0) { const int base = (int)atomicAdd(cnt + tid * 64, (unsigned)c); int r = 0;
            for (int i = 0; i < nent; ++i) if (selall[i] == tid) { const int row = ((int)blockIdx.x + (i >> 6) * G) * 16 + ((i & 63) >> 2); list[(size_t)tid * MT + base + r] = row; posb[(size_t)row * 4 + (i & 3)] = base + r; ++r; } } }
    __syncthreads();
}

__device__ __forceinline__ void moe_tables(unsigned char* ws, int l, LAS unsigned char* lds) {
    LAS int* tp = (LAS int*)(lds + MISC_OFF + 64); LAS int* cn = (LAS int*)(lds + MISC_OFF + 256);
    const unsigned* cnt = (const unsigned*)(ws + WS_CTL) + CW_CNT + l * 32 * 64;
    __syncthreads();
    if (threadIdx.x < 64) { const int ln = threadIdx.x;
        const int c = (ln < NE) ? (int)__hip_atomic_load(cnt + ln * 64, __ATOMIC_RELAXED, __HIP_MEMORY_SCOPE_AGENT) : 0;
        const int t = (c + 255) >> 8; int incl = t;
#pragma unroll
        for (int o = 1; o < 32; o <<= 1) { const int u = __shfl_up(incl, o); if (ln >= o) incl += u; }
        if (ln < NE) { tp[ln] = incl - t; cn[ln] = c; }
        if (ln == NE - 1) tp[NE] = incl; }
    __syncthreads();
}

PHASE_FN phase_moe_up(LAS unsigned char* lds, int l, int G) {
    lds = (LAS unsigned char*)__builtin_amdgcn_readfirstlane((int)(uintptr_t)lds); l = __builtin_amdgcn_readfirstlane(l); G = __builtin_amdgcn_readfirstlane(G);
    unsigned char* ws = WSP();
    moe_tables(ws, l, lds);
    pg8::MoeSched<true, D, 1> S; S.init((const LAS int*)(lds + MISC_OFF + 64), (const LAS int*)(lds + MISC_OFF + 256), ws + WS_NF8, ws + WS_W1 + (size_t)l * 32 * 2048 * D,
                                  (const int*)(ws + WS_ROUT + ROUT_LIST), G, (int)blockIdx.x);
    pg8::EpiSwiglu E{ws + WS_ACT, INP(I_B1) + (size_t)l * 32 * 2048};
    pg8::gemm_phase(lds, S, E);
}

PHASE_FN phase_moe_down(LAS unsigned char* lds, int l, int G) {
    lds = (LAS unsigned char*)__builtin_amdgcn_readfirstlane((int)(uintptr_t)lds); l = __builtin_amdgcn_readfirstlane(l); G = __builtin_amdgcn_readfirstlane(G);
    unsigned char* ws = WSP();
    moe_tables(ws, l, lds);
    pg8::MoeSched<false, DE, 1> S; S.init((const LAS int*)(lds + MISC_OFF + 64), (const LAS int*)(lds + MISC_OFF + 256), ws + WS_ACT, ws + WS_W2 + (size_t)l * 32 * D * DE,
                                   nullptr, G, (int)blockIdx.x);
    pg8::EpiF8 E{ws + WS_Y, D, INP(I_B2) + (size_t)l * 32 * D, D};
    pg8::gemm_phase(lds, S, E);
}

PHASE_FN phase_combine(LAS unsigned char* lds, int l, int G) {
    lds = (LAS unsigned char*)__builtin_amdgcn_readfirstlane((int)(uintptr_t)lds); l = __builtin_amdgcn_readfirstlane(l); G = __builtin_amdgcn_readfirstlane(G);
    const int tid = tid_local(), lane = tid & 63, wave = __builtin_amdgcn_readfirstlane(tid >> 6);
    unsigned char* ws = WSP();
    moe_tables(ws, l, lds);
    bf16_t* XR = (bf16_t*)(ws + WS_XR); unsigned char* N = ws + WS_N; const unsigned char* Y = ws + WS_Y;
    const float* MOD = (const float*)(ws + WS_MOD);
    const int* eid = (const int*)(ws + WS_ROUT + ROUT_EID); const float* gate = (const float*)(ws + WS_ROUT + ROUT_GATE); const int* posb = (const int*)(ws + WS_ROUT + ROUT_POS);
    const LAS int* tp = (const LAS int*)(lds + MISC_OFF + 64);
    const float* g1n = INP(I_G1) + D; const float* gf = INP(I_GF); float* out = OUTP();
    const int ntok = (l == 0) ? MT : ML;
    for (int row = blockIdx.x * NWAVES + wave; row < ntok; row += G * NWAVES) {
        const int bidx = row < ML ? (row >> 12) : 4; const float* m = MOD + ((size_t)l * 5 + bidx) * 12288;
        const int4 ev = *(const int4*)(eid + (size_t)row * 4), pv = *(const int4*)(posb + (size_t)row * 4); const f32x4 gv = *(const f32x4*)(gate + (size_t)row * 4);
        const unsigned char* yr[4];
        yr[0] = Y + ((size_t)tp[ev.x] * 256 + pv.x) * D; yr[1] = Y + ((size_t)tp[ev.y] * 256 + pv.y) * D; yr[2] = Y + ((size_t)tp[ev.z] * 256 + pv.z) * D; yr[3] = Y + ((size_t)tp[ev.w] * 256 + pv.w) * D;
        u32x2 yv[4][4]; f32x4 xv[4][2]; u32x4 xw[4];
#pragma unroll
        for (int j = 0; j < 4; ++j) { const int col = 8 * (lane + 64 * j);
#pragma unroll
            for (int k = 0; k < 4; ++k) yv[j][k] = *(const u32x2*)(yr[k] + col);
            xw[j] = *(const u32x4*)(XR + (size_t)row * D + col); }
#pragma unroll
        for (int j = 0; j < 4; ++j) pg8::unpack_bf16x8(xw[j], xv[j][0], xv[j][1]);
        float ss = 0.f;
#pragma unroll
        for (int j = 0; j < 4; ++j) { const int col = 8 * (lane + 64 * j);
            f32x4 s0 = (f32x4){0.f, 0.f, 0.f, 0.f}, s1 = s0;
#pragma unroll
            for (int k = 0; k < 4; ++k) { const u32x2 w = yv[j][k];
                const f32x2 a0 = __builtin_amdgcn_cvt_pk_f32_fp8((int)w.x, false), a1 = __builtin_amdgcn_cvt_pk_f32_fp8((int)w.x, true), a2 = __builtin_amdgcn_cvt_pk_f32_fp8((int)w.y, false), a3 = __builtin_amdgcn_cvt_pk_f32_fp8((int)w.y, true);
                s0 += gv[k] * (f32x4){a0.x, a0.y, a1.x, a1.y};
                s1 += gv[k] * (f32x4){a2.x, a2.y, a3.x, a3.y}; }
            const f32x4 gt0 = *(const f32x4*)(m + 5 * 2048 + col), gt1 = *(const f32x4*)(m + 5 * 2048 + col + 4);
            xv[j][0] += gt0 * s0; xv[j][1] += gt1 * s1;
            ss += (xv[j][0].x * xv[j][0].x + xv[j][0].y * xv[j][0].y) + (xv[j][0].z * xv[j][0].z + xv[j][0].w * xv[j][0].w);
            ss += (xv[j][1].x * xv[j][1].x + xv[j][1].y * xv[j][1].y) + (xv[j][1].z * xv[j][1].z + xv[j][1].w * xv[j][1].w); }
        const float rs = rsqrtf(wave_sum(ss) * (1.0f / D) + EPS);
        if (l == 0) {
            const float* m1 = MOD + ((size_t)5 + bidx) * 12288;
#pragma unroll
            for (int j = 0; j < 4; ++j) { const int col = 8 * (lane + 64 * j);
                *(u32x4*)(XR + (size_t)row * D + col) = pg8::pack_bf16x8(xv[j][0], xv[j][1]);
                int w0 = 0, w1 = 0;
#pragma unroll
                for (int q = 0; q < 2; ++q) { const f32x4 gg = *(const f32x4*)(g1n + col + 4 * q), sh = *(const f32x4*)(m1 + col + 4 * q), sc = *(const f32x4*)(m1 + 2048 + col + 4 * q);
                    const f32x4 n = ((xv[j][q] * rs) * gg) * (sc + 1.0f) + sh;
                    if (q == 0) { w0 = __builtin_amdgcn_cvt_pk_fp8_f32(n.x, n.y, w0, false); w0 = __builtin_amdgcn_cvt_pk_fp8_f32(n.z, n.w, w0, true); }
                    else { w1 = __builtin_amdgcn_cvt_pk_fp8_f32(n.x, n.y, w1, false); w1 = __builtin_amdgcn_cvt_pk_fp8_f32(n.z, n.w, w1, true); } }
                *(u32x2*)(N + (size_t)row * D + col) = (u32x2){(unsigned)w0, (unsigned)w1}; }
        } else {
            f32x4 gfv[4][2];
#pragma unroll
            for (int j = 0; j < 4; ++j)
#pragma unroll
                for (int q = 0; q < 2; ++q) gfv[j][q] = *(const f32x4*)(gf + 8 * (lane + 64 * j) + 4 * q);
            asm volatile("" ::: "memory");
#pragma unroll
            for (int j = 0; j < 4; ++j) { const int col = 8 * (lane + 64 * j);
                *(f32x4*)(out + (size_t)row * D + col) = (xv[j][0] * rs) * gfv[j][0];
                *(f32x4*)(out + (size_t)row * D + col + 4) = (xv[j][1] * rs) * gfv[j][1]; }
        }
    }
}

__global__ void __launch_bounds__(NTHREADS, 2) mk_fwd(Args a) {
    extern __shared__ __attribute__((aligned(16))) unsigned char lds_raw[];
    LAS unsigned char* lds = (LAS unsigned char*)lds_raw;
    const int tid = threadIdx.x; const int G = gridDim.x;
    if (tid < 16) ((LAS unsigned*)(lds + MISC_OFF))[tid] = 0u;
    if (tid == 64) { LAS unsigned long long* pt = (LAS unsigned long long*)(lds + PT_OFF);
#pragma unroll
        for (int i = 0; i < 26; ++i) pt[i] = (unsigned long long)a.in[i];
        pt[PT_OUT] = (unsigned long long)a.out; pt[PT_WS] = (unsigned long long)a.ws; }
    __syncthreads();
    const bool multi = (a.ph_hi - a.ph_lo) > 1;
    if (multi) (void)xcd_barrier_post((unsigned*)(a.ws + WS_CTL) + CW_BAR, (volatile LAS unsigned*)(lds + MISC_OFF));
    const int lo = a.ph_lo, hi = a.ph_hi;
#define IN(k) (lo <= (k) && (k) < hi)
#define SEAM(k) do { if (IN((k) + 1)) { XcdBarrier _b; _b.bar = (unsigned*)(a.ws + WS_CTL) + CW_BAR; _b.x = xb_xcc_id(); _b.st = (volatile LAS unsigned*)(lds + MISC_OFF); xcd_barrier(_b); if ((MK_REPEAT >> 11) & 1) xcd_barrier(_b); } } while (0)

    if (IN(0)) { REP(0) phase_prologue(lds, 0, G); SEAM(0); }
    if (IN(1)) { phase_modreduce(lds, 0, G); SEAM(1); }
#define LAYER_BODY(l) { \
        const int pb = 2 + 10 * l; \
        if (l == 0 && IN(pb + 0)) { phase_norm1_l0(lds, 0, G); SEAM(pb + 0); } \
        if (IN(pb + 1)) { REP(2) phase_inproj(lds, l, G); SEAM(pb + 1); } \
        if (IN(pb + 2)) { REP(3) phase_prep(lds, l, G); SEAM(pb + 2); } \
        if (IN(pb + 3)) { REP(4) phase_attention(lds, l, G); SEAM(pb + 3); } \
        if (IN(pb + 4)) { REP(5) phase_fixup(lds, l, G); SEAM(pb + 4); } \
        if (IN(pb + 5)) { if (l == 0) { REP(6) phase_outproj(lds, l, G); } else phase_outproj(lds, l, G); SEAM(pb + 5); } \
        if (IN(pb + 6)) { phase_router(lds, l, G); SEAM(pb + 6); } \
        if (IN(pb + 7)) { REP(8) phase_moe_up(lds, l, G); SEAM(pb + 7); } \
        if (IN(pb + 8)) { REP(9) phase_moe_down(lds, l, G); SEAM(pb + 8); } \
        if (IN(pb + 9)) { if (l == 1) { REP(10) phase_combine(lds, l, G); } else phase_combine(lds, l, G); if (l == 0) SEAM(pb + 9); } \
    }
    LAYER_BODY(0)
    LAYER_BODY(1)
#undef LAYER_BODY
#undef IN
#undef SEAM
}

extern "C" void kernel_launch(void* const* d_in, const int* in_sizes, int n_in, void* d_out, int out_size, void* d_ws, size_t ws_size, hipStream_t stream) {
    static int grid = 0;
    if (grid == 0) {
        if (n_in != 26 || in_sizes[0] != ML * D || out_size != ML * D || ws_size < WS_END) {
            fprintf(stderr, "kernel_launch: shape mismatch (n_in %d, in0 %d, out %d, ws %zu need %zu); nothing launched\n", n_in, n_in > 0 ? in_sizes[0] : -1, out_size, ws_size, (size_t)WS_END); grid = -1; return; }
        int dev = 0, cus = 0, per_cu = 0;
        if (hipGetDevice(&dev) != hipSuccess || hipDeviceGetAttribute(&cus, hipDeviceAttributeMultiprocessorCount, dev) != hipSuccess) { grid = -1; return; }
        if (hipFuncSetAttribute((const void*)mk_fwd, hipFuncAttributeMaxDynamicSharedMemorySize, LDS_BYTES) != hipSuccess) { fprintf(stderr, "kernel_launch: hipFuncSetAttribute failed\n"); grid = -1; return; }
        if (hipOccupancyMaxActiveBlocksPerMultiprocessor(&per_cu, (const void*)mk_fwd, NTHREADS, LDS_BYTES) != hipSuccess || per_cu < 1)
            fprintf(stderr, "kernel_launch: note: occupancy query reports %d workgroups per CU\n", per_cu);
        (void)hipGetLastError();
        grid = cus;
    }
    if (grid < 0) return;
    if (hipMemsetAsync((char*)d_ws + WS_CTL, 0, CTL_ZERO_BYTES, stream) != hipSuccess) { fprintf(stderr, "kernel_launch: memset failed\n"); return; }
    Args a{};
    for (int i = 0; i < 26; ++i) a.in[i] = (const float*)d_in[i];
    a.out = (float*)d_out; a.ws = (unsigned char*)d_ws;
#if MK_PER_PHASE_LAUNCH
    for (int p = 0; p < NPHASE; ++p) {
        if (p == 12) continue;
        a.ph_lo = p; a.ph_hi = p + 1;
        hipLaunchKernelGGL(mk_fwd, dim3(grid), dim3(NTHREADS), LDS_BYTES, stream, a);
    }
#else
    a.ph_lo = 0; a.ph_hi = NPHASE;
    hipLaunchKernelGGL(mk_fwd, dim3(grid), dim3(NTHREADS), LDS_BYTES, stream, a);
#endif
    const hipError_t le = hipPeekAtLastError();
    if (le != hipSuccess) fprintf(stderr, "kernel_launch: launch failed: %s\n", hipGetErrorName(le));
}
```

```cpp
#include <hip/hip_runtime.h>
#include <cstdio>
#include <cstdint>

#ifndef MK_PER_PHASE_LAUNCH
#define MK_PER_PHASE_LAUNCH 0
#endif

#ifndef MK_REPEAT
#define MK_REPEAT 0
#endif
#define REP(k) for (int _rep = 0; _rep < 1 + ((MK_REPEAT >> (k)) & 1); ++_rep)
#define GAS __attribute__((address_space(1)))
#define LAS __attribute__((address_space(3)))
typedef unsigned short bf16_t;
typedef short bf16x8 __attribute__((ext_vector_type(8)));
typedef short s16x4 __attribute__((ext_vector_type(4)));
typedef float f32x4 __attribute__((ext_vector_type(4)));
typedef float f32x2 __attribute__((ext_vector_type(2)));
typedef float f32x16 __attribute__((ext_vector_type(16)));
typedef unsigned u32x4 __attribute__((ext_vector_type(4)));
typedef unsigned u32x2 __attribute__((ext_vector_type(2)));
typedef int v8i __attribute__((ext_vector_type(8)));

constexpr int D = 2048, NB = 4, SEQ = 4096, CTX = 256, TK = CTX + SEQ  , DEPTH = 2;
constexpr int ML = NB * SEQ  , MC = NB * CTX  , MT = ML + MC  ;
constexpr int INW = 3584, NE = 32, DE = 1024;
constexpr int OFF_QA = 0, OFF_KA = 1024, OFF_VA = 1280, OFF_QB = 1536, OFF_KB = 2048, OFF_VB = 2560, OFF_UC = 3072;
constexpr float EPS = 1e-6f;
constexpr int MAXROWS = 77824;
constexpr int NWAVES = 8, NTHREADS = 512;

constexpr size_t MiB = 1u << 20;
constexpr size_t WS_CTL = 0, CTL_ZERO_BYTES = 2 * MiB;
constexpr size_t WS_MOD = 1 * MiB;
constexpr size_t WS_ROPE = 2 * MiB;
constexpr size_t WS_ROUT = 3 * MiB;
constexpr size_t WS_WRS = 7 * MiB;
constexpr size_t WS_XR = 8 * MiB;
constexpr size_t WS_N = 144 * MiB;
constexpr size_t WS_P = 212 * MiB;
constexpr size_t WS_QA = 332 * MiB;
constexpr size_t WS_KA = 366 * MiB;
constexpr size_t WS_VA = 375 * MiB;
constexpr size_t WS_QB = 384 * MiB;
constexpr size_t WS_KB = 401 * MiB;
constexpr size_t WS_VB = 418 * MiB;
constexpr size_t WS_CAT = 435 * MiB;
constexpr size_t WS_OB = 503 * MiB;
constexpr size_t WS_ACT = 571 * MiB;
constexpr size_t WS_Y = 723 * MiB;
constexpr size_t WS_WIN = 1027 * MiB;
constexpr size_t WS_WOUT = 1055 * MiB;
constexpr size_t WS_W1 = 1071 * MiB;
constexpr size_t WS_W2 = 1583 * MiB;
constexpr size_t WS_MODP = 1839 * MiB;
constexpr size_t WS_NF8 = 1871 * MiB;
constexpr size_t WS_END = 1907 * MiB;
static_assert(WS_XR + (size_t)MT * D * 4 <= WS_N && WS_N + (size_t)MT * D * 2 <= WS_P && WS_P + (size_t)MT * INW * 2 <= WS_QA, "ws map 1");
static_assert(WS_QA + (size_t)MT * 1024 * 2 <= WS_KA && WS_KA + (size_t)MT * 256 * 2 <= WS_VA && WS_VA + (size_t)MT * 256 * 2 <= WS_QB, "ws map 2");
static_assert(WS_QB + (size_t)MT * 512 * 2 <= WS_KB && WS_KB + (size_t)MT * 512 * 2 <= WS_VB && WS_VB + (size_t)MT * 512 * 2 <= WS_CAT, "ws map 3");
static_assert(WS_CAT + (size_t)MT * D * 2 <= WS_OB && WS_OB + (size_t)MT * 1024 * 4 <= WS_ACT && WS_ACT + (size_t)MAXROWS * 1024 * 2 <= WS_Y, "ws map 4");
static_assert(WS_Y + (size_t)MAXROWS * 2048 * 2 <= WS_WIN && WS_WIN + (size_t)2 * INW * D * 2 <= WS_WOUT && WS_WOUT + (size_t)2 * D * D * 2 <= WS_W1, "ws map 5");
static_assert(WS_W1 + (size_t)2 * 32 * 2048 * 2048 * 2 <= WS_W2 && WS_W2 + (size_t)2 * 32 * 2048 * 1024 * 2 <= WS_MODP && WS_MODP + (size_t)64 * 10 * 12288 * 4 <= WS_NF8 && WS_NF8 + (size_t)MT * D <= WS_END, "ws map 6");
static_assert(NB * TK == MT, "K/V row count");
constexpr size_t ROUT_EID = 0, ROUT_GATE = (size_t)MT * 16, ROUT_POS = (size_t)MT * 32, ROUT_LIST = (size_t)MT * 48;
static_assert(WS_ROUT + ROUT_LIST + (size_t)32 * MT * 4 <= WS_WRS && WS_WRS + (size_t)2 * 2 * 32 * 2048 * 2 <= WS_XR, "router map");
constexpr int CW_BAR = 4096;
constexpr int CW_CNT = 8192;
constexpr int CW_Q = 12288;
static_assert((CW_Q + 512) * 4 <= (int)WS_MOD && CW_CNT + 64 * 64 <= CW_Q, "ctl map");

constexpr int RING_BYTES = 131072;
constexpr int MISC_OFF = RING_BYTES + 1024;
constexpr int LDS_BYTES = 163840;
constexpr int SG_OFF = MISC_OFF + 6144;
constexpr int FLS = 2052;

#define VM_WAIT() asm volatile("s_waitcnt vmcnt(0)" ::: "memory")
#define LDS_WAIT() asm volatile("s_waitcnt lgkmcnt(0)" ::: "memory")
__device__ __forceinline__ unsigned cvt_pk_bf16(float lo, float hi) { unsigned r; asm volatile("v_cvt_pk_bf16_f32 %0, %1, %2" : "=v"(r) : "v"(lo), "v"(hi)); return r; }
__device__ __forceinline__ bf16_t f2bf(float f) { return (bf16_t)(cvt_pk_bf16(f, 0.f) & 0xffffu); }
__device__ __forceinline__ float bf2f(bf16_t b) { return __uint_as_float(((unsigned)b) << 16); }
__device__ __forceinline__ int tid_local() { int t = threadIdx.x; asm volatile("" : "+v"(t)); return t; }
template <class T> __device__ __forceinline__ T* uniform_ptr(T* p) {
    const unsigned long long v = (unsigned long long)p;
    const unsigned lo = __builtin_amdgcn_readfirstlane((unsigned)v), hi = __builtin_amdgcn_readfirstlane((unsigned)(v >> 32));
    return (T*)(GAS T*)(((unsigned long long)hi << 32) | lo);
}
__device__ __forceinline__ float wave_sum(float v) {
    v += __builtin_bit_cast(float, __builtin_amdgcn_update_dpp(0, __builtin_bit_cast(int, v), 0xB1, 0xF, 0xF, true));
    v += __builtin_bit_cast(float, __builtin_amdgcn_update_dpp(0, __builtin_bit_cast(int, v), 0x4E, 0xF, 0xF, true));
    v += __builtin_bit_cast(float, __builtin_amdgcn_update_dpp(0, __builtin_bit_cast(int, v), 0x141, 0xF, 0xF, true));
    v += __builtin_bit_cast(float, __builtin_amdgcn_update_dpp(0, __builtin_bit_cast(int, v), 0x140, 0xF, 0xF, true));
    const float a = __builtin_bit_cast(float, __builtin_amdgcn_readlane(__builtin_bit_cast(int, v), 0)), b = __builtin_bit_cast(float, __builtin_amdgcn_readlane(__builtin_bit_cast(int, v), 16));
    const float c = __builtin_bit_cast(float, __builtin_amdgcn_readlane(__builtin_bit_cast(int, v), 32)), d = __builtin_bit_cast(float, __builtin_amdgcn_readlane(__builtin_bit_cast(int, v), 48));
    return (a + b) + (c + d);
}

constexpr int PT_OFF = 131072 + 1024 + 3072;
constexpr int PT_OUT = 26, PT_WS = 27;
__device__ __forceinline__ unsigned long long ldp_raw(LAS unsigned char* lds, int i) {
    const u32x2 v = *(const LAS u32x2*)(lds + PT_OFF + 8 * i);
    const unsigned lo = __builtin_amdgcn_readfirstlane(v.x), hi = __builtin_amdgcn_readfirstlane(v.y);
    return ((unsigned long long)hi << 32) | lo;
}
#define INP(i) ((const float*)(const GAS float*)ldp_raw(lds, (i)))
#define WSP() ((unsigned char*)(GAS unsigned char*)ldp_raw(lds, PT_WS))
#define OUTP() ((float*)(GAS float*)ldp_raw(lds, PT_OUT))
#define PHASE_FN __device__ __forceinline__ void

#define XB_TMO      128
#define XB_XCNT(j)  (256  + 64 * (j))
#define XB_XSUB(j)  (1280 + 64 * (j))
#define XB_XGEN(j)  (2304 + 64 * (j))
#define XB_TOP      3328
#define XB_TOPGEN   3392
#define XCD_BAR_WORDS 3456
#define XB_SPIN_CAP (1u << 18)
__device__ __forceinline__ unsigned xb_ld(unsigned* p)              { return __hip_atomic_load(p, __ATOMIC_RELAXED, __HIP_MEMORY_SCOPE_AGENT); }
__device__ __forceinline__ unsigned xb_add(unsigned* p, unsigned v) { return __hip_atomic_fetch_add(p, v, __ATOMIC_RELAXED, __HIP_MEMORY_SCOPE_AGENT); }
__device__ __forceinline__ unsigned xb_xcc_id() { return (unsigned)__builtin_amdgcn_s_getreg((3 << 11) | 20) & 0xFu; }
#define XB_SPIN(cond, bar) do { unsigned _sp = 0; while (cond) { __builtin_amdgcn_s_sleep(1); \
    if ((++_sp & 255u) == 0u) { if (xb_ld(&(bar)[XB_TMO])) break; if (_sp > XB_SPIN_CAP) { atomicAdd(&(bar)[XB_TMO], 1u); break; } } } } while (0)
struct XcdBarrier { unsigned* bar; unsigned x; volatile LAS unsigned* st; };
__device__ __forceinline__ XcdBarrier xcd_barrier_post(unsigned* bar, volatile LAS unsigned* st) {
    XcdBarrier b; b.bar = bar; b.x = xb_xcc_id(); b.st = st;
    if (threadIdx.x == 0) (void)xb_add(&bar[XB_XCNT(b.x)], 1u);
    return b;
}
__device__ __forceinline__ void xcd_barrier_complete(unsigned* bar, unsigned x, unsigned& nloc, unsigned& nx) {
    const unsigned G = gridDim.x * gridDim.y * gridDim.z;
    unsigned sum, cnt, mine, sp = 0u;
    for (;;) {
        sum = 0u; cnt = 0u; mine = 0u;
#pragma unroll
        for (unsigned j = 0; j < 16; ++j) { const unsigned c = xb_ld(&bar[XB_XCNT(j)]); sum += c; cnt += (c > 0u) ? 1u : 0u; mine = (j == x) ? c : mine; }
        if (sum == G) break;
        __builtin_amdgcn_s_sleep(1);
        if ((++sp & 255u) == 0u) { if (xb_ld(&bar[XB_TMO])) break; if (sp > XB_SPIN_CAP) { atomicAdd(&bar[XB_TMO], 1u); break; } }
    }
    nloc = mine > 0u ? mine : 1u; nx = cnt > 0u ? cnt : 1u;
}
__device__ __forceinline__ void xcd_barrier(const XcdBarrier& b) {
    asm volatile("s_waitcnt vmcnt(0)" ::: "memory");
    __syncthreads();
    if (threadIdx.x == 0) {
        unsigned* bar = b.bar;
        __builtin_amdgcn_s_waitcnt(0);
        unsigned nloc = b.st[0], nx = b.st[1];
        if (nloc == 0u) { xcd_barrier_complete(bar, b.x, nloc, nx); b.st[0] = nloc; b.st[1] = nx; }
        const unsigned old = xb_add(&bar[XB_XSUB(b.x)], 1u);
        const unsigned gen = old / nloc;
        if (old + 1u == (gen + 1u) * nloc) {
            __builtin_amdgcn_fence(__ATOMIC_RELEASE, "agent");
            asm volatile("s_waitcnt vmcnt(0)" ::: "memory");
            const unsigned og = xb_add(&bar[XB_TOP], 1u);
            const unsigned tg = og / nx;
            if (og + 1u == (tg + 1u) * nx) xb_add(&bar[XB_TOPGEN], 1u);
            else XB_SPIN(xb_ld(&bar[XB_TOPGEN]) == tg, bar);
            __builtin_amdgcn_fence(__ATOMIC_ACQUIRE, "agent");
            xb_add(&bar[XB_XGEN(b.x)], 1u);
            asm volatile("s_waitcnt vmcnt(0)" ::: "memory");
        } else {
            XB_SPIN(xb_ld(&bar[XB_XGEN(b.x)]) == gen, bar);
            __builtin_amdgcn_fence(__ATOMIC_ACQUIRE, "agent");
            asm volatile("s_waitcnt vmcnt(0)" ::: "memory");
        }
    }
    __syncthreads();
}

namespace pg8 {
constexpr int BM = 256, BK = 64, HALF = 128, HTB = HALF * BK * 2, STAGE_BYTES = 8 * HTB, NXCD = 8, WGM = 8;
__host__ __device__ __forceinline__ int lds_byte(int r, int c) { const int st = (r >> 4) * 2 + (c >> 5), rr = r & 15, cc = c & 31, ob = rr * 64 + cc * 2; return st * 1024 + (ob ^ (((ob >> 9) & 1) << 5)); }
__host__ __device__ __forceinline__ void stage_rc(int b, int& R, int& C) { const int st = b / 1024, sb = b % 1024, swz = sb ^ (((sb >> 9) & 1) << 5); R = (st >> 1) * 16 + swz / 64; C = (st & 1) * 32 + (swz % 64) / 2; }
__host__ __device__ __forceinline__ int perm32(int rho) { const int n = rho >> 4, i = rho & 15; return 8 * (i >> 2) + 4 * n + (i & 3); }

__host__ __device__ __forceinline__ int f8_f(int rr) { return (0x9C >> (2 * (rr >> 2))) & 3; }
__host__ __device__ __forceinline__ int lds_byte8(int r, int b) { const int st = (r >> 4) * 2 + (b >> 6), rr = r & 15, q = (b >> 4) & 3; return st * 1024 + rr * 64 + ((q ^ f8_f(rr)) << 4) + (b & 15); }
__host__ __device__ __forceinline__ void stage_rc8(int o, int& R, int& Cb) { const int st = o / 1024, w = o % 1024, rr = w / 64, slot = (w % 64) / 16; R = (st >> 1) * 16 + rr; Cb = (st & 1) * 64 + ((slot ^ f8_f(rr)) << 4); }
template <int ESZ> __host__ __device__ __forceinline__ void stage_rcb(int o, int& R, int& Cb) { if constexpr (ESZ == 2) { int C; stage_rc(o, R, C); Cb = 2 * C; } else stage_rc8(o, R, Cb); }
struct Unit { int pm, pn, e; };

template <int K_, int ESZ_> struct DenseSched {
    static constexpr int K = K_, ESZ = ESZ_, SCALE_B = (ESZ_ == 1) ? 121 : 127;
    static constexpr bool GATHER_A = false;
    int nM, nN, nwg, G, c; const char* A; const char* Bt;
    __device__ void init(const void* A_, const void* Bt_, int M, int N, int G_, int c_) { A = (const char*)A_; Bt = (const char*)Bt_; nM = M / BM; nN = N / BM; nwg = nM * nN; G = G_; c = c_; }
    __device__ __forceinline__ bool next(int i, Unit& u) const {
        const long L = (long)i * G + c; if (L >= nwg) return false;
        int wgid = (int)L; { const int q = nwg / NXCD, r = nwg % NXCD, xcd = wgid % NXCD, off = wgid / NXCD; wgid = (xcd < r ? xcd * (q + 1) : r * (q + 1) + (xcd - r) * q) + off; }
        const int nig = WGM * nN, gid = wgid / nig, fm = gid * WGM, gsz = (nM - fm) < WGM ? (nM - fm) : WGM;
        u.pm = fm + ((wgid % nig) % gsz); u.pn = (wgid % nig) / gsz; u.e = 0; return true;
    }
    __device__ __forceinline__ int row0(const Unit& u) const { return u.pm * BM; }
    __device__ __forceinline__ const char* a_base() const { return A; }
    __device__ __forceinline__ const char* b_base(const Unit& u) const { return Bt + (size_t)u.pn * BM * K * ESZ; }
    __device__ __forceinline__ void a_voff(const Unit& u, int tid, unsigned (&v)[2][2]) const {
#pragma unroll
        for (int i = 0; i < 2; ++i) { int R, Cb; stage_rcb<ESZ>(tid * 16 + i * 8192, R, Cb);
#pragma unroll
            for (int h = 0; h < 2; ++h) v[h][i] = (unsigned)((u.pm * BM + h * HALF + R) * (K * ESZ) + Cb); }
    }
};
template <bool GATHER, int K_, int ESZ_> struct MoeSched {
    static constexpr int K = K_, ESZ = ESZ_, SCALE_B = (K_ == 2048) ? 121 : 122;
    static constexpr size_t BSTRIDE = (size_t)2048 * K * ESZ;
    static constexpr bool GATHER_A = GATHER;
    const LAS int* tp; const LAS int* cnt; int start, end, j, stride; const char* A; const char* Bt; const int* list;
    __device__ void init(const LAS int* tp_, const LAS int* cnt_, const void* A_, const void* Bt_, const int* list_, int G, int c) {
        tp = tp_; cnt = cnt_; A = (const char*)A_; Bt = (const char*)Bt_; list = list_;
        const int U = 8 * tp[NE];
        if (G == 256) { const int x = c & 7; j = c >> 3; stride = 32; start = (int)(((long)x * U) / 8); end = (int)(((long)(x + 1) * U) / 8); }
        else { start = 0; end = U; j = c; stride = G; }
    }
    __device__ __forceinline__ bool next(int i, Unit& u) const {
        const int idx = start + i * stride + j; if (idx >= end) return false;
        int e = 0;
        for (int q = 1; q < NE; ++q) e += (8 * tp[q] <= idx) ? 1 : 0;
        e = __builtin_amdgcn_readfirstlane(e);
        const int tiles = tp[e + 1] - tp[e], r = idx - 8 * tp[e];
        const int gi = r >> 5, fm = gi * 4, gsz = (tiles - fm) < 4 ? (tiles - fm) : 4, w = r - 32 * gi;
        u.e = e; u.pm = __builtin_amdgcn_readfirstlane(fm + (w % gsz)); u.pn = __builtin_amdgcn_readfirstlane(w / gsz); return true;
    }
    __device__ __forceinline__ int row0(const Unit& u) const { return __builtin_amdgcn_readfirstlane((tp[u.e] + u.pm) * BM); }
    __device__ __forceinline__ const char* a_base() const { return A; }
    __device__ __forceinline__ const char* b_base(const Unit& u) const { return Bt + (size_t)u.e * BSTRIDE + (size_t)u.pn * BM * K * ESZ; }
    __device__ __forceinline__ void a_voff(const Unit& u, int tid, unsigned (&v)[2][2]) const {
        if constexpr (GATHER) {
            const int* lp = list + (size_t)u.e * MT + u.pm * BM;
            const int nv = cnt[u.e] - u.pm * BM;
            int tok[2][2], Cc[2];
#pragma unroll
            for (int i = 0; i < 2; ++i) { int R; stage_rcb<ESZ>(tid * 16 + i * 8192, R, Cc[i]);
#pragma unroll
                for (int h = 0; h < 2; ++h) { const int lr = h * HALF + R; tok[h][i] = lp[lr < nv ? lr : 0]; } }
            asm volatile("s_waitcnt vmcnt(0)" ::: "memory");
#pragma unroll
            for (int h = 0; h < 2; ++h)
#pragma unroll
                for (int i = 0; i < 2; ++i) v[h][i] = (unsigned)(tok[h][i] * (K * ESZ) + Cc[i]);
        } else {
            const int r0 = row0(u);
#pragma unroll
            for (int i = 0; i < 2; ++i) { int R, Cb; stage_rcb<ESZ>(tid * 16 + i * 8192, R, Cb);
#pragma unroll
                for (int h = 0; h < 2; ++h) v[h][i] = (unsigned)((r0 + h * HALF + R) * (K * ESZ) + Cb); }
        }
    }
};

struct EpiBf16 {
    static constexpr bool PERM = true;
    bf16_t* O; int ldc; const float* bias; int bias_estride;
    __device__ __forceinline__ void operator()(const f32x4 (&acc)[2][2][4][2], const Unit& u, int urow0, int wr, int wc, int fr, int fq) const {
        const int row0 = urow0 + wr * 64 + fr; const int col0 = u.pn * BM + wc * 32 + 8 * fq;
        const float* bp = bias ? bias + (size_t)u.e * bias_estride + col0 : nullptr;
        f32x4 bv[2][2];
#pragma unroll
        for (int bj = 0; bj < 2; ++bj)
#pragma unroll
            for (int n = 0; n < 2; ++n) bv[bj][n] = bp ? *(const f32x4*)(bp + bj * HALF + 4 * n) : (f32x4){0.f, 0.f, 0.f, 0.f};
#pragma unroll
        for (int ai = 0; ai < 2; ++ai)
#pragma unroll
            for (int m = 0; m < 4; ++m) { bf16_t* rowp = O + (size_t)(row0 + ai * HALF + m * 16) * ldc + col0;
#pragma unroll
                for (int bj = 0; bj < 2; ++bj) { const f32x4 v0 = acc[ai][bj][m][0] + bv[bj][0], v1 = acc[ai][bj][m][1] + bv[bj][1];
                    u32x4 w; w.x = cvt_pk_bf16(v0[0], v0[1]); w.y = cvt_pk_bf16(v0[2], v0[3]); w.z = cvt_pk_bf16(v1[0], v1[1]); w.w = cvt_pk_bf16(v1[2], v1[3]);
                    *(u32x4*)(rowp + bj * HALF) = w; } }
    }
};
struct EpiF8 {
    static constexpr bool PERM = true;
    unsigned char* O; int ldc; const float* bias; int bias_estride;
    __device__ __forceinline__ void operator()(const f32x4 (&acc)[2][2][4][2], const Unit& u, int urow0, int wr, int wc, int fr, int fq) const {
        const int row0 = urow0 + wr * 64 + fr; const int col0 = u.pn * BM + wc * 32 + 8 * fq;
        const float* bp = bias + (size_t)u.e * bias_estride + col0;
        f32x4 bv[2][2];
#pragma unroll
        for (int bj = 0; bj < 2; ++bj)
#pragma unroll
            for (int n = 0; n < 2; ++n) bv[bj][n] = *(const f32x4*)(bp + bj * HALF + 4 * n);
#pragma unroll
        for (int ai = 0; ai < 2; ++ai)
#pragma unroll
            for (int m = 0; m < 4; ++m) { unsigned char* rowp = O + (size_t)(row0 + ai * HALF + m * 16) * ldc + col0;
#pragma unroll
                for (int bj = 0; bj < 2; ++bj) { const f32x4 v0 = acc[ai][bj][m][0] + bv[bj][0], v1 = acc[ai][bj][m][1] + bv[bj][1];
                    int w0 = 0, w1 = 0; w0 = __builtin_amdgcn_cvt_pk_fp8_f32(v0[0], v0[1], w0, false); w0 = __builtin_amdgcn_cvt_pk_fp8_f32(v0[2], v0[3], w0, true);
                    w1 = __builtin_amdgcn_cvt_pk_fp8_f32(v1[0], v1[1], w1, false); w1 = __builtin_amdgcn_cvt_pk_fp8_f32(v1[2], v1[3], w1, true);
                    *(u32x2*)(rowp + bj * HALF) = (u32x2){(unsigned)w0, (unsigned)w1}; } }
    }
};
__device__ __forceinline__ float swiglu1(float g, float l) {
    g = fminf(g, 7.0f); l = fminf(fmaxf(l, -7.0f), 7.0f);
    const float sg = __builtin_amdgcn_rcpf(1.0f + __builtin_amdgcn_exp2f(-1.702f * 1.4426950408889634f * g));
    return g * sg * (l + 1.0f);
}
struct EpiSwiglu {
    static constexpr bool PERM = true;
    unsigned char* O; const float* bias;
    __device__ __forceinline__ void operator()(const f32x4 (&acc)[2][2][4][2], const Unit& u, int urow0, int wr, int wc, int fr, int fq) const {
        const int row0 = urow0 + wr * 64 + fr; const int col0 = u.pn * BM + wc * 32 + 8 * fq;
        const float* bp = bias + (size_t)u.e * 2048 + col0;
        f32x4 bv[2][2];
#pragma unroll
        for (int bj = 0; bj < 2; ++bj)
#pragma unroll
            for (int n = 0; n < 2; ++n) bv[bj][n] = *(const f32x4*)(bp + bj * HALF + 4 * n);
#pragma unroll
        for (int ai = 0; ai < 2; ++ai)
#pragma unroll
            for (int m = 0; m < 4; ++m) { unsigned char* rowp = O + (size_t)(row0 + ai * HALF + m * 16) * DE + (col0 >> 1);
#pragma unroll
                for (int bj = 0; bj < 2; ++bj) { const f32x4 v0 = acc[ai][bj][m][0] + bv[bj][0], v1 = acc[ai][bj][m][1] + bv[bj][1];
                    int w = 0; w = __builtin_amdgcn_cvt_pk_fp8_f32(swiglu1(v0[0], v0[1]), swiglu1(v0[2], v0[3]), w, false); w = __builtin_amdgcn_cvt_pk_fp8_f32(swiglu1(v1[0], v1[1]), swiglu1(v1[2], v1[3]), w, true);
                    *(int*)(rowp + bj * (HALF / 2)) = w; } }
    }
};
__device__ __forceinline__ void unpack_bf16x8(const u32x4 w, f32x4& lo, f32x4& hi) {
    lo = (f32x4){__uint_as_float(w.x << 16), __uint_as_float(w.x & 0xffff0000u), __uint_as_float(w.y << 16), __uint_as_float(w.y & 0xffff0000u)};
    hi = (f32x4){__uint_as_float(w.z << 16), __uint_as_float(w.z & 0xffff0000u), __uint_as_float(w.w << 16), __uint_as_float(w.w & 0xffff0000u)};
}
__device__ __forceinline__ u32x4 pack_bf16x8(const f32x4 lo, const f32x4 hi) {
    u32x4 w; w.x = cvt_pk_bf16(lo[0], lo[1]); w.y = cvt_pk_bf16(lo[2], lo[3]); w.z = cvt_pk_bf16(hi[0], hi[1]); w.w = cvt_pk_bf16(hi[2], hi[3]); return w;
}
struct EpiResid {
    static constexpr bool PERM = true;
    const float* xin; const float* cin; const bf16_t* xr_in; bf16_t* xr_out; const float* mod; int layer;
    __device__ __forceinline__ void operator()(const f32x4 (&acc)[2][2][4][2], const Unit& u, int urow0, int wr, int wc, int fr, int fq) const {
        const int row0 = urow0 + wr * 64 + fr, col0 = u.pn * BM + wc * 32 + 8 * fq;
        const int bidx = urow0 < ML ? (urow0 >> 12) : 4;
        const float* gp = mod + (size_t)bidx * 12288 + 2 * 2048 + col0;
        f32x4 g[2][2];
#pragma unroll
        for (int bj = 0; bj < 2; ++bj)
#pragma unroll
            for (int n = 0; n < 2; ++n) g[bj][n] = *(const f32x4*)(gp + bj * HALF + 4 * n);
        if (layer == 0) {
            const float* bbase = urow0 < ML ? xin : cin - (size_t)ML * D;
#pragma unroll
            for (int ai = 0; ai < 2; ++ai)
#pragma unroll
                for (int mp = 0; mp < 2; ++mp) {
                    f32x4 bs[2][2][2];
#pragma unroll
                    for (int mq = 0; mq < 2; ++mq) { const int row = row0 + ai * HALF + (2 * mp + mq) * 16; const float* bp = bbase + (size_t)row * D + col0;
#pragma unroll
                        for (int bj = 0; bj < 2; ++bj)
#pragma unroll
                            for (int n = 0; n < 2; ++n) bs[mq][bj][n] = *(const f32x4*)(bp + bj * HALF + 4 * n); }
#pragma unroll
                    for (int mq = 0; mq < 2; ++mq) { const int m = 2 * mp + mq; const int row = row0 + ai * HALF + m * 16; bf16_t* op = xr_out + (size_t)row * D + col0;
#pragma unroll
                        for (int bj = 0; bj < 2; ++bj) *(u32x4*)(op + bj * HALF) = pack_bf16x8(bs[mq][bj][0] + g[bj][0] * acc[ai][bj][m][0], bs[mq][bj][1] + g[bj][1] * acc[ai][bj][m][1]); }
                    asm volatile("" ::: "memory"); }
        } else {
#pragma unroll
            for (int ai = 0; ai < 2; ++ai) {
                u32x4 bw[4][2];
#pragma unroll
                for (int m = 0; m < 4; ++m) { const int row = row0 + ai * HALF + m * 16; const bf16_t* bp = xr_in + (size_t)row * D + col0;
#pragma unroll
                    for (int bj = 0; bj < 2; ++bj) bw[m][bj] = *(const u32x4*)(bp + bj * HALF); }
#pragma unroll
                for (int m = 0; m < 4; ++m) { const int row = row0 + ai * HALF + m * 16; bf16_t* op = xr_out + (size_t)row * D + col0;
#pragma unroll
                    for (int bj = 0; bj < 2; ++bj) { f32x4 b0, b1; unpack_bf16x8(bw[m][bj], b0, b1);
                        *(u32x4*)(op + bj * HALF) = pack_bf16x8(b0 + g[bj][0] * acc[ai][bj][m][0], b1 + g[bj][1] * acc[ai][bj][m][1]); } }
                asm volatile("" ::: "memory"); }
        }
    }
};

template <class Epi, class Sched>
__device__ __forceinline__ void gemm_phase(LAS unsigned char* lds, const Sched& S, const Epi& E) {
    constexpr int K = Sched::K, ESZ = Sched::ESZ;
    const int tid = tid_local(), wid = __builtin_amdgcn_readfirstlane(tid >> 6), lane = tid & 63, wr = wid >> 2, wc = wid & 3, fr = lane & 15, fq = lane >> 4;
    constexpr int nt = K * ESZ / 128;
    constexpr int SCALE_A = 127, SCALE_B = Sched::SCALE_B;
    unsigned voffB[2], voffA[2][2];
#pragma unroll
    for (int i = 0; i < 2; ++i) { int R, Cb; stage_rcb<ESZ>(tid * 16 + i * 8192, R, Cb); const int Rb = Epi::PERM ? ((R & ~31) + perm32(R & 31)) : R; voffB[i] = (unsigned)(Rb * (K * ESZ) + Cb); }
    constexpr size_t kstep = 128;
    constexpr size_t hstep = (size_t)HALF * K * ESZ;
    const unsigned ldsw = (unsigned)wid * 1024u;
    const int aoff = ESZ == 2 ? lds_byte(wr * 64 + fr, fq * 8) : lds_byte8(wr * 64 + fr, fq * 32), boff = ESZ == 2 ? lds_byte(wc * 32 + fr, fq * 8) : lds_byte8(wc * 32 + fr, fq * 32);
    const int aoff2 = aoff ^ 16, boff2 = boff ^ 16;
#define PG8_SA(b, h) (((b) * 2 + (h)) * HTB)
#define PG8_SB(b, h) ((4 + (b) * 2 + (h)) * HTB)
#define PG8_STAGE(bufoff, gbase, voff) do { _Pragma("unroll") for (int _i = 0; _i < 2; ++_i) \
        __builtin_amdgcn_global_load_lds((const unsigned*)((const char*)(gbase) + (voff)[_i]), (LAS unsigned*)(lds + (bufoff) + ldsw + _i * 8192), 16, 0, 0); } while (0)
#define PG8_LDA(dst, b, h) do { if constexpr (ESZ == 2) { _Pragma("unroll") for (int m = 0; m < 4; ++m) _Pragma("unroll") for (int k = 0; k < 2; ++k) dst[m][k] = *(const LAS bf16x8*)(lds + PG8_SA(b, h) + aoff + m * 2048 + k * 1024); } \
        else { _Pragma("unroll") for (int m = 0; m < 4; ++m) { const u32x4 _lo = *(const LAS u32x4*)(lds + PG8_SA(b, h) + aoff + m * 2048), _hi = *(const LAS u32x4*)(lds + PG8_SA(b, h) + aoff2 + m * 2048); \
            dst##8[m] = (v8i){(int)_lo.x, (int)_lo.y, (int)_lo.z, (int)_lo.w, (int)_hi.x, (int)_hi.y, (int)_hi.z, (int)_hi.w}; } } } while (0)
#define PG8_LDB(dst, b, h) do { if constexpr (ESZ == 2) { _Pragma("unroll") for (int n = 0; n < 2; ++n) _Pragma("unroll") for (int k = 0; k < 2; ++k) dst[n][k] = *(const LAS bf16x8*)(lds + PG8_SB(b, h) + boff + n * 2048 + k * 1024); } \
        else { _Pragma("unroll") for (int n = 0; n < 2; ++n) { const u32x4 _lo = *(const LAS u32x4*)(lds + PG8_SB(b, h) + boff + n * 2048), _hi = *(const LAS u32x4*)(lds + PG8_SB(b, h) + boff2 + n * 2048); \
            dst##8[n] = (v8i){(int)_lo.x, (int)_lo.y, (int)_lo.z, (int)_lo.w, (int)_hi.x, (int)_hi.y, (int)_hi.z, (int)_hi.w}; } } } while (0)
#define PG8_MMA(ai, bj, At, Bt) do { __builtin_amdgcn_s_setprio(1); if constexpr (ESZ == 2) { _Pragma("unroll") for (int m = 0; m < 4; ++m) _Pragma("unroll") for (int n = 0; n < 2; ++n) _Pragma("unroll") for (int k = 0; k < 2; ++k) \
        acc[ai][bj][m][n] = __builtin_amdgcn_mfma_f32_16x16x32_bf16(Bt[n][k], At[m][k], acc[ai][bj][m][n], 0, 0, 0); } \
        else { _Pragma("unroll") for (int m = 0; m < 4; ++m) _Pragma("unroll") for (int n = 0; n < 2; ++n) \
        acc[ai][bj][m][n] = __builtin_amdgcn_mfma_scale_f32_16x16x128_f8f6f4(Bt##8[n], At##8[m], acc[ai][bj][m][n], 0, 0, 0, SCALE_B, 0, SCALE_A); } __builtin_amdgcn_s_setprio(0); } while (0)
#define PG8_WAIT_V(n) asm volatile("s_waitcnt vmcnt(" #n ")" ::: "memory")
#define PG8_WAIT_L(n) asm volatile("s_waitcnt lgkmcnt(" #n ")" ::: "memory")
#define PG8_BAR __builtin_amdgcn_s_barrier()
#define PG8_SCHED __builtin_amdgcn_sched_barrier(0)
    Unit cur, nxt; int ui = 0;
    if (!S.next(0, cur)) return;
    f32x4 acc[2][2][4][2];
#pragma unroll
    for (int a = 0; a < 2; ++a)
#pragma unroll
        for (int b = 0; b < 2; ++b)
#pragma unroll
            for (int m = 0; m < 4; ++m)
#pragma unroll
                for (int n = 0; n < 2; ++n) acc[a][b][m][n] = (f32x4){0.f, 0.f, 0.f, 0.f};
    bf16x8 At[4][2], B0[2][2], B1[2][2];
    v8i At8[4], B08[2], B18[2];
    const char* const Ab = S.a_base();
    const char* cB = S.b_base(cur);
    S.a_voff(cur, tid, voffA);
    PG8_STAGE(PG8_SB(0, 0), cB, voffB); PG8_STAGE(PG8_SB(0, 1), cB + hstep, voffB); PG8_STAGE(PG8_SA(0, 0), Ab, voffA[0]); PG8_STAGE(PG8_SA(0, 1), Ab, voffA[1]);
    if (wr == 1) PG8_BAR;
    PG8_WAIT_V(2); PG8_BAR;
    PG8_STAGE(PG8_SB(1, 0), cB + kstep, voffB); PG8_STAGE(PG8_SA(1, 0), Ab + kstep, voffA[0]); PG8_STAGE(PG8_SB(1, 1), cB + hstep + kstep, voffB);
    PG8_WAIT_V(6); PG8_BAR;
    for (;;) {
        const bool has_next = S.next(ui + 1, nxt);
        const char* nB = has_next ? S.b_base(nxt) : cB;
        unsigned voffN[2][2];
        if constexpr (Sched::GATHER_A) { if (has_next) S.a_voff(nxt, tid, voffN); }
#pragma unroll 1
        for (int t = 0; t < nt; t += 2) {
            const bool last = (t == nt - 2);
            const char* a1 = Ab + (size_t)(t + 1) * kstep;
            const char* a2 = last ? Ab : Ab + (size_t)(t + 2) * kstep; const char* b2 = last ? nB : cB + (size_t)(t + 2) * kstep;
            const char* a3 = a2 + kstep; const char* b3 = b2 + kstep;
            PG8_LDB(B0, 0, 0); PG8_LDB(B1, 0, 1); PG8_SCHED; PG8_LDA(At, 0, 0); PG8_STAGE(PG8_SA(1, 1), a1, voffA[1]);
            if (last && has_next) {
                if constexpr (Sched::GATHER_A) { voffA[0][0] = voffN[0][0]; voffA[0][1] = voffN[0][1]; voffA[1][0] = voffN[1][0]; voffA[1][1] = voffN[1][1]; }
                else S.a_voff(nxt, tid, voffA); }
            PG8_WAIT_V(8); PG8_WAIT_L(0); PG8_BAR; PG8_MMA(0, 0, At, B0); PG8_MMA(0, 1, At, B1); PG8_BAR; PG8_SCHED;
            PG8_LDA(At, 0, 1); PG8_STAGE(PG8_SB(0, 0), b2, voffB); PG8_STAGE(PG8_SB(0, 1), b2 + hstep, voffB); PG8_STAGE(PG8_SA(0, 0), a2, voffA[0]);
            PG8_WAIT_V(8); PG8_WAIT_L(0); PG8_BAR; PG8_MMA(1, 0, At, B0); PG8_MMA(1, 1, At, B1); PG8_BAR; PG8_SCHED;
            PG8_LDB(B0, 1, 0); PG8_LDB(B1, 1, 1); PG8_SCHED; PG8_LDA(At, 1, 0); PG8_STAGE(PG8_SA(0, 1), a2, voffA[1]);
            PG8_WAIT_V(8); PG8_WAIT_L(0); PG8_BAR; PG8_MMA(0, 0, At, B0); PG8_MMA(0, 1, At, B1); PG8_BAR; PG8_SCHED;
            PG8_LDA(At, 1, 1); PG8_STAGE(PG8_SB(1, 0), b3, voffB); PG8_STAGE(PG8_SB(1, 1), b3 + hstep, voffB); PG8_STAGE(PG8_SA(1, 0), a3, voffA[0]);
            PG8_WAIT_V(8); PG8_WAIT_L(0); PG8_BAR; PG8_MMA(1, 0, At, B0); PG8_MMA(1, 1, At, B1); PG8_BAR; PG8_SCHED;
        }
        if (wr == 0) PG8_BAR;
        E(acc, cur, S.row0(cur), wr, wc, fr, fq);
        if constexpr (Epi::PERM) { if ((MK_REPEAT >> 12) & 1) E(acc, cur, S.row0(cur), wr, wc, fr, fq); }
        if (!has_next) break;
#pragma unroll
        for (int a = 0; a < 2; ++a)
#pragma unroll
            for (int b = 0; b < 2; ++b)
#pragma unroll
                for (int m = 0; m < 4; ++m)
#pragma unroll
                    for (int n = 0; n < 2; ++n) acc[a][b][m][n] = (f32x4){0.f, 0.f, 0.f, 0.f};
        cur = nxt; cB = nB; ++ui;
        if (wr == 1) PG8_BAR;
    }
    PG8_WAIT_V(0);
    PG8_BAR;
#undef PG8_SA
#undef PG8_SB
#undef PG8_STAGE
#undef PG8_LDA
#undef PG8_LDB
#undef PG8_MMA
#undef PG8_WAIT_V
#undef PG8_WAIT_L
#undef PG8_BAR
#undef PG8_SCHED
}
}

namespace att {
constexpr int NW = 8, QBLK = 32, KVBLK = 64, DV = 128;
constexpr float THR = 8.f;
constexpr int SHM_V = KVBLK * DV * 2, SHM_K = KVBLK * 128 * 2, SHM_ATTN = 2 * SHM_V + 2 * SHM_K + NW * 64 * 4;
#define SBAR() __builtin_amdgcn_sched_barrier(0)
__device__ __forceinline__ int crow(int r, int hi) { return (r & 3) + 8 * (r >> 2) + 4 * hi; }
template <int DQK> __device__ __forceinline__ int kswz(int row, int colB) {
    if constexpr (DQK == 128) return row * 256 + (colB ^ ((row & 15) << 4));
    else return row * 128 + (colB ^ (((row >> 1) & 7) << 4));
}
template <int DQK> __device__ __forceinline__ void partialSM(f32x16& p0, f32x16& p1, float& m_reg, float& mn, float& alpha) {
    constexpr float SCALE = (DQK == 128) ? 0.088388347648318440f : 0.125f;
    constexpr float Cc = SCALE * 1.4426950408889634f;
    float pmax = p0[0];
#pragma unroll
    for (int r = 1; r < 16; ++r) pmax = fmaxf(pmax, p0[r]);
#pragma unroll
    for (int r = 0; r < 16; ++r) pmax = fmaxf(pmax, p1[r]);
    { auto rr = __builtin_amdgcn_permlane32_swap(__float_as_uint(pmax), __float_as_uint(pmax), false, false);
      pmax = fmaxf(__uint_as_float(rr[0]), __uint_as_float(rr[1])); }
    if (__builtin_expect(__all(pmax - m_reg <= THR / SCALE), 1)) { mn = m_reg; alpha = 1.f; }
    else { mn = fmaxf(m_reg, pmax); alpha = __builtin_amdgcn_exp2f((m_reg - mn) * Cc); m_reg = mn; }
    const float mnC = -mn * Cc;
#pragma unroll
    for (int r = 0; r < 16; ++r) p0[r] = fmaf(p0[r], Cc, mnC);
#pragma unroll
    for (int r = 0; r < 16; ++r) p1[r] = fmaf(p1[r], Cc, mnC);
#pragma unroll
    for (int r = 0; r < 16; ++r) p0[r] = __builtin_amdgcn_exp2f(p0[r]);
}
__device__ __forceinline__ void finishSM(f32x16& p0, f32x16& p1, float alpha, float& l_reg, bf16x8& pa0, bf16x8& pa1, bf16x8& pa2, bf16x8& pa3) {
#pragma unroll
    for (int r = 0; r < 16; ++r) p1[r] = __builtin_amdgcn_exp2f(p1[r]);
    float ps = 0;
#pragma unroll
    for (int r = 0; r < 16; ++r) ps += p0[r];
#pragma unroll
    for (int r = 0; r < 16; ++r) ps += p1[r];
    { auto rr = __builtin_amdgcn_permlane32_swap(__float_as_uint(ps), __float_as_uint(ps), false, false);
      ps = __uint_as_float(rr[0]) + __uint_as_float(rr[1]); }
    l_reg = l_reg * alpha + ps;
#define PK4(P, BASE, OUT) do { unsigned a0 = cvt_pk_bf16(P[BASE + 0], P[BASE + 1]), a1 = cvt_pk_bf16(P[BASE + 2], P[BASE + 3]);   \
    unsigned b0 = cvt_pk_bf16(P[BASE + 4], P[BASE + 5]), b1 = cvt_pk_bf16(P[BASE + 6], P[BASE + 7]);                              \
    auto r0 = __builtin_amdgcn_permlane32_swap(a0, b0, false, false); auto r1 = __builtin_amdgcn_permlane32_swap(a1, b1, false, false); \
    u32x4 w = {r0[0], r1[0], r0[1], r1[1]}; OUT = *reinterpret_cast<bf16x8*>(&w); } while (0)
    PK4(p0, 0, pa0); PK4(p0, 8, pa1); PK4(p1, 0, pa2); PK4(p1, 8, pa3);
#undef PK4
}
template <int DQK> __device__ __forceinline__ void qkt(f32x16& p0, f32x16& p1, const char* Ks, const bf16x8* qr, int r32, int hi) {
    p0 = f32x16{}; p1 = f32x16{};
#pragma unroll
    for (int d0 = 0; d0 < DQK / 16; ++d0) { const int cb = (d0 * 16 + hi * 8) * 2;
        const bf16x8 b0 = *reinterpret_cast<const bf16x8*>(Ks + kswz<DQK>(r32, cb));
        const bf16x8 b1 = *reinterpret_cast<const bf16x8*>(Ks + kswz<DQK>(32 + r32, cb));
        p0 = __builtin_amdgcn_mfma_f32_32x32x16_bf16(b0, qr[d0], p0, 0, 0, 0);
        p1 = __builtin_amdgcn_mfma_f32_32x32x16_bf16(b1, qr[d0], p1, 0, 0, 0); }
}
__device__ __forceinline__ int v_st(int k, int c) { const int kk = (k & ~0xC) | ((k & 4) << 1) | ((k & 8) >> 1); return ((kk >> 3) * 4 + (c >> 5)) * 512 + ((kk & 7) * 32 + (c & 31)) * 2; }
__device__ __forceinline__ int v_rd_base(int lane) { return ((lane & 3) << 3) | (((lane >> 2) & 3) << 6) | (((lane >> 4) & 1) << 5) | (((lane >> 5) & 1) << 8); }
constexpr int v_rd_off(int d0, int ks, int half) { return d0 * 512 + ks * 4096 + half * 2048; }
template <int OFF> __device__ __forceinline__ s16x4 tr_read(int vb) {
    s16x4 r; asm volatile("ds_read_b64_tr_b16 %0, %1 offset:%2" : "=&v"(r) : "v"(vb), "i"(OFF) : "memory"); return r;
}
template <int KS> __device__ __forceinline__ void pv_step(f32x16* o, int vb, bf16x8 pa) {
    const s16x4 l0 = tr_read<v_rd_off(0, KS, 0)>(vb), h0 = tr_read<v_rd_off(0, KS, 1)>(vb), l1 = tr_read<v_rd_off(1, KS, 0)>(vb), h1 = tr_read<v_rd_off(1, KS, 1)>(vb);
    const s16x4 l2 = tr_read<v_rd_off(2, KS, 0)>(vb), h2 = tr_read<v_rd_off(2, KS, 1)>(vb), l3 = tr_read<v_rd_off(3, KS, 0)>(vb), h3 = tr_read<v_rd_off(3, KS, 1)>(vb);
    asm volatile("s_waitcnt lgkmcnt(0)" ::: "memory"); SBAR();
#define PK(L, H) (bf16x8){L[0], L[1], L[2], L[3], H[0], H[1], H[2], H[3]}
    o[0] = __builtin_amdgcn_mfma_f32_32x32x16_bf16(pa, PK(l0, h0), o[0], 0, 0, 0);
    o[1] = __builtin_amdgcn_mfma_f32_32x32x16_bf16(pa, PK(l1, h1), o[1], 0, 0, 0);
    o[2] = __builtin_amdgcn_mfma_f32_32x32x16_bf16(pa, PK(l2, h2), o[2], 0, 0, 0);
    o[3] = __builtin_amdgcn_mfma_f32_32x32x16_bf16(pa, PK(l3, h3), o[3], 0, 0, 0);
#undef PK
}
__device__ __forceinline__ void pv_d0(f32x16* o, int vb, bf16x8 pa0, bf16x8 pa1, bf16x8 pa2, bf16x8 pa3) {
    pv_step<0>(o, vb, pa0); pv_step<1>(o, vb, pa1); pv_step<2>(o, vb, pa2); pv_step<3>(o, vb, pa3);
}
template <int DQK, int LDQ, int LDK, int LDV, int LDO, bool OUT_BF16>
__device__ __forceinline__ void attn_body(const bf16_t* __restrict__ Qb, const bf16_t* __restrict__ Kh, const bf16_t* __restrict__ Vh, void* __restrict__ Ob, int seq, char* lds) {
    const int tid = tid_local(), wid = tid >> 6, lane = tid & 63, r32 = lane & 31, hi = lane >> 5;
    Qb = uniform_ptr(Qb); Kh = uniform_ptr(Kh); Vh = uniform_ptr(Vh); Ob = uniform_ptr(Ob);
    char* V_lds = lds; char* K_lds = lds + 2 * SHM_V;
    float* ws = (float*)(lds + 2 * SHM_V + 2 * SHM_K) + wid * 64; float* li_l = ws; float* al_l = ws + 32;
    float m_reg = -1e30f, l_reg = 0; f32x16 o[4] = {}; bf16x8 qr[DQK / 16];
    const unsigned qoff = (unsigned)((wid * QBLK + r32) * LDQ + hi * 8) * 2u;
#pragma unroll
    for (int d0 = 0; d0 < DQK / 16; ++d0) qr[d0] = *reinterpret_cast<const bf16x8*>((const char*)Qb + qoff + d0 * 32);
    const int sr = tid >> 4, sc = (tid & 15) * 8, vst0 = v_st(sr, sc), vst1 = v_st(32 + sr, sc);
    const int kr = (DQK == 128) ? sr : (tid >> 3), kc = (DQK == 128) ? sc : (tid & 7) * 8;
    const unsigned voffV = (unsigned)(sr * LDV + sc) * 2u, voffK = (unsigned)(kr * LDK + kc) * 2u;
    const int vb0 = (int)(uintptr_t)V_lds + v_rd_base(lane);
    struct { bf16x8 vs0, vs1, ks0, ks1; } sr_[2];
#define SLOAD(i, k0) do { const char* _vb = (const char*)Vh + (size_t)(k0) * (LDV * 2); const char* _kb = (const char*)Kh + (size_t)(k0) * (LDK * 2); \
    sr_[i].vs0 = *reinterpret_cast<const bf16x8*>(_vb + voffV); sr_[i].vs1 = *reinterpret_cast<const bf16x8*>(_vb + voffV + 32 * LDV * 2); \
    sr_[i].ks0 = *reinterpret_cast<const bf16x8*>(_kb + voffK); if constexpr (DQK == 128) sr_[i].ks1 = *reinterpret_cast<const bf16x8*>(_kb + voffK + 32 * LDK * 2); } while (0)
#define SWRITE(b, i) do { *(bf16x8*)(V_lds + (b) * SHM_V + vst0) = sr_[i].vs0;          \
    *(bf16x8*)(V_lds + (b) * SHM_V + vst1) = sr_[i].vs1;               \
    *(bf16x8*)(K_lds + (b) * SHM_K + kswz<DQK>(kr, kc * 2)) = sr_[i].ks0;                       \
    if constexpr (DQK == 128) *(bf16x8*)(K_lds + (b) * SHM_K + kswz<DQK>(32 + kr, kc * 2)) = sr_[i].ks1; } while (0)
#define SWAIT() do { if constexpr (DQK == 128) asm volatile("s_waitcnt vmcnt(4)" ::: "memory"); else asm volatile("s_waitcnt vmcnt(3)" ::: "memory"); } while (0)
#define RESC(a) do { if (__any((a) < 1.f)) { if (hi == 0) al_l[r32] = (a); asm volatile("s_waitcnt lgkmcnt(0)" ::: "memory"); \
    _Pragma("unroll") for (int d = 0; d < 4; ++d) _Pragma("unroll") for (int r = 0; r < 16; ++r) o[d][r] *= al_l[crow(r, hi)]; } } while (0)
    f32x16 pA0, pA1, pB0, pB1; float mnA, mnB, alA, alB; bf16x8 pa0, pa1, pa2, pa3; const int NT = seq / KVBLK;
    constexpr int SE = 0, SO = 1;
    SLOAD(SE, 0); asm volatile("s_waitcnt vmcnt(0)" ::: "memory"); SWRITE(0, SE); __syncthreads();
    qkt<DQK>(pA0, pA1, K_lds, qr, r32, hi); partialSM<DQK>(pA0, pA1, m_reg, mnA, alA);
    SLOAD(SO, KVBLK); if (2 < NT) SLOAD(SE, 2 * KVBLK);
    SWAIT(); SWRITE(1, SO); __syncthreads();
    for (int j = 1; j + 1 < NT; j += 2) {
        SBAR(); qkt<DQK>(pB0, pB1, K_lds + SHM_K, qr, r32, hi);
        finishSM(pA0, pA1, alA, l_reg, pa0, pa1, pa2, pa3); SBAR();
        SLOAD(SO, (j + 2) * KVBLK); SBAR();
        pv_d0(o, vb0, pa0, pa1, pa2, pa3); partialSM<DQK>(pB0, pB1, m_reg, mnB, alB);
        __syncthreads(); SWAIT(); SWRITE(0, SE);
        RESC(alB); __syncthreads();
        SBAR(); qkt<DQK>(pA0, pA1, K_lds, qr, r32, hi);
        finishSM(pB0, pB1, alB, l_reg, pa0, pa1, pa2, pa3); SBAR();
        if (j + 3 < NT) SLOAD(SE, (j + 3) * KVBLK); SBAR();
        pv_d0(o, vb0 + (int)SHM_V, pa0, pa1, pa2, pa3); partialSM<DQK>(pA0, pA1, m_reg, mnA, alA);
        __syncthreads(); SWAIT(); SWRITE(1, SO);
        RESC(alA); __syncthreads();
    }
    SBAR(); qkt<DQK>(pB0, pB1, K_lds + SHM_K, qr, r32, hi);
    finishSM(pA0, pA1, alA, l_reg, pa0, pa1, pa2, pa3); SBAR();
    pv_d0(o, vb0, pa0, pa1, pa2, pa3); partialSM<DQK>(pB0, pB1, m_reg, mnB, alB);
    __syncthreads(); RESC(alB);
    finishSM(pB0, pB1, alB, l_reg, pa0, pa1, pa2, pa3); SBAR();
    pv_d0(o, vb0 + (int)SHM_V, pa0, pa1, pa2, pa3);
    if (hi == 0) li_l[r32] = l_reg; asm volatile("s_waitcnt lgkmcnt(0)" ::: "memory");
    float rli[16];
#pragma unroll
    for (int r = 0; r < 16; ++r) rli[r] = __builtin_amdgcn_rcpf(li_l[crow(r, hi)]);
    if constexpr (OUT_BF16) {
#pragma unroll
        for (int r = 0; r < 16; ++r) { const unsigned ob = (unsigned)((wid * QBLK + crow(r, hi)) * LDO + r32); const float sc16 = rli[r] * 16.0f;
#pragma unroll
            for (int d0 = 0; d0 < 4; ++d0) *((unsigned char*)Ob + ob + d0 * 32) = (unsigned char)(__builtin_amdgcn_cvt_pk_fp8_f32(o[d0][r] * sc16, 0.f, 0, false) & 0xff); }
    } else {
#pragma unroll
        for (int r = 0; r < 16; ++r) { const unsigned ob = (unsigned)((wid * QBLK + crow(r, hi)) * LDO + r32) * 4u;
#pragma unroll
            for (int d0 = 0; d0 < 4; ++d0) *(float*)((char*)Ob + ob + d0 * 128) = o[d0][r] * rli[r]; }
    }
#undef SLOAD
#undef SWRITE
#undef SWAIT
#undef RESC
}
}

struct Args { const float* in[26]; float* out; unsigned char* ws; int ph_lo, ph_hi; };
enum { I_X = 0, I_C, I_CTX, I_CCTX, I_WMOD, I_BMOD, I_G1, I_G2, I_WIN, I_GQ, I_GK, I_LQ1, I_LK1, I_LQ2, I_LK2, I_GSUB, I_WPOOL, I_PSCALE, I_WOUT, I_WR, I_BR, I_W1, I_B1, I_W2, I_B2, I_GF };
constexpr int NPHASE = 22;

struct TItem { const float* src; unsigned char* dst; int N, ldb; float scale; };
__device__ __forceinline__ TItem titem(int it, const float* win, const float* wout, const float* w1, const float* w2, unsigned char* ws, int lane) {
    constexpr int I_IN = 32 * (INW / 64), I_OUT = 24 * (D / 64), I_E1 = 32 * 32, I_E2 = 16 * 32;
    constexpr int T_IN = 2 * I_IN, T_OUT = 2 * I_OUT, T_E1 = 64 * I_E1;
    const float* W; unsigned char* WT; int N, ldb, item; float scale; int r = it;
    if (r < T_IN) { const int l = r / I_IN; W = win + (size_t)l * D * INW; N = INW; WT = ws + WS_WIN + (size_t)l * INW * D; ldb = D; item = r % I_IN; scale = 64.0f; }
    else if ((r -= T_IN) < T_OUT) { const int l = r / I_OUT; W = wout + (size_t)l * D * D; N = D; WT = ws + WS_WOUT + (size_t)l * D * D; ldb = D; item = r % I_OUT; scale = (item / (D / 64) < 16) ? 4.0f : 64.0f; }
    else if ((r -= T_OUT) < T_E1) { const int le = r / I_E1; W = w1 + (size_t)le * D * 2048; N = 2048; WT = ws + WS_W1 + (size_t)le * 2048 * D; ldb = D; item = r % I_E1; scale = 64.0f; }
    else { r -= T_E1; const int le = r / I_E2; W = w2 + (size_t)le * DE * D; N = D; WT = ws + WS_W2 + (size_t)le * D * DE; ldb = DE; item = r % I_E2; scale = 32.0f; }
    const int nblk = N / 64, kb = item / nblk, nb = item % nblk, k0 = 64 * kb + 16 * (lane >> 4), n0 = 64 * nb + 4 * (lane & 15);
    TItem t; t.src = W + (size_t)k0 * N + n0; t.dst = WT + (size_t)n0 * ldb + k0; t.N = N; t.ldb = ldb; t.scale = scale; return t;
}
#define TI_LOAD(v, t) do { _Pragma("unroll") for (int _i = 0; _i < 16; ++_i) v[_i] = *(const f32x4*)((t).src + (size_t)_i * (t).N); } while (0)
#define TI_STORE(v, t) do { const float _sc = (t).scale; _Pragma("unroll") for (int _c = 0; _c < 4; ++_c) { int _w[4]; \
        _Pragma("unroll") for (int _q = 0; _q < 4; ++_q) { int _x = 0; _x = __builtin_amdgcn_cvt_pk_fp8_f32(v[4 * _q][_c] * _sc, v[4 * _q + 1][_c] * _sc, _x, false); \
            _x = __builtin_amdgcn_cvt_pk_fp8_f32(v[4 * _q + 2][_c] * _sc, v[4 * _q + 3][_c] * _sc, _x, true); _w[_q] = _x; } \
        *(u32x4*)((t).dst + (size_t)_c * (t).ldb) = (u32x4){(unsigned)_w[0], (unsigned)_w[1], (unsigned)_w[2], (unsigned)_w[3]}; } } while (0)
__device__ __forceinline__ float silu_f(float x) { return x / (1.0f + __expf(-x)); }

__device__ __forceinline__ void fold_item(int it, const float* wpool, const float* pscale, const float* wout, unsigned char* WOUT) {
    const int n = it & 2047, cc = (it >> 11) & 15, g = (it >> 15) & 3, l = it >> 17;
    const float* wp = wpool + (((size_t)l * 4 + g) * 128 + cc * 8) * 128;
    const float* ps = pscale + (size_t)l * 512 + g * 128;
    const float* wo = wout + ((size_t)l * D + 1536 + g * 128) * D + n;
    float acc[8];
#pragma unroll
    for (int q = 0; q < 8; ++q) acc[q] = 0.f;
#pragma unroll 1
    for (int d0 = 0; d0 < 128; d0 += 32) { float av[32];
#pragma unroll
        for (int dd = 0; dd < 32; ++dd) av[dd] = wo[(size_t)(d0 + dd) * D];
#pragma unroll
        for (int dd = 0; dd < 32; ++dd) { const float x = ps[d0 + dd] * av[dd];
#pragma unroll
            for (int q = 0; q < 8; ++q) acc[q] = fmaf(wp[q * 128 + d0 + dd], x, acc[q]); } }
    int o0 = 0, o1 = 0; o0 = __builtin_amdgcn_cvt_pk_fp8_f32(acc[0] * 64.f, acc[1] * 64.f, o0, false); o0 = __builtin_amdgcn_cvt_pk_fp8_f32(acc[2] * 64.f, acc[3] * 64.f, o0, true);
    o1 = __builtin_amdgcn_cvt_pk_fp8_f32(acc[4] * 64.f, acc[5] * 64.f, o1, false); o1 = __builtin_amdgcn_cvt_pk_fp8_f32(acc[6] * 64.f, acc[7] * 64.f, o1, true);
    *(u32x2*)(WOUT + ((size_t)l * D + n) * D + 1536 + g * 128 + cc * 8) = (u32x2){(unsigned)o0, (unsigned)o1};
}

PHASE_FN phase_prologue(LAS unsigned char* lds, int l_unused, int G) {
    lds = (LAS unsigned char*)__builtin_amdgcn_readfirstlane((int)(uintptr_t)lds); G = __builtin_amdgcn_readfirstlane(G);
    const int tid = tid_local(), lane = tid & 63, wave = __builtin_amdgcn_readfirstlane(tid >> 6);
    unsigned char* ws = WSP();
    const int gw = blockIdx.x * NWAVES + wave, NGW = G * NWAVES;
    {
        float* MODP = (float*)(ws + WS_MODP);
        const float* cvec = INP(I_C); const float* cctx = INP(I_CCTX); const float* wmod = INP(I_WMOD);
        LAS float* st = (LAS float*)lds;
        for (int i = tid; i < 5 * D; i += NTHREADS) st[i] = silu_f(i < 4 * D ? cvec[i] : cctx[i - 4 * D]);
        __syncthreads();
        for (int u = gw; u < 2 * 64 * 48; u += NGW) {
            const int l = u / (64 * 48), r = u % (64 * 48), kc = r / 48, cg = r % 48;
            const int col = cg * 256 + lane * 4;
            const float* W = wmod + (size_t)l * D * 12288 + (size_t)(kc * 32) * 12288 + col;
            f32x4 acc[5];
#pragma unroll
            for (int v = 0; v < 5; ++v) acc[v] = (f32x4){0.f, 0.f, 0.f, 0.f};
#pragma unroll 1
            for (int k8 = 0; k8 < 32; k8 += 16) {
                f32x4 w[16];
#pragma unroll
                for (int kk = 0; kk < 16; ++kk) w[kk] = *(const f32x4*)(W + (size_t)(k8 + kk) * 12288);
#pragma unroll
                for (int kk = 0; kk < 16; ++kk) { const int k = kc * 32 + k8 + kk;
#pragma unroll
                    for (int v = 0; v < 5; ++v) acc[v] += st[v * D + k] * w[kk]; } }
#pragma unroll
            for (int v = 0; v < 5; ++v) *(f32x4*)(MODP + ((size_t)kc * 10 + l * 5 + v) * 12288 + col) = acc[v];
        }
        __syncthreads();
    }
    {
        f32x2* tabA = (f32x2*)(ws + WS_ROPE); f32x2* tabB = tabA + 64 * 32;
        for (int i = blockIdx.x * NTHREADS + tid; i < 64 * 32 + 64 * 16; i += G * NTHREADS) {
            if (i < 64 * 32) { const int pos = i >> 5, f = i & 31; const float inv = powf(10000.0f, -(float)f / 32.0f); const float ang = (float)pos * inv; tabA[i] = (f32x2){cosf(ang), sinf(ang)}; }
            else { const int q = i - 64 * 32; const int pos = q >> 4, f = q & 15; const float inv = powf(10000.0f, -(float)f / 16.0f); const float ang = (float)pos * inv; tabB[q] = (f32x2){cosf(ang), sinf(ang)}; }
        }
    }
    {
        const float* wr = INP(I_WR); bf16_t* WRS = (bf16_t*)(ws + WS_WRS);
        for (int i = blockIdx.x * NTHREADS + tid; i < 2 * D * NE; i += G * NTHREADS) {
            const int l = i / (D * NE), rem = i % (D * NE), k = rem >> 5, e = rem & 31;
            WRS[((size_t)l * NE + e) * D + k] = f2bf(wr[i]); }
    }
    {
        const float* win = INP(I_WIN); const float* wout = INP(I_WOUT); const float* w1 = INP(I_W1); const float* w2 = INP(I_W2);
        constexpr int TOT = 2 * 32 * (INW / 64);
        f32x4 va[16], vb[16]; TItem ta, tb;
        int it = gw;
        if (it < TOT) { ta = titem(it, win, wout, w1, w2, ws, lane); TI_LOAD(va, ta); }
        while (it < TOT) {
            const int i1 = it + NGW;
            if (i1 < TOT) { tb = titem(i1, win, wout, w1, w2, ws, lane); TI_LOAD(vb, tb); }
            TI_STORE(va, ta);
            if (i1 >= TOT) break;
            const int i2 = i1 + NGW;
            if (i2 < TOT) { ta = titem(i2, win, wout, w1, w2, ws, lane); TI_LOAD(va, ta); }
            TI_STORE(vb, tb);
            it = i2;
        }
    }
}

PHASE_FN phase_modreduce(LAS unsigned char* lds, int l_unused, int G) {
    lds = (LAS unsigned char*)__builtin_amdgcn_readfirstlane((int)(uintptr_t)lds); G = __builtin_amdgcn_readfirstlane(G);
    const int tid = tid_local();
    unsigned char* ws = WSP();
    const float* MODP = (const float*)(ws + WS_MODP); float* MOD = (float*)(ws + WS_MOD); const float* bmod = INP(I_BMOD); const float* g2 = INP(I_G2);
    for (int i = blockIdx.x * NTHREADS + tid; i < 10 * 12288 / 4; i += G * NTHREADS) {
        const int lv = i / 3072, col = (i % 3072) * 4, l = lv / 5;
        f32x4 s = *(const f32x4*)(bmod + (size_t)l * 12288 + col);
#pragma unroll 16
        for (int kc = 0; kc < 64; ++kc) s += *(const f32x4*)(MODP + ((size_t)kc * 10 + lv) * 12288 + col);
        if (col >= 4 * 2048 && col < 5 * 2048) s = *(const f32x4*)(g2 + (size_t)l * D + (col - 4 * 2048)) * (s + 1.0f);
        *(f32x4*)(MOD + (size_t)lv * 12288 + col) = s;
    }
}

__device__ __forceinline__ void norm_mod_store(const f32x4 (&v)[8], const f32x4 (&gg)[8], const f32x4 (&sh)[8], const f32x4 (&sc)[8], unsigned char* orow, int lane) {
    float ss = 0.f;
#pragma unroll
    for (int j = 0; j < 8; ++j) ss += (v[j].x * v[j].x + v[j].y * v[j].y) + (v[j].z * v[j].z + v[j].w * v[j].w);
    const float rs = rsqrtf(wave_sum(ss) * (1.0f / D) + EPS);
#pragma unroll
    for (int j = 0; j < 8; ++j) { const int col = 4 * (lane + 64 * j);
        const f32x4 y = (v[j] * rs) * gg[j]; const f32x4 n = y * (sc[j] + 1.0f) + sh[j];
        int w = 0; w = __builtin_amdgcn_cvt_pk_fp8_f32(n.x, n.y, w, false); w = __builtin_amdgcn_cvt_pk_fp8_f32(n.z, n.w, w, true);
        *(int*)(orow + col) = w; }
}

PHASE_FN phase_norm1_l0(LAS unsigned char* lds, int l_unused, int G) {
    lds = (LAS unsigned char*)__builtin_amdgcn_readfirstlane((int)(uintptr_t)lds); G = __builtin_amdgcn_readfirstlane(G);
    const int tid = tid_local(), lane = tid & 63, wave = __builtin_amdgcn_readfirstlane(tid >> 6);
    unsigned char* ws = WSP();
    const float* MOD = (const float*)(ws + WS_MOD);
    unsigned char* N = ws + WS_N;
    const float* x = INP(I_X); const float* ctx = INP(I_CTX); const float* g1 = INP(I_G1);
    f32x4 gg[8];
#pragma unroll
    for (int j = 0; j < 8; ++j) gg[j] = *(const f32x4*)(g1 + 4 * (lane + 64 * j));
    for (int row = blockIdx.x * NWAVES + wave; row < MT; row += G * NWAVES) {
        const float* src = row < ML ? x + (size_t)row * D : ctx + (size_t)(row - ML) * D;
        const int bidx = row < ML ? (row >> 12) : 4;
        const float* m = MOD + (size_t)bidx * 12288;
        f32x4 v[8], sh[8], sc[8];
#pragma unroll
        for (int j = 0; j < 8; ++j) { v[j] = *(const f32x4*)(src + 4 * (lane + 64 * j)); sh[j] = *(const f32x4*)(m + 4 * (lane + 64 * j)); sc[j] = *(const f32x4*)(m + 2048 + 4 * (lane + 64 * j)); }
        norm_mod_store(v, gg, sh, sc, N + (size_t)row * D, lane);
    }
}

PHASE_FN phase_inproj(LAS unsigned char* lds, int l, int G) {
    lds = (LAS unsigned char*)__builtin_amdgcn_readfirstlane((int)(uintptr_t)lds); l = __builtin_amdgcn_readfirstlane(l); G = __builtin_amdgcn_readfirstlane(G);
    unsigned char* ws = WSP();
    pg8::DenseSched<D, 1> S; S.init(ws + WS_N, ws + WS_WIN + (size_t)l * INW * D, MT, INW, G, (int)blockIdx.x);
    pg8::EpiBf16 E{(bf16_t*)(ws + WS_P), INW, nullptr, 0};
    pg8::gemm_phase(lds, S, E);
}

PHASE_FN phase_prep(LAS unsigned char* lds, int l, int G) {
    lds = (LAS unsigned char*)__builtin_amdgcn_readfirstlane((int)(uintptr_t)lds); l = __builtin_amdgcn_readfirstlane(l); G = __builtin_amdgcn_readfirstlane(G);
    const int tid = tid_local(), lane = tid & 63, wave = __builtin_amdgcn_readfirstlane(tid >> 6);
    unsigned char* ws = WSP();
    const bf16_t* P = (const bf16_t*)(ws + WS_P);
    unsigned* QA = (unsigned*)(ws + WS_QA); unsigned* KA = (unsigned*)(ws + WS_KA); unsigned* VA = (unsigned*)(ws + WS_VA);
    unsigned* QB = (unsigned*)(ws + WS_QB); unsigned* KB = (unsigned*)(ws + WS_KB); unsigned* VB = (unsigned*)(ws + WS_VB); unsigned char* CAT = ws + WS_CAT;
    const f32x2* tabA = (const f32x2*)(ws + WS_ROPE); const f32x2* tabB = tabA + 64 * 32;
    const f32x2 gq2 = *(const f32x2*)(INP(I_GQ) + l * 128 + 2 * lane), gk2 = *(const f32x2*)(INP(I_GK) + l * 128 + 2 * lane);
    const bool firstA = (lane & 16) == 0, firstB = (lane & 8) == 0;
    for (int unit = blockIdx.x; unit < MT / 8; unit += G) {
        const int ch = tid, hw = 1 << (ch >> 7);
        const int row0 = unit * 8; int base, s0, L;
        if (row0 < ML) { base = row0 & ~4095; s0 = row0 & 4095; L = SEQ; } else { const int r2 = row0 - ML; base = ML + (r2 & ~255); s0 = r2 & 255; L = CTX; }
        float pv_[23];
        { const bf16_t* pc = P + (size_t)base * INW + OFF_UC + ch;
#pragma unroll
            for (int j = 0; j < 23; ++j) { int sj = s0 - 8 + j; sj = sj < 0 ? 0 : (sj >= L ? L - 1 : sj);
                pv_[j] = bf2f(pc[(size_t)sj * INW]); } }
        {
            const int row = unit * 8 + wave;
            const bool lat = row < ML; int b, sq, trow;
            if (lat) { b = row >> 12; sq = row & 4095; trow = b * TK + CTX + sq; } else { const int r2 = row - ML; b = r2 >> 8; sq = r2 & 255; trow = b * TK + sq; }
            const unsigned* p = (const unsigned*)(P + (size_t)row * INW);
            unsigned ha[10], hb[8];
#pragma unroll
            for (int hh = 0; hh < 10; ++hh) ha[hh] = p[(hh < 8 ? hh * 64 : OFF_KA / 2 + (hh - 8) * 64) + lane];
#pragma unroll
            for (int jp = 0; jp < 8; ++jp) hb[jp] = p[(jp < 4 ? OFF_QB / 2 + jp * 64 : OFF_KB / 2 + (jp - 4) * 64) + lane];
            const u32x2 vva = *(const u32x2*)(p + OFF_VA / 2 + 2 * lane);
            const u32x4 vvb = *(const u32x4*)(p + OFF_VB / 2 + 4 * lane);
            const int prow = sq >> 6, pcol = sq & 63;
            const f32x4 csA = *(const f32x4*)(tabA + (lane < 32 ? prow : pcol) * 32 + 2 * (lane & 15));
            const f32x4 csB = *(const f32x4*)(tabB + ((lane & 16) == 0 ? prow : pcol) * 16 + 2 * (lane & 7));
#pragma unroll
            for (int hh = 0; hh < 10; ++hh) {
                float e0 = __uint_as_float(ha[hh] << 16), e1 = __uint_as_float(ha[hh] & 0xffff0000u);
                const float ss = wave_sum(e0 * e0 + e1 * e1); const float r = rsqrtf(ss * (1.0f / 128.0f) + EPS);
                const f32x2 g = hh < 8 ? gq2 : gk2;
                e0 = e0 * r * g.x; e1 = e1 * r * g.y;
                if (lat) {
                    const float o0 = __shfl_xor(e0, 16), o1 = __shfl_xor(e1, 16);
                    e0 = firstA ? (e0 * csA.x - o0 * csA.y) : (o0 * csA.y + e0 * csA.x);
                    e1 = firstA ? (e1 * csA.z - o1 * csA.w) : (o1 * csA.w + e1 * csA.z);
                }
                unsigned* dst = hh < 8 ? QA + (size_t)row * 512 + hh * 64 : KA + (size_t)trow * 128 + (hh - 8) * 64;
                dst[lane] = cvt_pk_bf16(e0, e1);
            }
            *(u32x2*)(VA + (size_t)trow * 128 + 2 * lane) = vva;
#pragma unroll
            for (int jp = 0; jp < 8; ++jp) {
                float e0 = __uint_as_float(hb[jp] << 16), e1 = __uint_as_float(hb[jp] & 0xffff0000u);
                if (lat) {
                    const float o0 = __shfl_xor(e0, 8), o1 = __shfl_xor(e1, 8);
                    e0 = firstB ? (e0 * csB.x - o0 * csB.y) : (o0 * csB.y + e0 * csB.x);
                    e1 = firstB ? (e1 * csB.z - o1 * csB.w) : (o1 * csB.w + e1 * csB.z);
                }
                unsigned* dst = jp < 4 ? QB + (size_t)row * 256 + jp * 64 : KB + (size_t)trow * 256 + (jp - 4) * 64;
                dst[lane] = cvt_pk_bf16(e0, e1);
            }
            *(u32x4*)(VB + (size_t)trow * 256 + 4 * lane) = vvb;
        }
        {
#pragma unroll
            for (int tk = 0; tk < 8; ++tk) { const int sq = s0 + tk;
                const int lo = (sq - hw) < 0 ? 0 : (sq - hw), hi = (sq + hw) > L ? L : (sq + hw);
                float sum = 0.f;
#pragma unroll
                for (int j = tk; j < tk + 16; ++j) { const int sj = s0 - 8 + j; sum += (sj >= lo && sj < hi) ? pv_[j] : 0.f; }
                CAT[(size_t)(row0 + tk) * D + 1536 + ch] = (unsigned char)(__builtin_amdgcn_cvt_pk_fp8_f32(sum / (float)(hi - lo) - pv_[tk + 8], 0.f, 0, false) & 0xff); }
        }
    }
}

constexpr int NCONV_WG = 32;
constexpr int CONV_BATCH = 128, CONV_E1 = 32 * 32 * 32, CONV_E2 = 32 * 16 * 32, CONV_ITEMS = CONV_E1 + CONV_E2  , CONV_FIRST = 2 * 32 * (INW / 64) + 2 * 24 * (D / 64);
constexpr int CONV_OUT0 = 2 * 32 * (INW / 64), CONV_OUT = 24 * (D / 64)  , NB_FOLD = 4 * 16 * 2048 / NTHREADS  , NB_OUT = CONV_OUT / CONV_BATCH, NB_EXP = CONV_ITEMS / CONV_BATCH;
static_assert(CONV_OUT % CONV_BATCH == 0, "w_out batches");
PHASE_FN phase_attention(LAS unsigned char* lds_, int l, int G) {
    lds_ = (LAS unsigned char*)__builtin_amdgcn_readfirstlane((int)(uintptr_t)lds_); l = __builtin_amdgcn_readfirstlane(l); G = __builtin_amdgcn_readfirstlane(G);
    LAS unsigned char* lds = lds_;
    unsigned char* ws = WSP();
    char* ldsg = (char*)lds_;
    const int tid = tid_local();
    const bf16_t* QA = (const bf16_t*)(ws + WS_QA); const bf16_t* KA = (const bf16_t*)(ws + WS_KA); const bf16_t* VA = (const bf16_t*)(ws + WS_VA);
    const bf16_t* QB = (const bf16_t*)(ws + WS_QB); const bf16_t* KB = (const bf16_t*)(ws + WS_KB); const bf16_t* VB = (const bf16_t*)(ws + WS_VB);
    unsigned char* CAT = ws + WS_CAT; float* OB = (float*)(ws + WS_OB);
    const int nA = 512 + (l == 0 ? 32 : 0), nB = 512 + (l == 0 ? 32 : 0);
    const bool dyn = (G > NCONV_WG);
    unsigned* qh = (unsigned*)(ws + WS_CTL) + CW_Q + l * 192;
    volatile LAS int* slot = (volatile LAS int*)(lds + MISC_OFF + 32);
    if (!dyn || (int)blockIdx.x < G - NCONV_WG) {
    for (int it = 0;; ++it) {
        int id;
        __syncthreads();
        if (dyn) { if (tid == 0) *slot = (int)atomicAdd(qh, 1u); __syncthreads(); id = __builtin_amdgcn_readfirstlane(*slot); } else id = (int)blockIdx.x + it * G;
        if (id >= nA) break;
        const bf16_t *q, *k, *v; unsigned char* o; int seq;
        if (id < 512) { int b, kvh, h, qb;
            if (dyn) { b = id >> 7; kvh = (id >> 6) & 1; h = kvh * 4 + ((id >> 4) & 3); qb = id & 15; }
            else { const int x = id & 7, i = id >> 8, j = (id >> 3) & 31; b = x >> 1; kvh = x & 1; h = kvh * 4 + 2 * i + (j >> 4); qb = j & 15; }
            const size_t r0 = (size_t)b * SEQ + qb * 256;
            q = QA + r0 * 1024 + h * 128; k = KA + (size_t)b * TK * 256 + kvh * 128; v = VA + (size_t)b * TK * 256 + kvh * 128; o = CAT + r0 * D + h * 128; seq = TK; }
        else { const int c = id - 512, b = c >> 3, h = c & 7; const size_t r0 = (size_t)ML + b * CTX;
            q = QA + r0 * 1024 + h * 128; k = KA + (size_t)b * TK * 256 + (h >> 2) * 128; v = VA + (size_t)b * TK * 256 + (h >> 2) * 128; o = CAT + r0 * D + h * 128; seq = CTX; }
        att::attn_body<128, 1024, 256, 256, D, true>(q, k, v, o, seq, ldsg);
    }
    for (int it = 0;; ++it) {
        int id;
        __syncthreads();
        if (dyn) { if (tid == 0) *slot = (int)atomicAdd(qh + 64, 1u); __syncthreads(); id = __builtin_amdgcn_readfirstlane(*slot); } else id = (int)blockIdx.x + it * G;
        if (id >= nB) break;
        const bf16_t *q, *k, *v; float* o; int seq;
        if (id < 512) { int b, h, comp, qb;
            if (dyn) { b = id >> 7; h = (id >> 5) & 3; comp = (id >> 4) & 1; qb = id & 15; }
            else { const int x = id & 7, i = id >> 8, j = (id >> 3) & 31; const int combo = 2 * x + i; b = combo >> 2; h = combo & 3; comp = j >> 4; qb = j & 15; }
            const int jj = comp * 4 + h; const size_t r0 = (size_t)b * SEQ + qb * 256;
            q = QB + r0 * 512 + jj * 64; k = KB + (size_t)b * TK * 512 + jj * 64; v = VB + (size_t)b * TK * 512 + h * 128; o = OB + r0 * 1024 + jj * 128; seq = TK; }
        else { const int c = id - 512, b = c >> 3, jj = c & 7, h = jj & 3; const size_t r0 = (size_t)ML + b * CTX;
            q = QB + r0 * 512 + jj * 64; k = KB + (size_t)b * TK * 512 + jj * 64; v = VB + (size_t)b * TK * 512 + h * 128; o = OB + r0 * 1024 + jj * 128; seq = CTX; }
        att::attn_body<64, 512, 512, 512, 1024, false>(q, k, v, o, seq, ldsg);
    }
    }
    {
        const int lane = tid & 63, wave = __builtin_amdgcn_readfirstlane(tid >> 6);
        const float* win = INP(I_WIN); const float* wout = INP(I_WOUT); const float* w1 = INP(I_W1); const float* w2 = INP(I_W2);
        for (;;) {
            __syncthreads();
            if (tid == 0) *slot = (int)atomicAdd(qh + 128, 1u);
            __syncthreads();
            const int bt = __builtin_amdgcn_readfirstlane(*slot);
            if (bt >= NB_FOLD + NB_OUT + NB_EXP) break;
            if (bt < NB_FOLD) { fold_item(l * (4 * 16 * 2048) + bt * NTHREADS + tid, INP(I_WPOOL), INP(I_PSCALE), wout, ws + WS_WOUT); continue; }
            int base;
            if (bt < NB_FOLD + NB_OUT) base = CONV_OUT0 + l * CONV_OUT + (bt - NB_FOLD) * CONV_BATCH + wave * (CONV_BATCH / NWAVES);
            else { const int li = (bt - NB_FOLD - NB_OUT) * CONV_BATCH + wave * (CONV_BATCH / NWAVES);
                base = li < CONV_E1 ? CONV_FIRST + l * CONV_E1 + li : CONV_FIRST + 2 * CONV_E1 + l * CONV_E2 + (li - CONV_E1); }
            f32x4 va[16], vb[16]; TItem ta, tb;
            ta = titem(base, win, wout, w1, w2, ws, lane); TI_LOAD(va, ta);
#pragma unroll 1
            for (int i = 0; i < CONV_BATCH / NWAVES; i += 2) {
                tb = titem(base + i + 1, win, wout, w1, w2, ws, lane); TI_LOAD(vb, tb);
                TI_STORE(va, ta);
                if (i + 2 < CONV_BATCH / NWAVES) { ta = titem(base + i + 2, win, wout, w1, w2, ws, lane); TI_LOAD(va, ta); }
                TI_STORE(vb, tb);
            }
        }
    }
}

PHASE_FN phase_fixup(LAS unsigned char* lds, int l, int G) {
    lds = (LAS unsigned char*)__builtin_amdgcn_readfirstlane((int)(uintptr_t)lds); l = __builtin_amdgcn_readfirstlane(l); G = __builtin_amdgcn_readfirstlane(G);
    const int tid = tid_local(), lane = tid & 63, wave = __builtin_amdgcn_readfirstlane(tid >> 6);
    unsigned char* ws = WSP();
    const float lam_init = 0.8f - 0.6f * expf(-0.3f * (float)l);
    float s1 = 0.f, s2 = 0.f;
    { const float* lq1 = INP(I_LQ1) + l * 64; const float* lk1 = INP(I_LK1) + l * 64; const float* lq2 = INP(I_LQ2) + l * 64; const float* lk2 = INP(I_LK2) + l * 64;
      s1 = wave_sum(lq1[lane] * lk1[lane]); s2 = wave_sum(lq2[lane] * lk2[lane]); }
    const float lam = expf(s1) - expf(s2) + lam_init;
    const float* OB = (const float*)(ws + WS_OB); unsigned char* CAT = ws + WS_CAT;
    const float* gs = INP(I_GSUB) + l * 128;
    const int nrows = (l == 0) ? MT : ML;
    const f32x2 g2 = *(const f32x2*)(gs + 2 * lane);
    for (int row = blockIdx.x * NWAVES + wave; row < nrows; row += G * NWAVES) {
        f32x2 o1[4], o2[4];
#pragma unroll
        for (int h = 0; h < 4; ++h) { o1[h] = *(const f32x2*)(OB + (size_t)row * 1024 + h * 128 + 2 * lane); o2[h] = *(const f32x2*)(OB + (size_t)row * 1024 + (4 + h) * 128 + 2 * lane); }
#pragma unroll
        for (int h = 0; h < 4; ++h) {
            const f32x2 d = o1[h] - lam * o2[h];
            const float ss = wave_sum(d.x * d.x + d.y * d.y); const float r = rsqrtf(ss * (1.0f / 128.0f) + EPS) * (1.0f - lam_init);
            *(unsigned short*)(CAT + (size_t)row * D + 1024 + h * 128 + 2 * lane) = (unsigned short)(__builtin_amdgcn_cvt_pk_fp8_f32(d.x * r * g2.x, d.y * r * g2.y, 0, false) & 0xffff);
        }
    }
}

PHASE_FN phase_outproj(LAS unsigned char* lds, int l, int G) {
    lds = (LAS unsigned char*)__builtin_amdgcn_readfirstlane((int)(uintptr_t)lds); l = __builtin_amdgcn_readfirstlane(l); G = __builtin_amdgcn_readfirstlane(G);
    unsigned char* ws = WSP();
    pg8::DenseSched<D, 1> S; S.init(ws + WS_CAT, ws + WS_WOUT + (size_t)l * D * D, (l == 0) ? MT : ML, D, G, (int)blockIdx.x);
    pg8::EpiResid E{INP(I_X), INP(I_CTX), (const bf16_t*)(ws + WS_XR), (bf16_t*)(ws + WS_XR), (const float*)(ws + WS_MOD) + (size_t)l * 5 * 12288, l};
    pg8::gemm_phase(lds, S, E);
}

PHASE_FN phase_router(LAS unsigned char* lds, int l, int G) {
    lds = (LAS unsigned char*)__builtin_amdgcn_readfirstlane((int)(uintptr_t)lds); l = __builtin_amdgcn_readfirstlane(l); G = __builtin_amdgcn_readfirstlane(G);
    const int tid = tid_local(), lane = tid & 63, wave = __builtin_amdgcn_readfirstlane(tid >> 6);
    unsigned char* ws = WSP();
    const bf16_t* XR = (const bf16_t*)(ws + WS_XR); unsigned char* NF8 = ws + WS_NF8;
    const float* MOD = (const float*)(ws + WS_MOD) + (size_t)l * 5 * 12288;
    int* eid = (int*)(ws + WS_ROUT + ROUT_EID); float* gate = (float*)(ws + WS_ROUT + ROUT_GATE); int* posb = (int*)(ws + WS_ROUT + ROUT_POS); int* list = (int*)(ws + WS_ROUT + ROUT_LIST);
    unsigned* cnt = (unsigned*)(ws + WS_CTL) + CW_CNT + l * 32 * 64;
    const float* br = INP(I_BR) + l * NE;
    const bf16_t* WRH = (const bf16_t*)(ws + WS_WRS) + (size_t)l * NE * D;
    constexpr int TST = 4112;
    LAS unsigned char* thi = lds; LAS unsigned char* tlo = lds + 16 * TST;
    static_assert(32 * TST <= MISC_OFF, "router token images");
    LAS float* fl = (LAS float*)lds;
    LAS float* lg = (LAS float*)(lds + MISC_OFF + 512);
    LAS float* tv = (LAS float*)(lds + MISC_OFF + 2560);
    LAS int* lc = (LAS int*)(lds + MISC_OFF + 2816); LAS int* lbase = (LAS int*)(lds + MISC_OFF + 2944);
    LAS int* selall = (LAS int*)(lds + MISC_OFF + 4096);
    const int ntok = (l == 0) ? MT : ML;
    if (tid < NE) lc[tid] = 0;
    const int fn = lane & 15, kg = lane >> 4;
    bf16x8 wh[8][2];
    { const char* bh = (const char*)uniform_ptr(WRH + wave * 256);
        const unsigned o0 = (unsigned)(fn * D + kg * 8) * 2u, o1 = o0 + 16u * D * 2u;
#pragma unroll
        for (int s = 0; s < 8; ++s) { wh[s][0] = *(const bf16x8*)(bh + o0 + s * 64); wh[s][1] = *(const bf16x8*)(bh + o1 + s * 64); } }
    int ui = 0;
    u32x2 ra[8], rb[8]; f32x4 psh, pg;
    LAS float* sg = (LAS float*)(lds + SG_OFF);
#define ROUTER_FETCH(u_) do { const int _row = (u_) * 16 + wave * 2; const int _b = _row < ML ? (_row >> 12) : 4; const float* _m = MOD + (size_t)_b * 12288; \
        const char* _x0 = (const char*)uniform_ptr(XR + (size_t)_row * D); const char* _x1 = (const char*)uniform_ptr(XR + (size_t)(_row + 1) * D); \
        const char* _ms = (const char*)uniform_ptr(_m + 3 * 2048); const char* _mg = (const char*)uniform_ptr(_m + 4 * 2048); \
        _Pragma("unroll") for (int j = 0; j < 8; ++j) { ra[j] = *(const u32x2*)(_x0 + lo8 + j * 512); rb[j] = *(const u32x2*)(_x1 + lo8 + j * 512); } \
        psh = *(const f32x4*)(_ms + (unsigned)tid * 16u); pg = *(const f32x4*)(_mg + (unsigned)tid * 16u); } while (0)
    const unsigned lo8 = (unsigned)lane * 8u, lo4 = (unsigned)lane * 4u, lo16 = (unsigned)lane * 16u;
    if ((int)blockIdx.x < ntok / 16) { ROUTER_FETCH((int)blockIdx.x); *(LAS f32x4*)(sg + 4 * tid) = psh; *(LAS f32x4*)(sg + 2048 + 4 * tid) = pg; }
    __syncthreads();
    for (int unit = blockIdx.x; unit < ntok / 16; unit += G) {
        LAS int* sel = selall + ui * 64;
        int tq = tid; asm volatile("" : "+v"(tq));
        const unsigned lq = (unsigned)(tq & 63);
        { const int tl = wave * 2, row = unit * 16 + tl;
            char* nfa = (char*)uniform_ptr(NF8 + (size_t)row * D); char* nfb = (char*)uniform_ptr(NF8 + (size_t)(row + 1) * D);
            float ssa = 0.f, ssb = 0.f;
#define UNPK4(w_) ((f32x4){__uint_as_float((w_).x << 16), __uint_as_float((w_).x & 0xffff0000u), __uint_as_float((w_).y << 16), __uint_as_float((w_).y & 0xffff0000u)})
#pragma unroll
            for (int j = 0; j < 8; ++j) { const f32x4 xa = UNPK4(ra[j]), xb = UNPK4(rb[j]);
                ssa += (xa.x * xa.x + xa.y * xa.y) + (xa.z * xa.z + xa.w * xa.w); ssb += (xb.x * xb.x + xb.y * xb.y) + (xb.z * xb.z + xb.w * xb.w); }
            const float rsa = rsqrtf(wave_sum(ssa) * (1.0f / D) + EPS), rsb = rsqrtf(wave_sum(ssb) * (1.0f / D) + EPS);
#pragma unroll
            for (int j = 0; j < 8; ++j) { const unsigned col = 4u * lq + 256u * j;
                const f32x4 shj = *(const LAS f32x4*)(sg + col), gj = *(const LAS f32x4*)(sg + 2048 + col);
                const f32x4 na = (UNPK4(ra[j]) * rsa) * gj + shj, nb = (UNPK4(rb[j]) * rsb) * gj + shj;
                int wa = 0, wb = 0; wa = __builtin_amdgcn_cvt_pk_fp8_f32(na.x, na.y, wa, false); wa = __builtin_amdgcn_cvt_pk_fp8_f32(na.z, na.w, wa, true);
                wb = __builtin_amdgcn_cvt_pk_fp8_f32(nb.x, nb.y, wb, false); wb = __builtin_amdgcn_cvt_pk_fp8_f32(nb.z, nb.w, wb, true);
                *(int*)(nfa + 4u * lq + j * 256) = wa; *(int*)(nfb + 4u * lq + j * 256) = wb;
                const unsigned ha0 = cvt_pk_bf16(na.x, na.y), ha1 = cvt_pk_bf16(na.z, na.w), hb0 = cvt_pk_bf16(nb.x, nb.y), hb1 = cvt_pk_bf16(nb.z, nb.w);
                const unsigned la0 = cvt_pk_bf16(na.x - __uint_as_float(ha0 << 16), na.y - __uint_as_float(ha0 & 0xffff0000u)), la1 = cvt_pk_bf16(na.z - __uint_as_float(ha1 << 16), na.w - __uint_as_float(ha1 & 0xffff0000u));
                const unsigned lb0 = cvt_pk_bf16(nb.x - __uint_as_float(hb0 << 16), nb.y - __uint_as_float(hb0 & 0xffff0000u)), lb1 = cvt_pk_bf16(nb.z - __uint_as_float(hb1 << 16), nb.w - __uint_as_float(hb1 & 0xffff0000u));
                *(LAS u32x2*)(thi + tl * TST + col * 2) = (u32x2){ha0, ha1}; *(LAS u32x2*)(tlo + tl * TST + col * 2) = (u32x2){la0, la1};
                *(LAS u32x2*)(thi + (tl + 1) * TST + col * 2) = (u32x2){hb0, hb1}; *(LAS u32x2*)(tlo + (tl + 1) * TST + col * 2) = (u32x2){lb0, lb1};
                }
            asm volatile("" ::: "memory");
            if (unit + G < ntok / 16) ROUTER_FETCH(unit + G);
        }
        __syncthreads();
        f32x4 acc0 = (f32x4){0.f, 0.f, 0.f, 0.f}, acc1 = (f32x4){0.f, 0.f, 0.f, 0.f};
#pragma unroll
        for (int s = 0; s < 8; ++s) { const int ko = (wave * 256 + s * 32 + kg * 8) * 2;
            const bf16x8 ah = *(const LAS bf16x8*)(thi + fn * TST + ko), al = *(const LAS bf16x8*)(tlo + fn * TST + ko);
            acc0 = __builtin_amdgcn_mfma_f32_16x16x32_bf16(ah, wh[s][0], acc0, 0, 0, 0); acc1 = __builtin_amdgcn_mfma_f32_16x16x32_bf16(ah, wh[s][1], acc1, 0, 0, 0);
            acc0 = __builtin_amdgcn_mfma_f32_16x16x32_bf16(al, wh[s][0], acc0, 0, 0, 0); acc1 = __builtin_amdgcn_mfma_f32_16x16x32_bf16(al, wh[s][1], acc1, 0, 0, 0); }
        __syncthreads();
        { LAS float* pw = fl + wave * 512;
#pragma unroll
            for (int r = 0; r < 4; ++r) { pw[(kg * 4 + r) * 32 + fn] = acc0[r]; pw[(kg * 4 + r) * 32 + 16 + fn] = acc1[r]; } }
        __syncthreads();
        { float sacc = br[tid & 31];
#pragma unroll
            for (int w = 0; w < 8; ++w) sacc += fl[w * 512 + tid];
            lg[tid] = sacc; }
        if (unit + G < ntok / 16) { *(LAS f32x4*)(sg + 4 * tid) = psh; *(LAS f32x4*)(sg + 2048 + 4 * tid) = pg; }
        __syncthreads();
        { const int t = tq >> 5, e = tq & 31; const float my = lg[tq]; int rank = 0;
#pragma unroll
            for (int q = 0; q < 8; ++q) { const f32x4 x = *(const LAS f32x4*)(lg + t * 32 + 4 * q);
#pragma unroll
                for (int c = 0; c < 4; ++c) rank += (x[c] > my || (x[c] == my && 4 * q + c < e)) ? 1 : 0; }
            if (rank < 4) { sel[t * 4 + rank] = e; tv[t * 4 + rank] = my; } }
        __syncthreads();
        if (tid < 16) { const int row = unit * 16 + tid; const f32x4 v = *(const LAS f32x4*)(tv + tid * 4);
            const float e1 = __expf(v[1] - v[0]), e2 = __expf(v[2] - v[0]), e3 = __expf(v[3] - v[0]); const float inv = 1.0f / (1.0f + e1 + e2 + e3);
            *(int4*)(eid + (size_t)row * 4) = make_int4(sel[tid * 4 + 0], sel[tid * 4 + 1], sel[tid * 4 + 2], sel[tid * 4 + 3]);
            *(f32x4*)(gate + (size_t)row * 4) = (f32x4){inv, e1 * inv, e2 * inv, e3 * inv}; }
        ++ui;
    }
    __syncthreads();
    const int nent = ui * 64; int ee = 0, rk = 0;
    if (tid < nent) { ee = selall[tid]; rk = __hip_atomic_fetch_add(lc + ee, 1, __ATOMIC_RELAXED, __HIP_MEMORY_SCOPE_WORKGROUP); }
    __syncthreads();
    if (tid < NE) { const int c = lc[tid]; if (c > 0) lbase[tid] = (int)atomicAdd(cnt + tid * 64, (unsigned)c); }
    __syncthreads();
    if (tid < nent) { const int p = lbase[ee] + rk; const int row = ((int)blockIdx.x + (tid >> 6) * G) * 16 + ((tid & 63) >> 2); list[(size_t)ee * MT + p] = row; posb[(size_t)row * 4 + (tid & 3)] = p; }
    __syncthreads();
#undef ROUTER_FETCH
#undef UNPK4
}

__device__ __forceinline__ void moe_tables(unsigned char* ws, int l, LAS unsigned char* lds) {
    LAS int* tp = (LAS int*)(lds + MISC_OFF + 64); LAS int* cn = (LAS int*)(lds + MISC_OFF + 256);
    const unsigned* cnt = (const unsigned*)(ws + WS_CTL) + CW_CNT + l * 32 * 64;
    __syncthreads();
    if (threadIdx.x < 64) { const int ln = threadIdx.x;
        const int c = (ln < NE) ? (int)__hip_atomic_load(cnt + ln * 64, __ATOMIC_RELAXED, __HIP_MEMORY_SCOPE_AGENT) : 0;
        const int t = (c + 255) >> 8; int incl = t;
#pragma unroll
        for (int o = 1; o < 32; o <<= 1) { const int u = __shfl_up(incl, o); if (ln >= o) incl += u; }
        if (ln < NE) { tp[ln] = incl - t; cn[ln] = c; }
        if (ln == NE - 1) tp[NE] = incl; }
    __syncthreads();
}

PHASE_FN phase_moe_up(LAS unsigned char* lds, int l, int G) {
    lds = (LAS unsigned char*)__builtin_amdgcn_readfirstlane((int)(uintptr_t)lds); l = __builtin_amdgcn_readfirstlane(l); G = __builtin_amdgcn_readfirstlane(G);
    unsigned char* ws = WSP();
    moe_tables(ws, l, lds);
    pg8::MoeSched<true, D, 1> S; S.init((const LAS int*)(lds + MISC_OFF + 64), (const LAS int*)(lds + MISC_OFF + 256), ws + WS_NF8, ws + WS_W1 + (size_t)l * 32 * 2048 * D,
                                  (const int*)(ws + WS_ROUT + ROUT_LIST), G, (int)blockIdx.x);
    pg8::EpiSwiglu E{ws + WS_ACT, INP(I_B1) + (size_t)l * 32 * 2048};
    pg8::gemm_phase(lds, S, E);
}

PHASE_FN phase_moe_down(LAS unsigned char* lds, int l, int G) {
    lds = (LAS unsigned char*)__builtin_amdgcn_readfirstlane((int)(uintptr_t)lds); l = __builtin_amdgcn_readfirstlane(l); G = __builtin_amdgcn_readfirstlane(G);
    unsigned char* ws = WSP();
    moe_tables(ws, l, lds);
    pg8::MoeSched<false, DE, 1> S; S.init((const LAS int*)(lds + MISC_OFF + 64), (const LAS int*)(lds + MISC_OFF + 256), ws + WS_ACT, ws + WS_W2 + (size_t)l * 32 * D * DE,
                                   nullptr, G, (int)blockIdx.x);
    pg8::EpiF8 E{ws + WS_Y, D, INP(I_B2) + (size_t)l * 32 * D, D};
    pg8::gemm_phase(lds, S, E);
}

PHASE_FN phase_combine(LAS unsigned char* lds, int l, int G) {
    lds = (LAS unsigned char*)__builtin_amdgcn_readfirstlane((int)(uintptr_t)lds); l = __builtin_amdgcn_readfirstlane(l); G = __builtin_amdgcn_readfirstlane(G);
    const int tid = tid_local(), lane = tid & 63, wave = __builtin_amdgcn_readfirstlane(tid >> 6);
    unsigned char* ws = WSP();
    moe_tables(ws, l, lds);
    bf16_t* XR = (bf16_t*)(ws + WS_XR); unsigned char* N = ws + WS_N; const unsigned char* Y = ws + WS_Y;
    const float* MOD = (const float*)(ws + WS_MOD);
    const int* eid = (const int*)(ws + WS_ROUT + ROUT_EID); const float* gate = (const float*)(ws + WS_ROUT + ROUT_GATE); const int* posb = (const int*)(ws + WS_ROUT + ROUT_POS);
    const LAS int* tp = (const LAS int*)(lds + MISC_OFF + 64);
    const float* g1n = INP(I_G1) + D; const float* gf = INP(I_GF); float* out = OUTP();
    const int ntok = (l == 0) ? MT : ML;
    for (int row = blockIdx.x * NWAVES + wave; row < ntok; row += G * NWAVES) {
        const int bidx = row < ML ? (row >> 12) : 4; const float* m = MOD + ((size_t)l * 5 + bidx) * 12288;
        const int4 ev = *(const int4*)(eid + (size_t)row * 4), pv = *(const int4*)(posb + (size_t)row * 4); const f32x4 gv = *(const f32x4*)(gate + (size_t)row * 4);
        const unsigned char* yr[4];
        yr[0] = Y + ((size_t)tp[ev.x] * 256 + pv.x) * D; yr[1] = Y + ((size_t)tp[ev.y] * 256 + pv.y) * D; yr[2] = Y + ((size_t)tp[ev.z] * 256 + pv.z) * D; yr[3] = Y + ((size_t)tp[ev.w] * 256 + pv.w) * D;
        u32x2 yv[4][4]; f32x4 xv[4][2]; u32x4 xw[4];
#pragma unroll
        for (int j = 0; j < 4; ++j) { const int col = 8 * (lane + 64 * j);
#pragma unroll
            for (int k = 0; k < 4; ++k) yv[j][k] = *(const u32x2*)(yr[k] + col);
            xw[j] = *(const u32x4*)(XR + (size_t)row * D + col); }
#pragma unroll
        for (int j = 0; j < 4; ++j) pg8::unpack_bf16x8(xw[j], xv[j][0], xv[j][1]);
        float ss = 0.f;
#pragma unroll
        for (int j = 0; j < 4; ++j) { const int col = 8 * (lane + 64 * j);
            f32x4 s0 = (f32x4){0.f, 0.f, 0.f, 0.f}, s1 = s0;
#pragma unroll
            for (int k = 0; k < 4; ++k) { const u32x2 w = yv[j][k];
                const f32x2 a0 = __builtin_amdgcn_cvt_pk_f32_fp8((int)w.x, false), a1 = __builtin_amdgcn_cvt_pk_f32_fp8((int)w.x, true), a2 = __builtin_amdgcn_cvt_pk_f32_fp8((int)w.y, false), a3 = __builtin_amdgcn_cvt_pk_f32_fp8((int)w.y, true);
                s0 += gv[k] * (f32x4){a0.x, a0.y, a1.x, a1.y};
                s1 += gv[k] * (f32x4){a2.x, a2.y, a3.x, a3.y}; }
            const f32x4 gt0 = *(const f32x4*)(m + 5 * 2048 + col), gt1 = *(const f32x4*)(m + 5 * 2048 + col + 4);
            xv[j][0] += gt0 * s0; xv[j][1] += gt1 * s1;
            ss += (xv[j][0].x * xv[j][0].x + xv[j][0].y * xv[j][0].y) + (xv[j][0].z * xv[j][0].z + xv[j][0].w * xv[j][0].w);
            ss += (xv[j][1].x * xv[j][1].x + xv[j][1].y * xv[j][1].y) + (xv[j][1].z * xv[j][1].z + xv[j][1].w * xv[j][1].w); }
        const float rs = rsqrtf(wave_sum(ss) * (1.0f / D) + EPS);
        if (l == 0) {
            const float* m1 = MOD + ((size_t)5 + bidx) * 12288;
#pragma unroll
            for (int j = 0; j < 4; ++j) { const int col = 8 * (lane + 64 * j);
                *(u32x4*)(XR + (size_t)row * D + col) = pg8::pack_bf16x8(xv[j][0], xv[j][1]);
                int w0 = 0, w1 = 0;
#pragma unroll
                for (int q = 0; q < 2; ++q) { const f32x4 gg = *(const f32x4*)(g1n + col + 4 * q), sh = *(const f32x4*)(m1 + col + 4 * q), sc = *(const f32x4*)(m1 + 2048 + col + 4 * q);
                    const f32x4 n = ((xv[j][q] * rs) * gg) * (sc + 1.0f) + sh;
                    if (q == 0) { w0 = __builtin_amdgcn_cvt_pk_fp8_f32(n.x, n.y, w0, false); w0 = __builtin_amdgcn_cvt_pk_fp8_f32(n.z, n.w, w0, true); }
                    else { w1 = __builtin_amdgcn_cvt_pk_fp8_f32(n.x, n.y, w1, false); w1 = __builtin_amdgcn_cvt_pk_fp8_f32(n.z, n.w, w1, true); } }
                *(u32x2*)(N + (size_t)row * D + col) = (u32x2){(unsigned)w0, (unsigned)w1}; }
        } else {
            f32x4 gfv[4][2];
#pragma unroll
            for (int j = 0; j < 4; ++j)
#pragma unroll
                for (int q = 0; q < 2; ++q) gfv[j][q] = *(const f32x4*)(gf + 8 * (lane + 64 * j) + 4 * q);
            asm volatile("" ::: "memory");
#pragma unroll
            for (int j = 0; j < 4; ++j) { const int col = 8 * (lane + 64 * j);
                *(f32x4*)(out + (size_t)row * D + col) = (xv[j][0] * rs) * gfv[j][0];
                *(f32x4*)(out + (size_t)row * D + col + 4) = (xv[j][1] * rs) * gfv[j][1]; }
        }
    }
}

__global__ void __launch_bounds__(NTHREADS, 2) mk_fwd(Args a) {
    extern __shared__ __attribute__((aligned(16))) unsigned char lds_raw[];
    LAS unsigned char* lds = (LAS unsigned char*)lds_raw;
    const int tid = threadIdx.x; const int G = gridDim.x;
    if (tid < 16) ((LAS unsigned*)(lds + MISC_OFF))[tid] = 0u;
    if (tid == 64) { LAS unsigned long long* pt = (LAS unsigned long long*)(lds + PT_OFF);
#pragma unroll
        for (int i = 0; i < 26; ++i) pt[i] = (unsigned long long)a.in[i];
        pt[PT_OUT] = (unsigned long long)a.out; pt[PT_WS] = (unsigned long long)a.ws; }
    __syncthreads();
    const bool multi = (a.ph_hi - a.ph_lo) > 1;
    if (multi) (void)xcd_barrier_post((unsigned*)(a.ws + WS_CTL) + CW_BAR, (volatile LAS unsigned*)(lds + MISC_OFF));
    const int lo = a.ph_lo, hi = a.ph_hi;
#define IN(k) (lo <= (k) && (k) < hi)
#define SEAM(k) do { if (IN((k) + 1)) { XcdBarrier _b; _b.bar = (unsigned*)(a.ws + WS_CTL) + CW_BAR; _b.x = xb_xcc_id(); _b.st = (volatile LAS unsigned*)(lds + MISC_OFF); xcd_barrier(_b); if ((MK_REPEAT >> 11) & 1) xcd_barrier(_b); } } while (0)

    if (IN(0)) { REP(0) phase_prologue(lds, 0, G); SEAM(0); }
    if (IN(1)) { phase_modreduce(lds, 0, G); SEAM(1); }
#define LAYER_BODY(l) { \
        const int pb = 2 + 10 * l; \
        if (l == 0 && IN(pb + 0)) { phase_norm1_l0(lds, 0, G); SEAM(pb + 0); } \
        if (IN(pb + 1)) { REP(2) phase_inproj(lds, l, G); SEAM(pb + 1); } \
        if (IN(pb + 2)) { REP(3) phase_prep(lds, l, G); SEAM(pb + 2); } \
        if (IN(pb + 3)) { REP(4) phase_attention(lds, l, G); SEAM(pb + 3); } \
        if (IN(pb + 4)) { REP(5) phase_fixup(lds, l, G); SEAM(pb + 4); } \
        if (IN(pb + 5)) { if (l == 0) { REP(6) phase_outproj(lds, l, G); } else phase_outproj(lds, l, G); SEAM(pb + 5); } \
        if (IN(pb + 6)) { phase_router(lds, l, G); SEAM(pb + 6); } \
        if (IN(pb + 7)) { REP(8) phase_moe_up(lds, l, G); SEAM(pb + 7); } \
        if (IN(pb + 8)) { REP(9) phase_moe_down(lds, l, G); SEAM(pb + 8); } \
        if (IN(pb + 9)) { if (l == 1) { REP(10) phase_combine(lds, l, G); } else phase_combine(lds, l, G); if (l == 0) SEAM(pb + 9); } \
    }
    LAYER_BODY(0)
    LAYER_BODY(1)
#undef LAYER_BODY
#undef IN
#undef SEAM
}

extern "C" void kernel_launch(void* const* d_in, const int* in_sizes, int n_in, void* d_out, int out_size, void* d_ws, size_t ws_size, hipStream_t stream) {
    static int grid = 0;
    if (grid == 0) {
        if (n_in != 26 || in_sizes[0] != ML * D || out_size != ML * D || ws_size < WS_END) {
            fprintf(stderr, "kernel_launch: shape mismatch (n_in %d, in0 %d, out %d, ws %zu need %zu); nothing launched\n", n_in, n_in > 0 ? in_sizes[0] : -1, out_size, ws_size, (size_t)WS_END); grid = -1; return; }
        int dev = 0, cus = 0, per_cu = 0;
        if (hipGetDevice(&dev) != hipSuccess || hipDeviceGetAttribute(&cus, hipDeviceAttributeMultiprocessorCount, dev) != hipSuccess) { grid = -1; return; }
        if (hipFuncSetAttribute((const void*)mk_fwd, hipFuncAttributeMaxDynamicSharedMemorySize, LDS_BYTES) != hipSuccess) { fprintf(stderr, "kernel_launch: hipFuncSetAttribute failed\n"); grid = -1; return; }
        if (hipOccupancyMaxActiveBlocksPerMultiprocessor(&per_cu, (const void*)mk_fwd, NTHREADS, LDS_BYTES) != hipSuccess || per_cu < 1)
            fprintf(stderr, "kernel_launch: note: occupancy query reports %d workgroups per CU\n", per_cu);
        (void)hipGetLastError();
        grid = cus;
    }
    if (grid < 0) return;
    if (hipMemsetAsync((char*)d_ws + WS_CTL, 0, CTL_ZERO_BYTES, stream) != hipSuccess) { fprintf(stderr, "kernel_launch: memset failed\n"); return; }
    Args a{};
    for (int i = 0; i < 26; ++i) a.in[i] = (const float*)d_in[i];
    a.out = (float*)d_out; a.ws = (unsigned char*)d_ws;
#if MK_PER_PHASE_LAUNCH
    for (int p = 0; p < NPHASE; ++p) {
        if (p == 12) continue;
        a.ph_lo = p; a.ph_hi = p + 1;
        hipLaunchKernelGGL(mk_fwd, dim3(grid), dim3(NTHREADS), LDS_BYTES, stream, a);
    }
#else
    a.ph_lo = 0; a.ph_hi = NPHASE;
    hipLaunchKernelGGL(mk_fwd, dim3(grid), dim3(NTHREADS), LDS_BYTES, stream, a);
#endif
    const hipError_t le = hipPeekAtLastError();
    if (le != hipSuccess) fprintf(stderr, "kernel_launch: launch failed: %s\n", hipGetErrorName(le));
}
```

```cpp
#include <hip/hip_runtime.h>
#include <cstdio>
#include <cstdint>

#ifndef MK_PER_PHASE_LAUNCH
#define MK_PER_PHASE_LAUNCH 0
#endif

#ifndef MK_REPEAT
#define MK_REPEAT 0
#endif
#define REP(k) for (int _rep = 0; _rep < 1 + ((MK_REPEAT >> (k)) & 1); ++_rep)
#define GAS __attribute__((address_space(1)))
#define LAS __attribute__((address_space(3)))
typedef unsigned short bf16_t;
typedef short bf16x8 __attribute__((ext_vector_type(8)));
typedef short s16x4 __attribute__((ext_vector_type(4)));
typedef float f32x4 __attribute__((ext_vector_type(4)));
typedef float f32x2 __attribute__((ext_vector_type(2)));
typedef float f32x16 __attribute__((ext_vector_type(16)));
typedef unsigned u32x4 __attribute__((ext_vector_type(4)));
typedef unsigned u32x2 __attribute__((ext_vector_type(2)));
typedef int v8i __attribute__((ext_vector_type(8)));

constexpr int D = 2048, NB = 4, SEQ = 4096, CTX = 256, TK = CTX + SEQ  , DEPTH = 2;
constexpr int ML = NB * SEQ  , MC = NB * CTX  , MT = ML + MC  ;
constexpr int INW = 3584, NE = 32, DE = 1024;
constexpr int OFF_QA = 0, OFF_KA = 1024, OFF_VA = 1280, OFF_QB = 1536, OFF_KB = 2048, OFF_VB = 2560, OFF_UC = 3072;
constexpr float EPS = 1e-6f;
constexpr int MAXROWS = 77824;
constexpr int NWAVES = 8, NTHREADS = 512;

constexpr size_t MiB = 1u << 20;
constexpr size_t WS_CTL = 0, CTL_ZERO_BYTES = 2 * MiB;
constexpr size_t WS_MOD = 1 * MiB;
constexpr size_t WS_ROPE = 2 * MiB;
constexpr size_t WS_ROUT = 3 * MiB;
constexpr size_t WS_WRS = 7 * MiB;
constexpr size_t WS_XR = 8 * MiB;
constexpr size_t WS_N = 144 * MiB;
constexpr size_t WS_P = 212 * MiB;
constexpr size_t WS_QA = 332 * MiB;
constexpr size_t WS_KA = 366 * MiB;
constexpr size_t WS_VA = 375 * MiB;
constexpr size_t WS_QB = 384 * MiB;
constexpr size_t WS_KB = 401 * MiB;
constexpr size_t WS_VB = 418 * MiB;
constexpr size_t WS_CAT = 435 * MiB;
constexpr size_t WS_OB = 503 * MiB;
constexpr size_t WS_ACT = 571 * MiB;
constexpr size_t WS_Y = 723 * MiB;
constexpr size_t WS_WIN = 1027 * MiB;
constexpr size_t WS_WOUT = 1055 * MiB;
constexpr size_t WS_W1 = 1071 * MiB;
constexpr size_t WS_W2 = 1583 * MiB;
constexpr size_t WS_MODP = 1839 * MiB;
constexpr size_t WS_NF8 = 1871 * MiB;
constexpr size_t WS_END = 1907 * MiB;
static_assert(WS_XR + (size_t)MT * D * 4 <= WS_N && WS_N + (size_t)MT * D * 2 <= WS_P && WS_P + (size_t)MT * INW * 2 <= WS_QA, "ws map 1");
static_assert(WS_QA + (size_t)MT * 1024 * 2 <= WS_KA && WS_KA + (size_t)MT * 256 * 2 <= WS_VA && WS_VA + (size_t)MT * 256 * 2 <= WS_QB, "ws map 2");
static_assert(WS_QB + (size_t)MT * 512 * 2 <= WS_KB && WS_KB + (size_t)MT * 512 * 2 <= WS_VB && WS_VB + (size_t)MT * 512 * 2 <= WS_CAT, "ws map 3");
static_assert(WS_CAT + (size_t)MT * D * 2 <= WS_OB && WS_OB + (size_t)MT * 1024 * 4 <= WS_ACT && WS_ACT + (size_t)MAXROWS * 1024 * 2 <= WS_Y, "ws map 4");
static_assert(WS_Y + (size_t)MAXROWS * 2048 * 2 <= WS_WIN && WS_WIN + (size_t)2 * INW * D * 2 <= WS_WOUT && WS_WOUT + (size_t)2 * D * D * 2 <= WS_W1, "ws map 5");
static_assert(WS_W1 + (size_t)2 * 32 * 2048 * 2048 * 2 <= WS_W2 && WS_W2 + (size_t)2 * 32 * 2048 * 1024 * 2 <= WS_MODP && WS_MODP + (size_t)64 * 10 * 12288 * 4 <= WS_NF8 && WS_NF8 + (size_t)MT * D <= WS_END, "ws map 6");
static_assert(NB * TK == MT, "K/V row count");
constexpr size_t ROUT_EID = 0, ROUT_GATE = (size_t)MT * 16, ROUT_POS = (size_t)MT * 32, ROUT_LIST = (size_t)MT * 48;
static_assert(WS_ROUT + ROUT_LIST + (size_t)32 * MT * 4 <= WS_WRS && WS_WRS + (size_t)2 * 2 * 32 * 2048 * 2 <= WS_XR, "router map");
constexpr int CW_BAR = 4096;
constexpr int CW_CNT = 8192;
constexpr int CW_Q = 12288;
static_assert((CW_Q + 512) * 4 <= (int)WS_MOD && CW_CNT + 64 * 64 <= CW_Q, "ctl map");

constexpr int RING_BYTES = 131072;
constexpr int MISC_OFF = RING_BYTES + 1024;
constexpr int LDS_BYTES = 163840;
constexpr int SG_OFF = MISC_OFF + 6144;
constexpr int FLS = 2052;

#define VM_WAIT() asm volatile("s_waitcnt vmcnt(0)" ::: "memory")
#define LDS_WAIT() asm volatile("s_waitcnt lgkmcnt(0)" ::: "memory")
__device__ __forceinline__ unsigned cvt_pk_bf16(float lo, float hi) { unsigned r; asm volatile("v_cvt_pk_bf16_f32 %0, %1, %2" : "=v"(r) : "v"(lo), "v"(hi)); return r; }
__device__ __forceinline__ bf16_t f2bf(float f) { return (bf16_t)(cvt_pk_bf16(f, 0.f) & 0xffffu); }
__device__ __forceinline__ float bf2f(bf16_t b) { return __uint_as_float(((unsigned)b) << 16); }
__device__ __forceinline__ int tid_local() { int t = threadIdx.x; asm volatile("" : "+v"(t)); return t; }
template <class T> __device__ __forceinline__ T* uniform_ptr(T* p) {
    const unsigned long long v = (unsigned long long)p;
    const unsigned lo = __builtin_amdgcn_readfirstlane((unsigned)v), hi = __builtin_amdgcn_readfirstlane((unsigned)(v >> 32));
    return (T*)(GAS T*)(((unsigned long long)hi << 32) | lo);
}
__device__ __forceinline__ float wave_sum(float v) {
    v += __builtin_bit_cast(float, __builtin_amdgcn_update_dpp(0, __builtin_bit_cast(int, v), 0xB1, 0xF, 0xF, true));
    v += __builtin_bit_cast(float, __builtin_amdgcn_update_dpp(0, __builtin_bit_cast(int, v), 0x4E, 0xF, 0xF, true));
    v += __builtin_bit_cast(float, __builtin_amdgcn_update_dpp(0, __builtin_bit_cast(int, v), 0x141, 0xF, 0xF, true));
    v += __builtin_bit_cast(float, __builtin_amdgcn_update_dpp(0, __builtin_bit_cast(int, v), 0x140, 0xF, 0xF, true));
    const float a = __builtin_bit_cast(float, __builtin_amdgcn_readlane(__builtin_bit_cast(int, v), 0)), b = __builtin_bit_cast(float, __builtin_amdgcn_readlane(__builtin_bit_cast(int, v), 16));
    const float c = __builtin_bit_cast(float, __builtin_amdgcn_readlane(__builtin_bit_cast(int, v), 32)), d = __builtin_bit_cast(float, __builtin_amdgcn_readlane(__builtin_bit_cast(int, v), 48));
    return (a + b) + (c + d);
}

constexpr int PT_OFF = 131072 + 1024 + 3072;
constexpr int PT_OUT = 26, PT_WS = 27;
__device__ __forceinline__ unsigned long long ldp_raw(LAS unsigned char* lds, int i) {
    const u32x2 v = *(const LAS u32x2*)(lds + PT_OFF + 8 * i);
    const unsigned lo = __builtin_amdgcn_readfirstlane(v.x), hi = __builtin_amdgcn_readfirstlane(v.y);
    return ((unsigned long long)hi << 32) | lo;
}
#define INP(i) ((const float*)(const GAS float*)ldp_raw(lds, (i)))
#define WSP() ((unsigned char*)(GAS unsigned char*)ldp_raw(lds, PT_WS))
#define OUTP() ((float*)(GAS float*)ldp_raw(lds, PT_OUT))
#define PHASE_FN __device__ __forceinline__ void

#define XB_TMO      128
#define XB_XCNT(j)  (256  + 64 * (j))
#define XB_XSUB(j)  (1280 + 64 * (j))
#define XB_XGEN(j)  (2304 + 64 * (j))
#define XB_TOP      3328
#define XB_TOPGEN   3392
#define XCD_BAR_WORDS 3456
#define XB_SPIN_CAP (1u << 18)
__device__ __forceinline__ unsigned xb_ld(unsigned* p)              { return __hip_atomic_load(p, __ATOMIC_RELAXED, __HIP_MEMORY_SCOPE_AGENT); }
__device__ __forceinline__ unsigned xb_add(unsigned* p, unsigned v) { return __hip_atomic_fetch_add(p, v, __ATOMIC_RELAXED, __HIP_MEMORY_SCOPE_AGENT); }
__device__ __forceinline__ unsigned xb_xcc_id() { return (unsigned)__builtin_amdgcn_s_getreg((3 << 11) | 20) & 0xFu; }
#define XB_SPIN(cond, bar) do { unsigned _sp = 0; while (cond) { __builtin_amdgcn_s_sleep(1); \
    if ((++_sp & 255u) == 0u) { if (xb_ld(&(bar)[XB_TMO])) break; if (_sp > XB_SPIN_CAP) { atomicAdd(&(bar)[XB_TMO], 1u); break; } } } } while (0)
struct XcdBarrier { unsigned* bar; unsigned x; volatile LAS unsigned* st; };
__device__ __forceinline__ XcdBarrier xcd_barrier_post(unsigned* bar, volatile LAS unsigned* st) {
    XcdBarrier b; b.bar = bar; b.x = xb_xcc_id(); b.st = st;
    if (threadIdx.x == 0) (void)xb_add(&bar[XB_XCNT(b.x)], 1u);
    return b;
}
__device__ __forceinline__ void xcd_barrier_complete(unsigned* bar, unsigned x, unsigned& nloc, unsigned& nx) {
    const unsigned G = gridDim.x * gridDim.y * gridDim.z;
    unsigned sum, cnt, mine, sp = 0u;
    for (;;) {
        sum = 0u; cnt = 0u; mine = 0u;
#pragma unroll
        for (unsigned j = 0; j < 16; ++j) { const unsigned c = xb_ld(&bar[XB_XCNT(j)]); sum += c; cnt += (c > 0u) ? 1u : 0u; mine = (j == x) ? c : mine; }
        if (sum == G) break;
        __builtin_amdgcn_s_sleep(1);
        if ((++sp & 255u) == 0u) { if (xb_ld(&bar[XB_TMO])) break; if (sp > XB_SPIN_CAP) { atomicAdd(&bar[XB_TMO], 1u); break; } }
    }
    nloc = mine > 0u ? mine : 1u; nx = cnt > 0u ? cnt : 1u;
}
__device__ __forceinline__ void xcd_barrier(const XcdBarrier& b) {
    asm volatile("s_waitcnt vmcnt(0)" ::: "memory");
    __syncthreads();
    if (threadIdx.x == 0) {
        unsigned* bar = b.bar;
        __builtin_amdgcn_s_waitcnt(0);
        unsigned nloc = b.st[0], nx = b.st[1];
        if (nloc == 0u) { xcd_barrier_complete(bar, b.x, nloc, nx); b.st[0] = nloc; b.st[1] = nx; }
        const unsigned old = xb_add(&bar[XB_XSUB(b.x)], 1u);
        const unsigned gen = old / nloc;
        if (old + 1u == (gen + 1u) * nloc) {
            __builtin_amdgcn_fence(__ATOMIC_RELEASE, "agent");
            asm volatile("s_waitcnt vmcnt(0)" ::: "memory");
            const unsigned og = xb_add(&bar[XB_TOP], 1u);
            const unsigned tg = og / nx;
            if (og + 1u == (tg + 1u) * nx) xb_add(&bar[XB_TOPGEN], 1u);
            else XB_SPIN(xb_ld(&bar[XB_TOPGEN]) == tg, bar);
            __builtin_amdgcn_fence(__ATOMIC_ACQUIRE, "agent");
            xb_add(&bar[XB_XGEN(b.x)], 1u);
            asm volatile("s_waitcnt vmcnt(0)" ::: "memory");
        } else {
            XB_SPIN(xb_ld(&bar[XB_XGEN(b.x)]) == gen, bar);
            __builtin_amdgcn_fence(__ATOMIC_ACQUIRE, "agent");
            asm volatile("s_waitcnt vmcnt(0)" ::: "memory");
        }
    }
    __syncthreads();
}

namespace pg8 {
constexpr int BM = 256, BK = 64, HALF = 128, HTB = HALF * BK * 2, STAGE_BYTES = 8 * HTB, NXCD = 8, WGM = 8;
__host__ __device__ __forceinline__ int lds_byte(int r, int c) { const int st = (r >> 4) * 2 + (c >> 5), rr = r & 15, cc = c & 31, ob = rr * 64 + cc * 2; return st * 1024 + (ob ^ (((ob >> 9) & 1) << 5)); }
__host__ __device__ __forceinline__ void stage_rc(int b, int& R, int& C) { const int st = b / 1024, sb = b % 1024, swz = sb ^ (((sb >> 9) & 1) << 5); R = (st >> 1) * 16 + swz / 64; C = (st & 1) * 32 + (swz % 64) / 2; }
__host__ __device__ __forceinline__ int perm32(int rho) { const int n = rho >> 4, i = rho & 15; return 8 * (i >> 2) + 4 * n + (i & 3); }

__host__ __device__ __forceinline__ int f8_f(int rr) { return (0x9C >> (2 * (rr >> 2))) & 3; }
__host__ __device__ __forceinline__ int lds_byte8(int r, int b) { const int st = (r >> 4) * 2 + (b >> 6), rr = r & 15, q = (b >> 4) & 3; return st * 1024 + rr * 64 + ((q ^ f8_f(rr)) << 4) + (b & 15); }
__host__ __device__ __forceinline__ void stage_rc8(int o, int& R, int& Cb) { const int st = o / 1024, w = o % 1024, rr = w / 64, slot = (w % 64) / 16; R = (st >> 1) * 16 + rr; Cb = (st & 1) * 64 + ((slot ^ f8_f(rr)) << 4); }
template <int ESZ> __host__ __device__ __forceinline__ void stage_rcb(int o, int& R, int& Cb) { if constexpr (ESZ == 2) { int C; stage_rc(o, R, C); Cb = 2 * C; } else stage_rc8(o, R, Cb); }
struct Unit { int pm, pn, e; };

template <int K_, int ESZ_> struct DenseSched {
    static constexpr int K = K_, ESZ = ESZ_, SCALE_B = (ESZ_ == 1) ? 121 : 127;
    static constexpr bool GATHER_A = false;
    int nM, nN, nwg, G, c; const char* A; const char* Bt;
    __device__ void init(const void* A_, const void* Bt_, int M, int N, int G_, int c_) { A = (const char*)A_; Bt = (const char*)Bt_; nM = M / BM; nN = N / BM; nwg = nM * nN; G = G_; c = c_; }
    __device__ __forceinline__ bool next(int i, Unit& u) const {
        const long L = (long)i * G + c; if (L >= nwg) return false;
        int wgid = (int)L; { const int q = nwg / NXCD, r = nwg % NXCD, xcd = wgid % NXCD, off = wgid / NXCD; wgid = (xcd < r ? xcd * (q + 1) : r * (q + 1) + (xcd - r) * q) + off; }
        const int nig = WGM * nN, gid = wgid / nig, fm = gid * WGM, gsz = (nM - fm) < WGM ? (nM - fm) : WGM;
        u.pm = fm + ((wgid % nig) % gsz); u.pn = (wgid % nig) / gsz; u.e = 0; return true;
    }
    __device__ __forceinline__ int row0(const Unit& u) const { return u.pm * BM; }
    __device__ __forceinline__ const char* a_base() const { return A; }
    __device__ __forceinline__ const char* b_base(const Unit& u) const { return Bt + (size_t)u.pn * BM * K * ESZ; }
    __device__ __forceinline__ void a_voff(const Unit& u, int tid, unsigned (&v)[2][2]) const {
#pragma unroll
        for (int i = 0; i < 2; ++i) { int R, Cb; stage_rcb<ESZ>(tid * 16 + i * 8192, R, Cb);
#pragma unroll
            for (int h = 0; h < 2; ++h) v[h][i] = (unsigned)((u.pm * BM + h * HALF + R) * (K * ESZ) + Cb); }
    }
};
template <bool GATHER, int K_, int ESZ_> struct MoeSched {
    static constexpr int K = K_, ESZ = ESZ_, SCALE_B = (K_ == 2048) ? 121 : 122;
    static constexpr size_t BSTRIDE = (size_t)2048 * K * ESZ;
    static constexpr bool GATHER_A = GATHER;
    const LAS int* tp; const LAS int* cnt; int start, end, j, stride; const char* A; const char* Bt; const int* list;
    __device__ void init(const LAS int* tp_, const LAS int* cnt_, const void* A_, const void* Bt_, const int* list_, int G, int c) {
        tp = tp_; cnt = cnt_; A = (const char*)A_; Bt = (const char*)Bt_; list = list_;
        const int U = 8 * tp[NE];
        if (G == 256) { const int x = c & 7; j = c >> 3; stride = 32; start = (int)(((long)x * U) / 8); end = (int)(((long)(x + 1) * U) / 8); }
        else { start = 0; end = U; j = c; stride = G; }
    }
    __device__ __forceinline__ bool next(int i, Unit& u) const {
        const int idx = start + i * stride + j; if (idx >= end) return false;
        int e = 0;
        for (int q = 1; q < NE; ++q) e += (8 * tp[q] <= idx) ? 1 : 0;
        e = __builtin_amdgcn_readfirstlane(e);
        const int tiles = tp[e + 1] - tp[e], r = idx - 8 * tp[e];
        const int gi = r >> 5, fm = gi * 4, gsz = (tiles - fm) < 4 ? (tiles - fm) : 4, w = r - 32 * gi;
        u.e = e; u.pm = __builtin_amdgcn_readfirstlane(fm + (w % gsz)); u.pn = __builtin_amdgcn_readfirstlane(w / gsz); return true;
    }
    __device__ __forceinline__ int row0(const Unit& u) const { return __builtin_amdgcn_readfirstlane((tp[u.e] + u.pm) * BM); }
    __device__ __forceinline__ const char* a_base() const { return A; }
    __device__ __forceinline__ const char* b_base(const Unit& u) const { return Bt + (size_t)u.e * BSTRIDE + (size_t)u.pn * BM * K * ESZ; }
    __device__ __forceinline__ void a_voff(const Unit& u, int tid, unsigned (&v)[2][2]) const {
        if constexpr (GATHER) {
            const int* lp = list + (size_t)u.e * MT + u.pm * BM;
            const int nv = cnt[u.e] - u.pm * BM;
            int tok[2][2], Cc[2];
#pragma unroll
            for (int i = 0; i < 2; ++i) { int R; stage_rcb<ESZ>(tid * 16 + i * 8192, R, Cc[i]);
#pragma unroll
                for (int h = 0; h < 2; ++h) { const int lr = h * HALF + R; tok[h][i] = lp[lr < nv ? lr : 0]; } }
            asm volatile("s_waitcnt vmcnt(0)" ::: "memory");
#pragma unroll
            for (int h = 0; h < 2; ++h)
#pragma unroll
                for (int i = 0; i < 2; ++i) v[h][i] = (unsigned)(tok[h][i] * (K * ESZ) + Cc[i]);
        } else {
            const int r0 = row0(u);
#pragma unroll
            for (int i = 0; i < 2; ++i) { int R, Cb; stage_rcb<ESZ>(tid * 16 + i * 8192, R, Cb);
#pragma unroll
                for (int h = 0; h < 2; ++h) v[h][i] = (unsigned)((r0 + h * HALF + R) * (K * ESZ) + Cb); }
        }
    }
};

struct EpiBf16 {
    static constexpr bool PERM = true;
    bf16_t* O; int ldc; const float* bias; int bias_estride;
    __device__ __forceinline__ void operator()(const f32x4 (&acc)[2][2][4][2], const Unit& u, int urow0, int wr, int wc, int fr, int fq) const {
        const int row0 = urow0 + wr * 64 + fr; const int col0 = u.pn * BM + wc * 32 + 8 * fq;
        const float* bp = bias ? bias + (size_t)u.e * bias_estride + col0 : nullptr;
        f32x4 bv[2][2];
#pragma unroll
        for (int bj = 0; bj < 2; ++bj)
#pragma unroll
            for (int n = 0; n < 2; ++n) bv[bj][n] = bp ? *(const f32x4*)(bp + bj * HALF + 4 * n) : (f32x4){0.f, 0.f, 0.f, 0.f};
#pragma unroll
        for (int ai = 0; ai < 2; ++ai)
#pragma unroll
            for (int m = 0; m < 4; ++m) { bf16_t* rowp = O + (size_t)(row0 + ai * HALF + m * 16) * ldc + col0;
#pragma unroll
                for (int bj = 0; bj < 2; ++bj) { const f32x4 v0 = acc[ai][bj][m][0] + bv[bj][0], v1 = acc[ai][bj][m][1] + bv[bj][1];
                    u32x4 w; w.x = cvt_pk_bf16(v0[0], v0[1]); w.y = cvt_pk_bf16(v0[2], v0[3]); w.z = cvt_pk_bf16(v1[0], v1[1]); w.w = cvt_pk_bf16(v1[2], v1[3]);
                    *(u32x4*)(rowp + bj * HALF) = w; } }
    }
};
struct EpiF8 {
    static constexpr bool PERM = true;
    unsigned char* O; int ldc; const float* bias; int bias_estride;
    __device__ __forceinline__ void operator()(const f32x4 (&acc)[2][2][4][2], const Unit& u, int urow0, int wr, int wc, int fr, int fq) const {
        const int row0 = urow0 + wr * 64 + fr; const int col0 = u.pn * BM + wc * 32 + 8 * fq;
        const float* bp = bias + (size_t)u.e * bias_estride + col0;
        f32x4 bv[2][2];
#pragma unroll
        for (int bj = 0; bj < 2; ++bj)
#pragma unroll
            for (int n = 0; n < 2; ++n) bv[bj][n] = *(const f32x4*)(bp + bj * HALF + 4 * n);
#pragma unroll
        for (int ai = 0; ai < 2; ++ai)
#pragma unroll
            for (int m = 0; m < 4; ++m) { unsigned char* rowp = O + (size_t)(row0 + ai * HALF + m * 16) * ldc + col0;
#pragma unroll
                for (int bj = 0; bj < 2; ++bj) { const f32x4 v0 = acc[ai][bj][m][0] + bv[bj][0], v1 = acc[ai][bj][m][1] + bv[bj][1];
                    int w0 = 0, w1 = 0; w0 = __builtin_amdgcn_cvt_pk_fp8_f32(v0[0], v0[1], w0, false); w0 = __builtin_amdgcn_cvt_pk_fp8_f32(v0[2], v0[3], w0, true);
                    w1 = __builtin_amdgcn_cvt_pk_fp8_f32(v1[0], v1[1], w1, false); w1 = __builtin_amdgcn_cvt_pk_fp8_f32(v1[2], v1[3], w1, true);
                    *(u32x2*)(rowp + bj * HALF) = (u32x2){(unsigned)w0, (unsigned)w1}; } }
    }
};
__device__ __forceinline__ float swiglu1(float g, float l) {
    g = fminf(g, 7.0f); l = fminf(fmaxf(l, -7.0f), 7.0f);
    const float sg = __builtin_amdgcn_rcpf(1.0f + __builtin_amdgcn_exp2f(-1.702f * 1.4426950408889634f * g));
    return g * sg * (l + 1.0f);
}
struct EpiSwiglu {
    static constexpr bool PERM = true;
    unsigned char* O; const float* bias;
    __device__ __forceinline__ void operator()(const f32x4 (&acc)[2][2][4][2], const Unit& u, int urow0, int wr, int wc, int fr, int fq) const {
        const int row0 = urow0 + wr * 64 + fr; const int col0 = u.pn * BM + wc * 32 + 8 * fq;
        const float* bp = bias + (size_t)u.e * 2048 + col0;
        f32x4 bv[2][2];
#pragma unroll
        for (int bj = 0; bj < 2; ++bj)
#pragma unroll
            for (int n = 0; n < 2; ++n) bv[bj][n] = *(const f32x4*)(bp + bj * HALF + 4 * n);
#pragma unroll
        for (int ai = 0; ai < 2; ++ai)
#pragma unroll
            for (int m = 0; m < 4; ++m) { unsigned char* rowp = O + (size_t)(row0 + ai * HALF + m * 16) * DE + (col0 >> 1);
#pragma unroll
                for (int bj = 0; bj < 2; ++bj) { const f32x4 v0 = acc[ai][bj][m][0] + bv[bj][0], v1 = acc[ai][bj][m][1] + bv[bj][1];
                    int w = 0; w = __builtin_amdgcn_cvt_pk_fp8_f32(swiglu1(v0[0], v0[1]), swiglu1(v0[2], v0[3]), w, false); w = __builtin_amdgcn_cvt_pk_fp8_f32(swiglu1(v1[0], v1[1]), swiglu1(v1[2], v1[3]), w, true);
                    *(int*)(rowp + bj * (HALF / 2)) = w; } }
    }
};
__device__ __forceinline__ void unpack_bf16x8(const u32x4 w, f32x4& lo, f32x4& hi) {
    lo = (f32x4){__uint_as_float(w.x << 16), __uint_as_float(w.x & 0xffff0000u), __uint_as_float(w.y << 16), __uint_as_float(w.y & 0xffff0000u)};
    hi = (f32x4){__uint_as_float(w.z << 16), __uint_as_float(w.z & 0xffff0000u), __uint_as_float(w.w << 16), __uint_as_float(w.w & 0xffff0000u)};
}
__device__ __forceinline__ u32x4 pack_bf16x8(const f32x4 lo, const f32x4 hi) {
    u32x4 w; w.x = cvt_pk_bf16(lo[0], lo[1]); w.y = cvt_pk_bf16(lo[2], lo[3]); w.z = cvt_pk_bf16(hi[0], hi[1]); w.w = cvt_pk_bf16(hi[2], hi[3]); return w;
}
struct EpiResid {
    static constexpr bool PERM = true;
    const float* xin; const float* cin; const bf16_t* xr_in; bf16_t* xr_out; const float* mod; int layer;
    __device__ __forceinline__ void operator()(const f32x4 (&acc)[2][2][4][2], const Unit& u, int urow0, int wr, int wc, int fr, int fq) const {
        const int row0 = urow0 + wr * 64 + fr, col0 = u.pn * BM + wc * 32 + 8 * fq;
        const int bidx = urow0 < ML ? (urow0 >> 12) : 4;
        const float* gp = mod + (size_t)bidx * 12288 + 2 * 2048 + col0;
        f32x4 g[2][2];
#pragma unroll
        for (int bj = 0; bj < 2; ++bj)
#pragma unroll
            for (int n = 0; n < 2; ++n) g[bj][n] = *(const f32x4*)(gp + bj * HALF + 4 * n);
        if (layer == 0) {
            const float* bbase = urow0 < ML ? xin : cin - (size_t)ML * D;
#pragma unroll
            for (int ai = 0; ai < 2; ++ai)
#pragma unroll
                for (int mp = 0; mp < 2; ++mp) {
                    f32x4 bs[2][2][2];
#pragma unroll
                    for (int mq = 0; mq < 2; ++mq) { const int row = row0 + ai * HALF + (2 * mp + mq) * 16; const float* bp = bbase + (size_t)row * D + col0;
#pragma unroll
                        for (int bj = 0; bj < 2; ++bj)
#pragma unroll
                            for (int n = 0; n < 2; ++n) bs[mq][bj][n] = *(const f32x4*)(bp + bj * HALF + 4 * n); }
#pragma unroll
                    for (int mq = 0; mq < 2; ++mq) { const int m = 2 * mp + mq; const int row = row0 + ai * HALF + m * 16; bf16_t* op = xr_out + (size_t)row * D + col0;
#pragma unroll
                        for (int bj = 0; bj < 2; ++bj) *(u32x4*)(op + bj * HALF) = pack_bf16x8(bs[mq][bj][0] + g[bj][0] * acc[ai][bj][m][0], bs[mq][bj][1] + g[bj][1] * acc[ai][bj][m][1]); }
                    asm volatile("" ::: "memory"); }
        } else {
#pragma unroll
            for (int ai = 0; ai < 2; ++ai) {
                u32x4 bw[4][2];
#pragma unroll
                for (int m = 0; m < 4; ++m) { const int row = row0 + ai * HALF + m * 16; const bf16_t* bp = xr_in + (size_t)row * D + col0;
#pragma unroll
                    for (int bj = 0; bj < 2; ++bj) bw[m][bj] = *(const u32x4*)(bp + bj * HALF); }
#pragma unroll
                for (int m = 0; m < 4; ++m) { const int row = row0 + ai * HALF + m * 16; bf16_t* op = xr_out + (size_t)row * D + col0;
#pragma unroll
                    for (int bj = 0; bj < 2; ++bj) { f32x4 b0, b1; unpack_bf16x8(bw[m][bj], b0, b1);
                        *(u32x4*)(op + bj * HALF) = pack_bf16x8(b0 + g[bj][0] * acc[ai][bj][m][0], b1 + g[bj][1] * acc[ai][bj][m][1]); } }
                asm volatile("" ::: "memory"); }
        }
    }
};

template <class Epi, class Sched>
__device__ __forceinline__ void gemm_phase(LAS unsigned char* lds, const Sched& S, const Epi& E) {
    constexpr int K = Sched::K, ESZ = Sched::ESZ;
    const int tid = tid_local(), wid = __builtin_amdgcn_readfirstlane(tid >> 6), lane = tid & 63, wr = wid >> 2, wc = wid & 3, fr = lane & 15, fq = lane >> 4;
    constexpr int nt = K * ESZ / 128;
    constexpr int SCALE_A = 127, SCALE_B = Sched::SCALE_B;
    unsigned voffB[2], voffA[2][2];
#pragma unroll
    for (int i = 0; i < 2; ++i) { int R, Cb; stage_rcb<ESZ>(tid * 16 + i * 8192, R, Cb); const int Rb = Epi::PERM ? ((R & ~31) + perm32(R & 31)) : R; voffB[i] = (unsigned)(Rb * (K * ESZ) + Cb); }
    constexpr size_t kstep = 128;
    constexpr size_t hstep = (size_t)HALF * K * ESZ;
    const unsigned ldsw = (unsigned)wid * 1024u;
    const int aoff = ESZ == 2 ? lds_byte(wr * 64 + fr, fq * 8) : lds_byte8(wr * 64 + fr, fq * 32), boff = ESZ == 2 ? lds_byte(wc * 32 + fr, fq * 8) : lds_byte8(wc * 32 + fr, fq * 32);
    const int aoff2 = aoff ^ 16, boff2 = boff ^ 16;
#define PG8_SA(b, h) (((b) * 2 + (h)) * HTB)
#define PG8_SB(b, h) ((4 + (b) * 2 + (h)) * HTB)
#define PG8_STAGE(bufoff, gbase, voff) do { _Pragma("unroll") for (int _i = 0; _i < 2; ++_i) \
        __builtin_amdgcn_global_load_lds((const unsigned*)((const char*)(gbase) + (voff)[_i]), (LAS unsigned*)(lds + (bufoff) + ldsw + _i * 8192), 16, 0, 0); } while (0)
#define PG8_LDA(dst, b, h) do { if constexpr (ESZ == 2) { _Pragma("unroll") for (int m = 0; m < 4; ++m) _Pragma("unroll") for (int k = 0; k < 2; ++k) dst[m][k] = *(const LAS bf16x8*)(lds + PG8_SA(b, h) + aoff + m * 2048 + k * 1024); } \
        else { _Pragma("unroll") for (int m = 0; m < 4; ++m) { const u32x4 _lo = *(const LAS u32x4*)(lds + PG8_SA(b, h) + aoff + m * 2048), _hi = *(const LAS u32x4*)(lds + PG8_SA(b, h) + aoff2 + m * 2048); \
            dst##8[m] = (v8i){(int)_lo.x, (int)_lo.y, (int)_lo.z, (int)_lo.w, (int)_hi.x, (int)_hi.y, (int)_hi.z, (int)_hi.w}; } } } while (0)
#define PG8_LDB(dst, b, h) do { if constexpr (ESZ == 2) { _Pragma("unroll") for (int n = 0; n < 2; ++n) _Pragma("unroll") for (int k = 0; k < 2; ++k) dst[n][k] = *(const LAS bf16x8*)(lds + PG8_SB(b, h) + boff + n * 2048 + k * 1024); } \
        else { _Pragma("unroll") for (int n = 0; n < 2; ++n) { const u32x4 _lo = *(const LAS u32x4*)(lds + PG8_SB(b, h) + boff + n * 2048), _hi = *(const LAS u32x4*)(lds + PG8_SB(b, h) + boff2 + n * 2048); \
            dst##8[n] = (v8i){(int)_lo.x, (int)_lo.y, (int)_lo.z, (int)_lo.w, (int)_hi.x, (int)_hi.y, (int)_hi.z, (int)_hi.w}; } } } while (0)
#define PG8_MMA(ai, bj, At, Bt) do { __builtin_amdgcn_s_setprio(1); if constexpr (ESZ == 2) { _Pragma("unroll") for (int m = 0; m < 4; ++m) _Pragma("unroll") for (int n = 0; n < 2; ++n) _Pragma("unroll") for (int k = 0; k < 2; ++k) \
        acc[ai][bj][m][n] = __builtin_amdgcn_mfma_f32_16x16x32_bf16(Bt[n][k], At[m][k], acc[ai][bj][m][n], 0, 0, 0); } \
        else { _Pragma("unroll") for (int m = 0; m < 4; ++m) _Pragma("unroll") for (int n = 0; n < 2; ++n) \
        acc[ai][bj][m][n] = __builtin_amdgcn_mfma_scale_f32_16x16x128_f8f6f4(Bt##8[n], At##8[m], acc[ai][bj][m][n], 0, 0, 0, SCALE_B, 0, SCALE_A); } __builtin_amdgcn_s_setprio(0); } while (0)
#define PG8_WAIT_V(n) asm volatile("s_waitcnt vmcnt(" #n ")" ::: "memory")
#define PG8_WAIT_L(n) asm volatile("s_waitcnt lgkmcnt(" #n ")" ::: "memory")
#define PG8_BAR __builtin_amdgcn_s_barrier()
#define PG8_SCHED __builtin_amdgcn_sched_barrier(0)
    Unit cur, nxt; int ui = 0;
    if (!S.next(0, cur)) return;
    f32x4 acc[2][2][4][2];
#pragma unroll
    for (int a = 0; a < 2; ++a)
#pragma unroll
        for (int b = 0; b < 2; ++b)
#pragma unroll
            for (int m = 0; m < 4; ++m)
#pragma unroll
                for (int n = 0; n < 2; ++n) acc[a][b][m][n] = (f32x4){0.f, 0.f, 0.f, 0.f};
    bf16x8 At[4][2], B0[2][2], B1[2][2];
    v8i At8[4], B08[2], B18[2];
    const char* const Ab = S.a_base();
    const char* cB = S.b_base(cur);
    S.a_voff(cur, tid, voffA);
    PG8_STAGE(PG8_SB(0, 0), cB, voffB); PG8_STAGE(PG8_SB(0, 1), cB + hstep, voffB); PG8_STAGE(PG8_SA(0, 0), Ab, voffA[0]); PG8_STAGE(PG8_SA(0, 1), Ab, voffA[1]);
    if (wr == 1) PG8_BAR;
    PG8_WAIT_V(2); PG8_BAR;
    PG8_STAGE(PG8_SB(1, 0), cB + kstep, voffB); PG8_STAGE(PG8_SA(1, 0), Ab + kstep, voffA[0]); PG8_STAGE(PG8_SB(1, 1), cB + hstep + kstep, voffB);
    PG8_WAIT_V(6); PG8_BAR;
    for (;;) {
        const bool has_next = S.next(ui + 1, nxt);
        const char* nB = has_next ? S.b_base(nxt) : cB;
        unsigned voffN[2][2];
        if constexpr (Sched::GATHER_A) { if (has_next) S.a_voff(nxt, tid, voffN); }
#pragma unroll 1
        for (int t = 0; t < nt; t += 2) {
            const bool last = (t == nt - 2);
            const char* a1 = Ab + (size_t)(t + 1) * kstep;
            const char* a2 = last ? Ab : Ab + (size_t)(t + 2) * kstep; const char* b2 = last ? nB : cB + (size_t)(t + 2) * kstep;
            const char* a3 = a2 + kstep; const char* b3 = b2 + kstep;
            PG8_LDB(B0, 0, 0); PG8_LDB(B1, 0, 1); PG8_SCHED; PG8_LDA(At, 0, 0); PG8_STAGE(PG8_SA(1, 1), a1, voffA[1]);
            if (last && has_next) {
                if constexpr (Sched::GATHER_A) { voffA[0][0] = voffN[0][0]; voffA[0][1] = voffN[0][1]; voffA[1][0] = voffN[1][0]; voffA[1][1] = voffN[1][1]; }
                else S.a_voff(nxt, tid, voffA); }
            PG8_WAIT_V(8); PG8_WAIT_L(0); PG8_BAR; PG8_MMA(0, 0, At, B0); PG8_MMA(0, 1, At, B1); PG8_BAR; PG8_SCHED;
            PG8_LDA(At, 0, 1); PG8_STAGE(PG8_SB(0, 0), b2, voffB); PG8_STAGE(PG8_SB(0, 1), b2 + hstep, voffB); PG8_STAGE(PG8_SA(0, 0), a2, voffA[0]);
            PG8_WAIT_V(8); PG8_WAIT_L(0); PG8_BAR; PG8_MMA(1, 0, At, B0); PG8_MMA(1, 1, At, B1); PG8_BAR; PG8_SCHED;
            PG8_LDB(B0, 1, 0); PG8_LDB(B1, 1, 1); PG8_SCHED; PG8_LDA(At, 1, 0); PG8_STAGE(PG8_SA(0, 1), a2, voffA[1]);
            PG8_WAIT_V(8); PG8_WAIT_L(0); PG8_BAR; PG8_MMA(0, 0, At, B0); PG8_MMA(0, 1, At, B1); PG8_BAR; PG8_SCHED;
            PG8_LDA(At, 1, 1); PG8_STAGE(PG8_SB(1, 0), b3, voffB); PG8_STAGE(PG8_SB(1, 1), b3 + hstep, voffB); PG8_STAGE(PG8_SA(1, 0), a3, voffA[0]);
            PG8_WAIT_V(8); PG8_WAIT_L(0); PG8_BAR; PG8_MMA(1, 0, At, B0); PG8_MMA(1, 1, At, B1); PG8_BAR; PG8_SCHED;
        }
        if (wr == 0) PG8_BAR;
        E(acc, cur, S.row0(cur), wr, wc, fr, fq);
        if constexpr (Epi::PERM) { if ((MK_REPEAT >> 12) & 1) E(acc, cur, S.row0(cur), wr, wc, fr, fq); }
        if (!has_next) break;
#pragma unroll
        for (int a = 0; a < 2; ++a)
#pragma unroll
            for (int b = 0; b < 2; ++b)
#pragma unroll
                for (int m = 0; m < 4; ++m)
#pragma unroll
                    for (int n = 0; n < 2; ++n) acc[a][b][m][n] = (f32x4){0.f, 0.f, 0.f, 0.f};
        cur = nxt; cB = nB; ++ui;
        if (wr == 1) PG8_BAR;
    }
    PG8_WAIT_V(0);
    PG8_BAR;
#undef PG8_SA
#undef PG8_SB
#undef PG8_STAGE
#undef PG8_LDA
#undef PG8_LDB
#undef PG8_MMA
#undef PG8_WAIT_V
#undef PG8_WAIT_L
#undef PG8_BAR
#undef PG8_SCHED
}
}

namespace att {
constexpr int NW = 8, QBLK = 32, KVBLK = 64, DV = 128;
constexpr float THR = 8.f;
constexpr int SHM_V = KVBLK * DV * 2, SHM_K = KVBLK * 128 * 2, SHM_ATTN = 2 * SHM_V + 2 * SHM_K + NW * 64 * 4;
#define SBAR() __builtin_amdgcn_sched_barrier(0)
__device__ __forceinline__ int crow(int r, int hi) { return (r & 3) + 8 * (r >> 2) + 4 * hi; }
template <int DQK> __device__ __forceinline__ int kswz(int row, int colB) {
    if constexpr (DQK == 128) return row * 256 + (colB ^ ((row & 15) << 4));
    else return row * 128 + (colB ^ (((row >> 1) & 7) << 4));
}
template <int DQK> __device__ __forceinline__ void partialSM(f32x16& p0, f32x16& p1, float& m_reg, float& mn, float& alpha) {
    constexpr float SCALE = (DQK == 128) ? 0.088388347648318440f : 0.125f;
    constexpr float Cc = SCALE * 1.4426950408889634f;
    float pmax = p0[0];
#pragma unroll
    for (int r = 1; r < 16; ++r) pmax = fmaxf(pmax, p0[r]);
#pragma unroll
    for (int r = 0; r < 16; ++r) pmax = fmaxf(pmax, p1[r]);
    { auto rr = __builtin_amdgcn_permlane32_swap(__float_as_uint(pmax), __float_as_uint(pmax), false, false);
      pmax = fmaxf(__uint_as_float(rr[0]), __uint_as_float(rr[1])); }
    if (__builtin_expect(__all(pmax - m_reg <= THR / SCALE), 1)) { mn = m_reg; alpha = 1.f; }
    else { mn = fmaxf(m_reg, pmax); alpha = __builtin_amdgcn_exp2f((m_reg - mn) * Cc); m_reg = mn; }
    const float mnC = -mn * Cc;
#pragma unroll
    for (int r = 0; r < 16; ++r) p0[r] = fmaf(p0[r], Cc, mnC);
#pragma unroll
    for (int r = 0; r < 16; ++r) p1[r] = fmaf(p1[r], Cc, mnC);
#pragma unroll
    for (int r = 0; r < 16; ++r) p0[r] = __builtin_amdgcn_exp2f(p0[r]);
}
__device__ __forceinline__ void finishSM(f32x16& p0, f32x16& p1, float alpha, float& l_reg, bf16x8& pa0, bf16x8& pa1, bf16x8& pa2, bf16x8& pa3) {
#pragma unroll
    for (int r = 0; r < 16; ++r) p1[r] = __builtin_amdgcn_exp2f(p1[r]);
    float ps = 0;
#pragma unroll
    for (int r = 0; r < 16; ++r) ps += p0[r];
#pragma unroll
    for (int r = 0; r < 16; ++r) ps += p1[r];
    { auto rr = __builtin_amdgcn_permlane32_swap(__float_as_uint(ps), __float_as_uint(ps), false, false);
      ps = __uint_as_float(rr[0]) + __uint_as_float(rr[1]); }
    l_reg = l_reg * alpha + ps;
#define PK4(P, BASE, OUT) do { unsigned a0 = cvt_pk_bf16(P[BASE + 0], P[BASE + 1]), a1 = cvt_pk_bf16(P[BASE + 2], P[BASE + 3]);   \
    unsigned b0 = cvt_pk_bf16(P[BASE + 4], P[BASE + 5]), b1 = cvt_pk_bf16(P[BASE + 6], P[BASE + 7]);                              \
    auto r0 = __builtin_amdgcn_permlane32_swap(a0, b0, false, false); auto r1 = __builtin_amdgcn_permlane32_swap(a1, b1, false, false); \
    u32x4 w = {r0[0], r1[0], r0[1], r1[1]}; OUT = *reinterpret_cast<bf16x8*>(&w); } while (0)
    PK4(p0, 0, pa0); PK4(p0, 8, pa1); PK4(p1, 0, pa2); PK4(p1, 8, pa3);
#undef PK4
}
template <int DQK> __device__ __forceinline__ void qkt(f32x16& p0, f32x16& p1, const char* Ks, const bf16x8* qr, int r32, int hi) {
    p0 = f32x16{}; p1 = f32x16{};
#pragma unroll
    for (int d0 = 0; d0 < DQK / 16; ++d0) { const int cb = (d0 * 16 + hi * 8) * 2;
        const bf16x8 b0 = *reinterpret_cast<const bf16x8*>(Ks + kswz<DQK>(r32, cb));
        const bf16x8 b1 = *reinterpret_cast<const bf16x8*>(Ks + kswz<DQK>(32 + r32, cb));
        p0 = __builtin_amdgcn_mfma_f32_32x32x16_bf16(b0, qr[d0], p0, 0, 0, 0);
        p1 = __builtin_amdgcn_mfma_f32_32x32x16_bf16(b1, qr[d0], p1, 0, 0, 0); }
}
__device__ __forceinline__ int v_st(int k, int c) { const int kk = (k & ~0xC) | ((k & 4) << 1) | ((k & 8) >> 1); return ((kk >> 3) * 4 + (c >> 5)) * 512 + ((kk & 7) * 32 + (c & 31)) * 2; }
__device__ __forceinline__ int v_rd_base(int lane) { return ((lane & 3) << 3) | (((lane >> 2) & 3) << 6) | (((lane >> 4) & 1) << 5) | (((lane >> 5) & 1) << 8); }
constexpr int v_rd_off(int d0, int ks, int half) { return d0 * 512 + ks * 4096 + half * 2048; }
template <int OFF> __device__ __forceinline__ s16x4 tr_read(int vb) {
    s16x4 r; asm volatile("ds_read_b64_tr_b16 %0, %1 offset:%2" : "=&v"(r) : "v"(vb), "i"(OFF) : "memory"); return r;
}
template <int KS> __device__ __forceinline__ void pv_step(f32x16* o, int vb, bf16x8 pa) {
    const s16x4 l0 = tr_read<v_rd_off(0, KS, 0)>(vb), h0 = tr_read<v_rd_off(0, KS, 1)>(vb), l1 = tr_read<v_rd_off(1, KS, 0)>(vb), h1 = tr_read<v_rd_off(1, KS, 1)>(vb);
    const s16x4 l2 = tr_read<v_rd_off(2, KS, 0)>(vb), h2 = tr_read<v_rd_off(2, KS, 1)>(vb), l3 = tr_read<v_rd_off(3, KS, 0)>(vb), h3 = tr_read<v_rd_off(3, KS, 1)>(vb);
    asm volatile("s_waitcnt lgkmcnt(0)" ::: "memory"); SBAR();
#define PK(L, H) (bf16x8){L[0], L[1], L[2], L[3], H[0], H[1], H[2], H[3]}
    o[0] = __builtin_amdgcn_mfma_f32_32x32x16_bf16(pa, PK(l0, h0), o[0], 0, 0, 0);
    o[1] = __builtin_amdgcn_mfma_f32_32x32x16_bf16(pa, PK(l1, h1), o[1], 0, 0, 0);
    o[2] = __builtin_amdgcn_mfma_f32_32x32x16_bf16(pa, PK(l2, h2), o[2], 0, 0, 0);
    o[3] = __builtin_amdgcn_mfma_f32_32x32x16_bf16(pa, PK(l3, h3), o[3], 0, 0, 0);
#undef PK
}
__device__ __forceinline__ void pv_d0(f32x16* o, int vb, bf16x8 pa0, bf16x8 pa1, bf16x8 pa2, bf16x8 pa3) {
    pv_step<0>(o, vb, pa0); pv_step<1>(o, vb, pa1); pv_step<2>(o, vb, pa2); pv_step<3>(o, vb, pa3);
}
template <int DQK, int LDQ, int LDK, int LDV, int LDO, bool OUT_BF16>
__device__ __forceinline__ void attn_body(const bf16_t* __restrict__ Qb, const bf16_t* __restrict__ Kh, const bf16_t* __restrict__ Vh, void* __restrict__ Ob, int seq, char* lds) {
    const int tid = tid_local(), wid = tid >> 6, lane = tid & 63, r32 = lane & 31, hi = lane >> 5;
    Qb = uniform_ptr(Qb); Kh = uniform_ptr(Kh); Vh = uniform_ptr(Vh); Ob = uniform_ptr(Ob);
    char* V_lds = lds; char* K_lds = lds + 2 * SHM_V;
    float* ws = (float*)(lds + 2 * SHM_V + 2 * SHM_K) + wid * 64; float* li_l = ws; float* al_l = ws + 32;
    float m_reg = -1e30f, l_reg = 0; f32x16 o[4] = {}; bf16x8 qr[DQK / 16];
    const unsigned qoff = (unsigned)((wid * QBLK + r32) * LDQ + hi * 8) * 2u;
#pragma unroll
    for (int d0 = 0; d0 < DQK / 16; ++d0) qr[d0] = *reinterpret_cast<const bf16x8*>((const char*)Qb + qoff + d0 * 32);
    const int sr = tid >> 4, sc = (tid & 15) * 8, vst0 = v_st(sr, sc), vst1 = v_st(32 + sr, sc);
    const int kr = (DQK == 128) ? sr : (tid >> 3), kc = (DQK == 128) ? sc : (tid & 7) * 8;
    const unsigned voffV = (unsigned)(sr * LDV + sc) * 2u, voffK = (unsigned)(kr * LDK + kc) * 2u;
    const int vb0 = (int)(uintptr_t)V_lds + v_rd_base(lane);
    struct { bf16x8 vs0, vs1, ks0, ks1; } sr_[2];
#define SLOAD(i, k0) do { const char* _vb = (const char*)Vh + (size_t)(k0) * (LDV * 2); const char* _kb = (const char*)Kh + (size_t)(k0) * (LDK * 2); \
    sr_[i].vs0 = *reinterpret_cast<const bf16x8*>(_vb + voffV); sr_[i].vs1 = *reinterpret_cast<const bf16x8*>(_vb + voffV + 32 * LDV * 2); \
    sr_[i].ks0 = *reinterpret_cast<const bf16x8*>(_kb + voffK); if constexpr (DQK == 128) sr_[i].ks1 = *reinterpret_cast<const bf16x8*>(_kb + voffK + 32 * LDK * 2); } while (0)
#define SWRITE(b, i) do { *(bf16x8*)(V_lds + (b) * SHM_V + vst0) = sr_[i].vs0;          \
    *(bf16x8*)(V_lds + (b) * SHM_V + vst1) = sr_[i].vs1;               \
    *(bf16x8*)(K_lds + (b) * SHM_K + kswz<DQK>(kr, kc * 2)) = sr_[i].ks0;                       \
    if constexpr (DQK == 128) *(bf16x8*)(K_lds + (b) * SHM_K + kswz<DQK>(32 + kr, kc * 2)) = sr_[i].ks1; } while (0)
#define SWAIT() do { if constexpr (DQK == 128) asm volatile("s_waitcnt vmcnt(4)" ::: "memory"); else asm volatile("s_waitcnt vmcnt(3)" ::: "memory"); } while (0)
#define RESC(a) do { if (__any((a) < 1.f)) { if (hi == 0) al_l[r32] = (a); asm volatile("s_waitcnt lgkmcnt(0)" ::: "memory"); \
    _Pragma("unroll") for (int d = 0; d < 4; ++d) _Pragma("unroll") for (int r = 0; r < 16; ++r) o[d][r] *= al_l[crow(r, hi)]; } } while (0)
    f32x16 pA0, pA1, pB0, pB1; float mnA, mnB, alA, alB; bf16x8 pa0, pa1, pa2, pa3; const int NT = seq / KVBLK;
    constexpr int SE = 0, SO = 1;
    SLOAD(SE, 0); asm volatile("s_waitcnt vmcnt(0)" ::: "memory"); SWRITE(0, SE); __syncthreads();
    qkt<DQK>(pA0, pA1, K_lds, qr, r32, hi); partialSM<DQK>(pA0, pA1, m_reg, mnA, alA);
    SLOAD(SO, KVBLK); if (2 < NT) SLOAD(SE, 2 * KVBLK);
    SWAIT(); SWRITE(1, SO); __syncthreads();
    for (int j = 1; j + 1 < NT; j += 2) {
        SBAR(); qkt<DQK>(pB0, pB1, K_lds + SHM_K, qr, r32, hi);
        finishSM(pA0, pA1, alA, l_reg, pa0, pa1, pa2, pa3); SBAR();
        SLOAD(SO, (j + 2) * KVBLK); SBAR();
        pv_d0(o, vb0, pa0, pa1, pa2, pa3); partialSM<DQK>(pB0, pB1, m_reg, mnB, alB);
        __syncthreads(); SWAIT(); SWRITE(0, SE);
        RESC(alB); __syncthreads();
        SBAR(); qkt<DQK>(pA0, pA1, K_lds, qr, r32, hi);
        finishSM(pB0, pB1, alB, l_reg, pa0, pa1, pa2, pa3); SBAR();
        if (j + 3 < NT) SLOAD(SE, (j + 3) * KVBLK); SBAR();
        pv_d0(o, vb0 + (int)SHM_V, pa0, pa1, pa2, pa3); partialSM<DQK>(pA0, pA1, m_reg, mnA, alA);
        __syncthreads(); SWAIT(); SWRITE(1, SO);
        RESC(alA); __syncthreads();
    }
    SBAR(); qkt<DQK>(pB0, pB1, K_lds + SHM_K, qr, r32, hi);
    finishSM(pA0, pA1, alA, l_reg, pa0, pa1, pa2, pa3); SBAR();
    pv_d0(o, vb0, pa0, pa1, pa2, pa3); partialSM<DQK>(pB0, pB1, m_reg, mnB, alB);
    __syncthreads(); RESC(alB);
    finishSM(pB0, pB1, alB, l_reg, pa0, pa1, pa2, pa3); SBAR();
    pv_d0(o, vb0 + (int)SHM_V, pa0, pa1, pa2, pa3);
    if (hi == 0) li_l[r32] = l_reg; asm volatile("s_waitcnt lgkmcnt(0)" ::: "memory");
    float rli[16];
#pragma unroll
    for (int r = 0; r < 16; ++r) rli[r] = __builtin_amdgcn_rcpf(li_l[crow(r, hi)]);
    if constexpr (OUT_BF16) {
#pragma unroll
        for (int r = 0; r < 16; ++r) { const unsigned ob = (unsigned)((wid * QBLK + crow(r, hi)) * LDO + r32); const float sc16 = rli[r] * 16.0f;
#pragma unroll
            for (int d0 = 0; d0 < 4; ++d0) *((unsigned char*)Ob + ob + d0 * 32) = (unsigned char)(__builtin_amdgcn_cvt_pk_fp8_f32(o[d0][r] * sc16, 0.f, 0, false) & 0xff); }
    } else {
#pragma unroll
        for (int r = 0; r < 16; ++r) { const unsigned ob = (unsigned)((wid * QBLK + crow(r, hi)) * LDO + r32) * 4u;
#pragma unroll
            for (int d0 = 0; d0 < 4; ++d0) *(float*)((char*)Ob + ob + d0 * 128) = o[d0][r] * rli[r]; }
    }
#undef SLOAD
#undef SWRITE
#undef SWAIT
#undef RESC
}
}

struct Args { const float* in[26]; float* out; unsigned char* ws; int ph_lo, ph_hi; };
enum { I_X = 0, I_C, I_CTX, I_CCTX, I_WMOD, I_BMOD, I_G1, I_G2, I_WIN, I_GQ, I_GK, I_LQ1, I_LK1, I_LQ2, I_LK2, I_GSUB, I_WPOOL, I_PSCALE, I_WOUT, I_WR, I_BR, I_W1, I_B1, I_W2, I_B2, I_GF };
constexpr int NPHASE = 22;

struct TItem { const char* src; unsigned char* dst; unsigned soff, doff, nb4, ldb; float scale; };
__device__ __forceinline__ TItem titem(int it, const float* win, const float* wout, const float* w1, const float* w2, unsigned char* ws, int lane) {
    constexpr int I_IN = 32 * (INW / 64), I_OUT = 24 * (D / 64), I_E1 = 32 * 32, I_E2 = 16 * 32;
    constexpr int T_IN = 2 * I_IN, T_OUT = 2 * I_OUT, T_E1 = 64 * I_E1;
    const float* W; unsigned char* WT; int N, ldb, item; float scale; int r = it;
    if (r < T_IN) { const int l = r / I_IN; W = win + (size_t)l * D * INW; N = INW; WT = ws + WS_WIN + (size_t)l * INW * D; ldb = D; item = r % I_IN; scale = 64.0f; }
    else if ((r -= T_IN) < T_OUT) { const int l = r / I_OUT; W = wout + (size_t)l * D * D; N = D; WT = ws + WS_WOUT + (size_t)l * D * D; ldb = D; item = r % I_OUT; scale = (item / (D / 32) < 8) ? 4.0f : 64.0f; }
    else if ((r -= T_OUT) < T_E1) { const int le = r / I_E1; W = w1 + (size_t)le * D * 2048; N = 2048; WT = ws + WS_W1 + (size_t)le * 2048 * D; ldb = D; item = r % I_E1; scale = 64.0f; }
    else { r -= T_E1; const int le = r / I_E2; W = w2 + (size_t)le * DE * D; N = D; WT = ws + WS_W2 + (size_t)le * D * DE; ldb = DE; item = r % I_E2; scale = 32.0f; }
    const int nblk = N / 32, kb = item / nblk, nb = item % nblk, k0 = 128 * kb + 16 * (lane >> 3), n0 = 32 * nb + 4 * (lane & 7);
    TItem t; t.src = (const char*)uniform_ptr(W); t.dst = uniform_ptr(WT); t.soff = (unsigned)(k0 * N + n0) * 4u; t.doff = (unsigned)(n0 * ldb + k0); t.nb4 = (unsigned)N * 4u; t.ldb = (unsigned)ldb; t.scale = scale; return t;
}
#define TI_LOAD(v, t) do { _Pragma("unroll") for (int _i = 0; _i < 16; ++_i) v[_i] = *(const f32x4*)((t).src + ((t).soff + (unsigned)_i * (t).nb4)); } while (0)
#define TI_STORE(v, t) do { const float _sc = (t).scale; _Pragma("unroll") for (int _c = 0; _c < 4; ++_c) { int _w[4]; \
        _Pragma("unroll") for (int _q = 0; _q < 4; ++_q) { int _x = 0; _x = __builtin_amdgcn_cvt_pk_fp8_f32(v[4 * _q][_c] * _sc, v[4 * _q + 1][_c] * _sc, _x, false); \
            _x = __builtin_amdgcn_cvt_pk_fp8_f32(v[4 * _q + 2][_c] * _sc, v[4 * _q + 3][_c] * _sc, _x, true); _w[_q] = _x; } \
        *(u32x4*)((t).dst + ((t).doff + (unsigned)_c * (t).ldb)) = (u32x4){(unsigned)_w[0], (unsigned)_w[1], (unsigned)_w[2], (unsigned)_w[3]}; } } while (0)
__device__ __forceinline__ float silu_f(float x) { return x / (1.0f + __expf(-x)); }

__device__ __forceinline__ void fold_item(int it, const float* wpool, const float* pscale, const float* wout, unsigned char* WOUT) {
    const int n = it & 2047, cc = (it >> 11) & 15, g = (it >> 15) & 3, l = it >> 17;
    const float* wp = wpool + (((size_t)l * 4 + g) * 128 + cc * 8) * 128;
    const float* ps = pscale + (size_t)l * 512 + g * 128;
    const float* wo = wout + ((size_t)l * D + 1536 + g * 128) * D + n;
    float acc[8];
#pragma unroll
    for (int q = 0; q < 8; ++q) acc[q] = 0.f;
#pragma unroll 1
    for (int d0 = 0; d0 < 128; d0 += 32) { float av[32];
#pragma unroll
        for (int dd = 0; dd < 32; ++dd) av[dd] = wo[(size_t)(d0 + dd) * D];
#pragma unroll
        for (int dd = 0; dd < 32; ++dd) { const float x = ps[d0 + dd] * av[dd];
#pragma unroll
            for (int q = 0; q < 8; ++q) acc[q] = fmaf(wp[q * 128 + d0 + dd], x, acc[q]); } }
    int o0 = 0, o1 = 0; o0 = __builtin_amdgcn_cvt_pk_fp8_f32(acc[0] * 64.f, acc[1] * 64.f, o0, false); o0 = __builtin_amdgcn_cvt_pk_fp8_f32(acc[2] * 64.f, acc[3] * 64.f, o0, true);
    o1 = __builtin_amdgcn_cvt_pk_fp8_f32(acc[4] * 64.f, acc[5] * 64.f, o1, false); o1 = __builtin_amdgcn_cvt_pk_fp8_f32(acc[6] * 64.f, acc[7] * 64.f, o1, true);
    *(u32x2*)(WOUT + ((size_t)l * D + n) * D + 1536 + g * 128 + cc * 8) = (u32x2){(unsigned)o0, (unsigned)o1};
}

PHASE_FN phase_prologue(LAS unsigned char* lds, int l_unused, int G) {
    lds = (LAS unsigned char*)__builtin_amdgcn_readfirstlane((int)(uintptr_t)lds); G = __builtin_amdgcn_readfirstlane(G);
    const int tid = tid_local(), lane = tid & 63, wave = __builtin_amdgcn_readfirstlane(tid >> 6);
    unsigned char* ws = WSP();
    const int gw = blockIdx.x * NWAVES + wave, NGW = G * NWAVES;
    {
        float* MODP = (float*)(ws + WS_MODP);
        const float* cvec = INP(I_C); const float* cctx = INP(I_CCTX); const float* wmod = INP(I_WMOD);
        LAS float* st = (LAS float*)lds;
        for (int i = tid; i < 5 * D; i += NTHREADS) st[i] = silu_f(i < 4 * D ? cvec[i] : cctx[i - 4 * D]);
        __syncthreads();
        for (int u = gw; u < 2 * 64 * 48; u += NGW) {
            const int l = u / (64 * 48), r = u % (64 * 48), kc = r / 48, cg = r % 48;
            const int col = cg * 256 + lane * 4;
            const float* W = wmod + (size_t)l * D * 12288 + (size_t)(kc * 32) * 12288 + col;
            f32x4 acc[5];
#pragma unroll
            for (int v = 0; v < 5; ++v) acc[v] = (f32x4){0.f, 0.f, 0.f, 0.f};
#pragma unroll 1
            for (int k8 = 0; k8 < 32; k8 += 16) {
                f32x4 w[16];
#pragma unroll
                for (int kk = 0; kk < 16; ++kk) w[kk] = *(const f32x4*)(W + (size_t)(k8 + kk) * 12288);
#pragma unroll
                for (int kk = 0; kk < 16; ++kk) { const int k = kc * 32 + k8 + kk;
#pragma unroll
                    for (int v = 0; v < 5; ++v) acc[v] += st[v * D + k] * w[kk]; } }
#pragma unroll
            for (int v = 0; v < 5; ++v) *(f32x4*)(MODP + ((size_t)kc * 10 + l * 5 + v) * 12288 + col) = acc[v];
        }
        __syncthreads();
    }
    {
        f32x2* tabA = (f32x2*)(ws + WS_ROPE); f32x2* tabB = tabA + 64 * 32;
        for (int i = blockIdx.x * NTHREADS + tid; i < 64 * 32 + 64 * 16; i += G * NTHREADS) {
            if (i < 64 * 32) { const int pos = i >> 5, f = i & 31; const float inv = powf(10000.0f, -(float)f / 32.0f); const float ang = (float)pos * inv; tabA[i] = (f32x2){cosf(ang), sinf(ang)}; }
            else { const int q = i - 64 * 32; const int pos = q >> 4, f = q & 15; const float inv = powf(10000.0f, -(float)f / 16.0f); const float ang = (float)pos * inv; tabB[q] = (f32x2){cosf(ang), sinf(ang)}; }
        }
    }
    {
        const float* wr = INP(I_WR); bf16_t* WRS = (bf16_t*)(ws + WS_WRS);
        for (int i = blockIdx.x * NTHREADS + tid; i < 2 * D * NE; i += G * NTHREADS) {
            const int l = i / (D * NE), rem = i % (D * NE), k = rem >> 5, e = rem & 31;
            WRS[((size_t)l * NE + e) * D + k] = f2bf(wr[i]); }
    }
    {
        const float* win = INP(I_WIN); const float* wout = INP(I_WOUT); const float* w1 = INP(I_W1); const float* w2 = INP(I_W2);
        constexpr int TOT = 2 * 32 * (INW / 64);
        f32x4 va[16], vb[16]; TItem ta, tb;
        int it = gw;
        if (it < TOT) { ta = titem(it, win, wout, w1, w2, ws, lane); TI_LOAD(va, ta); }
        while (it < TOT) {
            const int i1 = it + NGW;
            if (i1 < TOT) { tb = titem(i1, win, wout, w1, w2, ws, lane); TI_LOAD(vb, tb); }
            TI_STORE(va, ta);
            if (i1 >= TOT) break;
            const int i2 = i1 + NGW;
            if (i2 < TOT) { ta = titem(i2, win, wout, w1, w2, ws, lane); TI_LOAD(va, ta); }
            TI_STORE(vb, tb);
            it = i2;
        }
    }
}

PHASE_FN phase_modreduce(LAS unsigned char* lds, int l_unused, int G) {
    lds = (LAS unsigned char*)__builtin_amdgcn_readfirstlane((int)(uintptr_t)lds); G = __builtin_amdgcn_readfirstlane(G);
    const int tid = tid_local();
    unsigned char* ws = WSP();
    const float* MODP = (const float*)(ws + WS_MODP); float* MOD = (float*)(ws + WS_MOD); const float* bmod = INP(I_BMOD); const float* g2 = INP(I_G2);
    for (int i = blockIdx.x * NTHREADS + tid; i < 10 * 12288 / 4; i += G * NTHREADS) {
        const int lv = i / 3072, col = (i % 3072) * 4, l = lv / 5;
        f32x4 s = *(const f32x4*)(bmod + (size_t)l * 12288 + col);
#pragma unroll 16
        for (int kc = 0; kc < 64; ++kc) s += *(const f32x4*)(MODP + ((size_t)kc * 10 + lv) * 12288 + col);
        if (col >= 4 * 2048 && col < 5 * 2048) s = *(const f32x4*)(g2 + (size_t)l * D + (col - 4 * 2048)) * (s + 1.0f);
        *(f32x4*)(MOD + (size_t)lv * 12288 + col) = s;
    }
}

__device__ __forceinline__ void norm_mod_store(const f32x4 (&v)[8], const f32x4 (&gg)[8], const f32x4 (&sh)[8], const f32x4 (&sc)[8], unsigned char* orow, int lane) {
    float ss = 0.f;
#pragma unroll
    for (int j = 0; j < 8; ++j) ss += (v[j].x * v[j].x + v[j].y * v[j].y) + (v[j].z * v[j].z + v[j].w * v[j].w);
    const float rs = rsqrtf(wave_sum(ss) * (1.0f / D) + EPS);
#pragma unroll
    for (int j = 0; j < 8; ++j) { const int col = 4 * (lane + 64 * j);
        const f32x4 y = (v[j] * rs) * gg[j]; const f32x4 n = y * (sc[j] + 1.0f) + sh[j];
        int w = 0; w = __builtin_amdgcn_cvt_pk_fp8_f32(n.x, n.y, w, false); w = __builtin_amdgcn_cvt_pk_fp8_f32(n.z, n.w, w, true);
        *(int*)(orow + col) = w; }
}

PHASE_FN phase_norm1_l0(LAS unsigned char* lds, int l_unused, int G) {
    lds = (LAS unsigned char*)__builtin_amdgcn_readfirstlane((int)(uintptr_t)lds); G = __builtin_amdgcn_readfirstlane(G);
    const int tid = tid_local(), lane = tid & 63, wave = __builtin_amdgcn_readfirstlane(tid >> 6);
    unsigned char* ws = WSP();
    const float* MOD = (const float*)(ws + WS_MOD);
    unsigned char* N = ws + WS_N;
    const float* x = INP(I_X); const float* ctx = INP(I_CTX); const float* g1 = INP(I_G1);
    f32x4 gg[8];
#pragma unroll
    for (int j = 0; j < 8; ++j) gg[j] = *(const f32x4*)(g1 + 4 * (lane + 64 * j));
    for (int row = blockIdx.x * NWAVES + wave; row < MT; row += G * NWAVES) {
        const float* src = row < ML ? x + (size_t)row * D : ctx + (size_t)(row - ML) * D;
        const int bidx = row < ML ? (row >> 12) : 4;
        const float* m = MOD + (size_t)bidx * 12288;
        f32x4 v[8], sh[8], sc[8];
#pragma unroll
        for (int j = 0; j < 8; ++j) { v[j] = *(const f32x4*)(src + 4 * (lane + 64 * j)); sh[j] = *(const f32x4*)(m + 4 * (lane + 64 * j)); sc[j] = *(const f32x4*)(m + 2048 + 4 * (lane + 64 * j)); }
        norm_mod_store(v, gg, sh, sc, N + (size_t)row * D, lane);
    }
}

PHASE_FN phase_inproj(LAS unsigned char* lds, int l, int G) {
    lds = (LAS unsigned char*)__builtin_amdgcn_readfirstlane((int)(uintptr_t)lds); l = __builtin_amdgcn_readfirstlane(l); G = __builtin_amdgcn_readfirstlane(G);
    unsigned char* ws = WSP();
    pg8::DenseSched<D, 1> S; S.init(ws + WS_N, ws + WS_WIN + (size_t)l * INW * D, MT, INW, G, (int)blockIdx.x);
    pg8::EpiBf16 E{(bf16_t*)(ws + WS_P), INW, nullptr, 0};
    pg8::gemm_phase(lds, S, E);
}

PHASE_FN phase_prep(LAS unsigned char* lds, int l, int G) {
    lds = (LAS unsigned char*)__builtin_amdgcn_readfirstlane((int)(uintptr_t)lds); l = __builtin_amdgcn_readfirstlane(l); G = __builtin_amdgcn_readfirstlane(G);
    const int tid = tid_local(), lane = tid & 63, wave = __builtin_amdgcn_readfirstlane(tid >> 6);
    unsigned char* ws = WSP();
    const bf16_t* P = (const bf16_t*)(ws + WS_P);
    unsigned* QA = (unsigned*)(ws + WS_QA); unsigned* KA = (unsigned*)(ws + WS_KA); unsigned* VA = (unsigned*)(ws + WS_VA);
    unsigned* QB = (unsigned*)(ws + WS_QB); unsigned* KB = (unsigned*)(ws + WS_KB); unsigned* VB = (unsigned*)(ws + WS_VB); unsigned char* CAT = ws + WS_CAT;
    const f32x2* tabA = (const f32x2*)(ws + WS_ROPE); const f32x2* tabB = tabA + 64 * 32;
    const f32x2 gq2 = *(const f32x2*)(INP(I_GQ) + l * 128 + 2 * lane), gk2 = *(const f32x2*)(INP(I_GK) + l * 128 + 2 * lane);
    const bool firstA = (lane & 16) == 0, firstB = (lane & 8) == 0;
    for (int unit = blockIdx.x; unit < MT / 8; unit += G) {
        const int ch = tid, hw = 1 << (ch >> 7);
        const int row0 = unit * 8; int base, s0, L;
        if (row0 < ML) { base = row0 & ~4095; s0 = row0 & 4095; L = SEQ; } else { const int r2 = row0 - ML; base = ML + (r2 & ~255); s0 = r2 & 255; L = CTX; }
        float pv_[23];
        { const bf16_t* pc = P + (size_t)base * INW + OFF_UC + ch;
#pragma unroll
            for (int j = 0; j < 23; ++j) { int sj = s0 - 8 + j; sj = sj < 0 ? 0 : (sj >= L ? L - 1 : sj);
                pv_[j] = bf2f(pc[(size_t)sj * INW]); } }
        {
            const int row = unit * 8 + wave;
            const bool lat = row < ML; int b, sq, trow;
            if (lat) { b = row >> 12; sq = row & 4095; trow = b * TK + CTX + sq; } else { const int r2 = row - ML; b = r2 >> 8; sq = r2 & 255; trow = b * TK + sq; }
            const unsigned* p = (const unsigned*)(P + (size_t)row * INW);
            unsigned ha[10], hb[8];
#pragma unroll
            for (int hh = 0; hh < 10; ++hh) ha[hh] = p[(hh < 8 ? hh * 64 : OFF_KA / 2 + (hh - 8) * 64) + lane];
#pragma unroll
            for (int jp = 0; jp < 8; ++jp) hb[jp] = p[(jp < 4 ? OFF_QB / 2 + jp * 64 : OFF_KB / 2 + (jp - 4) * 64) + lane];
            const u32x2 vva = *(const u32x2*)(p + OFF_VA / 2 + 2 * lane);
            const u32x4 vvb = *(const u32x4*)(p + OFF_VB / 2 + 4 * lane);
            const int prow = sq >> 6, pcol = sq & 63;
            const f32x4 csA = *(const f32x4*)(tabA + (lane < 32 ? prow : pcol) * 32 + 2 * (lane & 15));
            const f32x4 csB = *(const f32x4*)(tabB + ((lane & 16) == 0 ? prow : pcol) * 16 + 2 * (lane & 7));
#pragma unroll
            for (int hh = 0; hh < 10; ++hh) {
                float e0 = __uint_as_float(ha[hh] << 16), e1 = __uint_as_float(ha[hh] & 0xffff0000u);
                const float ss = wave_sum(e0 * e0 + e1 * e1); const float r = rsqrtf(ss * (1.0f / 128.0f) + EPS);
                const f32x2 g = hh < 8 ? gq2 : gk2;
                e0 = e0 * r * g.x; e1 = e1 * r * g.y;
                if (lat) {
                    const float o0 = __shfl_xor(e0, 16), o1 = __shfl_xor(e1, 16);
                    e0 = firstA ? (e0 * csA.x - o0 * csA.y) : (o0 * csA.y + e0 * csA.x);
                    e1 = firstA ? (e1 * csA.z - o1 * csA.w) : (o1 * csA.w + e1 * csA.z);
                }
                unsigned* dst = hh < 8 ? QA + (size_t)row * 512 + hh * 64 : KA + (size_t)trow * 128 + (hh - 8) * 64;
                dst[lane] = cvt_pk_bf16(e0, e1);
            }
            *(u32x2*)(VA + (size_t)trow * 128 + 2 * lane) = vva;
#pragma unroll
            for (int jp = 0; jp < 8; ++jp) {
                float e0 = __uint_as_float(hb[jp] << 16), e1 = __uint_as_float(hb[jp] & 0xffff0000u);
                if (lat) {
                    const float o0 = __shfl_xor(e0, 8), o1 = __shfl_xor(e1, 8);
                    e0 = firstB ? (e0 * csB.x - o0 * csB.y) : (o0 * csB.y + e0 * csB.x);
                    e1 = firstB ? (e1 * csB.z - o1 * csB.w) : (o1 * csB.w + e1 * csB.z);
                }
                unsigned* dst = jp < 4 ? QB + (size_t)row * 256 + jp * 64 : KB + (size_t)trow * 256 + (jp - 4) * 64;
                dst[lane] = cvt_pk_bf16(e0, e1);
            }
            *(u32x4*)(VB + (size_t)trow * 256 + 4 * lane) = vvb;
        }
        {
#pragma unroll
            for (int tk = 0; tk < 8; ++tk) { const int sq = s0 + tk;
                const int lo = (sq - hw) < 0 ? 0 : (sq - hw), hi = (sq + hw) > L ? L : (sq + hw);
                float sum = 0.f;
#pragma unroll
                for (int j = tk; j < tk + 16; ++j) { const int sj = s0 - 8 + j; sum += (sj >= lo && sj < hi) ? pv_[j] : 0.f; }
                CAT[(size_t)(row0 + tk) * D + 1536 + ch] = (unsigned char)(__builtin_amdgcn_cvt_pk_fp8_f32(sum / (float)(hi - lo) - pv_[tk + 8], 0.f, 0, false) & 0xff); }
        }
    }
}

constexpr int NCONV_WG = 40;
constexpr int CONV_BATCH = 128, CONV_E1 = 32 * 32 * 32, CONV_E2 = 32 * 16 * 32, CONV_ITEMS = CONV_E1 + CONV_E2  , CONV_FIRST = 2 * 32 * (INW / 64) + 2 * 24 * (D / 64);
constexpr int CONV_OUT0 = 2 * 32 * (INW / 64), CONV_OUT = 24 * (D / 64)  , NB_FOLD = 4 * 16 * 2048 / NTHREADS  , NB_OUT = CONV_OUT / CONV_BATCH, NB_EXP = CONV_ITEMS / CONV_BATCH;
static_assert(CONV_OUT % CONV_BATCH == 0, "w_out batches");
PHASE_FN phase_attention(LAS unsigned char* lds_, int l, int G) {
    lds_ = (LAS unsigned char*)__builtin_amdgcn_readfirstlane((int)(uintptr_t)lds_); l = __builtin_amdgcn_readfirstlane(l); G = __builtin_amdgcn_readfirstlane(G);
    LAS unsigned char* lds = lds_;
    unsigned char* ws = WSP();
    char* ldsg = (char*)lds_;
    const int tid = tid_local();
    const bf16_t* QA = (const bf16_t*)(ws + WS_QA); const bf16_t* KA = (const bf16_t*)(ws + WS_KA); const bf16_t* VA = (const bf16_t*)(ws + WS_VA);
    const bf16_t* QB = (const bf16_t*)(ws + WS_QB); const bf16_t* KB = (const bf16_t*)(ws + WS_KB); const bf16_t* VB = (const bf16_t*)(ws + WS_VB);
    unsigned char* CAT = ws + WS_CAT; float* OB = (float*)(ws + WS_OB);
    const int nA = 512 + (l == 0 ? 32 : 0), nB = 512 + (l == 0 ? 32 : 0);
    const bool dyn = (G > NCONV_WG);
    unsigned* qh = (unsigned*)(ws + WS_CTL) + CW_Q + l * 192;
    volatile LAS int* slot = (volatile LAS int*)(lds + MISC_OFF + 32);
    if (!dyn || (int)blockIdx.x < G - NCONV_WG) {
    for (int it = 0;; ++it) {
        int id;
        __syncthreads();
        if (dyn) { if (tid == 0) *slot = (int)atomicAdd(qh, 1u); __syncthreads(); id = __builtin_amdgcn_readfirstlane(*slot); } else id = (int)blockIdx.x + it * G;
        if (id >= nA) break;
        const bf16_t *q, *k, *v; unsigned char* o; int seq;
        if (id < 512) { int b, kvh, h, qb;
            if (dyn) { b = id >> 7; kvh = (id >> 6) & 1; h = kvh * 4 + ((id >> 4) & 3); qb = id & 15; }
            else { const int x = id & 7, i = id >> 8, j = (id >> 3) & 31; b = x >> 1; kvh = x & 1; h = kvh * 4 + 2 * i + (j >> 4); qb = j & 15; }
            const size_t r0 = (size_t)b * SEQ + qb * 256;
            q = QA + r0 * 1024 + h * 128; k = KA + (size_t)b * TK * 256 + kvh * 128; v = VA + (size_t)b * TK * 256 + kvh * 128; o = CAT + r0 * D + h * 128; seq = TK; }
        else { const int c = id - 512, b = c >> 3, h = c & 7; const size_t r0 = (size_t)ML + b * CTX;
            q = QA + r0 * 1024 + h * 128; k = KA + (size_t)b * TK * 256 + (h >> 2) * 128; v = VA + (size_t)b * TK * 256 + (h >> 2) * 128; o = CAT + r0 * D + h * 128; seq = CTX; }
        att::attn_body<128, 1024, 256, 256, D, true>(q, k, v, o, seq, ldsg);
    }
    for (int it = 0;; ++it) {
        int id;
        __syncthreads();
        if (dyn) { if (tid == 0) *slot = (int)atomicAdd(qh + 64, 1u); __syncthreads(); id = __builtin_amdgcn_readfirstlane(*slot); } else id = (int)blockIdx.x + it * G;
        if (id >= nB) break;
        const bf16_t *q, *k, *v; float* o; int seq;
        if (id < 512) { int b, h, comp, qb;
            if (dyn) { b = id >> 7; h = (id >> 5) & 3; comp = (id >> 4) & 1; qb = id & 15; }
            else { const int x = id & 7, i = id >> 8, j = (id >> 3) & 31; const int combo = 2 * x + i; b = combo >> 2; h = combo & 3; comp = j >> 4; qb = j & 15; }
            const int jj = comp * 4 + h; const size_t r0 = (size_t)b * SEQ + qb * 256;
            q = QB + r0 * 512 + jj * 64; k = KB + (size_t)b * TK * 512 + jj * 64; v = VB + (size_t)b * TK * 512 + h * 128; o = OB + r0 * 1024 + jj * 128; seq = TK; }
        else { const int c = id - 512, b = c >> 3, jj = c & 7, h = jj & 3; const size_t r0 = (size_t)ML + b * CTX;
            q = QB + r0 * 512 + jj * 64; k = KB + (size_t)b * TK * 512 + jj * 64; v = VB + (size_t)b * TK * 512 + h * 128; o = OB + r0 * 1024 + jj * 128; seq = CTX; }
        att::attn_body<64, 512, 512, 512, 1024, false>(q, k, v, o, seq, ldsg);
    }
    }
    {
        const int lane = tid & 63, wave = __builtin_amdgcn_readfirstlane(tid >> 6);
        int bt;
#define CONV_PULL() do { __syncthreads(); if (tid == 0) *slot = (int)atomicAdd(qh + 128, 1u); __syncthreads(); bt = __builtin_amdgcn_readfirstlane(*slot); } while (0)
        for (;;) {
            CONV_PULL();
            if (bt >= NB_FOLD) break;
            fold_item(l * (4 * 16 * 2048) + bt * NTHREADS + tid, INP(I_WPOOL), INP(I_PSCALE), INP(I_WOUT), ws + WS_WOUT);
        }
        const float* win = INP(I_WIN); const float* wout = INP(I_WOUT); const float* w1 = INP(I_W1); const float* w2 = INP(I_W2);
        for (;; ) {
            if (bt >= NB_FOLD + NB_OUT + NB_EXP) break;
            int base;
            if (bt < NB_FOLD + NB_OUT) base = CONV_OUT0 + l * CONV_OUT + (bt - NB_FOLD) * CONV_BATCH + wave * (CONV_BATCH / NWAVES);
            else { const int li = (bt - NB_FOLD - NB_OUT) * CONV_BATCH + wave * (CONV_BATCH / NWAVES);
                base = li < CONV_E1 ? CONV_FIRST + l * CONV_E1 + li : CONV_FIRST + 2 * CONV_E1 + l * CONV_E2 + (li - CONV_E1); }
            f32x4 va[16], vb[16], vc[16]; TItem ta, tb, tc;
            constexpr int NI = CONV_BATCH / NWAVES;
            ta = titem(base, win, wout, w1, w2, ws, lane); TI_LOAD(va, ta); tb = titem(base + 1, win, wout, w1, w2, ws, lane); TI_LOAD(vb, tb);
#pragma unroll 1
            for (int i = 0; i < NI; i += 3) {
                if (i + 2 < NI) { tc = titem(base + i + 2, win, wout, w1, w2, ws, lane); TI_LOAD(vc, tc); }
                TI_STORE(va, ta);
                if (i + 3 < NI) { ta = titem(base + i + 3, win, wout, w1, w2, ws, lane); TI_LOAD(va, ta); }
                if (i + 1 < NI) TI_STORE(vb, tb);
                if (i + 4 < NI) { tb = titem(base + i + 4, win, wout, w1, w2, ws, lane); TI_LOAD(vb, tb); }
                if (i + 2 < NI) TI_STORE(vc, tc);
            }
            CONV_PULL();
        }
#undef CONV_PULL
    }
}

PHASE_FN phase_fixup(LAS unsigned char* lds, int l, int G) {
    lds = (LAS unsigned char*)__builtin_amdgcn_readfirstlane((int)(uintptr_t)lds); l = __builtin_amdgcn_readfirstlane(l); G = __builtin_amdgcn_readfirstlane(G);
    const int tid = tid_local(), lane = tid & 63, wave = __builtin_amdgcn_readfirstlane(tid >> 6);
    unsigned char* ws = WSP();
    const float lam_init = 0.8f - 0.6f * expf(-0.3f * (float)l);
    float s1 = 0.f, s2 = 0.f;
    { const float* lq1 = INP(I_LQ1) + l * 64; const float* lk1 = INP(I_LK1) + l * 64; const float* lq2 = INP(I_LQ2) + l * 64; const float* lk2 = INP(I_LK2) + l * 64;
      s1 = wave_sum(lq1[lane] * lk1[lane]); s2 = wave_sum(lq2[lane] * lk2[lane]); }
    const float lam = expf(s1) - expf(s2) + lam_init;
    const float* OB = (const float*)(ws + WS_OB); unsigned char* CAT = ws + WS_CAT;
    const float* gs = INP(I_GSUB) + l * 128;
    const int nrows = (l == 0) ? MT : ML;
    const f32x2 g2 = *(const f32x2*)(gs + 2 * lane);
    for (int row = blockIdx.x * NWAVES + wave; row < nrows; row += G * NWAVES) {
        f32x2 o1[4], o2[4];
#pragma unroll
        for (int h = 0; h < 4; ++h) { o1[h] = *(const f32x2*)(OB + (size_t)row * 1024 + h * 128 + 2 * lane); o2[h] = *(const f32x2*)(OB + (size_t)row * 1024 + (4 + h) * 128 + 2 * lane); }
#pragma unroll
        for (int h = 0; h < 4; ++h) {
            const f32x2 d = o1[h] - lam * o2[h];
            const float ss = wave_sum(d.x * d.x + d.y * d.y); const float r = rsqrtf(ss * (1.0f / 128.0f) + EPS) * (1.0f - lam_init);
            *(unsigned short*)(CAT + (size_t)row * D + 1024 + h * 128 + 2 * lane) = (unsigned short)(__builtin_amdgcn_cvt_pk_fp8_f32(d.x * r * g2.x, d.y * r * g2.y, 0, false) & 0xffff);
        }
    }
}

PHASE_FN phase_outproj(LAS unsigned char* lds, int l, int G) {
    lds = (LAS unsigned char*)__builtin_amdgcn_readfirstlane((int)(uintptr_t)lds); l = __builtin_amdgcn_readfirstlane(l); G = __builtin_amdgcn_readfirstlane(G);
    unsigned char* ws = WSP();
    pg8::DenseSched<D, 1> S; S.init(ws + WS_CAT, ws + WS_WOUT + (size_t)l * D * D, (l == 0) ? MT : ML, D, G, (int)blockIdx.x);
    pg8::EpiResid E{INP(I_X), INP(I_CTX), (const bf16_t*)(ws + WS_XR), (bf16_t*)(ws + WS_XR), (const float*)(ws + WS_MOD) + (size_t)l * 5 * 12288, l};
    pg8::gemm_phase(lds, S, E);
}

PHASE_FN phase_router(LAS unsigned char* lds, int l, int G) {
    lds = (LAS unsigned char*)__builtin_amdgcn_readfirstlane((int)(uintptr_t)lds); l = __builtin_amdgcn_readfirstlane(l); G = __builtin_amdgcn_readfirstlane(G);
    const int tid = tid_local(), lane = tid & 63, wave = __builtin_amdgcn_readfirstlane(tid >> 6);
    unsigned char* ws = WSP();
    const bf16_t* XR = (const bf16_t*)(ws + WS_XR); unsigned char* NF8 = ws + WS_NF8;
    const float* MOD = (const float*)(ws + WS_MOD) + (size_t)l * 5 * 12288;
    int* eid = (int*)(ws + WS_ROUT + ROUT_EID); float* gate = (float*)(ws + WS_ROUT + ROUT_GATE); int* posb = (int*)(ws + WS_ROUT + ROUT_POS); int* list = (int*)(ws + WS_ROUT + ROUT_LIST);
    unsigned* cnt = (unsigned*)(ws + WS_CTL) + CW_CNT + l * 32 * 64;
    const float* br = INP(I_BR) + l * NE;
    const bf16_t* WRH = (const bf16_t*)(ws + WS_WRS) + (size_t)l * NE * D;
    constexpr int TST = 4112;
    LAS unsigned char* thi = lds; LAS unsigned char* tlo = lds + 16 * TST;
    static_assert(32 * TST <= MISC_OFF, "router token images");
    LAS float* fl = (LAS float*)lds;
    LAS float* lg = (LAS float*)(lds + MISC_OFF + 512);
    LAS float* tv = (LAS float*)(lds + MISC_OFF + 2560);
    LAS int* lc = (LAS int*)(lds + MISC_OFF + 2816); LAS int* lbase = (LAS int*)(lds + MISC_OFF + 2944);
    LAS int* selall = (LAS int*)(lds + MISC_OFF + 4096);
    const int ntok = (l == 0) ? MT : ML;
    if (tid < NE) lc[tid] = 0;
    const int fn = lane & 15, kg = lane >> 4;
    bf16x8 wh[8][2];
    { const char* bh = (const char*)uniform_ptr(WRH + wave * 256);
        const unsigned o0 = (unsigned)(fn * D + kg * 8) * 2u, o1 = o0 + 16u * D * 2u;
#pragma unroll
        for (int s = 0; s < 8; ++s) { wh[s][0] = *(const bf16x8*)(bh + o0 + s * 64); wh[s][1] = *(const bf16x8*)(bh + o1 + s * 64); } }
    int ui = 0;
    u32x2 ra[8], rb[8]; f32x4 psh, pg;
    LAS float* sg = (LAS float*)(lds + SG_OFF);
#define ROUTER_FETCH(u_) do { const int _row = (u_) * 16 + wave * 2; const int _b = _row < ML ? (_row >> 12) : 4; const float* _m = MOD + (size_t)_b * 12288; \
        const char* _x0 = (const char*)uniform_ptr(XR + (size_t)_row * D); const char* _x1 = (const char*)uniform_ptr(XR + (size_t)(_row + 1) * D); \
        const char* _ms = (const char*)uniform_ptr(_m + 3 * 2048); const char* _mg = (const char*)uniform_ptr(_m + 4 * 2048); \
        _Pragma("unroll") for (int j = 0; j < 8; ++j) { ra[j] = *(const u32x2*)(_x0 + lo8 + j * 512); rb[j] = *(const u32x2*)(_x1 + lo8 + j * 512); } \
        psh = *(const f32x4*)(_ms + (unsigned)tid * 16u); pg = *(const f32x4*)(_mg + (unsigned)tid * 16u); } while (0)
    const unsigned lo8 = (unsigned)lane * 8u, lo4 = (unsigned)lane * 4u, lo16 = (unsigned)lane * 16u;
    if ((int)blockIdx.x < ntok / 16) { ROUTER_FETCH((int)blockIdx.x); *(LAS f32x4*)(sg + 4 * tid) = psh; *(LAS f32x4*)(sg + 2048 + 4 * tid) = pg; }
    __syncthreads();
    for (int unit = blockIdx.x; unit < ntok / 16; unit += G) {
        LAS int* sel = selall + ui * 64;
        int tq = tid; asm volatile("" : "+v"(tq));
        const unsigned lq = (unsigned)(tq & 63);
        { const int tl = wave * 2, row = unit * 16 + tl;
            char* nfa = (char*)uniform_ptr(NF8 + (size_t)row * D); char* nfb = (char*)uniform_ptr(NF8 + (size_t)(row + 1) * D);
            float ssa = 0.f, ssb = 0.f;
#define UNPK4(w_) ((f32x4){__uint_as_float((w_).x << 16), __uint_as_float((w_).x & 0xffff0000u), __uint_as_float((w_).y << 16), __uint_as_float((w_).y & 0xffff0000u)})
#pragma unroll
            for (int j = 0; j < 8; ++j) { const f32x4 xa = UNPK4(ra[j]), xb = UNPK4(rb[j]);
                ssa += (xa.x * xa.x + xa.y * xa.y) + (xa.z * xa.z + xa.w * xa.w); ssb += (xb.x * xb.x + xb.y * xb.y) + (xb.z * xb.z + xb.w * xb.w); }
            const float rsa = rsqrtf(wave_sum(ssa) * (1.0f / D) + EPS), rsb = rsqrtf(wave_sum(ssb) * (1.0f / D) + EPS);
#pragma unroll
            for (int j = 0; j < 8; ++j) { const unsigned col = 4u * lq + 256u * j;
                const f32x4 shj = *(const LAS f32x4*)(sg + col), gj = *(const LAS f32x4*)(sg + 2048 + col);
                const f32x4 na = (UNPK4(ra[j]) * rsa) * gj + shj, nb = (UNPK4(rb[j]) * rsb) * gj + shj;
                int wa = 0, wb = 0; wa = __builtin_amdgcn_cvt_pk_fp8_f32(na.x, na.y, wa, false); wa = __builtin_amdgcn_cvt_pk_fp8_f32(na.z, na.w, wa, true);
                wb = __builtin_amdgcn_cvt_pk_fp8_f32(nb.x, nb.y, wb, false); wb = __builtin_amdgcn_cvt_pk_fp8_f32(nb.z, nb.w, wb, true);
                *(int*)(nfa + 4u * lq + j * 256) = wa; *(int*)(nfb + 4u * lq + j * 256) = wb;
                const unsigned ha0 = cvt_pk_bf16(na.x, na.y), ha1 = cvt_pk_bf16(na.z, na.w), hb0 = cvt_pk_bf16(nb.x, nb.y), hb1 = cvt_pk_bf16(nb.z, nb.w);
                const unsigned la0 = cvt_pk_bf16(na.x - __uint_as_float(ha0 << 16), na.y - __uint_as_float(ha0 & 0xffff0000u)), la1 = cvt_pk_bf16(na.z - __uint_as_float(ha1 << 16), na.w - __uint_as_float(ha1 & 0xffff0000u));
                const unsigned lb0 = cvt_pk_bf16(nb.x - __uint_as_float(hb0 << 16), nb.y - __uint_as_float(hb0 & 0xffff0000u)), lb1 = cvt_pk_bf16(nb.z - __uint_as_float(hb1 << 16), nb.w - __uint_as_float(hb1 & 0xffff0000u));
                *(LAS u32x2*)(thi + tl * TST + col * 2) = (u32x2){ha0, ha1}; *(LAS u32x2*)(tlo + tl * TST + col * 2) = (u32x2){la0, la1};
                *(LAS u32x2*)(thi + (tl + 1) * TST + col * 2) = (u32x2){hb0, hb1}; *(LAS u32x2*)(tlo + (tl + 1) * TST + col * 2) = (u32x2){lb0, lb1};
                }
            asm volatile("" ::: "memory");
            if (unit + G < ntok / 16) ROUTER_FETCH(unit + G);
        }
        __syncthreads();
        f32x4 acc0 = (f32x4){0.f, 0.f, 0.f, 0.f}, acc1 = (f32x4){0.f, 0.f, 0.f, 0.f};
#pragma unroll
        for (int s = 0; s < 8; ++s) { const int ko = (wave * 256 + s * 32 + kg * 8) * 2;
            const bf16x8 ah = *(const LAS bf16x8*)(thi + fn * TST + ko), al = *(const LAS bf16x8*)(tlo + fn * TST + ko);
            acc0 = __builtin_amdgcn_mfma_f32_16x16x32_bf16(ah, wh[s][0], acc0, 0, 0, 0); acc1 = __builtin_amdgcn_mfma_f32_16x16x32_bf16(ah, wh[s][1], acc1, 0, 0, 0);
            acc0 = __builtin_amdgcn_mfma_f32_16x16x32_bf16(al, wh[s][0], acc0, 0, 0, 0); acc1 = __builtin_amdgcn_mfma_f32_16x16x32_bf16(al, wh[s][1], acc1, 0, 0, 0); }
        __syncthreads();
        { LAS float* pw = fl + wave * 512;
#pragma unroll
            for (int r = 0; r < 4; ++r) { pw[(kg * 4 + r) * 32 + fn] = acc0[r]; pw[(kg * 4 + r) * 32 + 16 + fn] = acc1[r]; } }
        __syncthreads();
        { float sacc = br[tid & 31];
#pragma unroll
            for (int w = 0; w < 8; ++w) sacc += fl[w * 512 + tid];
            lg[tid] = sacc; }
        if (unit + G < ntok / 16) { *(LAS f32x4*)(sg + 4 * tid) = psh; *(LAS f32x4*)(sg + 2048 + 4 * tid) = pg; }
        __syncthreads();
        { const int t = tq >> 5, e = tq & 31; const float my = lg[tq]; int rank = 0;
#pragma unroll
            for (int q = 0; q < 8; ++q) { const f32x4 x = *(const LAS f32x4*)(lg + t * 32 + 4 * q);
#pragma unroll
                for (int c = 0; c < 4; ++c) rank += (x[c] > my || (x[c] == my && 4 * q + c < e)) ? 1 : 0; }
            if (rank < 4) { sel[t * 4 + rank] = e; tv[t * 4 + rank] = my; } }
        __syncthreads();
        if (tid < 16) { const int row = unit * 16 + tid; const f32x4 v = *(const LAS f32x4*)(tv + tid * 4);
            const float e1 = __expf(v[1] - v[0]), e2 = __expf(v[2] - v[0]), e3 = __expf(v[3] - v[0]); const float inv = 1.0f / (1.0f + e1 + e2 + e3);
            *(int4*)(eid + (size_t)row * 4) = make_int4(sel[tid * 4 + 0], sel[tid * 4 + 1], sel[tid * 4 + 2], sel[tid * 4 + 3]);
            *(f32x4*)(gate + (size_t)row * 4) = (f32x4){inv, e1 * inv, e2 * inv, e3 * inv}; }
        ++ui;
    }
    __syncthreads();
    const int nent = ui * 64; int ee = 0, rk = 0;
    if (tid < nent) { ee = selall[tid]; rk = __hip_atomic_fetch_add(lc + ee, 1, __ATOMIC_RELAXED, __HIP_MEMORY_SCOPE_WORKGROUP); }
    __syncthreads();
    if (tid < NE) { const int c = lc[tid]; if (c > 0) lbase[tid] = (int)atomicAdd(cnt + tid * 64, (unsigned)c); }
    __syncthreads();
    if (tid < nent) { const int p = lbase[ee] + rk; const int row = ((int)blockIdx.x + (tid >> 6) * G) * 16 + ((tid & 63) >> 2); list[(size_t)ee * MT + p] = row; posb[(size_t)row * 4 + (tid & 3)] = p; }
    __syncthreads();
#undef ROUTER_FETCH
#undef UNPK4
}

__device__ __forceinline__ void moe_tables(unsigned char* ws, int l, LAS unsigned char* lds) {
    LAS int* tp = (LAS int*)(lds + MISC_OFF + 64); LAS int* cn = (LAS int*)(lds + MISC_OFF + 256);
    const unsigned* cnt = (const unsigned*)(ws + WS_CTL) + CW_CNT + l * 32 * 64;
    __syncthreads();
    if (threadIdx.x < 64) { const int ln = threadIdx.x;
        const int c = (ln < NE) ? (int)__hip_atomic_load(cnt + ln * 64, __ATOMIC_RELAXED, __HIP_MEMORY_SCOPE_AGENT) : 0;
        const int t = (c + 255) >> 8; int incl = t;
#pragma unroll
        for (int o = 1; o < 32; o <<= 1) { const int u = __shfl_up(incl, o); if (ln >= o) incl += u; }
        if (ln < NE) { tp[ln] = incl - t; cn[ln] = c; }
        if (ln == NE - 1) tp[NE] = incl; }
    __syncthreads();
}

PHASE_FN phase_moe_up(LAS unsigned char* lds, int l, int G) {
    lds = (LAS unsigned char*)__builtin_amdgcn_readfirstlane((int)(uintptr_t)lds); l = __builtin_amdgcn_readfirstlane(l); G = __builtin_amdgcn_readfirstlane(G);
    unsigned char* ws = WSP();
    moe_tables(ws, l, lds);
    pg8::MoeSched<true, D, 1> S; S.init((const LAS int*)(lds + MISC_OFF + 64), (const LAS int*)(lds + MISC_OFF + 256), ws + WS_NF8, ws + WS_W1 + (size_t)l * 32 * 2048 * D,
                                  (const int*)(ws + WS_ROUT + ROUT_LIST), G, (int)blockIdx.x);
    pg8::EpiSwiglu E{ws + WS_ACT, INP(I_B1) + (size_t)l * 32 * 2048};
    pg8::gemm_phase(lds, S, E);
}

PHASE_FN phase_moe_down(LAS unsigned char* lds, int l, int G) {
    lds = (LAS unsigned char*)__builtin_amdgcn_readfirstlane((int)(uintptr_t)lds); l = __builtin_amdgcn_readfirstlane(l); G = __builtin_amdgcn_readfirstlane(G);
    unsigned char* ws = WSP();
    moe_tables(ws, l, lds);
    pg8::MoeSched<false, DE, 1> S; S.init((const LAS int*)(lds + MISC_OFF + 64), (const LAS int*)(lds + MISC_OFF + 256), ws + WS_ACT, ws + WS_W2 + (size_t)l * 32 * D * DE,
                                   nullptr, G, (int)blockIdx.x);
    pg8::EpiF8 E{ws + WS_Y, D, INP(I_B2) + (size_t)l * 32 * D, D};
    pg8::gemm_phase(lds, S, E);
}

PHASE_FN phase_combine(LAS unsigned char* lds, int l, int G) {
    lds = (LAS unsigned char*)__builtin_amdgcn_readfirstlane((int)(uintptr_t)lds); l = __builtin_amdgcn_readfirstlane(l); G = __builtin_amdgcn_readfirstlane(G);
    const int tid = tid_local(), lane = tid & 63, wave = __builtin_amdgcn_readfirstlane(tid >> 6);
    unsigned char* ws = WSP();
    moe_tables(ws, l, lds);
    bf16_t* XR = (bf16_t*)(ws + WS_XR); unsigned char* N = ws + WS_N; const unsigned char* Y = ws + WS_Y;
    const float* MOD = (const float*)(ws + WS_MOD);
    const int* eid = (const int*)(ws + WS_ROUT + ROUT_EID); const float* gate = (const float*)(ws + WS_ROUT + ROUT_GATE); const int* posb = (const int*)(ws + WS_ROUT + ROUT_POS);
    const LAS int* tp = (const LAS int*)(lds + MISC_OFF + 64);
    const float* g1n = INP(I_G1) + D; const float* gf = INP(I_GF); float* out = OUTP();
    const int ntok = (l == 0) ? MT : ML;
    for (int row = blockIdx.x * NWAVES + wave; row < ntok; row += G * NWAVES) {
        const int bidx = row < ML ? (row >> 12) : 4; const float* m = MOD + ((size_t)l * 5 + bidx) * 12288;
        const int4 ev = *(const int4*)(eid + (size_t)row * 4), pv = *(const int4*)(posb + (size_t)row * 4); const f32x4 gv = *(const f32x4*)(gate + (size_t)row * 4);
        const unsigned char* yr[4];
        yr[0] = Y + ((size_t)tp[ev.x] * 256 + pv.x) * D; yr[1] = Y + ((size_t)tp[ev.y] * 256 + pv.y) * D; yr[2] = Y + ((size_t)tp[ev.z] * 256 + pv.z) * D; yr[3] = Y + ((size_t)tp[ev.w] * 256 + pv.w) * D;
        u32x2 yv[4][4]; f32x4 xv[4][2]; u32x4 xw[4];
#pragma unroll
        for (int j = 0; j < 4; ++j) { const int col = 8 * (lane + 64 * j);
#pragma unroll
            for (int k = 0; k < 4; ++k) yv[j][k] = *(const u32x2*)(yr[k] + col);
            xw[j] = *(const u32x4*)(XR + (size_t)row * D + col); }
#pragma unroll
        for (int j = 0; j < 4; ++j) pg8::unpack_bf16x8(xw[j], xv[j][0], xv[j][1]);
        float ss = 0.f;
#pragma unroll
        for (int j = 0; j < 4; ++j) { const int col = 8 * (lane + 64 * j);
            f32x4 s0 = (f32x4){0.f, 0.f, 0.f, 0.f}, s1 = s0;
#pragma unroll
            for (int k = 0; k < 4; ++k) { const u32x2 w = yv[j][k];
                const f32x2 a0 = __builtin_amdgcn_cvt_pk_f32_fp8((int)w.x, false), a1 = __builtin_amdgcn_cvt_pk_f32_fp8((int)w.x, true), a2 = __builtin_amdgcn_cvt_pk_f32_fp8((int)w.y, false), a3 = __builtin_amdgcn_cvt_pk_f32_fp8((int)w.y, true);
                s0 += gv[k] * (f32x4){a0.x, a0.y, a1.x, a1.y};
                s1 += gv[k] * (f32x4){a2.x, a2.y, a3.x, a3.y}; }
            const f32x4 gt0 = *(const f32x4*)(m + 5 * 2048 + col), gt1 = *(const f32x4*)(m + 5 * 2048 + col + 4);
            xv[j][0] += gt0 * s0; xv[j][1] += gt1 * s1;
            ss += (xv[j][0].x * xv[j][0].x + xv[j][0].y * xv[j][0].y) + (xv[j][0].z * xv[j][0].z + xv[j][0].w * xv[j][0].w);
            ss += (xv[j][1].x * xv[j][1].x + xv[j][1].y * xv[j][1].y) + (xv[j][1].z * xv[j][1].z + xv[j][1].w * xv[j][1].w); }
        const float rs = rsqrtf(wave_sum(ss) * (1.0f / D) + EPS);
        if (l == 0) {
            const float* m1 = MOD + ((size_t)5 + bidx) * 12288;
#pragma unroll
            for (int j = 0; j < 4; ++j) { const int col = 8 * (lane + 64 * j);
                *(u32x4*)(XR + (size_t)row * D + col) = pg8::pack_bf16x8(xv[j][0], xv[j][1]);
                int w0 = 0, w1 = 0;
#pragma unroll
                for (int q = 0; q < 2; ++q) { const f32x4 gg = *(const f32x4*)(g1n + col + 4 * q), sh = *(const f32x4*)(m1 + col + 4 * q), sc = *(const f32x4*)(m1 + 2048 + col + 4 * q);
                    const f32x4 n = ((xv[j][q] * rs) * gg) * (sc + 1.0f) + sh;
                    if (q == 0) { w0 = __builtin_amdgcn_cvt_pk_fp8_f32(n.x, n.y, w0, false); w0 = __builtin_amdgcn_cvt_pk_fp8_f32(n.z, n.w, w0, true); }
                    else { w1 = __builtin_amdgcn_cvt_pk_fp8_f32(n.x, n.y, w1, false); w1 = __builtin_amdgcn_cvt_pk_fp8_f32(n.z, n.w, w1, true); } }
                *(u32x2*)(N + (size_t)row * D + col) = (u32x2){(unsigned)w0, (unsigned)w1}; }
        } else {
            f32x4 gfv[4][2];
#pragma unroll
            for (int j = 0; j < 4; ++j)
#pragma unroll
                for (int q = 0; q < 2; ++q) gfv[j][q] = *(const f32x4*)(gf + 8 * (lane + 64 * j) + 4 * q);
            asm volatile("" ::: "memory");
#pragma unroll
            for (int j = 0; j < 4; ++j) { const int col = 8 * (lane + 64 * j);
                *(f32x4*)(out + (size_t)row * D + col) = (xv[j][0] * rs) * gfv[j][0];
                *(f32x4*)(out + (size_t)row * D + col + 4) = (xv[j][1] * rs) * gfv[j][1]; }
        }
    }
}

__global__ void __launch_bounds__(NTHREADS, 2) mk_fwd(Args a) {
    extern __shared__ __attribute__((aligned(16))) unsigned char lds_raw[];
    LAS unsigned char* lds = (LAS unsigned char*)lds_raw;
    const int tid = threadIdx.x; const int G = gridDim.x;
    if (tid < 16) ((LAS unsigned*)(lds + MISC_OFF))[tid] = 0u;
    if (tid == 64) { LAS unsigned long long* pt = (LAS unsigned long long*)(lds + PT_OFF);
#pragma unroll
        for (int i = 0; i < 26; ++i) pt[i] = (unsigned long long)a.in[i];
        pt[PT_OUT] = (unsigned long long)a.out; pt[PT_WS] = (unsigned long long)a.ws; }
    __syncthreads();
    const bool multi = (a.ph_hi - a.ph_lo) > 1;
    if (multi) (void)xcd_barrier_post((unsigned*)(a.ws + WS_CTL) + CW_BAR, (volatile LAS unsigned*)(lds + MISC_OFF));
    const int lo = a.ph_lo, hi = a.ph_hi;
#define IN(k) (lo <= (k) && (k) < hi)
#define SEAM(k) do { if (IN((k) + 1)) { XcdBarrier _b; _b.bar = (unsigned*)(a.ws + WS_CTL) + CW_BAR; _b.x = xb_xcc_id(); _b.st = (volatile LAS unsigned*)(lds + MISC_OFF); xcd_barrier(_b); if ((MK_REPEAT >> 11) & 1) xcd_barrier(_b); } } while (0)

    if (IN(0)) { REP(0) phase_prologue(lds, 0, G); SEAM(0); }
    if (IN(1)) { phase_modreduce(lds, 0, G); SEAM(1); }
#define LAYER_BODY(l) { \
        const int pb = 2 + 10 * l; \
        if (l == 0 && IN(pb + 0)) { phase_norm1_l0(lds, 0, G); SEAM(pb + 0); } \
        if (IN(pb + 1)) { REP(2) phase_inproj(lds, l, G); SEAM(pb + 1); } \
        if (IN(pb + 2)) { REP(3) phase_prep(lds, l, G); SEAM(pb + 2); } \
        if (IN(pb + 3)) { REP(4) phase_attention(lds, l, G); SEAM(pb + 3); } \
        if (IN(pb + 4)) { REP(5) phase_fixup(lds, l, G); SEAM(pb + 4); } \
        if (IN(pb + 5)) { if (l == 0) { REP(6) phase_outproj(lds, l, G); } else phase_outproj(lds, l, G); SEAM(pb + 5); } \
        if (IN(pb + 6)) { phase_router(lds, l, G); SEAM(pb + 6); } \
        if (IN(pb + 7)) { REP(8) phase_moe_up(lds, l, G); SEAM(pb + 7); } \
        if (IN(pb + 8)) { REP(9) phase_moe_down(lds, l, G); SEAM(pb + 8); } \
        if (IN(pb + 9)) { if (l == 1) { REP(10) phase_combine(lds, l, G); } else phase_combine(lds, l, G); if (l == 0) SEAM(pb + 9); } \
    }
    LAYER_BODY(0)
    LAYER_BODY(1)
#undef LAYER_BODY
#undef IN
#undef SEAM
}

extern "C" void kernel_launch(void* const* d_in, const int* in_sizes, int n_in, void* d_out, int out_size, void* d_ws, size_t ws_size, hipStream_t stream) {
    static int grid = 0;
    if (grid == 0) {
        if (n_in != 26 || in_sizes[0] != ML * D || out_size != ML * D || ws_size < WS_END) {
            fprintf(stderr, "kernel_launch: shape mismatch (n_in %d, in0 %d, out %d, ws %zu need %zu); nothing launched\n", n_in, n_in > 0 ? in_sizes[0] : -1, out_size, ws_size, (size_t)WS_END); grid = -1; return; }
        int dev = 0, cus = 0, per_cu = 0;
        if (hipGetDevice(&dev) != hipSuccess || hipDeviceGetAttribute(&cus, hipDeviceAttributeMultiprocessorCount, dev) != hipSuccess) { grid = -1; return; }
        if (hipFuncSetAttribute((const void*)mk_fwd, hipFuncAttributeMaxDynamicSharedMemorySize, LDS_BYTES) != hipSuccess) { fprintf(stderr, "kernel_launch: hipFuncSetAttribute failed\n"); grid = -1; return; }
        if (hipOccupancyMaxActiveBlocksPerMultiprocessor(&per_cu, (const void*)mk_fwd, NTHREADS, LDS_BYTES) != hipSuccess || per_cu < 1)
            fprintf(stderr, "kernel_launch: note: occupancy query reports %d workgroups per CU\n", per_cu);
        (void)hipGetLastError();
        grid = cus;
    }
    if (grid < 0) return;
    if (hipMemsetAsync((char*)d_ws + WS_CTL, 0, CTL_ZERO_BYTES, stream) != hipSuccess) { fprintf(stderr, "kernel_launch: memset failed\n"); return; }
    Args a{};
    for (int i = 0; i < 26; ++i) a.in[i] = (const float*)d_in[i];
    a.out = (float*)d_out; a.ws = (unsigned char*)d_ws;
#if MK_PER_PHASE_LAUNCH
    for (int p = 0; p < NPHASE; ++p) {
        if (p == 12) continue;
        a.ph_lo = p; a.ph_hi = p + 1;
        hipLaunchKernelGGL(mk_fwd, dim3(grid), dim3(NTHREADS), LDS_BYTES, stream, a);
    }
#else
    a.ph_lo = 0; a.ph_hi = NPHASE;
    hipLaunchKernelGGL(mk_fwd, dim3(grid), dim3(NTHREADS), LDS_BYTES, stream, a);
#endif
    const hipError_t le = hipPeekAtLastError();
    if (le != hipSuccess) fprintf(stderr, "kernel_launch: launch failed: %s\n", hipGetErrorName(le));
}
```

```cpp
#include <hip/hip_runtime.h>
#include <cstdio>
#include <cstdint>

#ifndef MK_PER_PHASE_LAUNCH
#define MK_PER_PHASE_LAUNCH 0
#endif

#ifndef MK_REPEAT
#define MK_REPEAT 0
#endif
#define REP(k) for (int _rep = 0; _rep < 1 + ((MK_REPEAT >> (k)) & 1); ++_rep)
#define GAS __attribute__((address_space(1)))
#define LAS __attribute__((address_space(3)))
typedef unsigned short bf16_t;
typedef short bf16x8 __attribute__((ext_vector_type(8)));
typedef short s16x4 __attribute__((ext_vector_type(4)));
typedef float f32x4 __attribute__((ext_vector_type(4)));
typedef float f32x2 __attribute__((ext_vector_type(2)));
typedef float f32x16 __attribute__((ext_vector_type(16)));
typedef unsigned u32x4 __attribute__((ext_vector_type(4)));
typedef unsigned u32x2 __attribute__((ext_vector_type(2)));
typedef int v8i __attribute__((ext_vector_type(8)));

constexpr int D = 2048, NB = 4, SEQ = 4096, CTX = 256, TK = CTX + SEQ  , DEPTH = 2;
constexpr int ML = NB * SEQ  , MC = NB * CTX  , MT = ML + MC  ;
constexpr int INW = 3584, NE = 32, DE = 1024;
constexpr int OFF_QA = 0, OFF_KA = 1024, OFF_VA = 1280, OFF_QB = 1536, OFF_KB = 2048, OFF_VB = 2560, OFF_UC = 3072;
constexpr float EPS = 1e-6f;
constexpr int MAXROWS = 77824;
constexpr int NWAVES = 8, NTHREADS = 512;

constexpr size_t MiB = 1u << 20;
constexpr size_t WS_CTL = 0, CTL_ZERO_BYTES = 2 * MiB;
constexpr size_t WS_MOD = 1 * MiB;
constexpr size_t WS_ROPE = 2 * MiB;
constexpr size_t WS_ROUT = 3 * MiB;
constexpr size_t WS_WRS = 7 * MiB;
constexpr size_t WS_XR = 8 * MiB;
constexpr size_t WS_N = 144 * MiB;
constexpr size_t WS_P = 212 * MiB;
constexpr size_t WS_QA = 332 * MiB;
constexpr size_t WS_KA = 366 * MiB;
constexpr size_t WS_VA = 375 * MiB;
constexpr size_t WS_QB = 384 * MiB;
constexpr size_t WS_KB = 401 * MiB;
constexpr size_t WS_VB = 418 * MiB;
constexpr size_t WS_CAT = 435 * MiB;
constexpr size_t WS_OB = 503 * MiB;
constexpr size_t WS_ACT = 571 * MiB;
constexpr size_t WS_Y = 723 * MiB;
constexpr size_t WS_WIN = 1027 * MiB;
constexpr size_t WS_WOUT = 1055 * MiB;
constexpr size_t WS_W1 = 1071 * MiB;
constexpr size_t WS_W2 = 1583 * MiB;
constexpr size_t WS_MODP = 1839 * MiB;
constexpr size_t WS_NF8 = 1871 * MiB;
constexpr size_t WS_END = 1907 * MiB;
static_assert(WS_XR + (size_t)MT * D * 4 <= WS_N && WS_N + (size_t)MT * D * 2 <= WS_P && WS_P + (size_t)MT * INW * 2 <= WS_QA, "ws map 1");
static_assert(WS_QA + (size_t)MT * 1024 * 2 <= WS_KA && WS_KA + (size_t)MT * 256 * 2 <= WS_VA && WS_VA + (size_t)MT * 256 * 2 <= WS_QB, "ws map 2");
static_assert(WS_QB + (size_t)MT * 512 * 2 <= WS_KB && WS_KB + (size_t)MT * 512 * 2 <= WS_VB && WS_VB + (size_t)MT * 512 * 2 <= WS_CAT, "ws map 3");
static_assert(WS_CAT + (size_t)MT * D * 2 <= WS_OB && WS_OB + (size_t)MT * 1024 * 4 <= WS_ACT && WS_ACT + (size_t)MAXROWS * 1024 * 2 <= WS_Y, "ws map 4");
static_assert(WS_Y + (size_t)MAXROWS * 2048 * 2 <= WS_WIN && WS_WIN + (size_t)2 * INW * D * 2 <= WS_WOUT && WS_WOUT + (size_t)2 * D * D * 2 <= WS_W1, "ws map 5");
static_assert(WS_W1 + (size_t)2 * 32 * 2048 * 2048 * 2 <= WS_W2 && WS_W2 + (size_t)2 * 32 * 2048 * 1024 * 2 <= WS_MODP && WS_MODP + (size_t)64 * 10 * 12288 * 4 <= WS_NF8 && WS_NF8 + (size_t)MT * D <= WS_END, "ws map 6");
static_assert(NB * TK == MT, "K/V row count");
constexpr size_t ROUT_EID = 0, ROUT_GATE = (size_t)MT * 16, ROUT_POS = (size_t)MT * 32, ROUT_LIST = (size_t)MT * 48;
static_assert(WS_ROUT + ROUT_LIST + (size_t)32 * MT * 4 <= WS_WRS && WS_WRS + (size_t)2 * 2 * 32 * 2048 * 2 <= WS_XR, "router map");
constexpr int CW_BAR = 4096;
constexpr int CW_CNT = 8192;
constexpr int CW_Q = 12288;
static_assert((CW_Q + 512) * 4 <= (int)WS_MOD && CW_CNT + 64 * 64 <= CW_Q, "ctl map");

constexpr int RING_BYTES = 131072;
constexpr int MISC_OFF = RING_BYTES + 1024;
constexpr int LDS_BYTES = 163840;
constexpr int SG_OFF = MISC_OFF + 6144;
constexpr int FLS = 2052;

#define VM_WAIT() asm volatile("s_waitcnt vmcnt(0)" ::: "memory")
#define LDS_WAIT() asm volatile("s_waitcnt lgkmcnt(0)" ::: "memory")
__device__ __forceinline__ unsigned cvt_pk_bf16(float lo, float hi) { unsigned r; asm volatile("v_cvt_pk_bf16_f32 %0, %1, %2" : "=v"(r) : "v"(lo), "v"(hi)); return r; }
__device__ __forceinline__ bf16_t f2bf(float f) { return (bf16_t)(cvt_pk_bf16(f, 0.f) & 0xffffu); }
__device__ __forceinline__ float bf2f(bf16_t b) { return __uint_as_float(((unsigned)b) << 16); }
__device__ __forceinline__ int tid_local() { int t = threadIdx.x; asm volatile("" : "+v"(t)); return t; }
template <class T> __device__ __forceinline__ T* uniform_ptr(T* p) {
    const unsigned long long v = (unsigned long long)p;
    const unsigned lo = __builtin_amdgcn_readfirstlane((unsigned)v), hi = __builtin_amdgcn_readfirstlane((unsigned)(v >> 32));
    return (T*)(GAS T*)(((unsigned long long)hi << 32) | lo);
}
__device__ __forceinline__ float wave_sum(float v) {
    v += __builtin_bit_cast(float, __builtin_amdgcn_update_dpp(0, __builtin_bit_cast(int, v), 0xB1, 0xF, 0xF, true));
    v += __builtin_bit_cast(float, __builtin_amdgcn_update_dpp(0, __builtin_bit_cast(int, v), 0x4E, 0xF, 0xF, true));
    v += __builtin_bit_cast(float, __builtin_amdgcn_update_dpp(0, __builtin_bit_cast(int, v), 0x141, 0xF, 0xF, true));
    v += __builtin_bit_cast(float, __builtin_amdgcn_update_dpp(0, __builtin_bit_cast(int, v), 0x140, 0xF, 0xF, true));
    const float a = __builtin_bit_cast(float, __builtin_amdgcn_readlane(__builtin_bit_cast(int, v), 0)), b = __builtin_bit_cast(float, __builtin_amdgcn_readlane(__builtin_bit_cast(int, v), 16));
    const float c = __builtin_bit_cast(float, __builtin_amdgcn_readlane(__builtin_bit_cast(int, v), 32)), d = __builtin_bit_cast(float, __builtin_amdgcn_readlane(__builtin_bit_cast(int, v), 48));
    return (a + b) + (c + d);
}

constexpr int PT_OFF = 131072 + 1024 + 3072;
constexpr int PT_OUT = 26, PT_WS = 27;
__device__ __forceinline__ unsigned long long ldp_raw(LAS unsigned char* lds, int i) {
    const u32x2 v = *(const LAS u32x2*)(lds + PT_OFF + 8 * i);
    const unsigned lo = __builtin_amdgcn_readfirstlane(v.x), hi = __builtin_amdgcn_readfirstlane(v.y);
    return ((unsigned long long)hi << 32) | lo;
}
#define INP(i) ((const float*)(const GAS float*)ldp_raw(lds, (i)))
#define WSP() ((unsigned char*)(GAS unsigned char*)ldp_raw(lds, PT_WS))
#define OUTP() ((float*)(GAS float*)ldp_raw(lds, PT_OUT))
#define PHASE_FN __device__ __forceinline__ void

#define XB_TMO      128
#define XB_XCNT(j)  (256  + 64 * (j))
#define XB_XSUB(j)  (1280 + 64 * (j))
#define XB_XGEN(j)  (2304 + 64 * (j))
#define XB_TOP      3328
#define XB_TOPGEN   3392
#define XCD_BAR_WORDS 3456
#define XB_SPIN_CAP (1u << 18)
__device__ __forceinline__ unsigned xb_ld(unsigned* p)              { return __hip_atomic_load(p, __ATOMIC_RELAXED, __HIP_MEMORY_SCOPE_AGENT); }
__device__ __forceinline__ unsigned xb_add(unsigned* p, unsigned v) { return __hip_atomic_fetch_add(p, v, __ATOMIC_RELAXED, __HIP_MEMORY_SCOPE_AGENT); }
__device__ __forceinline__ unsigned xb_xcc_id() { return (unsigned)__builtin_amdgcn_s_getreg((3 << 11) | 20) & 0xFu; }
#define XB_SPIN(cond, bar) do { unsigned _sp = 0; while (cond) { __builtin_amdgcn_s_sleep(1); \
    if ((++_sp & 255u) == 0u) { if (xb_ld(&(bar)[XB_TMO])) break; if (_sp > XB_SPIN_CAP) { atomicAdd(&(bar)[XB_TMO], 1u); break; } } } } while (0)
struct XcdBarrier { unsigned* bar; unsigned x; volatile LAS unsigned* st; };
__device__ __forceinline__ XcdBarrier xcd_barrier_post(unsigned* bar, volatile LAS unsigned* st) {
    XcdBarrier b; b.bar = bar; b.x = xb_xcc_id(); b.st = st;
    if (threadIdx.x == 0) (void)xb_add(&bar[XB_XCNT(b.x)], 1u);
    return b;
}
__device__ __forceinline__ void xcd_barrier_complete(unsigned* bar, unsigned x, unsigned& nloc, unsigned& nx) {
    const unsigned G = gridDim.x * gridDim.y * gridDim.z;
    unsigned sum, cnt, mine, sp = 0u;
    for (;;) {
        sum = 0u; cnt = 0u; mine = 0u;
#pragma unroll
        for (unsigned j = 0; j < 16; ++j) { const unsigned c = xb_ld(&bar[XB_XCNT(j)]); sum += c; cnt += (c > 0u) ? 1u : 0u; mine = (j == x) ? c : mine; }
        if (sum == G) break;
        __builtin_amdgcn_s_sleep(1);
        if ((++sp & 255u) == 0u) { if (xb_ld(&bar[XB_TMO])) break; if (sp > XB_SPIN_CAP) { atomicAdd(&bar[XB_TMO], 1u); break; } }
    }
    nloc = mine > 0u ? mine : 1u; nx = cnt > 0u ? cnt : 1u;
}
__device__ __forceinline__ void xcd_barrier(const XcdBarrier& b) {
    asm volatile("s_waitcnt vmcnt(0)" ::: "memory");
    __syncthreads();
    if (threadIdx.x == 0) {
        unsigned* bar = b.bar;
        __builtin_amdgcn_s_waitcnt(0);
        unsigned nloc = b.st[0], nx = b.st[1];
        if (nloc == 0u) { xcd_barrier_complete(bar, b.x, nloc, nx); b.st[0] = nloc; b.st[1] = nx; }
        const unsigned old = xb_add(&bar[XB_XSUB(b.x)], 1u);
        const unsigned gen = old / nloc;
        if (old + 1u == (gen + 1u) * nloc) {
            __builtin_amdgcn_fence(__ATOMIC_RELEASE, "agent");
            asm volatile("s_waitcnt vmcnt(0)" ::: "memory");
            const unsigned og = xb_add(&bar[XB_TOP], 1u);
            const unsigned tg = og / nx;
            if (og + 1u == (tg + 1u) * nx) xb_add(&bar[XB_TOPGEN], 1u);
            else XB_SPIN(xb_ld(&bar[XB_TOPGEN]) == tg, bar);
            __builtin_amdgcn_fence(__ATOMIC_ACQUIRE, "agent");
            xb_add(&bar[XB_XGEN(b.x)], 1u);
            asm volatile("s_waitcnt vmcnt(0)" ::: "memory");
        } else {
            XB_SPIN(xb_ld(&bar[XB_XGEN(b.x)]) == gen, bar);
            __builtin_amdgcn_fence(__ATOMIC_ACQUIRE, "agent");
            asm volatile("s_waitcnt vmcnt(0)" ::: "memory");
        }
    }
    __syncthreads();
}

namespace pg8 {
constexpr int BM = 256, BK = 64, HALF = 128, HTB = HALF * BK * 2, STAGE_BYTES = 8 * HTB, NXCD = 8, WGM = 8;
__host__ __device__ __forceinline__ int lds_byte(int r, int c) { const int st = (r >> 4) * 2 + (c >> 5), rr = r & 15, cc = c & 31, ob = rr * 64 + cc * 2; return st * 1024 + (ob ^ (((ob >> 9) & 1) << 5)); }
__host__ __device__ __forceinline__ void stage_rc(int b, int& R, int& C) { const int st = b / 1024, sb = b % 1024, swz = sb ^ (((sb >> 9) & 1) << 5); R = (st >> 1) * 16 + swz / 64; C = (st & 1) * 32 + (swz % 64) / 2; }
__host__ __device__ __forceinline__ int perm32(int rho) { const int n = rho >> 4, i = rho & 15; return 8 * (i >> 2) + 4 * n + (i & 3); }

__host__ __device__ __forceinline__ int f8_f(int rr) { return (0x9C >> (2 * (rr >> 2))) & 3; }
__host__ __device__ __forceinline__ int lds_byte8(int r, int b) { const int st = (r >> 4) * 2 + (b >> 6), rr = r & 15, q = (b >> 4) & 3; return st * 1024 + rr * 64 + ((q ^ f8_f(rr)) << 4) + (b & 15); }
__host__ __device__ __forceinline__ void stage_rc8(int o, int& R, int& Cb) { const int st = o / 1024, w = o % 1024, rr = w / 64, slot = (w % 64) / 16; R = (st >> 1) * 16 + rr; Cb = (st & 1) * 64 + ((slot ^ f8_f(rr)) << 4); }
template <int ESZ> __host__ __device__ __forceinline__ void stage_rcb(int o, int& R, int& Cb) { if constexpr (ESZ == 2) { int C; stage_rc(o, R, C); Cb = 2 * C; } else stage_rc8(o, R, Cb); }
struct Unit { int pm, pn, e; };

template <int K_, int ESZ_> struct DenseSched {
    static constexpr int K = K_, ESZ = ESZ_, SCALE_B = (ESZ_ == 1) ? 121 : 127;
    static constexpr bool GATHER_A = false;
    int nM, nN, nwg, G, c; const char* A; const char* Bt;
    __device__ void init(const void* A_, const void* Bt_, int M, int N, int G_, int c_) { A = (const char*)A_; Bt = (const char*)Bt_; nM = M / BM; nN = N / BM; nwg = nM * nN; G = G_; c = c_; }
    __device__ __forceinline__ bool next(int i, Unit& u) const {
        const long L = (long)i * G + c; if (L >= nwg) return false;
        int wgid = (int)L; { const int q = nwg / NXCD, r = nwg % NXCD, xcd = wgid % NXCD, off = wgid / NXCD; wgid = (xcd < r ? xcd * (q + 1) : r * (q + 1) + (xcd - r) * q) + off; }
        const int nig = WGM * nN, gid = wgid / nig, fm = gid * WGM, gsz = (nM - fm) < WGM ? (nM - fm) : WGM;
        u.pm = fm + ((wgid % nig) % gsz); u.pn = (wgid % nig) / gsz; u.e = 0; return true;
    }
    __device__ __forceinline__ int row0(const Unit& u) const { return u.pm * BM; }
    __device__ __forceinline__ const char* a_base() const { return A; }
    __device__ __forceinline__ const char* b_base(const Unit& u) const { return Bt + (size_t)u.pn * BM * K * ESZ; }
    __device__ __forceinline__ void a_voff(const Unit& u, int tid, unsigned (&v)[2][2]) const {
#pragma unroll
        for (int i = 0; i < 2; ++i) { int R, Cb; stage_rcb<ESZ>(tid * 16 + i * 8192, R, Cb);
#pragma unroll
            for (int h = 0; h < 2; ++h) v[h][i] = (unsigned)((u.pm * BM + h * HALF + R) * (K * ESZ) + Cb); }
    }
};
template <bool GATHER, int K_, int ESZ_> struct MoeSched {
    static constexpr int K = K_, ESZ = ESZ_, SCALE_B = (K_ == 2048) ? 121 : 122;
    static constexpr size_t BSTRIDE = (size_t)2048 * K * ESZ;
    static constexpr bool GATHER_A = GATHER;
    const LAS int* tp; const LAS int* cnt; int start, end, j, stride; const char* A; const char* Bt; const int* list;
    __device__ void init(const LAS int* tp_, const LAS int* cnt_, const void* A_, const void* Bt_, const int* list_, int G, int c) {
        tp = tp_; cnt = cnt_; A = (const char*)A_; Bt = (const char*)Bt_; list = list_;
        const int U = 8 * tp[NE];
        if (G == 256) { const int x = c & 7; j = c >> 3; stride = 32; start = (int)(((long)x * U) / 8); end = (int)(((long)(x + 1) * U) / 8); }
        else { start = 0; end = U; j = c; stride = G; }
    }
    __device__ __forceinline__ bool next(int i, Unit& u) const {
        const int idx = start + i * stride + j; if (idx >= end) return false;
        int e = 0;
        for (int q = 1; q < NE; ++q) e += (8 * tp[q] <= idx) ? 1 : 0;
        e = __builtin_amdgcn_readfirstlane(e);
        const int tiles = tp[e + 1] - tp[e], r = idx - 8 * tp[e];
        const int gi = r >> 5, fm = gi * 4, gsz = (tiles - fm) < 4 ? (tiles - fm) : 4, w = r - 32 * gi;
        u.e = e; u.pm = __builtin_amdgcn_readfirstlane(fm + (w % gsz)); u.pn = __builtin_amdgcn_readfirstlane(w / gsz); return true;
    }
    __device__ __forceinline__ int row0(const Unit& u) const { return __builtin_amdgcn_readfirstlane((tp[u.e] + u.pm) * BM); }
    __device__ __forceinline__ const char* a_base() const { return A; }
    __device__ __forceinline__ const char* b_base(const Unit& u) const { return Bt + (size_t)u.e * BSTRIDE + (size_t)u.pn * BM * K * ESZ; }
    __device__ __forceinline__ void a_voff(const Unit& u, int tid, unsigned (&v)[2][2]) const {
        if constexpr (GATHER) {
            const int* lp = list + (size_t)u.e * MT + u.pm * BM;
            const int nv = cnt[u.e] - u.pm * BM;
            int tok[2][2], Cc[2];
#pragma unroll
            for (int i = 0; i < 2; ++i) { int R; stage_rcb<ESZ>(tid * 16 + i * 8192, R, Cc[i]);
#pragma unroll
                for (int h = 0; h < 2; ++h) { const int lr = h * HALF + R; tok[h][i] = lp[lr < nv ? lr : 0]; } }
            asm volatile("s_waitcnt vmcnt(0)" ::: "memory");
#pragma unroll
            for (int h = 0; h < 2; ++h)
#pragma unroll
                for (int i = 0; i < 2; ++i) v[h][i] = (unsigned)(tok[h][i] * (K * ESZ) + Cc[i]);
        } else {
            const int r0 = row0(u);
#pragma unroll
            for (int i = 0; i < 2; ++i) { int R, Cb; stage_rcb<ESZ>(tid * 16 + i * 8192, R, Cb);
#pragma unroll
                for (int h = 0; h < 2; ++h) v[h][i] = (unsigned)((r0 + h * HALF + R) * (K * ESZ) + Cb); }
        }
    }
};

struct EpiProj {
    static constexpr bool PERM = true;
    bf16_t* P; bf16_t* VA; bf16_t* VB;
    __device__ __forceinline__ void operator()(const f32x4 (&acc)[2][2][4][2], const Unit& u, int urow0, int wr, int wc, int fr, int fq) const {
        bf16_t* O; int ldc; int rbase;
        const int kvrow0 = urow0 < ML ? (urow0 >> 12) * TK + CTX + (urow0 & 4095) : ((urow0 - ML) >> 8) * TK;
        if (u.pn == OFF_VA / BM) { O = VA; ldc = 256; rbase = kvrow0; }
        else if (u.pn == OFF_VB / BM || u.pn == OFF_VB / BM + 1) { O = VB + (u.pn - OFF_VB / BM) * BM; ldc = 512; rbase = kvrow0; }
        else { O = P + u.pn * BM; ldc = INW; rbase = urow0; }
        const int row0 = rbase + wr * 64 + fr; const int col0 = wc * 32 + 8 * fq;
#pragma unroll
        for (int ai = 0; ai < 2; ++ai)
#pragma unroll
            for (int m = 0; m < 4; ++m) { bf16_t* rowp = O + (size_t)(row0 + ai * HALF + m * 16) * ldc + col0;
#pragma unroll
                for (int bj = 0; bj < 2; ++bj) { const f32x4 v0 = acc[ai][bj][m][0], v1 = acc[ai][bj][m][1];
                    u32x4 w; w.x = cvt_pk_bf16(v0[0], v0[1]); w.y = cvt_pk_bf16(v0[2], v0[3]); w.z = cvt_pk_bf16(v1[0], v1[1]); w.w = cvt_pk_bf16(v1[2], v1[3]);
                    *(u32x4*)(rowp + bj * HALF) = w; } }
    }
};
static_assert(OFF_VA % BM == 0 && OFF_VB % BM == 0 && OFF_VB + 2 * BM == OFF_UC && OFF_VA + BM == OFF_QB, "value columns are whole unit columns");
struct EpiF8 {
    static constexpr bool PERM = true;
    unsigned char* O; int ldc; const float* bias; int bias_estride;
    __device__ __forceinline__ void operator()(const f32x4 (&acc)[2][2][4][2], const Unit& u, int urow0, int wr, int wc, int fr, int fq) const {
        const int row0 = urow0 + wr * 64 + fr; const int col0 = u.pn * BM + wc * 32 + 8 * fq;
        const float* bp = bias + (size_t)u.e * bias_estride + col0;
        f32x4 bv[2][2];
#pragma unroll
        for (int bj = 0; bj < 2; ++bj)
#pragma unroll
            for (int n = 0; n < 2; ++n) bv[bj][n] = *(const f32x4*)(bp + bj * HALF + 4 * n);
#pragma unroll
        for (int ai = 0; ai < 2; ++ai)
#pragma unroll
            for (int m = 0; m < 4; ++m) { unsigned char* rowp = O + (size_t)(row0 + ai * HALF + m * 16) * ldc + col0;
#pragma unroll
                for (int bj = 0; bj < 2; ++bj) { const f32x4 v0 = acc[ai][bj][m][0] + bv[bj][0], v1 = acc[ai][bj][m][1] + bv[bj][1];
                    int w0 = 0, w1 = 0; w0 = __builtin_amdgcn_cvt_pk_fp8_f32(v0[0], v0[1], w0, false); w0 = __builtin_amdgcn_cvt_pk_fp8_f32(v0[2], v0[3], w0, true);
                    w1 = __builtin_amdgcn_cvt_pk_fp8_f32(v1[0], v1[1], w1, false); w1 = __builtin_amdgcn_cvt_pk_fp8_f32(v1[2], v1[3], w1, true);
                    *(u32x2*)(rowp + bj * HALF) = (u32x2){(unsigned)w0, (unsigned)w1}; } }
    }
};
__device__ __forceinline__ float swiglu1(float g, float l) {
    g = fminf(g, 7.0f); l = fminf(fmaxf(l, -7.0f), 7.0f);
    const float sg = __builtin_amdgcn_rcpf(1.0f + __builtin_amdgcn_exp2f(-1.702f * 1.4426950408889634f * g));
    return g * sg * (l + 1.0f);
}
struct EpiSwiglu {
    static constexpr bool PERM = true;
    unsigned char* O; const float* bias;
    __device__ __forceinline__ void operator()(const f32x4 (&acc)[2][2][4][2], const Unit& u, int urow0, int wr, int wc, int fr, int fq) const {
        const int row0 = urow0 + wr * 64 + fr; const int col0 = u.pn * BM + wc * 32 + 8 * fq;
        const float* bp = bias + (size_t)u.e * 2048 + col0;
        f32x4 bv[2][2];
#pragma unroll
        for (int bj = 0; bj < 2; ++bj)
#pragma unroll
            for (int n = 0; n < 2; ++n) bv[bj][n] = *(const f32x4*)(bp + bj * HALF + 4 * n);
#pragma unroll
        for (int ai = 0; ai < 2; ++ai)
#pragma unroll
            for (int m = 0; m < 4; ++m) { unsigned char* rowp = O + (size_t)(row0 + ai * HALF + m * 16) * DE + (col0 >> 1);
#pragma unroll
                for (int bj = 0; bj < 2; ++bj) { const f32x4 v0 = acc[ai][bj][m][0] + bv[bj][0], v1 = acc[ai][bj][m][1] + bv[bj][1];
                    int w = 0; w = __builtin_amdgcn_cvt_pk_fp8_f32(swiglu1(v0[0], v0[1]), swiglu1(v0[2], v0[3]), w, false); w = __builtin_amdgcn_cvt_pk_fp8_f32(swiglu1(v1[0], v1[1]), swiglu1(v1[2], v1[3]), w, true);
                    *(int*)(rowp + bj * (HALF / 2)) = w; } }
    }
};
__device__ __forceinline__ void unpack_bf16x8(const u32x4 w, f32x4& lo, f32x4& hi) {
    lo = (f32x4){__uint_as_float(w.x << 16), __uint_as_float(w.x & 0xffff0000u), __uint_as_float(w.y << 16), __uint_as_float(w.y & 0xffff0000u)};
    hi = (f32x4){__uint_as_float(w.z << 16), __uint_as_float(w.z & 0xffff0000u), __uint_as_float(w.w << 16), __uint_as_float(w.w & 0xffff0000u)};
}
__device__ __forceinline__ u32x4 pack_bf16x8(const f32x4 lo, const f32x4 hi) {
    u32x4 w; w.x = cvt_pk_bf16(lo[0], lo[1]); w.y = cvt_pk_bf16(lo[2], lo[3]); w.z = cvt_pk_bf16(hi[0], hi[1]); w.w = cvt_pk_bf16(hi[2], hi[3]); return w;
}
struct EpiResid {
    static constexpr bool PERM = true;
    const float* xin; const float* cin; const bf16_t* xr_in; bf16_t* xr_out; const float* mod; int layer;
    __device__ __forceinline__ void operator()(const f32x4 (&acc)[2][2][4][2], const Unit& u, int urow0, int wr, int wc, int fr, int fq) const {
        const int row0 = urow0 + wr * 64 + fr, col0 = u.pn * BM + wc * 32 + 8 * fq;
        const int bidx = urow0 < ML ? (urow0 >> 12) : 4;
        const float* gp = mod + (size_t)bidx * 12288 + 2 * 2048 + col0;
        f32x4 g[2][2];
#pragma unroll
        for (int bj = 0; bj < 2; ++bj)
#pragma unroll
            for (int n = 0; n < 2; ++n) g[bj][n] = *(const f32x4*)(gp + bj * HALF + 4 * n);
        if (layer == 0) {
            const float* bbase = urow0 < ML ? xin : cin - (size_t)ML * D;
#pragma unroll
            for (int ai = 0; ai < 2; ++ai)
#pragma unroll
                for (int mp = 0; mp < 2; ++mp) {
                    f32x4 bs[2][2][2];
#pragma unroll
                    for (int mq = 0; mq < 2; ++mq) { const int row = row0 + ai * HALF + (2 * mp + mq) * 16; const float* bp = bbase + (size_t)row * D + col0;
#pragma unroll
                        for (int bj = 0; bj < 2; ++bj)
#pragma unroll
                            for (int n = 0; n < 2; ++n) bs[mq][bj][n] = *(const f32x4*)(bp + bj * HALF + 4 * n); }
#pragma unroll
                    for (int mq = 0; mq < 2; ++mq) { const int m = 2 * mp + mq; const int row = row0 + ai * HALF + m * 16; bf16_t* op = xr_out + (size_t)row * D + col0;
#pragma unroll
                        for (int bj = 0; bj < 2; ++bj) *(u32x4*)(op + bj * HALF) = pack_bf16x8(bs[mq][bj][0] + g[bj][0] * acc[ai][bj][m][0], bs[mq][bj][1] + g[bj][1] * acc[ai][bj][m][1]); }
                    asm volatile("" ::: "memory"); }
        } else {
#pragma unroll
            for (int ai = 0; ai < 2; ++ai) {
                u32x4 bw[4][2];
#pragma unroll
                for (int m = 0; m < 4; ++m) { const int row = row0 + ai * HALF + m * 16; const bf16_t* bp = xr_in + (size_t)row * D + col0;
#pragma unroll
                    for (int bj = 0; bj < 2; ++bj) bw[m][bj] = *(const u32x4*)(bp + bj * HALF); }
#pragma unroll
                for (int m = 0; m < 4; ++m) { const int row = row0 + ai * HALF + m * 16; bf16_t* op = xr_out + (size_t)row * D + col0;
#pragma unroll
                    for (int bj = 0; bj < 2; ++bj) { f32x4 b0, b1; unpack_bf16x8(bw[m][bj], b0, b1);
                        *(u32x4*)(op + bj * HALF) = pack_bf16x8(b0 + g[bj][0] * acc[ai][bj][m][0], b1 + g[bj][1] * acc[ai][bj][m][1]); } }
                asm volatile("" ::: "memory"); }
        }
    }
};

template <class Epi, class Sched>
__device__ __forceinline__ void gemm_phase(LAS unsigned char* lds, const Sched& S, const Epi& E) {
    constexpr int K = Sched::K, ESZ = Sched::ESZ;
    const int tid = tid_local(), wid = __builtin_amdgcn_readfirstlane(tid >> 6), lane = tid & 63, wr = wid >> 2, wc = wid & 3, fr = lane & 15, fq = lane >> 4;
    constexpr int nt = K * ESZ / 128;
    constexpr int SCALE_A = 127, SCALE_B = Sched::SCALE_B;
    unsigned voffB[2], voffA[2][2];
#pragma unroll
    for (int i = 0; i < 2; ++i) { int R, Cb; stage_rcb<ESZ>(tid * 16 + i * 8192, R, Cb); const int Rb = Epi::PERM ? ((R & ~31) + perm32(R & 31)) : R; voffB[i] = (unsigned)(Rb * (K * ESZ) + Cb); }
    constexpr size_t kstep = 128;
    constexpr size_t hstep = (size_t)HALF * K * ESZ;
    const unsigned ldsw = (unsigned)wid * 1024u;
    const int aoff = ESZ == 2 ? lds_byte(wr * 64 + fr, fq * 8) : lds_byte8(wr * 64 + fr, fq * 32), boff = ESZ == 2 ? lds_byte(wc * 32 + fr, fq * 8) : lds_byte8(wc * 32 + fr, fq * 32);
    const int aoff2 = aoff ^ 16, boff2 = boff ^ 16;
#define PG8_SA(b, h) (((b) * 2 + (h)) * HTB)
#define PG8_SB(b, h) ((4 + (b) * 2 + (h)) * HTB)
#define PG8_STAGE(bufoff, gbase, voff) do { _Pragma("unroll") for (int _i = 0; _i < 2; ++_i) \
        __builtin_amdgcn_global_load_lds((const unsigned*)((const char*)(gbase) + (voff)[_i]), (LAS unsigned*)(lds + (bufoff) + ldsw + _i * 8192), 16, 0, 0); } while (0)
#define PG8_LDA(dst, b, h) do { if constexpr (ESZ == 2) { _Pragma("unroll") for (int m = 0; m < 4; ++m) _Pragma("unroll") for (int k = 0; k < 2; ++k) dst[m][k] = *(const LAS bf16x8*)(lds + PG8_SA(b, h) + aoff + m * 2048 + k * 1024); } \
        else { _Pragma("unroll") for (int m = 0; m < 4; ++m) { const u32x4 _lo = *(const LAS u32x4*)(lds + PG8_SA(b, h) + aoff + m * 2048), _hi = *(const LAS u32x4*)(lds + PG8_SA(b, h) + aoff2 + m * 2048); \
            dst##8[m] = (v8i){(int)_lo.x, (int)_lo.y, (int)_lo.z, (int)_lo.w, (int)_hi.x, (int)_hi.y, (int)_hi.z, (int)_hi.w}; } } } while (0)
#define PG8_LDB(dst, b, h) do { if constexpr (ESZ == 2) { _Pragma("unroll") for (int n = 0; n < 2; ++n) _Pragma("unroll") for (int k = 0; k < 2; ++k) dst[n][k] = *(const LAS bf16x8*)(lds + PG8_SB(b, h) + boff + n * 2048 + k * 1024); } \
        else { _Pragma("unroll") for (int n = 0; n < 2; ++n) { const u32x4 _lo = *(const LAS u32x4*)(lds + PG8_SB(b, h) + boff + n * 2048), _hi = *(const LAS u32x4*)(lds + PG8_SB(b, h) + boff2 + n * 2048); \
            dst##8[n] = (v8i){(int)_lo.x, (int)_lo.y, (int)_lo.z, (int)_lo.w, (int)_hi.x, (int)_hi.y, (int)_hi.z, (int)_hi.w}; } } } while (0)
#define PG8_MMA(ai, bj, At, Bt) do { __builtin_amdgcn_s_setprio(1); if constexpr (ESZ == 2) { _Pragma("unroll") for (int m = 0; m < 4; ++m) _Pragma("unroll") for (int n = 0; n < 2; ++n) _Pragma("unroll") for (int k = 0; k < 2; ++k) \
        acc[ai][bj][m][n] = __builtin_amdgcn_mfma_f32_16x16x32_bf16(Bt[n][k], At[m][k], acc[ai][bj][m][n], 0, 0, 0); } \
        else { _Pragma("unroll") for (int m = 0; m < 4; ++m) _Pragma("unroll") for (int n = 0; n < 2; ++n) \
        acc[ai][bj][m][n] = __builtin_amdgcn_mfma_scale_f32_16x16x128_f8f6f4(Bt##8[n], At##8[m], acc[ai][bj][m][n], 0, 0, 0, SCALE_B, 0, SCALE_A); } __builtin_amdgcn_s_setprio(0); } while (0)
#define PG8_WAIT_V(n) asm volatile("s_waitcnt vmcnt(" #n ")" ::: "memory")
#define PG8_WAIT_L(n) asm volatile("s_waitcnt lgkmcnt(" #n ")" ::: "memory")
#define PG8_BAR __builtin_amdgcn_s_barrier()
#define PG8_SCHED __builtin_amdgcn_sched_barrier(0)
    Unit cur, nxt; int ui = 0;
    if (!S.next(0, cur)) return;
    f32x4 acc[2][2][4][2];
#pragma unroll
    for (int a = 0; a < 2; ++a)
#pragma unroll
        for (int b = 0; b < 2; ++b)
#pragma unroll
            for (int m = 0; m < 4; ++m)
#pragma unroll
                for (int n = 0; n < 2; ++n) acc[a][b][m][n] = (f32x4){0.f, 0.f, 0.f, 0.f};
    bf16x8 At[4][2], B0[2][2], B1[2][2];
    v8i At8[4], B08[2], B18[2];
    const char* const Ab = S.a_base();
    const char* cB = S.b_base(cur);
    S.a_voff(cur, tid, voffA);
    PG8_STAGE(PG8_SB(0, 0), cB, voffB); PG8_STAGE(PG8_SB(0, 1), cB + hstep, voffB); PG8_STAGE(PG8_SA(0, 0), Ab, voffA[0]); PG8_STAGE(PG8_SA(0, 1), Ab, voffA[1]);
    if (wr == 1) PG8_BAR;
    PG8_WAIT_V(2); PG8_BAR;
    PG8_STAGE(PG8_SB(1, 0), cB + kstep, voffB); PG8_STAGE(PG8_SA(1, 0), Ab + kstep, voffA[0]); PG8_STAGE(PG8_SB(1, 1), cB + hstep + kstep, voffB);
    PG8_WAIT_V(6); PG8_BAR;
    for (;;) {
        const bool has_next = S.next(ui + 1, nxt);
        const char* nB = has_next ? S.b_base(nxt) : cB;
        unsigned voffN[2][2];
        if constexpr (Sched::GATHER_A) { if (has_next) S.a_voff(nxt, tid, voffN); }
#pragma unroll 1
        for (int t = 0; t < nt; t += 2) {
            const bool last = (t == nt - 2);
            const char* a1 = Ab + (size_t)(t + 1) * kstep;
            const char* a2 = last ? Ab : Ab + (size_t)(t + 2) * kstep; const char* b2 = last ? nB : cB + (size_t)(t + 2) * kstep;
            const char* a3 = a2 + kstep; const char* b3 = b2 + kstep;
            PG8_LDB(B0, 0, 0); PG8_LDB(B1, 0, 1); PG8_SCHED; PG8_LDA(At, 0, 0); PG8_STAGE(PG8_SA(1, 1), a1, voffA[1]);
            if (last && has_next) {
                if constexpr (Sched::GATHER_A) { voffA[0][0] = voffN[0][0]; voffA[0][1] = voffN[0][1]; voffA[1][0] = voffN[1][0]; voffA[1][1] = voffN[1][1]; }
                else S.a_voff(nxt, tid, voffA); }
            PG8_WAIT_V(8); PG8_WAIT_L(0); PG8_BAR; PG8_MMA(0, 0, At, B0); PG8_MMA(0, 1, At, B1); PG8_BAR; PG8_SCHED;
            PG8_LDA(At, 0, 1); PG8_STAGE(PG8_SB(0, 0), b2, voffB); PG8_STAGE(PG8_SB(0, 1), b2 + hstep, voffB); PG8_STAGE(PG8_SA(0, 0), a2, voffA[0]);
            PG8_WAIT_V(8); PG8_WAIT_L(0); PG8_BAR; PG8_MMA(1, 0, At, B0); PG8_MMA(1, 1, At, B1); PG8_BAR; PG8_SCHED;
            PG8_LDB(B0, 1, 0); PG8_LDB(B1, 1, 1); PG8_SCHED; PG8_LDA(At, 1, 0); PG8_STAGE(PG8_SA(0, 1), a2, voffA[1]);
            PG8_WAIT_V(8); PG8_WAIT_L(0); PG8_BAR; PG8_MMA(0, 0, At, B0); PG8_MMA(0, 1, At, B1); PG8_BAR; PG8_SCHED;
            PG8_LDA(At, 1, 1); PG8_STAGE(PG8_SB(1, 0), b3, voffB); PG8_STAGE(PG8_SB(1, 1), b3 + hstep, voffB); PG8_STAGE(PG8_SA(1, 0), a3, voffA[0]);
            PG8_WAIT_V(8); PG8_WAIT_L(0); PG8_BAR; PG8_MMA(1, 0, At, B0); PG8_MMA(1, 1, At, B1); PG8_BAR; PG8_SCHED;
        }
        if (wr == 0) PG8_BAR;
        E(acc, cur, S.row0(cur), wr, wc, fr, fq);
        if constexpr (Epi::PERM) { if ((MK_REPEAT >> 12) & 1) E(acc, cur, S.row0(cur), wr, wc, fr, fq); }
        if (!has_next) break;
#pragma unroll
        for (int a = 0; a < 2; ++a)
#pragma unroll
            for (int b = 0; b < 2; ++b)
#pragma unroll
                for (int m = 0; m < 4; ++m)
#pragma unroll
                    for (int n = 0; n < 2; ++n) acc[a][b][m][n] = (f32x4){0.f, 0.f, 0.f, 0.f};
        cur = nxt; cB = nB; ++ui;
        if (wr == 1) PG8_BAR;
    }
    PG8_WAIT_V(0);
    PG8_BAR;
#undef PG8_SA
#undef PG8_SB
#undef PG8_STAGE
#undef PG8_LDA
#undef PG8_LDB
#undef PG8_MMA
#undef PG8_WAIT_V
#undef PG8_WAIT_L
#undef PG8_BAR
#undef PG8_SCHED
}
}

namespace att {
constexpr int NW = 8, QBLK = 32, KVBLK = 64, DV = 128;
constexpr float THR = 8.f;
constexpr int SHM_V = KVBLK * DV * 2, SHM_K = KVBLK * 128 * 2, SHM_ATTN = 2 * SHM_V + 2 * SHM_K + NW * 64 * 4;
#define SBAR() __builtin_amdgcn_sched_barrier(0)
__device__ __forceinline__ int crow(int r, int hi) { return (r & 3) + 8 * (r >> 2) + 4 * hi; }
template <int DQK> __device__ __forceinline__ int kswz(int row, int colB) {
    if constexpr (DQK == 128) return row * 256 + (colB ^ ((row & 15) << 4));
    else return row * 128 + (colB ^ (((row >> 1) & 7) << 4));
}
template <int DQK> __device__ __forceinline__ void partialSM(f32x16& p0, f32x16& p1, float& m_reg, float& mn, float& alpha) {
    constexpr float SCALE = (DQK == 128) ? 0.088388347648318440f : 0.125f;
    constexpr float Cc = SCALE * 1.4426950408889634f;
    float pmax = p0[0];
#pragma unroll
    for (int r = 1; r < 16; ++r) pmax = fmaxf(pmax, p0[r]);
#pragma unroll
    for (int r = 0; r < 16; ++r) pmax = fmaxf(pmax, p1[r]);
    { auto rr = __builtin_amdgcn_permlane32_swap(__float_as_uint(pmax), __float_as_uint(pmax), false, false);
      pmax = fmaxf(__uint_as_float(rr[0]), __uint_as_float(rr[1])); }
    if (__builtin_expect(__all(pmax - m_reg <= THR / SCALE), 1)) { mn = m_reg; alpha = 1.f; }
    else { mn = fmaxf(m_reg, pmax); alpha = __builtin_amdgcn_exp2f((m_reg - mn) * Cc); m_reg = mn; }
    const float mnC = -mn * Cc;
#pragma unroll
    for (int r = 0; r < 16; ++r) p0[r] = fmaf(p0[r], Cc, mnC);
#pragma unroll
    for (int r = 0; r < 16; ++r) p1[r] = fmaf(p1[r], Cc, mnC);
#pragma unroll
    for (int r = 0; r < 16; ++r) p0[r] = __builtin_amdgcn_exp2f(p0[r]);
}
__device__ __forceinline__ void finishSM(f32x16& p0, f32x16& p1, float alpha, float& l_reg, bf16x8& pa0, bf16x8& pa1, bf16x8& pa2, bf16x8& pa3) {
#pragma unroll
    for (int r = 0; r < 16; ++r) p1[r] = __builtin_amdgcn_exp2f(p1[r]);
    float ps = 0;
#pragma unroll
    for (int r = 0; r < 16; ++r) ps += p0[r];
#pragma unroll
    for (int r = 0; r < 16; ++r) ps += p1[r];
    { auto rr = __builtin_amdgcn_permlane32_swap(__float_as_uint(ps), __float_as_uint(ps), false, false);
      ps = __uint_as_float(rr[0]) + __uint_as_float(rr[1]); }
    l_reg = l_reg * alpha + ps;
#define PK4(P, BASE, OUT) do { unsigned a0 = cvt_pk_bf16(P[BASE + 0], P[BASE + 1]), a1 = cvt_pk_bf16(P[BASE + 2], P[BASE + 3]);   \
    unsigned b0 = cvt_pk_bf16(P[BASE + 4], P[BASE + 5]), b1 = cvt_pk_bf16(P[BASE + 6], P[BASE + 7]);                              \
    auto r0 = __builtin_amdgcn_permlane32_swap(a0, b0, false, false); auto r1 = __builtin_amdgcn_permlane32_swap(a1, b1, false, false); \
    u32x4 w = {r0[0], r1[0], r0[1], r1[1]}; OUT = *reinterpret_cast<bf16x8*>(&w); } while (0)
    PK4(p0, 0, pa0); PK4(p0, 8, pa1); PK4(p1, 0, pa2); PK4(p1, 8, pa3);
#undef PK4
}
template <int DQK> __device__ __forceinline__ void qkt(f32x16& p0, f32x16& p1, const char* Ks, const bf16x8* qr, int r32, int hi) {
    p0 = f32x16{}; p1 = f32x16{};
#pragma unroll
    for (int d0 = 0; d0 < DQK / 16; ++d0) { const int cb = (d0 * 16 + hi * 8) * 2;
        const bf16x8 b0 = *reinterpret_cast<const bf16x8*>(Ks + kswz<DQK>(r32, cb));
        const bf16x8 b1 = *reinterpret_cast<const bf16x8*>(Ks + kswz<DQK>(32 + r32, cb));
        p0 = __builtin_amdgcn_mfma_f32_32x32x16_bf16(b0, qr[d0], p0, 0, 0, 0);
        p1 = __builtin_amdgcn_mfma_f32_32x32x16_bf16(b1, qr[d0], p1, 0, 0, 0); }
}
__device__ __forceinline__ int v_st(int k, int c) { const int kk = (k & ~0xC) | ((k & 4) << 1) | ((k & 8) >> 1); return ((kk >> 3) * 4 + (c >> 5)) * 512 + ((kk & 7) * 32 + (c & 31)) * 2; }
__device__ __forceinline__ int v_rd_base(int lane) { return ((lane & 3) << 3) | (((lane >> 2) & 3) << 6) | (((lane >> 4) & 1) << 5) | (((lane >> 5) & 1) << 8); }
constexpr int v_rd_off(int d0, int ks, int half) { return d0 * 512 + ks * 4096 + half * 2048; }
template <int OFF> __device__ __forceinline__ s16x4 tr_read(int vb) {
    s16x4 r; asm volatile("ds_read_b64_tr_b16 %0, %1 offset:%2" : "=&v"(r) : "v"(vb), "i"(OFF) : "memory"); return r;
}
template <int KS> __device__ __forceinline__ void pv_step(f32x16* o, int vb, bf16x8 pa) {
    const s16x4 l0 = tr_read<v_rd_off(0, KS, 0)>(vb), h0 = tr_read<v_rd_off(0, KS, 1)>(vb), l1 = tr_read<v_rd_off(1, KS, 0)>(vb), h1 = tr_read<v_rd_off(1, KS, 1)>(vb);
    const s16x4 l2 = tr_read<v_rd_off(2, KS, 0)>(vb), h2 = tr_read<v_rd_off(2, KS, 1)>(vb), l3 = tr_read<v_rd_off(3, KS, 0)>(vb), h3 = tr_read<v_rd_off(3, KS, 1)>(vb);
    asm volatile("s_waitcnt lgkmcnt(0)" ::: "memory"); SBAR();
#define PK(L, H) (bf16x8){L[0], L[1], L[2], L[3], H[0], H[1], H[2], H[3]}
    o[0] = __builtin_amdgcn_mfma_f32_32x32x16_bf16(pa, PK(l0, h0), o[0], 0, 0, 0);
    o[1] = __builtin_amdgcn_mfma_f32_32x32x16_bf16(pa, PK(l1, h1), o[1], 0, 0, 0);
    o[2] = __builtin_amdgcn_mfma_f32_32x32x16_bf16(pa, PK(l2, h2), o[2], 0, 0, 0);
    o[3] = __builtin_amdgcn_mfma_f32_32x32x16_bf16(pa, PK(l3, h3), o[3], 0, 0, 0);
#undef PK
}
__device__ __forceinline__ void pv_d0(f32x16* o, int vb, bf16x8 pa0, bf16x8 pa1, bf16x8 pa2, bf16x8 pa3) {
    pv_step<0>(o, vb, pa0); pv_step<1>(o, vb, pa1); pv_step<2>(o, vb, pa2); pv_step<3>(o, vb, pa3);
}
template <int DQK, int LDQ, int LDK, int LDV, int LDO, bool OUT_BF16>
__device__ __forceinline__ void attn_body(const bf16_t* __restrict__ Qb, const bf16_t* __restrict__ Kh, const bf16_t* __restrict__ Vh, void* __restrict__ Ob, int seq, char* lds) {
    const int tid = tid_local(), wid = tid >> 6, lane = tid & 63, r32 = lane & 31, hi = lane >> 5;
    Qb = uniform_ptr(Qb); Kh = uniform_ptr(Kh); Vh = uniform_ptr(Vh); Ob = uniform_ptr(Ob);
    char* V_lds = lds; char* K_lds = lds + 2 * SHM_V;
    float* ws = (float*)(lds + 2 * SHM_V + 2 * SHM_K) + wid * 64; float* li_l = ws; float* al_l = ws + 32;
    float m_reg = -1e30f, l_reg = 0; f32x16 o[4] = {}; bf16x8 qr[DQK / 16];
    const unsigned qoff = (unsigned)((wid * QBLK + r32) * LDQ + hi * 8) * 2u;
#pragma unroll
    for (int d0 = 0; d0 < DQK / 16; ++d0) qr[d0] = *reinterpret_cast<const bf16x8*>((const char*)Qb + qoff + d0 * 32);
    const int sr = tid >> 4, sc = (tid & 15) * 8, vst0 = v_st(sr, sc), vst1 = v_st(32 + sr, sc);
    const int kr = (DQK == 128) ? sr : (tid >> 3), kc = (DQK == 128) ? sc : (tid & 7) * 8;
    const unsigned voffV = (unsigned)(sr * LDV + sc) * 2u, voffK = (unsigned)(kr * LDK + kc) * 2u;
    const int vb0 = (int)(uintptr_t)V_lds + v_rd_base(lane);
    struct { bf16x8 vs0, vs1, ks0, ks1; } sr_[2];
#define SLOAD(i, k0) do { const char* _vb = (const char*)Vh + (size_t)(k0) * (LDV * 2); const char* _kb = (const char*)Kh + (size_t)(k0) * (LDK * 2); \
    sr_[i].vs0 = *reinterpret_cast<const bf16x8*>(_vb + voffV); sr_[i].vs1 = *reinterpret_cast<const bf16x8*>(_vb + voffV + 32 * LDV * 2); \
    sr_[i].ks0 = *reinterpret_cast<const bf16x8*>(_kb + voffK); if constexpr (DQK == 128) sr_[i].ks1 = *reinterpret_cast<const bf16x8*>(_kb + voffK + 32 * LDK * 2); } while (0)
#define SWRITE(b, i) do { *(bf16x8*)(V_lds + (b) * SHM_V + vst0) = sr_[i].vs0;          \
    *(bf16x8*)(V_lds + (b) * SHM_V + vst1) = sr_[i].vs1;               \
    *(bf16x8*)(K_lds + (b) * SHM_K + kswz<DQK>(kr, kc * 2)) = sr_[i].ks0;                       \
    if constexpr (DQK == 128) *(bf16x8*)(K_lds + (b) * SHM_K + kswz<DQK>(32 + kr, kc * 2)) = sr_[i].ks1; } while (0)
#define SWAIT() do { if constexpr (DQK == 128) asm volatile("s_waitcnt vmcnt(4)" ::: "memory"); else asm volatile("s_waitcnt vmcnt(3)" ::: "memory"); } while (0)
#define RESC(a) do { if (__any((a) < 1.f)) { if (hi == 0) al_l[r32] = (a); asm volatile("s_waitcnt lgkmcnt(0)" ::: "memory"); \
    _Pragma("unroll") for (int d = 0; d < 4; ++d) _Pragma("unroll") for (int r = 0; r < 16; ++r) o[d][r] *= al_l[crow(r, hi)]; } } while (0)
    f32x16 pA0, pA1, pB0, pB1; float mnA, mnB, alA, alB; bf16x8 pa0, pa1, pa2, pa3; const int NT = seq / KVBLK;
    constexpr int SE = 0, SO = 1;
    SLOAD(SE, 0); asm volatile("s_waitcnt vmcnt(0)" ::: "memory"); SWRITE(0, SE); __syncthreads();
    qkt<DQK>(pA0, pA1, K_lds, qr, r32, hi); partialSM<DQK>(pA0, pA1, m_reg, mnA, alA);
    SLOAD(SO, KVBLK); if (2 < NT) SLOAD(SE, 2 * KVBLK);
    SWAIT(); SWRITE(1, SO); __syncthreads();
    for (int j = 1; j + 1 < NT; j += 2) {
        SBAR(); qkt<DQK>(pB0, pB1, K_lds + SHM_K, qr, r32, hi);
        finishSM(pA0, pA1, alA, l_reg, pa0, pa1, pa2, pa3); SBAR();
        SLOAD(SO, (j + 2) * KVBLK); SBAR();
        pv_d0(o, vb0, pa0, pa1, pa2, pa3); partialSM<DQK>(pB0, pB1, m_reg, mnB, alB);
        __syncthreads(); SWAIT(); SWRITE(0, SE);
        RESC(alB); __syncthreads();
        SBAR(); qkt<DQK>(pA0, pA1, K_lds, qr, r32, hi);
        finishSM(pB0, pB1, alB, l_reg, pa0, pa1, pa2, pa3); SBAR();
        if (j + 3 < NT) SLOAD(SE, (j + 3) * KVBLK); SBAR();
        pv_d0(o, vb0 + (int)SHM_V, pa0, pa1, pa2, pa3); partialSM<DQK>(pA0, pA1, m_reg, mnA, alA);
        __syncthreads(); SWAIT(); SWRITE(1, SO);
        RESC(alA); __syncthreads();
    }
    SBAR(); qkt<DQK>(pB0, pB1, K_lds + SHM_K, qr, r32, hi);
    finishSM(pA0, pA1, alA, l_reg, pa0, pa1, pa2, pa3); SBAR();
    pv_d0(o, vb0, pa0, pa1, pa2, pa3); partialSM<DQK>(pB0, pB1, m_reg, mnB, alB);
    __syncthreads(); RESC(alB);
    finishSM(pB0, pB1, alB, l_reg, pa0, pa1, pa2, pa3); SBAR();
    pv_d0(o, vb0 + (int)SHM_V, pa0, pa1, pa2, pa3);
    if (hi == 0) li_l[r32] = l_reg; asm volatile("s_waitcnt lgkmcnt(0)" ::: "memory");
    float rli[16];
#pragma unroll
    for (int r = 0; r < 16; ++r) rli[r] = __builtin_amdgcn_rcpf(li_l[crow(r, hi)]);
    if constexpr (OUT_BF16) {
#pragma unroll
        for (int r = 0; r < 16; ++r) { const unsigned ob = (unsigned)((wid * QBLK + crow(r, hi)) * LDO + r32); const float sc16 = rli[r] * 16.0f;
#pragma unroll
            for (int d0 = 0; d0 < 4; ++d0) *((unsigned char*)Ob + ob + d0 * 32) = (unsigned char)(__builtin_amdgcn_cvt_pk_fp8_f32(o[d0][r] * sc16, 0.f, 0, false) & 0xff); }
    } else {
#pragma unroll
        for (int r = 0; r < 16; ++r) { const unsigned ob = (unsigned)((wid * QBLK + crow(r, hi)) * LDO + r32) * 4u;
#pragma unroll
            for (int d0 = 0; d0 < 4; ++d0) *(float*)((char*)Ob + ob + d0 * 128) = o[d0][r] * rli[r]; }
    }
#undef SLOAD
#undef SWRITE
#undef SWAIT
#undef RESC
}
}

struct Args { const float* in[26]; float* out; unsigned char* ws; int ph_lo, ph_hi; };
enum { I_X = 0, I_C, I_CTX, I_CCTX, I_WMOD, I_BMOD, I_G1, I_G2, I_WIN, I_GQ, I_GK, I_LQ1, I_LK1, I_LQ2, I_LK2, I_GSUB, I_WPOOL, I_PSCALE, I_WOUT, I_WR, I_BR, I_W1, I_B1, I_W2, I_B2, I_GF };
constexpr int NPHASE = 22;

struct TItem { const char* src; unsigned char* dst; unsigned soff, doff, nb4, ldb; float scale; };
__device__ __forceinline__ TItem titem(int it, const float* win, const float* wout, const float* w1, const float* w2, unsigned char* ws, int lane) {
    constexpr int I_IN = 32 * (INW / 64), I_OUT = 24 * (D / 64), I_E1 = 32 * 32, I_E2 = 16 * 32;
    constexpr int T_IN = 2 * I_IN, T_OUT = 2 * I_OUT, T_E1 = 64 * I_E1;
    const float* W; unsigned char* WT; int N, ldb, item; float scale; int r = it;
    if (r < T_IN) { const int l = r / I_IN; W = win + (size_t)l * D * INW; N = INW; WT = ws + WS_WIN + (size_t)l * INW * D; ldb = D; item = r % I_IN; scale = 64.0f; }
    else if ((r -= T_IN) < T_OUT) { const int l = r / I_OUT; W = wout + (size_t)l * D * D; N = D; WT = ws + WS_WOUT + (size_t)l * D * D; ldb = D; item = r % I_OUT; scale = (item / (D / 32) < 8) ? 4.0f : 64.0f; }
    else if ((r -= T_OUT) < T_E1) { const int le = r / I_E1; W = w1 + (size_t)le * D * 2048; N = 2048; WT = ws + WS_W1 + (size_t)le * 2048 * D; ldb = D; item = r % I_E1; scale = 64.0f; }
    else { r -= T_E1; const int le = r / I_E2; W = w2 + (size_t)le * DE * D; N = D; WT = ws + WS_W2 + (size_t)le * D * DE; ldb = DE; item = r % I_E2; scale = 32.0f; }
    const int nblk = N / 32, kb = item / nblk, nb = item % nblk, k0 = 128 * kb + 16 * (lane >> 3), n0 = 32 * nb + 4 * (lane & 7);
    TItem t; t.src = (const char*)uniform_ptr(W); t.dst = uniform_ptr(WT); t.soff = (unsigned)(k0 * N + n0) * 4u; t.doff = (unsigned)(n0 * ldb + k0); t.nb4 = (unsigned)N * 4u; t.ldb = (unsigned)ldb; t.scale = scale; return t;
}
#define TI_LOAD(v, t) do { _Pragma("unroll") for (int _i = 0; _i < 16; ++_i) v[_i] = *(const f32x4*)((t).src + ((t).soff + (unsigned)_i * (t).nb4)); } while (0)
#define TI_STORE(v, t) do { const float _sc = (t).scale; _Pragma("unroll") for (int _c = 0; _c < 4; ++_c) { int _w[4]; \
        _Pragma("unroll") for (int _q = 0; _q < 4; ++_q) { int _x = 0; _x = __builtin_amdgcn_cvt_pk_fp8_f32(v[4 * _q][_c] * _sc, v[4 * _q + 1][_c] * _sc, _x, false); \
            _x = __builtin_amdgcn_cvt_pk_fp8_f32(v[4 * _q + 2][_c] * _sc, v[4 * _q + 3][_c] * _sc, _x, true); _w[_q] = _x; } \
        *(u32x4*)((t).dst + ((t).doff + (unsigned)_c * (t).ldb)) = (u32x4){(unsigned)_w[0], (unsigned)_w[1], (unsigned)_w[2], (unsigned)_w[3]}; } } while (0)
__device__ __forceinline__ float silu_f(float x) { return x / (1.0f + __expf(-x)); }

__device__ __forceinline__ void fold_item(int it, const float* wpool, const float* pscale, const float* wout, unsigned char* WOUT) {
    const int n = it & 2047, cc = (it >> 11) & 15, g = (it >> 15) & 3, l = it >> 17;
    const float* wp = wpool + (((size_t)l * 4 + g) * 128 + cc * 8) * 128;
    const float* ps = pscale + (size_t)l * 512 + g * 128;
    const float* wo = wout + ((size_t)l * D + 1536 + g * 128) * D + n;
    float acc[8];
#pragma unroll
    for (int q = 0; q < 8; ++q) acc[q] = 0.f;
#pragma unroll 1
    for (int d0 = 0; d0 < 128; d0 += 32) { float av[32];
#pragma unroll
        for (int dd = 0; dd < 32; ++dd) av[dd] = wo[(size_t)(d0 + dd) * D];
#pragma unroll
        for (int dd = 0; dd < 32; ++dd) { const float x = ps[d0 + dd] * av[dd];
#pragma unroll
            for (int q = 0; q < 8; ++q) acc[q] = fmaf(wp[q * 128 + d0 + dd], x, acc[q]); } }
    int o0 = 0, o1 = 0; o0 = __builtin_amdgcn_cvt_pk_fp8_f32(acc[0] * 64.f, acc[1] * 64.f, o0, false); o0 = __builtin_amdgcn_cvt_pk_fp8_f32(acc[2] * 64.f, acc[3] * 64.f, o0, true);
    o1 = __builtin_amdgcn_cvt_pk_fp8_f32(acc[4] * 64.f, acc[5] * 64.f, o1, false); o1 = __builtin_amdgcn_cvt_pk_fp8_f32(acc[6] * 64.f, acc[7] * 64.f, o1, true);
    *(u32x2*)(WOUT + ((size_t)l * D + n) * D + 1536 + g * 128 + cc * 8) = (u32x2){(unsigned)o0, (unsigned)o1};
}

PHASE_FN phase_prologue(LAS unsigned char* lds, int l_unused, int G) {
    lds = (LAS unsigned char*)__builtin_amdgcn_readfirstlane((int)(uintptr_t)lds); G = __builtin_amdgcn_readfirstlane(G);
    const int tid = tid_local(), lane = tid & 63, wave = __builtin_amdgcn_readfirstlane(tid >> 6);
    unsigned char* ws = WSP();
    const int gw = blockIdx.x * NWAVES + wave, NGW = G * NWAVES;
    {
        float* MODP = (float*)(ws + WS_MODP);
        const float* cvec = INP(I_C); const float* cctx = INP(I_CCTX); const float* wmod = INP(I_WMOD);
        LAS float* st = (LAS float*)lds;
        for (int i = tid; i < 5 * D; i += NTHREADS) st[i] = silu_f(i < 4 * D ? cvec[i] : cctx[i - 4 * D]);
        __syncthreads();
        for (int u = gw; u < 2 * 64 * 48; u += NGW) {
            const int l = u / (64 * 48), r = u % (64 * 48), kc = r / 48, cg = r % 48;
            const int col = cg * 256 + lane * 4;
            const float* W = wmod + (size_t)l * D * 12288 + (size_t)(kc * 32) * 12288 + col;
            f32x4 acc[5];
#pragma unroll
            for (int v = 0; v < 5; ++v) acc[v] = (f32x4){0.f, 0.f, 0.f, 0.f};
#pragma unroll 1
            for (int k8 = 0; k8 < 32; k8 += 16) {
                f32x4 w[16];
#pragma unroll
                for (int kk = 0; kk < 16; ++kk) w[kk] = *(const f32x4*)(W + (size_t)(k8 + kk) * 12288);
#pragma unroll
                for (int kk = 0; kk < 16; ++kk) { const int k = kc * 32 + k8 + kk;
#pragma unroll
                    for (int v = 0; v < 5; ++v) acc[v] += st[v * D + k] * w[kk]; } }
#pragma unroll
            for (int v = 0; v < 5; ++v) *(f32x4*)(MODP + ((size_t)kc * 10 + l * 5 + v) * 12288 + col) = acc[v];
        }
        __syncthreads();
    }
    {
        f32x2* tabA = (f32x2*)(ws + WS_ROPE); f32x2* tabB = tabA + 64 * 32;
        for (int i = blockIdx.x * NTHREADS + tid; i < 64 * 32 + 64 * 16; i += G * NTHREADS) {
            if (i < 64 * 32) { const int pos = i >> 5, f = i & 31; const float inv = powf(10000.0f, -(float)f / 32.0f); const float ang = (float)pos * inv; tabA[i] = (f32x2){cosf(ang), sinf(ang)}; }
            else { const int q = i - 64 * 32; const int pos = q >> 4, f = q & 15; const float inv = powf(10000.0f, -(float)f / 16.0f); const float ang = (float)pos * inv; tabB[q] = (f32x2){cosf(ang), sinf(ang)}; }
        }
    }
    {
        const float* wr = INP(I_WR); bf16_t* WRS = (bf16_t*)(ws + WS_WRS);
        for (int i = blockIdx.x * NTHREADS + tid; i < 2 * D * NE; i += G * NTHREADS) {
            const int l = i / (D * NE), rem = i % (D * NE), k = rem >> 5, e = rem & 31;
            WRS[((size_t)l * NE + e) * D + k] = f2bf(wr[i]); }
    }
    {
        const float* win = INP(I_WIN); const float* wout = INP(I_WOUT); const float* w1 = INP(I_W1); const float* w2 = INP(I_W2);
        constexpr int TOT = 2 * 32 * (INW / 64);
        f32x4 va[16], vb[16]; TItem ta, tb;
        int it = gw;
        if (it < TOT) { ta = titem(it, win, wout, w1, w2, ws, lane); TI_LOAD(va, ta); }
        while (it < TOT) {
            const int i1 = it + NGW;
            if (i1 < TOT) { tb = titem(i1, win, wout, w1, w2, ws, lane); TI_LOAD(vb, tb); }
            TI_STORE(va, ta);
            if (i1 >= TOT) break;
            const int i2 = i1 + NGW;
            if (i2 < TOT) { ta = titem(i2, win, wout, w1, w2, ws, lane); TI_LOAD(va, ta); }
            TI_STORE(vb, tb);
            it = i2;
        }
    }
}

PHASE_FN phase_modreduce(LAS unsigned char* lds, int l_unused, int G) {
    lds = (LAS unsigned char*)__builtin_amdgcn_readfirstlane((int)(uintptr_t)lds); G = __builtin_amdgcn_readfirstlane(G);
    const int tid = tid_local();
    unsigned char* ws = WSP();
    const float* MODP = (const float*)(ws + WS_MODP); float* MOD = (float*)(ws + WS_MOD); const float* bmod = INP(I_BMOD); const float* g2 = INP(I_G2);
    for (int i = blockIdx.x * NTHREADS + tid; i < 10 * 12288 / 4; i += G * NTHREADS) {
        const int lv = i / 3072, col = (i % 3072) * 4, l = lv / 5;
        f32x4 s = *(const f32x4*)(bmod + (size_t)l * 12288 + col);
#pragma unroll 16
        for (int kc = 0; kc < 64; ++kc) s += *(const f32x4*)(MODP + ((size_t)kc * 10 + lv) * 12288 + col);
        if (col >= 4 * 2048 && col < 5 * 2048) s = *(const f32x4*)(g2 + (size_t)l * D + (col - 4 * 2048)) * (s + 1.0f);
        *(f32x4*)(MOD + (size_t)lv * 12288 + col) = s;
    }
}

__device__ __forceinline__ void norm_mod_store(const f32x4 (&v)[8], const f32x4 (&gg)[8], const f32x4 (&sh)[8], const f32x4 (&sc)[8], unsigned char* orow, int lane) {
    float ss = 0.f;
#pragma unroll
    for (int j = 0; j < 8; ++j) ss += (v[j].x * v[j].x + v[j].y * v[j].y) + (v[j].z * v[j].z + v[j].w * v[j].w);
    const float rs = rsqrtf(wave_sum(ss) * (1.0f / D) + EPS);
#pragma unroll
    for (int j = 0; j < 8; ++j) { const int col = 4 * (lane + 64 * j);
        const f32x4 y = (v[j] * rs) * gg[j]; const f32x4 n = y * (sc[j] + 1.0f) + sh[j];
        int w = 0; w = __builtin_amdgcn_cvt_pk_fp8_f32(n.x, n.y, w, false); w = __builtin_amdgcn_cvt_pk_fp8_f32(n.z, n.w, w, true);
        *(int*)(orow + col) = w; }
}

PHASE_FN phase_norm1_l0(LAS unsigned char* lds, int l_unused, int G) {
    lds = (LAS unsigned char*)__builtin_amdgcn_readfirstlane((int)(uintptr_t)lds); G = __builtin_amdgcn_readfirstlane(G);
    const int tid = tid_local(), lane = tid & 63, wave = __builtin_amdgcn_readfirstlane(tid >> 6);
    unsigned char* ws = WSP();
    const float* MOD = (const float*)(ws + WS_MOD);
    unsigned char* N = ws + WS_N;
    const float* x = INP(I_X); const float* ctx = INP(I_CTX); const float* g1 = INP(I_G1);
    f32x4 gg[8];
#pragma unroll
    for (int j = 0; j < 8; ++j) gg[j] = *(const f32x4*)(g1 + 4 * (lane + 64 * j));
    for (int row = blockIdx.x * NWAVES + wave; row < MT; row += G * NWAVES) {
        const float* src = row < ML ? x + (size_t)row * D : ctx + (size_t)(row - ML) * D;
        const int bidx = row < ML ? (row >> 12) : 4;
        const float* m = MOD + (size_t)bidx * 12288;
        f32x4 v[8], sh[8], sc[8];
#pragma unroll
        for (int j = 0; j < 8; ++j) { v[j] = *(const f32x4*)(src + 4 * (lane + 64 * j)); sh[j] = *(const f32x4*)(m + 4 * (lane + 64 * j)); sc[j] = *(const f32x4*)(m + 2048 + 4 * (lane + 64 * j)); }
        norm_mod_store(v, gg, sh, sc, N + (size_t)row * D, lane);
    }
}

PHASE_FN phase_inproj(LAS unsigned char* lds, int l, int G) {
    lds = (LAS unsigned char*)__builtin_amdgcn_readfirstlane((int)(uintptr_t)lds); l = __builtin_amdgcn_readfirstlane(l); G = __builtin_amdgcn_readfirstlane(G);
    unsigned char* ws = WSP();
    pg8::DenseSched<D, 1> S; S.init(ws + WS_N, ws + WS_WIN + (size_t)l * INW * D, MT, INW, G, (int)blockIdx.x);
    pg8::EpiProj E{(bf16_t*)(ws + WS_P), (bf16_t*)(ws + WS_VA), (bf16_t*)(ws + WS_VB)};
    pg8::gemm_phase(lds, S, E);
}

PHASE_FN phase_prep(LAS unsigned char* lds, int l, int G) {
    lds = (LAS unsigned char*)__builtin_amdgcn_readfirstlane((int)(uintptr_t)lds); l = __builtin_amdgcn_readfirstlane(l); G = __builtin_amdgcn_readfirstlane(G);
    const int tid = tid_local(), lane = tid & 63, wave = __builtin_amdgcn_readfirstlane(tid >> 6);
    unsigned char* ws = WSP();
    const bf16_t* P = (const bf16_t*)(ws + WS_P);
    unsigned* QA = (unsigned*)(ws + WS_QA); unsigned* KA = (unsigned*)(ws + WS_KA); unsigned* VA = (unsigned*)(ws + WS_VA);
    unsigned* QB = (unsigned*)(ws + WS_QB); unsigned* KB = (unsigned*)(ws + WS_KB); unsigned* VB = (unsigned*)(ws + WS_VB); unsigned char* CAT = ws + WS_CAT;
    const f32x2* tabA = (const f32x2*)(ws + WS_ROPE); const f32x2* tabB = tabA + 64 * 32;
    const f32x2 gq2 = *(const f32x2*)(INP(I_GQ) + l * 128 + 2 * lane), gk2 = *(const f32x2*)(INP(I_GK) + l * 128 + 2 * lane);
    const bool firstA = (lane & 16) == 0, firstB = (lane & 8) == 0;
    for (int unit = blockIdx.x; unit < MT / 8; unit += G) {
        const int ch = tid, hw = 1 << (ch >> 7);
        const int row0 = unit * 8; int base, s0, L;
        if (row0 < ML) { base = row0 & ~4095; s0 = row0 & 4095; L = SEQ; } else { const int r2 = row0 - ML; base = ML + (r2 & ~255); s0 = r2 & 255; L = CTX; }
        float pv_[23];
        { const bf16_t* pc = P + (size_t)base * INW + OFF_UC + ch;
#pragma unroll
            for (int j = 0; j < 23; ++j) { int sj = s0 - 8 + j; sj = sj < 0 ? 0 : (sj >= L ? L - 1 : sj);
                pv_[j] = bf2f(pc[(size_t)sj * INW]); } }
        {
            const int row = unit * 8 + wave;
            const bool lat = row < ML; int b, sq, trow;
            if (lat) { b = row >> 12; sq = row & 4095; trow = b * TK + CTX + sq; } else { const int r2 = row - ML; b = r2 >> 8; sq = r2 & 255; trow = b * TK + sq; }
            const unsigned* p = (const unsigned*)(P + (size_t)row * INW);
            unsigned ha[10], hb[8];
#pragma unroll
            for (int hh = 0; hh < 10; ++hh) ha[hh] = p[(hh < 8 ? hh * 64 : OFF_KA / 2 + (hh - 8) * 64) + lane];
#pragma unroll
            for (int jp = 0; jp < 8; ++jp) hb[jp] = p[(jp < 4 ? OFF_QB / 2 + jp * 64 : OFF_KB / 2 + (jp - 4) * 64) + lane];
            const int prow = sq >> 6, pcol = sq & 63;
            const f32x4 csA = *(const f32x4*)(tabA + (lane < 32 ? prow : pcol) * 32 + 2 * (lane & 15));
            const f32x4 csB = *(const f32x4*)(tabB + ((lane & 16) == 0 ? prow : pcol) * 16 + 2 * (lane & 7));
#pragma unroll
            for (int hh = 0; hh < 10; ++hh) {
                float e0 = __uint_as_float(ha[hh] << 16), e1 = __uint_as_float(ha[hh] & 0xffff0000u);
                const float ss = wave_sum(e0 * e0 + e1 * e1); const float r = rsqrtf(ss * (1.0f / 128.0f) + EPS);
                const f32x2 g = hh < 8 ? gq2 : gk2;
                e0 = e0 * r * g.x; e1 = e1 * r * g.y;
                if (lat) {
                    const float o0 = __shfl_xor(e0, 16), o1 = __shfl_xor(e1, 16);
                    e0 = firstA ? (e0 * csA.x - o0 * csA.y) : (o0 * csA.y + e0 * csA.x);
                    e1 = firstA ? (e1 * csA.z - o1 * csA.w) : (o1 * csA.w + e1 * csA.z);
                }
                unsigned* dst = hh < 8 ? QA + (size_t)row * 512 + hh * 64 : KA + (size_t)trow * 128 + (hh - 8) * 64;
                dst[lane] = cvt_pk_bf16(e0, e1);
            }
#pragma unroll
            for (int jp = 0; jp < 8; ++jp) {
                float e0 = __uint_as_float(hb[jp] << 16), e1 = __uint_as_float(hb[jp] & 0xffff0000u);
                if (lat) {
                    const float o0 = __shfl_xor(e0, 8), o1 = __shfl_xor(e1, 8);
                    e0 = firstB ? (e0 * csB.x - o0 * csB.y) : (o0 * csB.y + e0 * csB.x);
                    e1 = firstB ? (e1 * csB.z - o1 * csB.w) : (o1 * csB.w + e1 * csB.z);
                }
                unsigned* dst = jp < 4 ? QB + (size_t)row * 256 + jp * 64 : KB + (size_t)trow * 256 + (jp - 4) * 64;
                dst[lane] = cvt_pk_bf16(e0, e1);
            }
        }
        {
#pragma unroll
            for (int tk = 0; tk < 8; ++tk) { const int sq = s0 + tk;
                const int lo = (sq - hw) < 0 ? 0 : (sq - hw), hi = (sq + hw) > L ? L : (sq + hw);
                float sum = 0.f;
#pragma unroll
                for (int j = tk; j < tk + 16; ++j) { const int sj = s0 - 8 + j; sum += (sj >= lo && sj < hi) ? pv_[j] : 0.f; }
                CAT[(size_t)(row0 + tk) * D + 1536 + ch] = (unsigned char)(__builtin_amdgcn_cvt_pk_fp8_f32(sum / (float)(hi - lo) - pv_[tk + 8], 0.f, 0, false) & 0xff); }
        }
    }
}

constexpr int NCONV_WG = 40;
constexpr int CONV_BATCH = 128, CONV_E1 = 32 * 32 * 32, CONV_E2 = 32 * 16 * 32, CONV_ITEMS = CONV_E1 + CONV_E2  , CONV_FIRST = 2 * 32 * (INW / 64) + 2 * 24 * (D / 64);
constexpr int CONV_OUT0 = 2 * 32 * (INW / 64), CONV_OUT = 24 * (D / 64)  , NB_FOLD = 4 * 16 * 2048 / NTHREADS  , NB_OUT = CONV_OUT / CONV_BATCH, NB_EXP = CONV_ITEMS / CONV_BATCH;
static_assert(CONV_OUT % CONV_BATCH == 0, "w_out batches");
PHASE_FN phase_attention(LAS unsigned char* lds_, int l, int G) {
    lds_ = (LAS unsigned char*)__builtin_amdgcn_readfirstlane((int)(uintptr_t)lds_); l = __builtin_amdgcn_readfirstlane(l); G = __builtin_amdgcn_readfirstlane(G);
    LAS unsigned char* lds = lds_;
    unsigned char* ws = WSP();
    char* ldsg = (char*)lds_;
    const int tid = tid_local();
    const bf16_t* QA = (const bf16_t*)(ws + WS_QA); const bf16_t* KA = (const bf16_t*)(ws + WS_KA); const bf16_t* VA = (const bf16_t*)(ws + WS_VA);
    const bf16_t* QB = (const bf16_t*)(ws + WS_QB); const bf16_t* KB = (const bf16_t*)(ws + WS_KB); const bf16_t* VB = (const bf16_t*)(ws + WS_VB);
    unsigned char* CAT = ws + WS_CAT; float* OB = (float*)(ws + WS_OB);
    const int nA = 512 + (l == 0 ? 32 : 0), nB = 512 + (l == 0 ? 32 : 0);
    const bool dyn = (G > NCONV_WG);
    unsigned* qh = (unsigned*)(ws + WS_CTL) + CW_Q + l * 192;
    volatile LAS int* slot = (volatile LAS int*)(lds + MISC_OFF + 32);
    if (!dyn || (int)blockIdx.x < G - NCONV_WG) {
    for (int it = 0;; ++it) {
        int id;
        __syncthreads();
        if (dyn) { if (tid == 0) *slot = (int)atomicAdd(qh, 1u); __syncthreads(); id = __builtin_amdgcn_readfirstlane(*slot); } else id = (int)blockIdx.x + it * G;
        if (id >= nA) break;
        const bf16_t *q, *k, *v; unsigned char* o; int seq;
        if (id < 512) { int b, kvh, h, qb;
            if (dyn) { b = id >> 7; kvh = (id >> 6) & 1; h = kvh * 4 + ((id >> 4) & 3); qb = id & 15; }
            else { const int x = id & 7, i = id >> 8, j = (id >> 3) & 31; b = x >> 1; kvh = x & 1; h = kvh * 4 + 2 * i + (j >> 4); qb = j & 15; }
            const size_t r0 = (size_t)b * SEQ + qb * 256;
            q = QA + r0 * 1024 + h * 128; k = KA + (size_t)b * TK * 256 + kvh * 128; v = VA + (size_t)b * TK * 256 + kvh * 128; o = CAT + r0 * D + h * 128; seq = TK; }
        else { const int c = id - 512, b = c >> 3, h = c & 7; const size_t r0 = (size_t)ML + b * CTX;
            q = QA + r0 * 1024 + h * 128; k = KA + (size_t)b * TK * 256 + (h >> 2) * 128; v = VA + (size_t)b * TK * 256 + (h >> 2) * 128; o = CAT + r0 * D + h * 128; seq = CTX; }
        att::attn_body<128, 1024, 256, 256, D, true>(q, k, v, o, seq, ldsg);
    }
    for (int it = 0;; ++it) {
        int id;
        __syncthreads();
        if (dyn) { if (tid == 0) *slot = (int)atomicAdd(qh + 64, 1u); __syncthreads(); id = __builtin_amdgcn_readfirstlane(*slot); } else id = (int)blockIdx.x + it * G;
        if (id >= nB) break;
        const bf16_t *q, *k, *v; float* o; int seq;
        if (id < 512) { int b, h, comp, qb;
            if (dyn) { b = id >> 7; h = (id >> 5) & 3; comp = (id >> 4) & 1; qb = id & 15; }
            else { const int x = id & 7, i = id >> 8, j = (id >> 3) & 31; const int combo = 2 * x + i; b = combo >> 2; h = combo & 3; comp = j >> 4; qb = j & 15; }
            const int jj = comp * 4 + h; const size_t r0 = (size_t)b * SEQ + qb * 256;
            q = QB + r0 * 512 + jj * 64; k = KB + (size_t)b * TK * 512 + jj * 64; v = VB + (size_t)b * TK * 512 + h * 128; o = OB + r0 * 1024 + jj * 128; seq = TK; }
        else { const int c = id - 512, b = c >> 3, jj = c & 7, h = jj & 3; const size_t r0 = (size_t)ML + b * CTX;
            q = QB + r0 * 512 + jj * 64; k = KB + (size_t)b * TK * 512 + jj * 64; v = VB + (size_t)b * TK * 512 + h * 128; o = OB + r0 * 1024 + jj * 128; seq = CTX; }
        att::attn_body<64, 512, 512, 512, 1024, false>(q, k, v, o, seq, ldsg);
    }
    }
    {
        const int lane = tid & 63, wave = __builtin_amdgcn_readfirstlane(tid >> 6);
        int bt;
#define CONV_PULL() do { __syncthreads(); if (tid == 0) *slot = (int)atomicAdd(qh + 128, 1u); __syncthreads(); bt = __builtin_amdgcn_readfirstlane(*slot); } while (0)
        for (;;) {
            CONV_PULL();
            if (bt >= NB_FOLD) break;
            fold_item(l * (4 * 16 * 2048) + bt * NTHREADS + tid, INP(I_WPOOL), INP(I_PSCALE), INP(I_WOUT), ws + WS_WOUT);
        }
        const float* win = INP(I_WIN); const float* wout = INP(I_WOUT); const float* w1 = INP(I_W1); const float* w2 = INP(I_W2);
        for (;; ) {
            if (bt >= NB_FOLD + NB_OUT + NB_EXP) break;
            int base;
            if (bt < NB_FOLD + NB_OUT) base = CONV_OUT0 + l * CONV_OUT + (bt - NB_FOLD) * CONV_BATCH + wave * (CONV_BATCH / NWAVES);
            else { const int li = (bt - NB_FOLD - NB_OUT) * CONV_BATCH + wave * (CONV_BATCH / NWAVES);
                base = li < CONV_E1 ? CONV_FIRST + l * CONV_E1 + li : CONV_FIRST + 2 * CONV_E1 + l * CONV_E2 + (li - CONV_E1); }
            f32x4 va[16], vb[16], vc[16]; TItem ta, tb, tc;
            constexpr int NI = CONV_BATCH / NWAVES;
            ta = titem(base, win, wout, w1, w2, ws, lane); TI_LOAD(va, ta); tb = titem(base + 1, win, wout, w1, w2, ws, lane); TI_LOAD(vb, tb);
#pragma unroll 1
            for (int i = 0; i < NI; i += 3) {
                if (i + 2 < NI) { tc = titem(base + i + 2, win, wout, w1, w2, ws, lane); TI_LOAD(vc, tc); }
                TI_STORE(va, ta);
                if (i + 3 < NI) { ta = titem(base + i + 3, win, wout, w1, w2, ws, lane); TI_LOAD(va, ta); }
                if (i + 1 < NI) TI_STORE(vb, tb);
                if (i + 4 < NI) { tb = titem(base + i + 4, win, wout, w1, w2, ws, lane); TI_LOAD(vb, tb); }
                if (i + 2 < NI) TI_STORE(vc, tc);
            }
            CONV_PULL();
        }
#undef CONV_PULL
    }
}

PHASE_FN phase_fixup(LAS unsigned char* lds, int l, int G) {
    lds = (LAS unsigned char*)__builtin_amdgcn_readfirstlane((int)(uintptr_t)lds); l = __builtin_amdgcn_readfirstlane(l); G = __builtin_amdgcn_readfirstlane(G);
    const int tid = tid_local(), lane = tid & 63, wave = __builtin_amdgcn_readfirstlane(tid >> 6);
    unsigned char* ws = WSP();
    const float lam_init = 0.8f - 0.6f * expf(-0.3f * (float)l);
    float s1 = 0.f, s2 = 0.f;
    { const float* lq1 = INP(I_LQ1) + l * 64; const float* lk1 = INP(I_LK1) + l * 64; const float* lq2 = INP(I_LQ2) + l * 64; const float* lk2 = INP(I_LK2) + l * 64;
      s1 = wave_sum(lq1[lane] * lk1[lane]); s2 = wave_sum(lq2[lane] * lk2[lane]); }
    const float lam = expf(s1) - expf(s2) + lam_init;
    const float* OB = (const float*)(ws + WS_OB); unsigned char* CAT = ws + WS_CAT;
    const float* gs = INP(I_GSUB) + l * 128;
    const int nrows = (l == 0) ? MT : ML;
    const f32x2 g2 = *(const f32x2*)(gs + 2 * lane);
    for (int row = blockIdx.x * NWAVES + wave; row < nrows; row += G * NWAVES) {
        f32x2 o1[4], o2[4];
#pragma unroll
        for (int h = 0; h < 4; ++h) { o1[h] = *(const f32x2*)(OB + (size_t)row * 1024 + h * 128 + 2 * lane); o2[h] = *(const f32x2*)(OB + (size_t)row * 1024 + (4 + h) * 128 + 2 * lane); }
#pragma unroll
        for (int h = 0; h < 4; ++h) {
            const f32x2 d = o1[h] - lam * o2[h];
            const float ss = wave_sum(d.x * d.x + d.y * d.y); const float r = rsqrtf(ss * (1.0f / 128.0f) + EPS) * (1.0f - lam_init);
            *(unsigned short*)(CAT + (size_t)row * D + 1024 + h * 128 + 2 * lane) = (unsigned short)(__builtin_amdgcn_cvt_pk_fp8_f32(d.x * r * g2.x, d.y * r * g2.y, 0, false) & 0xffff);
        }
    }
}

PHASE_FN phase_outproj(LAS unsigned char* lds, int l, int G) {
    lds = (LAS unsigned char*)__builtin_amdgcn_readfirstlane((int)(uintptr_t)lds); l = __builtin_amdgcn_readfirstlane(l); G = __builtin_amdgcn_readfirstlane(G);
    unsigned char* ws = WSP();
    pg8::DenseSched<D, 1> S; S.init(ws + WS_CAT, ws + WS_WOUT + (size_t)l * D * D, (l == 0) ? MT : ML, D, G, (int)blockIdx.x);
    pg8::EpiResid E{INP(I_X), INP(I_CTX), (const bf16_t*)(ws + WS_XR), (bf16_t*)(ws + WS_XR), (const float*)(ws + WS_MOD) + (size_t)l * 5 * 12288, l};
    pg8::gemm_phase(lds, S, E);
}

PHASE_FN phase_router(LAS unsigned char* lds, int l, int G) {
    lds = (LAS unsigned char*)__builtin_amdgcn_readfirstlane((int)(uintptr_t)lds); l = __builtin_amdgcn_readfirstlane(l); G = __builtin_amdgcn_readfirstlane(G);
    const int tid = tid_local(), lane = tid & 63, wave = __builtin_amdgcn_readfirstlane(tid >> 6);
    unsigned char* ws = WSP();
    const bf16_t* XR = (const bf16_t*)(ws + WS_XR); unsigned char* NF8 = ws + WS_NF8;
    const float* MOD = (const float*)(ws + WS_MOD) + (size_t)l * 5 * 12288;
    int* eid = (int*)(ws + WS_ROUT + ROUT_EID); float* gate = (float*)(ws + WS_ROUT + ROUT_GATE); int* posb = (int*)(ws + WS_ROUT + ROUT_POS); int* list = (int*)(ws + WS_ROUT + ROUT_LIST);
    unsigned* cnt = (unsigned*)(ws + WS_CTL) + CW_CNT + l * 32 * 64;
    const float* br = INP(I_BR) + l * NE;
    const bf16_t* WRH = (const bf16_t*)(ws + WS_WRS) + (size_t)l * NE * D;
    constexpr int TST = 4112;
    LAS unsigned char* thi = lds; LAS unsigned char* tlo = lds + 16 * TST;
    static_assert(32 * TST <= MISC_OFF, "router token images");
    LAS float* fl = (LAS float*)lds;
    LAS float* lg = (LAS float*)(lds + MISC_OFF + 512);
    LAS float* tv = (LAS float*)(lds + MISC_OFF + 2560);
    LAS int* lc = (LAS int*)(lds + MISC_OFF + 2816); LAS int* lbase = (LAS int*)(lds + MISC_OFF + 2944);
    LAS int* selall = (LAS int*)(lds + MISC_OFF + 4096);
    const int ntok = (l == 0) ? MT : ML;
    if (tid < NE) lc[tid] = 0;
    const int fn = lane & 15, kg = lane >> 4;
    bf16x8 wh[8][2];
    { const char* bh = (const char*)uniform_ptr(WRH + wave * 256);
        const unsigned o0 = (unsigned)(fn * D + kg * 8) * 2u, o1 = o0 + 16u * D * 2u;
#pragma unroll
        for (int s = 0; s < 8; ++s) { wh[s][0] = *(const bf16x8*)(bh + o0 + s * 64); wh[s][1] = *(const bf16x8*)(bh + o1 + s * 64); } }
    int ui = 0;
    u32x2 ra[8], rb[8]; f32x4 psh, pg;
    LAS float* sg = (LAS float*)(lds + SG_OFF);
#define ROUTER_FETCH(u_) do { const int _row = (u_) * 16 + wave * 2; const int _b = _row < ML ? (_row >> 12) : 4; const float* _m = MOD + (size_t)_b * 12288; \
        const char* _x0 = (const char*)uniform_ptr(XR + (size_t)_row * D); const char* _x1 = (const char*)uniform_ptr(XR + (size_t)(_row + 1) * D); \
        const char* _ms = (const char*)uniform_ptr(_m + 3 * 2048); const char* _mg = (const char*)uniform_ptr(_m + 4 * 2048); \
        _Pragma("unroll") for (int j = 0; j < 8; ++j) { ra[j] = *(const u32x2*)(_x0 + lo8 + j * 512); rb[j] = *(const u32x2*)(_x1 + lo8 + j * 512); } \
        psh = *(const f32x4*)(_ms + (unsigned)tid * 16u); pg = *(const f32x4*)(_mg + (unsigned)tid * 16u); } while (0)
    const unsigned lo8 = (unsigned)lane * 8u, lo4 = (unsigned)lane * 4u, lo16 = (unsigned)lane * 16u;
    if ((int)blockIdx.x < ntok / 16) { ROUTER_FETCH((int)blockIdx.x); *(LAS f32x4*)(sg + 4 * tid) = psh; *(LAS f32x4*)(sg + 2048 + 4 * tid) = pg; }
    __syncthreads();
    for (int unit = blockIdx.x; unit < ntok / 16; unit += G) {
        LAS int* sel = selall + ui * 64;
        int tq = tid; asm volatile("" : "+v"(tq));
        const unsigned lq = (unsigned)(tq & 63);
        { const int tl = wave * 2, row = unit * 16 + tl;
            char* nfa = (char*)uniform_ptr(NF8 + (size_t)row * D); char* nfb = (char*)uniform_ptr(NF8 + (size_t)(row + 1) * D);
            float ssa = 0.f, ssb = 0.f;
#define UNPK4(w_) ((f32x4){__uint_as_float((w_).x << 16), __uint_as_float((w_).x & 0xffff0000u), __uint_as_float((w_).y << 16), __uint_as_float((w_).y & 0xffff0000u)})
#pragma unroll
            for (int j = 0; j < 8; ++j) { const f32x4 xa = UNPK4(ra[j]), xb = UNPK4(rb[j]);
                ssa += (xa.x * xa.x + xa.y * xa.y) + (xa.z * xa.z + xa.w * xa.w); ssb += (xb.x * xb.x + xb.y * xb.y) + (xb.z * xb.z + xb.w * xb.w); }
            const float rsa = rsqrtf(wave_sum(ssa) * (1.0f / D) + EPS), rsb = rsqrtf(wave_sum(ssb) * (1.0f / D) + EPS);
#pragma unroll
            for (int j = 0; j < 8; ++j) { const unsigned col = 4u * lq + 256u * j;
                const f32x4 shj = *(const LAS f32x4*)(sg + col), gj = *(const LAS f32x4*)(sg + 2048 + col);
                const f32x4 na = (UNPK4(ra[j]) * rsa) * gj + shj, nb = (UNPK4(rb[j]) * rsb) * gj + shj;
                int wa = 0, wb = 0; wa = __builtin_amdgcn_cvt_pk_fp8_f32(na.x, na.y, wa, false); wa = __builtin_amdgcn_cvt_pk_fp8_f32(na.z, na.w, wa, true);
                wb = __builtin_amdgcn_cvt_pk_fp8_f32(nb.x, nb.y, wb, false); wb = __builtin_amdgcn_cvt_pk_fp8_f32(nb.z, nb.w, wb, true);
                *(int*)(nfa + 4u * lq + j * 256) = wa; *(int*)(nfb + 4u * lq + j * 256) = wb;
                const unsigned ha0 = cvt_pk_bf16(na.x, na.y), ha1 = cvt_pk_bf16(na.z, na.w), hb0 = cvt_pk_bf16(nb.x, nb.y), hb1 = cvt_pk_bf16(nb.z, nb.w);
                const unsigned la0 = cvt_pk_bf16(na.x - __uint_as_float(ha0 << 16), na.y - __uint_as_float(ha0 & 0xffff0000u)), la1 = cvt_pk_bf16(na.z - __uint_as_float(ha1 << 16), na.w - __uint_as_float(ha1 & 0xffff0000u));
                const unsigned lb0 = cvt_pk_bf16(nb.x - __uint_as_float(hb0 << 16), nb.y - __uint_as_float(hb0 & 0xffff0000u)), lb1 = cvt_pk_bf16(nb.z - __uint_as_float(hb1 << 16), nb.w - __uint_as_float(hb1 & 0xffff0000u));
                *(LAS u32x2*)(thi + tl * TST + col * 2) = (u32x2){ha0, ha1}; *(LAS u32x2*)(tlo + tl * TST + col * 2) = (u32x2){la0, la1};
                *(LAS u32x2*)(thi + (tl + 1) * TST + col * 2) = (u32x2){hb0, hb1}; *(LAS u32x2*)(tlo + (tl + 1) * TST + col * 2) = (u32x2){lb0, lb1};
                }
            asm volatile("" ::: "memory");
            if (unit + G < ntok / 16) ROUTER_FETCH(unit + G);
        }
        __syncthreads();
        f32x4 acc0 = (f32x4){0.f, 0.f, 0.f, 0.f}, acc1 = (f32x4){0.f, 0.f, 0.f, 0.f};
#pragma unroll
        for (int s = 0; s < 8; ++s) { const int ko = (wave * 256 + s * 32 + kg * 8) * 2;
            const bf16x8 ah = *(const LAS bf16x8*)(thi + fn * TST + ko), al = *(const LAS bf16x8*)(tlo + fn * TST + ko);
            acc0 = __builtin_amdgcn_mfma_f32_16x16x32_bf16(ah, wh[s][0], acc0, 0, 0, 0); acc1 = __builtin_amdgcn_mfma_f32_16x16x32_bf16(ah, wh[s][1], acc1, 0, 0, 0);
            acc0 = __builtin_amdgcn_mfma_f32_16x16x32_bf16(al, wh[s][0], acc0, 0, 0, 0); acc1 = __builtin_amdgcn_mfma_f32_16x16x32_bf16(al, wh[s][1], acc1, 0, 0, 0); }
        __syncthreads();
        { LAS float* pw = fl + wave * 512;
#pragma unroll
            for (int r = 0; r < 4; ++r) { pw[(kg * 4 + r) * 32 + fn] = acc0[r]; pw[(kg * 4 + r) * 32 + 16 + fn] = acc1[r]; } }
        __syncthreads();
        { float sacc = br[tid & 31];
#pragma unroll
            for (int w = 0; w < 8; ++w) sacc += fl[w * 512 + tid];
            lg[tid] = sacc; }
        if (unit + G < ntok / 16) { *(LAS f32x4*)(sg + 4 * tid) = psh; *(LAS f32x4*)(sg + 2048 + 4 * tid) = pg; }
        __syncthreads();
        { const int t = tq >> 5, e = tq & 31; const float my = lg[tq]; int rank = 0;
#pragma unroll
            for (int q = 0; q < 8; ++q) { const f32x4 x = *(const LAS f32x4*)(lg + t * 32 + 4 * q);
#pragma unroll
                for (int c = 0; c < 4; ++c) rank += (x[c] > my || (x[c] == my && 4 * q + c < e)) ? 1 : 0; }
            if (rank < 4) { sel[t * 4 + rank] = e; tv[t * 4 + rank] = my; } }
        __syncthreads();
        if (tid < 16) { const int row = unit * 16 + tid; const f32x4 v = *(const LAS f32x4*)(tv + tid * 4);
            const float e1 = __expf(v[1] - v[0]), e2 = __expf(v[2] - v[0]), e3 = __expf(v[3] - v[0]); const float inv = 1.0f / (1.0f + e1 + e2 + e3);
            *(int4*)(eid + (size_t)row * 4) = make_int4(sel[tid * 4 + 0], sel[tid * 4 + 1], sel[tid * 4 + 2], sel[tid * 4 + 3]);
            *(f32x4*)(gate + (size_t)row * 4) = (f32x4){inv, e1 * inv, e2 * inv, e3 * inv}; }
        ++ui;
    }
    __syncthreads();
    const int nent = ui * 64; int ee = 0, rk = 0;
    if (tid < nent) { ee = selall[tid]; rk = __hip_atomic_fetch_add(lc + ee, 1, __ATOMIC_RELAXED, __HIP_MEMORY_SCOPE_WORKGROUP); }
    __syncthreads();
    if (tid < NE) { const int c = lc[tid]; if (c > 0) lbase[tid] = (int)atomicAdd(cnt + tid * 64, (unsigned)c); }
    __syncthreads();
    if (tid < nent) { const int p = lbase[ee] + rk; const int row = ((int)blockIdx.x + (tid >> 6) * G) * 16 + ((tid & 63) >> 2); list[(size_t)ee * MT + p] = row; posb[(size_t)row * 4 + (tid & 3)] = p; }
    __syncthreads();
#undef ROUTER_FETCH
#undef UNPK4
}

__device__ __forceinline__ void moe_tables(unsigned char* ws, int l, LAS unsigned char* lds) {
    LAS int* tp = (LAS int*)(lds + MISC_OFF + 64); LAS int* cn = (LAS int*)(lds + MISC_OFF + 256);
    const unsigned* cnt = (const unsigned*)(ws + WS_CTL) + CW_CNT + l * 32 * 64;
    __syncthreads();
    if (threadIdx.x < 64) { const int ln = threadIdx.x;
        const int c = (ln < NE) ? (int)__hip_atomic_load(cnt + ln * 64, __ATOMIC_RELAXED, __HIP_MEMORY_SCOPE_AGENT) : 0;
        const int t = (c + 255) >> 8; int incl = t;
#pragma unroll
        for (int o = 1; o < 32; o <<= 1) { const int u = __shfl_up(incl, o); if (ln >= o) incl += u; }
        if (ln < NE) { tp[ln] = incl - t; cn[ln] = c; }
        if (ln == NE - 1) tp[NE] = incl; }
    __syncthreads();
}

PHASE_FN phase_moe_up(LAS unsigned char* lds, int l, int G) {
    lds = (LAS unsigned char*)__builtin_amdgcn_readfirstlane((int)(uintptr_t)lds); l = __builtin_amdgcn_readfirstlane(l); G = __builtin_amdgcn_readfirstlane(G);
    unsigned char* ws = WSP();
    moe_tables(ws, l, lds);
    pg8::MoeSched<true, D, 1> S; S.init((const LAS int*)(lds + MISC_OFF + 64), (const LAS int*)(lds + MISC_OFF + 256), ws + WS_NF8, ws + WS_W1 + (size_t)l * 32 * 2048 * D,
                                  (const int*)(ws + WS_ROUT + ROUT_LIST), G, (int)blockIdx.x);
    pg8::EpiSwiglu E{ws + WS_ACT, INP(I_B1) + (size_t)l * 32 * 2048};
    pg8::gemm_phase(lds, S, E);
}

PHASE_FN phase_moe_down(LAS unsigned char* lds, int l, int G) {
    lds = (LAS unsigned char*)__builtin_amdgcn_readfirstlane((int)(uintptr_t)lds); l = __builtin_amdgcn_readfirstlane(l); G = __builtin_amdgcn_readfirstlane(G);
    unsigned char* ws = WSP();
    moe_tables(ws, l, lds);
    pg8::MoeSched<false, DE, 1> S; S.init((const LAS int*)(lds + MISC_OFF + 64), (const LAS int*)(lds + MISC_OFF + 256), ws + WS_ACT, ws + WS_W2 + (size_t)l * 32 * D * DE,
                                   nullptr, G, (int)blockIdx.x);
    pg8::EpiF8 E{ws + WS_Y, D, INP(I_B2) + (size_t)l * 32 * D, D};
    pg8::gemm_phase(lds, S, E);
}

PHASE_FN phase_combine(LAS unsigned char* lds, int l, int G) {
    lds = (LAS unsigned char*)__builtin_amdgcn_readfirstlane((int)(uintptr_t)lds); l = __builtin_amdgcn_readfirstlane(l); G = __builtin_amdgcn_readfirstlane(G);
    const int tid = tid_local(), lane = tid & 63, wave = __builtin_amdgcn_readfirstlane(tid >> 6);
    unsigned char* ws = WSP();
    moe_tables(ws, l, lds);
    bf16_t* XR = (bf16_t*)(ws + WS_XR); unsigned char* N = ws + WS_N; const unsigned char* Y = ws + WS_Y;
    const float* MOD = (const float*)(ws + WS_MOD);
    const int* eid = (const int*)(ws + WS_ROUT + ROUT_EID); const float* gate = (const float*)(ws + WS_ROUT + ROUT_GATE); const int* posb = (const int*)(ws + WS_ROUT + ROUT_POS);
    const LAS int* tp = (const LAS int*)(lds + MISC_OFF + 64);
    const float* g1n = INP(I_G1) + D; const float* gf = INP(I_GF); float* out = OUTP();
    const int ntok = (l == 0) ? MT : ML;
    for (int row = blockIdx.x * NWAVES + wave; row < ntok; row += G * NWAVES) {
        const int bidx = row < ML ? (row >> 12) : 4; const float* m = MOD + ((size_t)l * 5 + bidx) * 12288;
        const int4 ev = *(const int4*)(eid + (size_t)row * 4), pv = *(const int4*)(posb + (size_t)row * 4); const f32x4 gv = *(const f32x4*)(gate + (size_t)row * 4);
        const unsigned char* yr[4];
        yr[0] = Y + ((size_t)tp[ev.x] * 256 + pv.x) * D; yr[1] = Y + ((size_t)tp[ev.y] * 256 + pv.y) * D; yr[2] = Y + ((size_t)tp[ev.z] * 256 + pv.z) * D; yr[3] = Y + ((size_t)tp[ev.w] * 256 + pv.w) * D;
        u32x2 yv[4][4]; f32x4 xv[4][2]; u32x4 xw[4];
#pragma unroll
        for (int j = 0; j < 4; ++j) { const int col = 8 * (lane + 64 * j);
#pragma unroll
            for (int k = 0; k < 4; ++k) yv[j][k] = *(const u32x2*)(yr[k] + col);
            xw[j] = *(const u32x4*)(XR + (size_t)row * D + col); }
#pragma unroll
        for (int j = 0; j < 4; ++j) pg8::unpack_bf16x8(xw[j], xv[j][0], xv[j][1]);
        float ss = 0.f;
#pragma unroll
        for (int j = 0; j < 4; ++j) { const int col = 8 * (lane + 64 * j);
            f32x4 s0 = (f32x4){0.f, 0.f, 0.f, 0.f}, s1 = s0;
#pragma unroll
            for (int k = 0; k < 4; ++k) { const u32x2 w = yv[j][k];
                const f32x2 a0 = __builtin_amdgcn_cvt_pk_f32_fp8((int)w.x, false), a1 = __builtin_amdgcn_cvt_pk_f32_fp8((int)w.x, true), a2 = __builtin_amdgcn_cvt_pk_f32_fp8((int)w.y, false), a3 = __builtin_amdgcn_cvt_pk_f32_fp8((int)w.y, true);
                s0 += gv[k] * (f32x4){a0.x, a0.y, a1.x, a1.y};
                s1 += gv[k] * (f32x4){a2.x, a2.y, a3.x, a3.y}; }
            const f32x4 gt0 = *(const f32x4*)(m + 5 * 2048 + col), gt1 = *(const f32x4*)(m + 5 * 2048 + col + 4);
            xv[j][0] += gt0 * s0; xv[j][1] += gt1 * s1;
            ss += (xv[j][0].x * xv[j][0].x + xv[j][0].y * xv[j][0].y) + (xv[j][0].z * xv[j][0].z + xv[j][0].w * xv[j][0].w);
            ss += (xv[j][1].x * xv[j][1].x + xv[j][1].y * xv[j][1].y) + (xv[j][1].z * xv[j][1].z + xv[j][1].w * xv[j][1].w); }
        const float rs = rsqrtf(wave_sum(ss) * (1.0f / D) + EPS);
        if (l == 0) {
            const float* m1 = MOD + ((size_t)5 + bidx) * 12288;
#pragma unroll
            for (int j = 0; j < 4; ++j) { const int col = 8 * (lane + 64 * j);
                *(u32x4*)(XR + (size_t)row * D + col) = pg8::pack_bf16x8(xv[j][0], xv[j][1]);
                int w0 = 0, w1 = 0;
#pragma unroll
                for (int q = 0; q < 2; ++q) { const f32x4 gg = *(const f32x4*)(g1n + col + 4 * q), sh = *(const f32x4*)(m1 + col + 4 * q), sc = *(const f32x4*)(m1 + 2048 + col + 4 * q);
                    const f32x4 n = ((xv[j][q] * rs) * gg) * (sc + 1.0f) + sh;
                    if (q == 0) { w0 = __builtin_amdgcn_cvt_pk_fp8_f32(n.x, n.y, w0, false); w0 = __builtin_amdgcn_cvt_pk_fp8_f32(n.z, n.w, w0, true); }
                    else { w1 = __builtin_amdgcn_cvt_pk_fp8_f32(n.x, n.y, w1, false); w1 = __builtin_amdgcn_cvt_pk_fp8_f32(n.z, n.w, w1, true); } }
                *(u32x2*)(N + (size_t)row * D + col) = (u32x2){(unsigned)w0, (unsigned)w1}; }
        } else {
            f32x4 gfv[4][2];
#pragma unroll
            for (int j = 0; j < 4; ++j)
#pragma unroll
                for (int q = 0; q < 2; ++q) gfv[j][q] = *(const f32x4*)(gf + 8 * (lane + 64 * j) + 4 * q);
            asm volatile("" ::: "memory");
#pragma unroll
            for (int j = 0; j < 4; ++j) { const int col = 8 * (lane + 64 * j);
                *(f32x4*)(out + (size_t)row * D + col) = (xv[j][0] * rs) * gfv[j][0];
                *(f32x4*)(out + (size_t)row * D + col + 4) = (xv[j][1] * rs) * gfv[j][1]; }
        }
    }
}

__global__ void __launch_bounds__(NTHREADS, 2) mk_fwd(Args a) {
    extern __shared__ __attribute__((aligned(16))) unsigned char lds_raw[];
    LAS unsigned char* lds = (LAS unsigned char*)lds_raw;
    const int tid = threadIdx.x; const int G = gridDim.x;
    if (tid < 16) ((LAS unsigned*)(lds + MISC_OFF))[tid] = 0u;
    if (tid == 64) { LAS unsigned long long* pt = (LAS unsigned long long*)(lds + PT_OFF);
#pragma unroll
        for (int i = 0; i < 26; ++i) pt[i] = (unsigned long long)a.in[i];
        pt[PT_OUT] = (unsigned long long)a.out; pt[PT_WS] = (unsigned long long)a.ws; }
    __syncthreads();
    const bool multi = (a.ph_hi - a.ph_lo) > 1;
    if (multi) (void)xcd_barrier_post((unsigned*)(a.ws + WS_CTL) + CW_BAR, (volatile LAS unsigned*)(lds + MISC_OFF));
    const int lo = a.ph_lo, hi = a.ph_hi;
#define IN(k) (lo <= (k) && (k) < hi)
#define SEAM(k) do { if (IN((k) + 1)) { XcdBarrier _b; _b.bar = (unsigned*)(a.ws + WS_CTL) + CW_BAR; _b.x = xb_xcc_id(); _b.st = (volatile LAS unsigned*)(lds + MISC_OFF); xcd_barrier(_b); if ((MK_REPEAT >> 11) & 1) xcd_barrier(_b); } } while (0)

    if (IN(0)) { REP(0) phase_prologue(lds, 0, G); SEAM(0); }
    if (IN(1)) { phase_modreduce(lds, 0, G); SEAM(1); }
#define LAYER_BODY(l) { \
        const int pb = 2 + 10 * l; \
        if (l == 0 && IN(pb + 0)) { phase_norm1_l0(lds, 0, G); SEAM(pb + 0); } \
        if (IN(pb + 1)) { REP(2) phase_inproj(lds, l, G); SEAM(pb + 1); } \
        if (IN(pb + 2)) { REP(3) phase_prep(lds, l, G); SEAM(pb + 2); } \
        if (IN(pb + 3)) { REP(4) phase_attention(lds, l, G); SEAM(pb + 3); } \
        if (IN(pb + 4)) { REP(5) phase_fixup(lds, l, G); SEAM(pb + 4); } \
        if (IN(pb + 5)) { if (l == 0) { REP(6) phase_outproj(lds, l, G); } else phase_outproj(lds, l, G); SEAM(pb + 5); } \
        if (IN(pb + 6)) { phase_router(lds, l, G); SEAM(pb + 6); } \
        if (IN(pb + 7)) { REP(8) phase_moe_up(lds, l, G); SEAM(pb + 7); } \
        if (IN(pb + 8)) { REP(9) phase_moe_down(lds, l, G); SEAM(pb + 8); } \
        if (IN(pb + 9)) { if (l == 1) { REP(10) phase_combine(lds, l, G); } else phase_combine(lds, l, G); if (l == 0) SEAM(pb + 9); } \
    }
    LAYER_BODY(0)
    LAYER_BODY(1)
#undef LAYER_BODY
#undef IN
#undef SEAM
}

extern "C" void kernel_launch(void* const* d_in, const int* in_sizes, int n_in, void* d_out, int out_size, void* d_ws, size_t ws_size, hipStream_t stream) {
    static int grid = 0;
    if (grid == 0) {
        if (n_in != 26 || in_sizes[0] != ML * D || out_size != ML * D || ws_size < WS_END) {
            fprintf(stderr, "kernel_launch: shape mismatch (n_in %d, in0 %d, out %d, ws %zu need %zu); nothing launched\n", n_in, n_in > 0 ? in_sizes[0] : -1, out_size, ws_size, (size_t)WS_END); grid = -1; return; }
        int dev = 0, cus = 0, per_cu = 0;
        if (hipGetDevice(&dev) != hipSuccess || hipDeviceGetAttribute(&cus, hipDeviceAttributeMultiprocessorCount, dev) != hipSuccess) { grid = -1; return; }
        if (hipFuncSetAttribute((const void*)mk_fwd, hipFuncAttributeMaxDynamicSharedMemorySize, LDS_BYTES) != hipSuccess) { fprintf(stderr, "kernel_launch: hipFuncSetAttribute failed\n"); grid = -1; return; }
        if (hipOccupancyMaxActiveBlocksPerMultiprocessor(&per_cu, (const void*)mk_fwd, NTHREADS, LDS_BYTES) != hipSuccess || per_cu < 1)
            fprintf(stderr, "kernel_launch: note: occupancy query reports %d workgroups per CU\n", per_cu);
        (void)hipGetLastError();
        grid = cus;
    }
    if (grid < 0) return;
    if (hipMemsetAsync((char*)d_ws + WS_CTL, 0, CTL_ZERO_BYTES, stream) != hipSuccess) { fprintf(stderr, "kernel_launch: memset failed\n"); return; }
    Args a{};
    for (int i = 0; i < 26; ++i) a.in[i] = (const float*)d_in[i];
    a.out = (float*)d_out; a.ws = (unsigned char*)d_ws;
#if MK_PER_PHASE_LAUNCH
    for (int p = 0; p < NPHASE; ++p) {
        if (p == 12) continue;
        a.ph_lo = p; a.ph_hi = p + 1;
        hipLaunchKernelGGL(mk_fwd, dim3(grid), dim3(NTHREADS), LDS_BYTES, stream, a);
    }
#else
    a.ph_lo = 0; a.ph_hi = NPHASE;
    hipLaunchKernelGGL(mk_fwd, dim3(grid), dim3(NTHREADS), LDS_BYTES, stream, a);
#endif
    const hipError_t le = hipPeekAtLastError();
    if (le != hipSuccess) fprintf(stderr, "kernel_launch: launch failed: %s\n", hipGetErrorName(le));
}
```

```cpp
#include <hip/hip_runtime.h>
#include <cstdio>
#include <cstdint>

#ifndef MK_PER_PHASE_LAUNCH
#define MK_PER_PHASE_LAUNCH 0
#endif

#ifndef MK_REPEAT
#define MK_REPEAT 0
#endif
#define REP(k) for (int _rep = 0; _rep < 1 + ((MK_REPEAT >> (k)) & 1); ++_rep)
#define GAS __attribute__((address_space(1)))
#define LAS __attribute__((address_space(3)))
typedef unsigned short bf16_t;
typedef short bf16x8 __attribute__((ext_vector_type(8)));
typedef short s16x4 __attribute__((ext_vector_type(4)));
typedef float f32x4 __attribute__((ext_vector_type(4)));
typedef float f32x2 __attribute__((ext_vector_type(2)));
typedef float f32x16 __attribute__((ext_vector_type(16)));
typedef unsigned u32x4 __attribute__((ext_vector_type(4)));
typedef unsigned u32x2 __attribute__((ext_vector_type(2)));
typedef int v8i __attribute__((ext_vector_type(8)));

constexpr int D = 2048, NB = 4, SEQ = 4096, CTX = 256, TK = CTX + SEQ  , DEPTH = 2;
constexpr int ML = NB * SEQ  , MC = NB * CTX  , MT = ML + MC  ;
constexpr int INW = 3584, NE = 32, DE = 1024;
constexpr int OFF_QA = 0, OFF_KA = 1024, OFF_VA = 1280, OFF_QB = 1536, OFF_KB = 2048, OFF_VB = 2560, OFF_UC = 3072;
constexpr float EPS = 1e-6f;
constexpr int MAXROWS = 77824;
constexpr int NWAVES = 8, NTHREADS = 512;

constexpr size_t MiB = 1u << 20;
constexpr size_t WS_CTL = 0, CTL_ZERO_BYTES = 2 * MiB;
constexpr size_t WS_MOD = 1 * MiB;
constexpr size_t WS_ROPE = 2 * MiB;
constexpr size_t WS_ROUT = 3 * MiB;
constexpr size_t WS_WRS = 7 * MiB;
constexpr size_t WS_XR = 8 * MiB;
constexpr size_t WS_N = 144 * MiB;
constexpr size_t WS_P = 212 * MiB;
constexpr size_t WS_QA = 332 * MiB;
constexpr size_t WS_KA = 366 * MiB;
constexpr size_t WS_VA = 375 * MiB;
constexpr size_t WS_QB = 384 * MiB;
constexpr size_t WS_KB = 401 * MiB;
constexpr size_t WS_VB = 418 * MiB;
constexpr size_t WS_CAT = 435 * MiB;
constexpr size_t WS_OB = 503 * MiB;
constexpr size_t WS_ACT = 571 * MiB;
constexpr size_t WS_Y = 723 * MiB;
constexpr size_t WS_WIN = 1027 * MiB;
constexpr size_t WS_WOUT = 1055 * MiB;
constexpr size_t WS_W1 = 1071 * MiB;
constexpr size_t WS_W2 = 1583 * MiB;
constexpr size_t WS_MODP = 1839 * MiB;
constexpr size_t WS_NF8 = 1871 * MiB;
constexpr size_t WS_END = 1907 * MiB;
static_assert(WS_XR + (size_t)MT * D * 4 <= WS_N && WS_N + (size_t)MT * D * 2 <= WS_P && WS_P + (size_t)MT * INW * 2 <= WS_QA, "ws map 1");
static_assert(WS_QA + (size_t)MT * 1024 * 2 <= WS_KA && WS_KA + (size_t)MT * 256 * 2 <= WS_VA && WS_VA + (size_t)MT * 256 * 2 <= WS_QB, "ws map 2");
static_assert(WS_QB + (size_t)MT * 512 * 2 <= WS_KB && WS_KB + (size_t)MT * 512 * 2 <= WS_VB && WS_VB + (size_t)MT * 512 * 2 <= WS_CAT, "ws map 3");
static_assert(WS_CAT + (size_t)MT * D * 2 <= WS_OB && WS_OB + (size_t)MT * 1024 * 4 <= WS_ACT && WS_ACT + (size_t)MAXROWS * 1024 * 2 <= WS_Y, "ws map 4");
static_assert(WS_Y + (size_t)MAXROWS * 2048 * 2 <= WS_WIN && WS_WIN + (size_t)2 * INW * D * 2 <= WS_WOUT && WS_WOUT + (size_t)2 * D * D * 2 <= WS_W1, "ws map 5");
static_assert(WS_W1 + (size_t)2 * 32 * 2048 * 2048 * 2 <= WS_W2 && WS_W2 + (size_t)2 * 32 * 2048 * 1024 * 2 <= WS_MODP && WS_MODP + (size_t)64 * 10 * 12288 * 4 <= WS_NF8 && WS_NF8 + (size_t)MT * D <= WS_END, "ws map 6");
static_assert(NB * TK == MT, "K/V row count");
constexpr size_t ROUT_EID = 0, ROUT_GATE = (size_t)MT * 16, ROUT_POS = (size_t)MT * 32, ROUT_LIST = (size_t)MT * 48;
static_assert(WS_ROUT + ROUT_LIST + (size_t)32 * MT * 4 <= WS_WRS && WS_WRS + (size_t)2 * 2 * 32 * 2048 * 2 <= WS_XR, "router map");
constexpr int CW_BAR = 4096;
constexpr int CW_CNT = 8192;
constexpr int CW_Q = 12288;
static_assert((CW_Q + 512) * 4 <= (int)WS_MOD && CW_CNT + 64 * 64 <= CW_Q, "ctl map");

constexpr int RING_BYTES = 131072;
constexpr int MISC_OFF = RING_BYTES + 1024;
constexpr int LDS_BYTES = 163840;
constexpr int SG_OFF = MISC_OFF + 6144;
constexpr int FLS = 2052;

#define VM_WAIT() asm volatile("s_waitcnt vmcnt(0)" ::: "memory")
#define LDS_WAIT() asm volatile("s_waitcnt lgkmcnt(0)" ::: "memory")
__device__ __forceinline__ unsigned cvt_pk_bf16(float lo, float hi) { unsigned r; asm volatile("v_cvt_pk_bf16_f32 %0, %1, %2" : "=v"(r) : "v"(lo), "v"(hi)); return r; }
__device__ __forceinline__ bf16_t f2bf(float f) { return (bf16_t)(cvt_pk_bf16(f, 0.f) & 0xffffu); }
__device__ __forceinline__ float bf2f(bf16_t b) { return __uint_as_float(((unsigned)b) << 16); }
__device__ __forceinline__ int tid_local() { int t = threadIdx.x; asm volatile("" : "+v"(t)); return t; }
template <class T> __device__ __forceinline__ T* uniform_ptr(T* p) {
    const unsigned long long v = (unsigned long long)p;
    const unsigned lo = __builtin_amdgcn_readfirstlane((unsigned)v), hi = __builtin_amdgcn_readfirstlane((unsigned)(v >> 32));
    return (T*)(GAS T*)(((unsigned long long)hi << 32) | lo);
}
__device__ __forceinline__ float wave_sum(float v) {
    v += __builtin_bit_cast(float, __builtin_amdgcn_update_dpp(0, __builtin_bit_cast(int, v), 0xB1, 0xF, 0xF, true));
    v += __builtin_bit_cast(float, __builtin_amdgcn_update_dpp(0, __builtin_bit_cast(int, v), 0x4E, 0xF, 0xF, true));
    v += __builtin_bit_cast(float, __builtin_amdgcn_update_dpp(0, __builtin_bit_cast(int, v), 0x141, 0xF, 0xF, true));
    v += __builtin_bit_cast(float, __builtin_amdgcn_update_dpp(0, __builtin_bit_cast(int, v), 0x140, 0xF, 0xF, true));
    const float a = __builtin_bit_cast(float, __builtin_amdgcn_readlane(__builtin_bit_cast(int, v), 0)), b = __builtin_bit_cast(float, __builtin_amdgcn_readlane(__builtin_bit_cast(int, v), 16));
    const float c = __builtin_bit_cast(float, __builtin_amdgcn_readlane(__builtin_bit_cast(int, v), 32)), d = __builtin_bit_cast(float, __builtin_amdgcn_readlane(__builtin_bit_cast(int, v), 48));
    return (a + b) + (c + d);
}

constexpr int PT_OFF = 131072 + 1024 + 3072;
constexpr int PT_OUT = 26, PT_WS = 27;
__device__ __forceinline__ unsigned long long ldp_raw(LAS unsigned char* lds, int i) {
    const u32x2 v = *(const LAS u32x2*)(lds + PT_OFF + 8 * i);
    const unsigned lo = __builtin_amdgcn_readfirstlane(v.x), hi = __builtin_amdgcn_readfirstlane(v.y);
    return ((unsigned long long)hi << 32) | lo;
}
#define INP(i) ((const float*)(const GAS float*)ldp_raw(lds, (i)))
#define WSP() ((unsigned char*)(GAS unsigned char*)ldp_raw(lds, PT_WS))
#define OUTP() ((float*)(GAS float*)ldp_raw(lds, PT_OUT))
#define PHASE_FN __device__ __forceinline__ void

#define XB_TMO      128
#define XB_XCNT(j)  (256  + 64 * (j))
#define XB_XSUB(j)  (1280 + 64 * (j))
#define XB_XGEN(j)  (2304 + 64 * (j))
#define XB_TOP      3328
#define XB_TOPGEN   3392
#define XCD_BAR_WORDS 3456
#define XB_SPIN_CAP (1u << 18)
__device__ __forceinline__ unsigned xb_ld(unsigned* p)              { return __hip_atomic_load(p, __ATOMIC_RELAXED, __HIP_MEMORY_SCOPE_AGENT); }
__device__ __forceinline__ unsigned xb_add(unsigned* p, unsigned v) { return __hip_atomic_fetch_add(p, v, __ATOMIC_RELAXED, __HIP_MEMORY_SCOPE_AGENT); }
__device__ __forceinline__ unsigned xb_xcc_id() { return (unsigned)__builtin_amdgcn_s_getreg((3 << 11) | 20) & 0xFu; }
#define XB_SPIN(cond, bar) do { unsigned _sp = 0; while (cond) { __builtin_amdgcn_s_sleep(1); \
    if ((++_sp & 255u) == 0u) { if (xb_ld(&(bar)[XB_TMO])) break; if (_sp > XB_SPIN_CAP) { atomicAdd(&(bar)[XB_TMO], 1u); break; } } } } while (0)
struct XcdBarrier { unsigned* bar; unsigned x; volatile LAS unsigned* st; };
__device__ __forceinline__ XcdBarrier xcd_barrier_post(unsigned* bar, volatile LAS unsigned* st) {
    XcdBarrier b; b.bar = bar; b.x = xb_xcc_id(); b.st = st;
    if (threadIdx.x == 0) (void)xb_add(&bar[XB_XCNT(b.x)], 1u);
    return b;
}
__device__ __forceinline__ void xcd_barrier_complete(unsigned* bar, unsigned x, unsigned& nloc, unsigned& nx) {
    const unsigned G = gridDim.x * gridDim.y * gridDim.z;
    unsigned sum, cnt, mine, sp = 0u;
    for (;;) {
        sum = 0u; cnt = 0u; mine = 0u;
#pragma unroll
        for (unsigned j = 0; j < 16; ++j) { const unsigned c = xb_ld(&bar[XB_XCNT(j)]); sum += c; cnt += (c > 0u) ? 1u : 0u; mine = (j == x) ? c : mine; }
        if (sum == G) break;
        __builtin_amdgcn_s_sleep(1);
        if ((++sp & 255u) == 0u) { if (xb_ld(&bar[XB_TMO])) break; if (sp > XB_SPIN_CAP) { atomicAdd(&bar[XB_TMO], 1u); break; } }
    }
    nloc = mine > 0u ? mine : 1u; nx = cnt > 0u ? cnt : 1u;
}
__device__ __forceinline__ void xcd_barrier(const XcdBarrier& b) {
    asm volatile("s_waitcnt vmcnt(0)" ::: "memory");
    __syncthreads();
    if (threadIdx.x == 0) {
        unsigned* bar = b.bar;
        __builtin_amdgcn_s_waitcnt(0);
        unsigned nloc = b.st[0], nx = b.st[1];
        if (nloc == 0u) { xcd_barrier_complete(bar, b.x, nloc, nx); b.st[0] = nloc; b.st[1] = nx; }
        const unsigned old = xb_add(&bar[XB_XSUB(b.x)], 1u);
        const unsigned gen = old / nloc;
        if (old + 1u == (gen + 1u) * nloc) {
            __builtin_amdgcn_fence(__ATOMIC_RELEASE, "agent");
            asm volatile("s_waitcnt vmcnt(0)" ::: "memory");
            const unsigned og = xb_add(&bar[XB_TOP], 1u);
            const unsigned tg = og / nx;
            if (og + 1u == (tg + 1u) * nx) xb_add(&bar[XB_TOPGEN], 1u);
            else XB_SPIN(xb_ld(&bar[XB_TOPGEN]) == tg, bar);
            __builtin_amdgcn_fence(__ATOMIC_ACQUIRE, "agent");
            xb_add(&bar[XB_XGEN(b.x)], 1u);
            asm volatile("s_waitcnt vmcnt(0)" ::: "memory");
        } else {
            XB_SPIN(xb_ld(&bar[XB_XGEN(b.x)]) == gen, bar);
            __builtin_amdgcn_fence(__ATOMIC_ACQUIRE, "agent");
            asm volatile("s_waitcnt vmcnt(0)" ::: "memory");
        }
    }
    __syncthreads();
}

namespace pg8 {
constexpr int BM = 256, BK = 64, HALF = 128, HTB = HALF * BK * 2, STAGE_BYTES = 8 * HTB, NXCD = 8, WGM = 8;
__host__ __device__ __forceinline__ int lds_byte(int r, int c) { const int st = (r >> 4) * 2 + (c >> 5), rr = r & 15, cc = c & 31, ob = rr * 64 + cc * 2; return st * 1024 + (ob ^ (((ob >> 9) & 1) << 5)); }
__host__ __device__ __forceinline__ void stage_rc(int b, int& R, int& C) { const int st = b / 1024, sb = b % 1024, swz = sb ^ (((sb >> 9) & 1) << 5); R = (st >> 1) * 16 + swz / 64; C = (st & 1) * 32 + (swz % 64) / 2; }
__host__ __device__ __forceinline__ int perm32(int rho) { const int n = rho >> 4, i = rho & 15; return 8 * (i >> 2) + 4 * n + (i & 3); }

__host__ __device__ __forceinline__ int f8_f(int rr) { return (0x9C >> (2 * (rr >> 2))) & 3; }
__host__ __device__ __forceinline__ int lds_byte8(int r, int b) { const int st = (r >> 4) * 2 + (b >> 6), rr = r & 15, q = (b >> 4) & 3; return st * 1024 + rr * 64 + ((q ^ f8_f(rr)) << 4) + (b & 15); }
__host__ __device__ __forceinline__ void stage_rc8(int o, int& R, int& Cb) { const int st = o / 1024, w = o % 1024, rr = w / 64, slot = (w % 64) / 16; R = (st >> 1) * 16 + rr; Cb = (st & 1) * 64 + ((slot ^ f8_f(rr)) << 4); }
template <int ESZ> __host__ __device__ __forceinline__ void stage_rcb(int o, int& R, int& Cb) { if constexpr (ESZ == 2) { int C; stage_rc(o, R, C); Cb = 2 * C; } else stage_rc8(o, R, Cb); }
struct Unit { int pm, pn, e; };

template <int K_, int ESZ_> struct DenseSched {
    static constexpr int K = K_, ESZ = ESZ_, SCALE_B = (ESZ_ == 1) ? 121 : 127;
    static constexpr bool GATHER_A = false;
    int nM, nN, nwg, G, c; const char* A; const char* Bt;
    __device__ void init(const void* A_, const void* Bt_, int M, int N, int G_, int c_) { A = (const char*)A_; Bt = (const char*)Bt_; nM = M / BM; nN = N / BM; nwg = nM * nN; G = G_; c = c_; }
    __device__ __forceinline__ bool next(int i, Unit& u) const {
        const long L = (long)i * G + c; if (L >= nwg) return false;
        int wgid = (int)L; { const int q = nwg / NXCD, r = nwg % NXCD, xcd = wgid % NXCD, off = wgid / NXCD; wgid = (xcd < r ? xcd * (q + 1) : r * (q + 1) + (xcd - r) * q) + off; }
        const int nig = WGM * nN, gid = wgid / nig, fm = gid * WGM, gsz = (nM - fm) < WGM ? (nM - fm) : WGM;
        u.pm = fm + ((wgid % nig) % gsz); u.pn = (wgid % nig) / gsz; u.e = 0; return true;
    }
    __device__ __forceinline__ int row0(const Unit& u) const { return u.pm * BM; }
    __device__ __forceinline__ const char* a_base() const { return A; }
    __device__ __forceinline__ const char* b_base(const Unit& u) const { return Bt + (size_t)u.pn * BM * K * ESZ; }
    __device__ __forceinline__ void a_voff(const Unit& u, int tid, unsigned (&v)[2][2]) const {
#pragma unroll
        for (int i = 0; i < 2; ++i) { int R, Cb; stage_rcb<ESZ>(tid * 16 + i * 8192, R, Cb);
#pragma unroll
            for (int h = 0; h < 2; ++h) v[h][i] = (unsigned)((u.pm * BM + h * HALF + R) * (K * ESZ) + Cb); }
    }
};
template <bool GATHER, int K_, int ESZ_> struct MoeSched {
    static constexpr int K = K_, ESZ = ESZ_, SCALE_B = (K_ == 2048) ? 121 : 122;
    static constexpr size_t BSTRIDE = (size_t)2048 * K * ESZ;
    static constexpr bool GATHER_A = GATHER;
    const LAS int* tp; const LAS int* cnt; int start, end, j, stride; const char* A; const char* Bt; const int* list;
    __device__ void init(const LAS int* tp_, const LAS int* cnt_, const void* A_, const void* Bt_, const int* list_, int G, int c) {
        tp = tp_; cnt = cnt_; A = (const char*)A_; Bt = (const char*)Bt_; list = list_;
        const int U = 8 * tp[NE];
        if (G == 256) { const int x = c & 7; j = c >> 3; stride = 32; start = (int)(((long)x * U) / 8); end = (int)(((long)(x + 1) * U) / 8); }
        else { start = 0; end = U; j = c; stride = G; }
    }
    __device__ __forceinline__ bool next(int i, Unit& u) const {
        const int idx = start + i * stride + j; if (idx >= end) return false;
        int e = 0;
        for (int q = 1; q < NE; ++q) e += (8 * tp[q] <= idx) ? 1 : 0;
        e = __builtin_amdgcn_readfirstlane(e);
        const int tiles = tp[e + 1] - tp[e], r = idx - 8 * tp[e];
        const int gi = r >> 5, fm = gi * 4, gsz = (tiles - fm) < 4 ? (tiles - fm) : 4, w = r - 32 * gi;
        u.e = e; u.pm = __builtin_amdgcn_readfirstlane(fm + (w % gsz)); u.pn = __builtin_amdgcn_readfirstlane(w / gsz); return true;
    }
    __device__ __forceinline__ int row0(const Unit& u) const { return __builtin_amdgcn_readfirstlane((tp[u.e] + u.pm) * BM); }
    __device__ __forceinline__ const char* a_base() const { return A; }
    __device__ __forceinline__ const char* b_base(const Unit& u) const { return Bt + (size_t)u.e * BSTRIDE + (size_t)u.pn * BM * K * ESZ; }
    __device__ __forceinline__ void a_voff(const Unit& u, int tid, unsigned (&v)[2][2]) const {
        if constexpr (GATHER) {
            const int* lp = list + (size_t)u.e * MT + u.pm * BM;
            const int nv = cnt[u.e] - u.pm * BM;
            int tok[2][2], Cc[2];
#pragma unroll
            for (int i = 0; i < 2; ++i) { int R; stage_rcb<ESZ>(tid * 16 + i * 8192, R, Cc[i]);
#pragma unroll
                for (int h = 0; h < 2; ++h) { const int lr = h * HALF + R; tok[h][i] = lp[lr < nv ? lr : 0]; } }
            asm volatile("s_waitcnt vmcnt(0)" ::: "memory");
#pragma unroll
            for (int h = 0; h < 2; ++h)
#pragma unroll
                for (int i = 0; i < 2; ++i) v[h][i] = (unsigned)(tok[h][i] * (K * ESZ) + Cc[i]);
        } else {
            const int r0 = row0(u);
#pragma unroll
            for (int i = 0; i < 2; ++i) { int R, Cb; stage_rcb<ESZ>(tid * 16 + i * 8192, R, Cb);
#pragma unroll
                for (int h = 0; h < 2; ++h) v[h][i] = (unsigned)((r0 + h * HALF + R) * (K * ESZ) + Cb); }
        }
    }
};

struct EpiProj {
    static constexpr bool PERM = true;
    bf16_t* P; bf16_t* VA; bf16_t* VB;
    __device__ __forceinline__ void operator()(const f32x4 (&acc)[2][2][4][2], const Unit& u, int urow0, int wr, int wc, int fr, int fq) const {
        bf16_t* O; int ldc; int rbase;
        const int kvrow0 = urow0 < ML ? (urow0 >> 12) * TK + CTX + (urow0 & 4095) : ((urow0 - ML) >> 8) * TK;
        if (u.pn == OFF_VA / BM) { O = VA; ldc = 256; rbase = kvrow0; }
        else if (u.pn == OFF_VB / BM || u.pn == OFF_VB / BM + 1) { O = VB + (u.pn - OFF_VB / BM) * BM; ldc = 512; rbase = kvrow0; }
        else { O = P + u.pn * BM; ldc = INW; rbase = urow0; }
        const int row0 = rbase + wr * 64 + fr; const int col0 = wc * 32 + 8 * fq;
#pragma unroll
        for (int ai = 0; ai < 2; ++ai)
#pragma unroll
            for (int m = 0; m < 4; ++m) { bf16_t* rowp = O + (size_t)(row0 + ai * HALF + m * 16) * ldc + col0;
#pragma unroll
                for (int bj = 0; bj < 2; ++bj) { const f32x4 v0 = acc[ai][bj][m][0], v1 = acc[ai][bj][m][1];
                    u32x4 w; w.x = cvt_pk_bf16(v0[0], v0[1]); w.y = cvt_pk_bf16(v0[2], v0[3]); w.z = cvt_pk_bf16(v1[0], v1[1]); w.w = cvt_pk_bf16(v1[2], v1[3]);
                    *(u32x4*)(rowp + bj * HALF) = w; } }
    }
};
static_assert(OFF_VA % BM == 0 && OFF_VB % BM == 0 && OFF_VB + 2 * BM == OFF_UC && OFF_VA + BM == OFF_QB, "value columns are whole unit columns");
struct EpiF8 {
    static constexpr bool PERM = true;
    unsigned char* O; int ldc; const float* bias; int bias_estride;
    __device__ __forceinline__ void operator()(const f32x4 (&acc)[2][2][4][2], const Unit& u, int urow0, int wr, int wc, int fr, int fq) const {
        const int row0 = urow0 + wr * 64 + fr; const int col0 = u.pn * BM + wc * 32 + 8 * fq;
        const float* bp = bias + (size_t)u.e * bias_estride + col0;
        f32x4 bv[2][2];
#pragma unroll
        for (int bj = 0; bj < 2; ++bj)
#pragma unroll
            for (int n = 0; n < 2; ++n) bv[bj][n] = *(const f32x4*)(bp + bj * HALF + 4 * n);
#pragma unroll
        for (int ai = 0; ai < 2; ++ai)
#pragma unroll
            for (int m = 0; m < 4; ++m) { unsigned char* rowp = O + (size_t)(row0 + ai * HALF + m * 16) * ldc + col0;
#pragma unroll
                for (int bj = 0; bj < 2; ++bj) { const f32x4 v0 = acc[ai][bj][m][0] + bv[bj][0], v1 = acc[ai][bj][m][1] + bv[bj][1];
                    int w0 = 0, w1 = 0; w0 = __builtin_amdgcn_cvt_pk_fp8_f32(v0[0], v0[1], w0, false); w0 = __builtin_amdgcn_cvt_pk_fp8_f32(v0[2], v0[3], w0, true);
                    w1 = __builtin_amdgcn_cvt_pk_fp8_f32(v1[0], v1[1], w1, false); w1 = __builtin_amdgcn_cvt_pk_fp8_f32(v1[2], v1[3], w1, true);
                    *(u32x2*)(rowp + bj * HALF) = (u32x2){(unsigned)w0, (unsigned)w1}; } }
    }
};
__device__ __forceinline__ float swiglu1(float g, float l) {
    g = fminf(g, 7.0f); l = fminf(fmaxf(l, -7.0f), 7.0f);
    const float sg = __builtin_amdgcn_rcpf(1.0f + __builtin_amdgcn_exp2f(-1.702f * 1.4426950408889634f * g));
    return g * sg * (l + 1.0f);
}
struct EpiSwiglu {
    static constexpr bool PERM = true;
    unsigned char* O; const float* bias;
    __device__ __forceinline__ void operator()(const f32x4 (&acc)[2][2][4][2], const Unit& u, int urow0, int wr, int wc, int fr, int fq) const {
        const int row0 = urow0 + wr * 64 + fr; const int col0 = u.pn * BM + wc * 32 + 8 * fq;
        const float* bp = bias + (size_t)u.e * 2048 + col0;
        f32x4 bv[2][2];
#pragma unroll
        for (int bj = 0; bj < 2; ++bj)
#pragma unroll
            for (int n = 0; n < 2; ++n) bv[bj][n] = *(const f32x4*)(bp + bj * HALF + 4 * n);
#pragma unroll
        for (int ai = 0; ai < 2; ++ai)
#pragma unroll
            for (int m = 0; m < 4; ++m) { unsigned char* rowp = O + (size_t)(row0 + ai * HALF + m * 16) * DE + (col0 >> 1);
#pragma unroll
                for (int bj = 0; bj < 2; ++bj) { const f32x4 v0 = acc[ai][bj][m][0] + bv[bj][0], v1 = acc[ai][bj][m][1] + bv[bj][1];
                    int w = 0; w = __builtin_amdgcn_cvt_pk_fp8_f32(swiglu1(v0[0], v0[1]), swiglu1(v0[2], v0[3]), w, false); w = __builtin_amdgcn_cvt_pk_fp8_f32(swiglu1(v1[0], v1[1]), swiglu1(v1[2], v1[3]), w, true);
                    *(int*)(rowp + bj * (HALF / 2)) = w; } }
    }
};
__device__ __forceinline__ void unpack_bf16x8(const u32x4 w, f32x4& lo, f32x4& hi) {
    lo = (f32x4){__uint_as_float(w.x << 16), __uint_as_float(w.x & 0xffff0000u), __uint_as_float(w.y << 16), __uint_as_float(w.y & 0xffff0000u)};
    hi = (f32x4){__uint_as_float(w.z << 16), __uint_as_float(w.z & 0xffff0000u), __uint_as_float(w.w << 16), __uint_as_float(w.w & 0xffff0000u)};
}
__device__ __forceinline__ u32x4 pack_bf16x8(const f32x4 lo, const f32x4 hi) {
    u32x4 w; w.x = cvt_pk_bf16(lo[0], lo[1]); w.y = cvt_pk_bf16(lo[2], lo[3]); w.z = cvt_pk_bf16(hi[0], hi[1]); w.w = cvt_pk_bf16(hi[2], hi[3]); return w;
}
struct EpiResid {
    static constexpr bool PERM = true;
    const float* xin; const float* cin; const bf16_t* xr_in; bf16_t* xr_out; const float* mod; int layer;
    __device__ __forceinline__ void operator()(const f32x4 (&acc)[2][2][4][2], const Unit& u, int urow0, int wr, int wc, int fr, int fq) const {
        const int row0 = urow0 + wr * 64 + fr, col0 = u.pn * BM + wc * 32 + 8 * fq;
        const int bidx = urow0 < ML ? (urow0 >> 12) : 4;
        const float* gp = mod + (size_t)bidx * 12288 + 2 * 2048 + col0;
        f32x4 g[2][2];
#pragma unroll
        for (int bj = 0; bj < 2; ++bj)
#pragma unroll
            for (int n = 0; n < 2; ++n) g[bj][n] = *(const f32x4*)(gp + bj * HALF + 4 * n);
        if (layer == 0) {
            const float* bbase = urow0 < ML ? xin : cin - (size_t)ML * D;
#pragma unroll
            for (int ai = 0; ai < 2; ++ai)
#pragma unroll
                for (int mp = 0; mp < 2; ++mp) {
                    f32x4 bs[2][2][2];
#pragma unroll
                    for (int mq = 0; mq < 2; ++mq) { const int row = row0 + ai * HALF + (2 * mp + mq) * 16; const float* bp = bbase + (size_t)row * D + col0;
#pragma unroll
                        for (int bj = 0; bj < 2; ++bj)
#pragma unroll
                            for (int n = 0; n < 2; ++n) bs[mq][bj][n] = *(const f32x4*)(bp + bj * HALF + 4 * n); }
#pragma unroll
                    for (int mq = 0; mq < 2; ++mq) { const int m = 2 * mp + mq; const int row = row0 + ai * HALF + m * 16; bf16_t* op = xr_out + (size_t)row * D + col0;
#pragma unroll
                        for (int bj = 0; bj < 2; ++bj) *(u32x4*)(op + bj * HALF) = pack_bf16x8(bs[mq][bj][0] + g[bj][0] * acc[ai][bj][m][0], bs[mq][bj][1] + g[bj][1] * acc[ai][bj][m][1]); }
                    asm volatile("" ::: "memory"); }
        } else {
#pragma unroll
            for (int ai = 0; ai < 2; ++ai) {
                u32x4 bw[4][2];
#pragma unroll
                for (int m = 0; m < 4; ++m) { const int row = row0 + ai * HALF + m * 16; const bf16_t* bp = xr_in + (size_t)row * D + col0;
#pragma unroll
                    for (int bj = 0; bj < 2; ++bj) bw[m][bj] = *(const u32x4*)(bp + bj * HALF); }
#pragma unroll
                for (int m = 0; m < 4; ++m) { const int row = row0 + ai * HALF + m * 16; bf16_t* op = xr_out + (size_t)row * D + col0;
#pragma unroll
                    for (int bj = 0; bj < 2; ++bj) { f32x4 b0, b1; unpack_bf16x8(bw[m][bj], b0, b1);
                        *(u32x4*)(op + bj * HALF) = pack_bf16x8(b0 + g[bj][0] * acc[ai][bj][m][0], b1 + g[bj][1] * acc[ai][bj][m][1]); } }
                asm volatile("" ::: "memory"); }
        }
    }
};

template <class Epi, class Sched>
__device__ __forceinline__ void gemm_phase(LAS unsigned char* lds, const Sched& S, const Epi& E) {
    constexpr int K = Sched::K, ESZ = Sched::ESZ;
    const int tid = tid_local(), wid = __builtin_amdgcn_readfirstlane(tid >> 6), lane = tid & 63, wr = wid >> 2, wc = wid & 3, fr = lane & 15, fq = lane >> 4;
    constexpr int nt = K * ESZ / 128;
    constexpr int SCALE_A = 127, SCALE_B = Sched::SCALE_B;
    unsigned voffB[2], voffA[2][2];
#pragma unroll
    for (int i = 0; i < 2; ++i) { int R, Cb; stage_rcb<ESZ>(tid * 16 + i * 8192, R, Cb); const int Rb = Epi::PERM ? ((R & ~31) + perm32(R & 31)) : R; voffB[i] = (unsigned)(Rb * (K * ESZ) + Cb); }
    constexpr size_t kstep = 128;
    constexpr size_t hstep = (size_t)HALF * K * ESZ;
    const unsigned ldsw = (unsigned)wid * 1024u;
    const int aoff = ESZ == 2 ? lds_byte(wr * 64 + fr, fq * 8) : lds_byte8(wr * 64 + fr, fq * 32), boff = ESZ == 2 ? lds_byte(wc * 32 + fr, fq * 8) : lds_byte8(wc * 32 + fr, fq * 32);
    const int aoff2 = aoff ^ 16, boff2 = boff ^ 16;
#define PG8_SA(b, h) (((b) * 2 + (h)) * HTB)
#define PG8_SB(b, h) ((4 + (b) * 2 + (h)) * HTB)
#define PG8_STAGE(bufoff, gbase, voff) do { _Pragma("unroll") for (int _i = 0; _i < 2; ++_i) \
        __builtin_amdgcn_global_load_lds((const unsigned*)((const char*)(gbase) + (voff)[_i]), (LAS unsigned*)(lds + (bufoff) + ldsw + _i * 8192), 16, 0, 0); } while (0)
#define PG8_LDA(dst, b, h) do { if constexpr (ESZ == 2) { _Pragma("unroll") for (int m = 0; m < 4; ++m) _Pragma("unroll") for (int k = 0; k < 2; ++k) dst[m][k] = *(const LAS bf16x8*)(lds + PG8_SA(b, h) + aoff + m * 2048 + k * 1024); } \
        else { _Pragma("unroll") for (int m = 0; m < 4; ++m) { const u32x4 _lo = *(const LAS u32x4*)(lds + PG8_SA(b, h) + aoff + m * 2048), _hi = *(const LAS u32x4*)(lds + PG8_SA(b, h) + aoff2 + m * 2048); \
            dst##8[m] = (v8i){(int)_lo.x, (int)_lo.y, (int)_lo.z, (int)_lo.w, (int)_hi.x, (int)_hi.y, (int)_hi.z, (int)_hi.w}; } } } while (0)
#define PG8_LDB(dst, b, h) do { if constexpr (ESZ == 2) { _Pragma("unroll") for (int n = 0; n < 2; ++n) _Pragma("unroll") for (int k = 0; k < 2; ++k) dst[n][k] = *(const LAS bf16x8*)(lds + PG8_SB(b, h) + boff + n * 2048 + k * 1024); } \
        else { _Pragma("unroll") for (int n = 0; n < 2; ++n) { const u32x4 _lo = *(const LAS u32x4*)(lds + PG8_SB(b, h) + boff + n * 2048), _hi = *(const LAS u32x4*)(lds + PG8_SB(b, h) + boff2 + n * 2048); \
            dst##8[n] = (v8i){(int)_lo.x, (int)_lo.y, (int)_lo.z, (int)_lo.w, (int)_hi.x, (int)_hi.y, (int)_hi.z, (int)_hi.w}; } } } while (0)
#define PG8_MMA(ai, bj, At, Bt) do { __builtin_amdgcn_s_setprio(1); if constexpr (ESZ == 2) { _Pragma("unroll") for (int m = 0; m < 4; ++m) _Pragma("unroll") for (int n = 0; n < 2; ++n) _Pragma("unroll") for (int k = 0; k < 2; ++k) \
        acc[ai][bj][m][n] = __builtin_amdgcn_mfma_f32_16x16x32_bf16(Bt[n][k], At[m][k], acc[ai][bj][m][n], 0, 0, 0); } \
        else { _Pragma("unroll") for (int m = 0; m < 4; ++m) _Pragma("unroll") for (int n = 0; n < 2; ++n) \
        acc[ai][bj][m][n] = __builtin_amdgcn_mfma_scale_f32_16x16x128_f8f6f4(Bt##8[n], At##8[m], acc[ai][bj][m][n], 0, 0, 0, SCALE_B, 0, SCALE_A); } __builtin_amdgcn_s_setprio(0); } while (0)
#define PG8_WAIT_V(n) asm volatile("s_waitcnt vmcnt(" #n ")" ::: "memory")
#define PG8_WAIT_L(n) asm volatile("s_waitcnt lgkmcnt(" #n ")" ::: "memory")
#define PG8_BAR __builtin_amdgcn_s_barrier()
#define PG8_SCHED __builtin_amdgcn_sched_barrier(0)
    Unit cur, nxt; int ui = 0;
    if (!S.next(0, cur)) return;
    f32x4 acc[2][2][4][2];
#pragma unroll
    for (int a = 0; a < 2; ++a)
#pragma unroll
        for (int b = 0; b < 2; ++b)
#pragma unroll
            for (int m = 0; m < 4; ++m)
#pragma unroll
                for (int n = 0; n < 2; ++n) acc[a][b][m][n] = (f32x4){0.f, 0.f, 0.f, 0.f};
    bf16x8 At[4][2], B0[2][2], B1[2][2];
    v8i At8[4], B08[2], B18[2];
    const char* const Ab = S.a_base();
    const char* cB = S.b_base(cur);
    S.a_voff(cur, tid, voffA);
    PG8_STAGE(PG8_SB(0, 0), cB, voffB); PG8_STAGE(PG8_SB(0, 1), cB + hstep, voffB); PG8_STAGE(PG8_SA(0, 0), Ab, voffA[0]); PG8_STAGE(PG8_SA(0, 1), Ab, voffA[1]);
    if (wr == 1) PG8_BAR;
    PG8_WAIT_V(2); PG8_BAR;
    PG8_STAGE(PG8_SB(1, 0), cB + kstep, voffB); PG8_STAGE(PG8_SA(1, 0), Ab + kstep, voffA[0]); PG8_STAGE(PG8_SB(1, 1), cB + hstep + kstep, voffB);
    PG8_WAIT_V(6); PG8_BAR;
    for (;;) {
        const bool has_next = S.next(ui + 1, nxt);
        const char* nB = has_next ? S.b_base(nxt) : cB;
        unsigned voffN[2][2];
        if constexpr (Sched::GATHER_A) { if (has_next) S.a_voff(nxt, tid, voffN); }
#pragma unroll 1
        for (int t = 0; t < nt; t += 2) {
            const bool last = (t == nt - 2);
            const char* a1 = Ab + (size_t)(t + 1) * kstep;
            const char* a2 = last ? Ab : Ab + (size_t)(t + 2) * kstep; const char* b2 = last ? nB : cB + (size_t)(t + 2) * kstep;
            const char* a3 = a2 + kstep; const char* b3 = b2 + kstep;
            PG8_LDB(B0, 0, 0); PG8_LDB(B1, 0, 1); PG8_SCHED; PG8_LDA(At, 0, 0); PG8_STAGE(PG8_SA(1, 1), a1, voffA[1]);
            if (last && has_next) {
                if constexpr (Sched::GATHER_A) { voffA[0][0] = voffN[0][0]; voffA[0][1] = voffN[0][1]; voffA[1][0] = voffN[1][0]; voffA[1][1] = voffN[1][1]; }
                else S.a_voff(nxt, tid, voffA); }
            PG8_WAIT_V(8); PG8_WAIT_L(0); PG8_BAR; PG8_MMA(0, 0, At, B0); PG8_MMA(0, 1, At, B1); PG8_BAR; PG8_SCHED;
            PG8_LDA(At, 0, 1); PG8_STAGE(PG8_SB(0, 0), b2, voffB); PG8_STAGE(PG8_SB(0, 1), b2 + hstep, voffB); PG8_STAGE(PG8_SA(0, 0), a2, voffA[0]);
            PG8_WAIT_V(8); PG8_WAIT_L(0); PG8_BAR; PG8_MMA(1, 0, At, B0); PG8_MMA(1, 1, At, B1); PG8_BAR; PG8_SCHED;
            PG8_LDB(B0, 1, 0); PG8_LDB(B1, 1, 1); PG8_SCHED; PG8_LDA(At, 1, 0); PG8_STAGE(PG8_SA(0, 1), a2, voffA[1]);
            PG8_WAIT_V(8); PG8_WAIT_L(0); PG8_BAR; PG8_MMA(0, 0, At, B0); PG8_MMA(0, 1, At, B1); PG8_BAR; PG8_SCHED;
            PG8_LDA(At, 1, 1); PG8_STAGE(PG8_SB(1, 0), b3, voffB); PG8_STAGE(PG8_SB(1, 1), b3 + hstep, voffB); PG8_STAGE(PG8_SA(1, 0), a3, voffA[0]);
            PG8_WAIT_V(8); PG8_WAIT_L(0); PG8_BAR; PG8_MMA(1, 0, At, B0); PG8_MMA(1, 1, At, B1); PG8_BAR; PG8_SCHED;
        }
        if (wr == 0) PG8_BAR;
        E(acc, cur, S.row0(cur), wr, wc, fr, fq);
        if constexpr (Epi::PERM) { if ((MK_REPEAT >> 12) & 1) E(acc, cur, S.row0(cur), wr, wc, fr, fq); }
        if (!has_next) break;
#pragma unroll
        for (int a = 0; a < 2; ++a)
#pragma unroll
            for (int b = 0; b < 2; ++b)
#pragma unroll
                for (int m = 0; m < 4; ++m)
#pragma unroll
                    for (int n = 0; n < 2; ++n) acc[a][b][m][n] = (f32x4){0.f, 0.f, 0.f, 0.f};
        cur = nxt; cB = nB; ++ui;
        if (wr == 1) PG8_BAR;
    }
    PG8_WAIT_V(0);
    PG8_BAR;
#undef PG8_SA
#undef PG8_SB
#undef PG8_STAGE
#undef PG8_LDA
#undef PG8_LDB
#undef PG8_MMA
#undef PG8_WAIT_V
#undef PG8_WAIT_L
#undef PG8_BAR
#undef PG8_SCHED
}
}

namespace att {
constexpr int NW = 8, QBLK = 32, KVBLK = 64, DV = 128;
constexpr float THR = 8.f;
constexpr int SHM_V = KVBLK * DV * 2, SHM_K = KVBLK * 128 * 2, SHM_ATTN = 2 * SHM_V + 2 * SHM_K + NW * 64 * 4;
#define SBAR() __builtin_amdgcn_sched_barrier(0)
__device__ __forceinline__ int crow(int r, int hi) { return (r & 3) + 8 * (r >> 2) + 4 * hi; }
template <int DQK> __device__ __forceinline__ int kswz(int row, int colB) {
    if constexpr (DQK == 128) return row * 256 + (colB ^ ((row & 15) << 4));
    else return row * 128 + (colB ^ (((row >> 1) & 7) << 4));
}
template <int DQK> __device__ __forceinline__ void partialSM(f32x16& p0, f32x16& p1, float& m_reg, float& mn, float& alpha) {
    constexpr float SCALE = (DQK == 128) ? 0.088388347648318440f : 0.125f;
    constexpr float Cc = SCALE * 1.4426950408889634f;
    float pmax = p0[0];
#pragma unroll
    for (int r = 1; r < 16; ++r) pmax = fmaxf(pmax, p0[r]);
#pragma unroll
    for (int r = 0; r < 16; ++r) pmax = fmaxf(pmax, p1[r]);
    { auto rr = __builtin_amdgcn_permlane32_swap(__float_as_uint(pmax), __float_as_uint(pmax), false, false);
      pmax = fmaxf(__uint_as_float(rr[0]), __uint_as_float(rr[1])); }
    if (__builtin_expect(__all(pmax - m_reg <= THR / SCALE), 1)) { mn = m_reg; alpha = 1.f; }
    else { mn = fmaxf(m_reg, pmax); alpha = __builtin_amdgcn_exp2f((m_reg - mn) * Cc); m_reg = mn; }
    const float mnC = -mn * Cc;
#pragma unroll
    for (int r = 0; r < 16; ++r) p0[r] = fmaf(p0[r], Cc, mnC);
#pragma unroll
    for (int r = 0; r < 16; ++r) p1[r] = fmaf(p1[r], Cc, mnC);
#pragma unroll
    for (int r = 0; r < 16; ++r) p0[r] = __builtin_amdgcn_exp2f(p0[r]);
}
__device__ __forceinline__ void finishSM(f32x16& p0, f32x16& p1, float alpha, float& l_reg, bf16x8& pa0, bf16x8& pa1, bf16x8& pa2, bf16x8& pa3) {
#pragma unroll
    for (int r = 0; r < 16; ++r) p1[r] = __builtin_amdgcn_exp2f(p1[r]);
    float ps = 0;
#pragma unroll
    for (int r = 0; r < 16; ++r) ps += p0[r];
#pragma unroll
    for (int r = 0; r < 16; ++r) ps += p1[r];
    { auto rr = __builtin_amdgcn_permlane32_swap(__float_as_uint(ps), __float_as_uint(ps), false, false);
      ps = __uint_as_float(rr[0]) + __uint_as_float(rr[1]); }
    l_reg = l_reg * alpha + ps;
#define PK4(P, BASE, OUT) do { unsigned a0 = cvt_pk_bf16(P[BASE + 0], P[BASE + 1]), a1 = cvt_pk_bf16(P[BASE + 2], P[BASE + 3]);   \
    unsigned b0 = cvt_pk_bf16(P[BASE + 4], P[BASE + 5]), b1 = cvt_pk_bf16(P[BASE + 6], P[BASE + 7]);                              \
    auto r0 = __builtin_amdgcn_permlane32_swap(a0, b0, false, false); auto r1 = __builtin_amdgcn_permlane32_swap(a1, b1, false, false); \
    u32x4 w = {r0[0], r1[0], r0[1], r1[1]}; OUT = *reinterpret_cast<bf16x8*>(&w); } while (0)
    PK4(p0, 0, pa0); PK4(p0, 8, pa1); PK4(p1, 0, pa2); PK4(p1, 8, pa3);
#undef PK4
}
template <int DQK> __device__ __forceinline__ void qkt(f32x16& p0, f32x16& p1, const char* Ks, const bf16x8* qr, int r32, int hi) {
    p0 = f32x16{}; p1 = f32x16{};
#pragma unroll
    for (int d0 = 0; d0 < DQK / 16; ++d0) { const int cb = (d0 * 16 + hi * 8) * 2;
        const bf16x8 b0 = *reinterpret_cast<const bf16x8*>(Ks + kswz<DQK>(r32, cb));
        const bf16x8 b1 = *reinterpret_cast<const bf16x8*>(Ks + kswz<DQK>(32 + r32, cb));
        p0 = __builtin_amdgcn_mfma_f32_32x32x16_bf16(b0, qr[d0], p0, 0, 0, 0);
        p1 = __builtin_amdgcn_mfma_f32_32x32x16_bf16(b1, qr[d0], p1, 0, 0, 0); }
}
__device__ __forceinline__ int v_st(int k, int c) { const int kk = (k & ~0xC) | ((k & 4) << 1) | ((k & 8) >> 1); return ((kk >> 3) * 4 + (c >> 5)) * 512 + ((kk & 7) * 32 + (c & 31)) * 2; }
__device__ __forceinline__ int v_rd_base(int lane) { return ((lane & 3) << 3) | (((lane >> 2) & 3) << 6) | (((lane >> 4) & 1) << 5) | (((lane >> 5) & 1) << 8); }
constexpr int v_rd_off(int d0, int ks, int half) { return d0 * 512 + ks * 4096 + half * 2048; }
template <int OFF> __device__ __forceinline__ s16x4 tr_read(int vb) {
    s16x4 r; asm volatile("ds_read_b64_tr_b16 %0, %1 offset:%2" : "=&v"(r) : "v"(vb), "i"(OFF) : "memory"); return r;
}
template <int KS> __device__ __forceinline__ void pv_step(f32x16* o, int vb, bf16x8 pa) {
    const s16x4 l0 = tr_read<v_rd_off(0, KS, 0)>(vb), h0 = tr_read<v_rd_off(0, KS, 1)>(vb), l1 = tr_read<v_rd_off(1, KS, 0)>(vb), h1 = tr_read<v_rd_off(1, KS, 1)>(vb);
    const s16x4 l2 = tr_read<v_rd_off(2, KS, 0)>(vb), h2 = tr_read<v_rd_off(2, KS, 1)>(vb), l3 = tr_read<v_rd_off(3, KS, 0)>(vb), h3 = tr_read<v_rd_off(3, KS, 1)>(vb);
    asm volatile("s_waitcnt lgkmcnt(0)" ::: "memory"); SBAR();
#define PK(L, H) (bf16x8){L[0], L[1], L[2], L[3], H[0], H[1], H[2], H[3]}
    o[0] = __builtin_amdgcn_mfma_f32_32x32x16_bf16(pa, PK(l0, h0), o[0], 0, 0, 0);
    o[1] = __builtin_amdgcn_mfma_f32_32x32x16_bf16(pa, PK(l1, h1), o[1], 0, 0, 0);
    o[2] = __builtin_amdgcn_mfma_f32_32x32x16_bf16(pa, PK(l2, h2), o[2], 0, 0, 0);
    o[3] = __builtin_amdgcn_mfma_f32_32x32x16_bf16(pa, PK(l3, h3), o[3], 0, 0, 0);
#undef PK
}
__device__ __forceinline__ void pv_d0(f32x16* o, int vb, bf16x8 pa0, bf16x8 pa1, bf16x8 pa2, bf16x8 pa3) {
    pv_step<0>(o, vb, pa0); pv_step<1>(o, vb, pa1); pv_step<2>(o, vb, pa2); pv_step<3>(o, vb, pa3);
}
template <int DQK, int LDQ, int LDK, int LDV, int LDO, bool OUT_BF16>
__device__ __forceinline__ void attn_body(const bf16_t* __restrict__ Qb, const bf16_t* __restrict__ Kh, const bf16_t* __restrict__ Vh, void* __restrict__ Ob, int seq, char* lds) {
    const int tid = tid_local(), wid = tid >> 6, lane = tid & 63, r32 = lane & 31, hi = lane >> 5;
    Qb = uniform_ptr(Qb); Kh = uniform_ptr(Kh); Vh = uniform_ptr(Vh); Ob = uniform_ptr(Ob);
    char* V_lds = lds; char* K_lds = lds + 2 * SHM_V;
    float* ws = (float*)(lds + 2 * SHM_V + 2 * SHM_K) + wid * 64; float* li_l = ws; float* al_l = ws + 32;
    float m_reg = -1e30f, l_reg = 0; f32x16 o[4] = {}; bf16x8 qr[DQK / 16];
    const unsigned qoff = (unsigned)((wid * QBLK + r32) * LDQ + hi * 8) * 2u;
#pragma unroll
    for (int d0 = 0; d0 < DQK / 16; ++d0) qr[d0] = *reinterpret_cast<const bf16x8*>((const char*)Qb + qoff + d0 * 32);
    const int sr = tid >> 4, sc = (tid & 15) * 8, vst0 = v_st(sr, sc), vst1 = v_st(32 + sr, sc);
    const int kr = (DQK == 128) ? sr : (tid >> 3), kc = (DQK == 128) ? sc : (tid & 7) * 8;
    const unsigned voffV = (unsigned)(sr * LDV + sc) * 2u, voffK = (unsigned)(kr * LDK + kc) * 2u;
    const int vb0 = (int)(uintptr_t)V_lds + v_rd_base(lane);
    struct { bf16x8 vs0, vs1, ks0, ks1; } sr_[2];
#define SLOAD(i, k0) do { const char* _vb = (const char*)Vh + (size_t)(k0) * (LDV * 2); const char* _kb = (const char*)Kh + (size_t)(k0) * (LDK * 2); \
    sr_[i].vs0 = *reinterpret_cast<const bf16x8*>(_vb + voffV); sr_[i].vs1 = *reinterpret_cast<const bf16x8*>(_vb + voffV + 32 * LDV * 2); \
    sr_[i].ks0 = *reinterpret_cast<const bf16x8*>(_kb + voffK); if constexpr (DQK == 128) sr_[i].ks1 = *reinterpret_cast<const bf16x8*>(_kb + voffK + 32 * LDK * 2); } while (0)
#define SWRITE(b, i) do { *(bf16x8*)(V_lds + (b) * SHM_V + vst0) = sr_[i].vs0;          \
    *(bf16x8*)(V_lds + (b) * SHM_V + vst1) = sr_[i].vs1;               \
    *(bf16x8*)(K_lds + (b) * SHM_K + kswz<DQK>(kr, kc * 2)) = sr_[i].ks0;                       \
    if constexpr (DQK == 128) *(bf16x8*)(K_lds + (b) * SHM_K + kswz<DQK>(32 + kr, kc * 2)) = sr_[i].ks1; } while (0)
#define SWAIT() do { if constexpr (DQK == 128) asm volatile("s_waitcnt vmcnt(4)" ::: "memory"); else asm volatile("s_waitcnt vmcnt(3)" ::: "memory"); } while (0)
#define RESC(a) do { if (__any((a) < 1.f)) { if (hi == 0) al_l[r32] = (a); asm volatile("s_waitcnt lgkmcnt(0)" ::: "memory"); \
    _Pragma("unroll") for (int d = 0; d < 4; ++d) _Pragma("unroll") for (int r = 0; r < 16; ++r) o[d][r] *= al_l[crow(r, hi)]; } } while (0)
    f32x16 pA0, pA1, pB0, pB1; float mnA, mnB, alA, alB; bf16x8 pa0, pa1, pa2, pa3; const int NT = seq / KVBLK;
    constexpr int SE = 0, SO = 1;
    SLOAD(SE, 0); asm volatile("s_waitcnt vmcnt(0)" ::: "memory"); SWRITE(0, SE); __syncthreads();
    qkt<DQK>(pA0, pA1, K_lds, qr, r32, hi); partialSM<DQK>(pA0, pA1, m_reg, mnA, alA);
    SLOAD(SO, KVBLK); if (2 < NT) SLOAD(SE, 2 * KVBLK);
    SWAIT(); SWRITE(1, SO); __syncthreads();
    for (int j = 1; j + 1 < NT; j += 2) {
        SBAR(); qkt<DQK>(pB0, pB1, K_lds + SHM_K, qr, r32, hi);
        finishSM(pA0, pA1, alA, l_reg, pa0, pa1, pa2, pa3); SBAR();
        SLOAD(SO, (j + 2) * KVBLK); SBAR();
        pv_d0(o, vb0, pa0, pa1, pa2, pa3); partialSM<DQK>(pB0, pB1, m_reg, mnB, alB);
        __syncthreads(); SWAIT(); SWRITE(0, SE);
        RESC(alB); __syncthreads();
        SBAR(); qkt<DQK>(pA0, pA1, K_lds, qr, r32, hi);
        finishSM(pB0, pB1, alB, l_reg, pa0, pa1, pa2, pa3); SBAR();
        if (j + 3 < NT) SLOAD(SE, (j + 3) * KVBLK); SBAR();
        pv_d0(o, vb0 + (int)SHM_V, pa0, pa1, pa2, pa3); partialSM<DQK>(pA0, pA1, m_reg, mnA, alA);
        __syncthreads(); SWAIT(); SWRITE(1, SO);
        RESC(alA); __syncthreads();
    }
    SBAR(); qkt<DQK>(pB0, pB1, K_lds + SHM_K, qr, r32, hi);
    finishSM(pA0, pA1, alA, l_reg, pa0, pa1, pa2, pa3); SBAR();
    pv_d0(o, vb0, pa0, pa1, pa2, pa3); partialSM<DQK>(pB0, pB1, m_reg, mnB, alB);
    __syncthreads(); RESC(alB);
    finishSM(pB0, pB1, alB, l_reg, pa0, pa1, pa2, pa3); SBAR();
    pv_d0(o, vb0 + (int)SHM_V, pa0, pa1, pa2, pa3);
    if (hi == 0) li_l[r32] = l_reg; asm volatile("s_waitcnt lgkmcnt(0)" ::: "memory");
    float rli[16];
#pragma unroll
    for (int r = 0; r < 16; ++r) rli[r] = __builtin_amdgcn_rcpf(li_l[crow(r, hi)]);
    if constexpr (OUT_BF16) {
#pragma unroll
        for (int r = 0; r < 16; ++r) { const unsigned ob = (unsigned)((wid * QBLK + crow(r, hi)) * LDO + r32); const float sc16 = rli[r] * 16.0f;
#pragma unroll
            for (int d0 = 0; d0 < 4; ++d0) *((unsigned char*)Ob + ob + d0 * 32) = (unsigned char)(__builtin_amdgcn_cvt_pk_fp8_f32(o[d0][r] * sc16, 0.f, 0, false) & 0xff); }
    } else {
#pragma unroll
        for (int r = 0; r < 16; ++r) { const unsigned ob = (unsigned)((wid * QBLK + crow(r, hi)) * LDO + r32) * 2u;
#pragma unroll
            for (int d0 = 0; d0 < 4; ++d0) *(bf16_t*)((char*)Ob + ob + d0 * 64) = f2bf(o[d0][r] * rli[r]); }
    }
#undef SLOAD
#undef SWRITE
#undef SWAIT
#undef RESC
}
}

struct Args { const float* in[26]; float* out; unsigned char* ws; int ph_lo, ph_hi; };
enum { I_X = 0, I_C, I_CTX, I_CCTX, I_WMOD, I_BMOD, I_G1, I_G2, I_WIN, I_GQ, I_GK, I_LQ1, I_LK1, I_LQ2, I_LK2, I_GSUB, I_WPOOL, I_PSCALE, I_WOUT, I_WR, I_BR, I_W1, I_B1, I_W2, I_B2, I_GF };
constexpr int NPHASE = 22;

struct TItem { const char* src; unsigned char* dst; unsigned soff, doff, nb4, ldb; float scale; };
__device__ __forceinline__ TItem titem(int it, const float* win, const float* wout, const float* w1, const float* w2, unsigned char* ws, int lane) {
    constexpr int I_IN = 32 * (INW / 64), I_OUT = 24 * (D / 64), I_E1 = 32 * 32, I_E2 = 16 * 32;
    constexpr int T_IN = 2 * I_IN, T_OUT = 2 * I_OUT, T_E1 = 64 * I_E1;
    const float* W; unsigned char* WT; int N, ldb, item; float scale; int r = it;
    if (r < T_IN) { const int l = r / I_IN; W = win + (size_t)l * D * INW; N = INW; WT = ws + WS_WIN + (size_t)l * INW * D; ldb = D; item = r % I_IN; scale = 64.0f; }
    else if ((r -= T_IN) < T_OUT) { const int l = r / I_OUT; W = wout + (size_t)l * D * D; N = D; WT = ws + WS_WOUT + (size_t)l * D * D; ldb = D; item = r % I_OUT; scale = (item / (D / 32) < 8) ? 4.0f : 64.0f; }
    else if ((r -= T_OUT) < T_E1) { const int le = r / I_E1; W = w1 + (size_t)le * D * 2048; N = 2048; WT = ws + WS_W1 + (size_t)le * 2048 * D; ldb = D; item = r % I_E1; scale = 64.0f; }
    else { r -= T_E1; const int le = r / I_E2; W = w2 + (size_t)le * DE * D; N = D; WT = ws + WS_W2 + (size_t)le * D * DE; ldb = DE; item = r % I_E2; scale = 32.0f; }
    const int nblk = N / 32, kb = item / nblk, nb = item % nblk, k0 = 128 * kb + 16 * (lane >> 3), n0 = 32 * nb + 4 * (lane & 7);
    TItem t; t.src = (const char*)uniform_ptr(W); t.dst = uniform_ptr(WT); t.soff = (unsigned)(k0 * N + n0) * 4u; t.doff = (unsigned)(n0 * ldb + k0); t.nb4 = (unsigned)N * 4u; t.ldb = (unsigned)ldb; t.scale = scale; return t;
}
#define TI_LOAD(v, t) do { _Pragma("unroll") for (int _i = 0; _i < 16; ++_i) v[_i] = *(const f32x4*)((t).src + ((t).soff + (unsigned)_i * (t).nb4)); } while (0)
#define TI_STORE(v, t) do { const float _sc = (t).scale; _Pragma("unroll") for (int _c = 0; _c < 4; ++_c) { int _w[4]; \
        _Pragma("unroll") for (int _q = 0; _q < 4; ++_q) { int _x = 0; _x = __builtin_amdgcn_cvt_pk_fp8_f32(v[4 * _q][_c] * _sc, v[4 * _q + 1][_c] * _sc, _x, false); \
            _x = __builtin_amdgcn_cvt_pk_fp8_f32(v[4 * _q + 2][_c] * _sc, v[4 * _q + 3][_c] * _sc, _x, true); _w[_q] = _x; } \
        *(u32x4*)((t).dst + ((t).doff + (unsigned)_c * (t).ldb)) = (u32x4){(unsigned)_w[0], (unsigned)_w[1], (unsigned)_w[2], (unsigned)_w[3]}; } } while (0)
__device__ __forceinline__ float silu_f(float x) { return x / (1.0f + __expf(-x)); }

__device__ __forceinline__ void fold_item(int it, const float* wpool, const float* pscale, const float* wout, unsigned char* WOUT) {
    const int n = it & 2047, cc = (it >> 11) & 15, g = (it >> 15) & 3, l = it >> 17;
    const float* wp = wpool + (((size_t)l * 4 + g) * 128 + cc * 8) * 128;
    const float* ps = pscale + (size_t)l * 512 + g * 128;
    const float* wo = wout + ((size_t)l * D + 1536 + g * 128) * D + n;
    float acc[8];
#pragma unroll
    for (int q = 0; q < 8; ++q) acc[q] = 0.f;
#pragma unroll 1
    for (int d0 = 0; d0 < 128; d0 += 32) { float av[32];
#pragma unroll
        for (int dd = 0; dd < 32; ++dd) av[dd] = wo[(size_t)(d0 + dd) * D];
#pragma unroll
        for (int dd = 0; dd < 32; ++dd) { const float x = ps[d0 + dd] * av[dd];
#pragma unroll
            for (int q = 0; q < 8; ++q) acc[q] = fmaf(wp[q * 128 + d0 + dd], x, acc[q]); } }
    int o0 = 0, o1 = 0; o0 = __builtin_amdgcn_cvt_pk_fp8_f32(acc[0] * 64.f, acc[1] * 64.f, o0, false); o0 = __builtin_amdgcn_cvt_pk_fp8_f32(acc[2] * 64.f, acc[3] * 64.f, o0, true);
    o1 = __builtin_amdgcn_cvt_pk_fp8_f32(acc[4] * 64.f, acc[5] * 64.f, o1, false); o1 = __builtin_amdgcn_cvt_pk_fp8_f32(acc[6] * 64.f, acc[7] * 64.f, o1, true);
    *(u32x2*)(WOUT + ((size_t)l * D + n) * D + 1536 + g * 128 + cc * 8) = (u32x2){(unsigned)o0, (unsigned)o1};
}

PHASE_FN phase_prologue(LAS unsigned char* lds, int l_unused, int G) {
    lds = (LAS unsigned char*)__builtin_amdgcn_readfirstlane((int)(uintptr_t)lds); G = __builtin_amdgcn_readfirstlane(G);
    const int tid = tid_local(), lane = tid & 63, wave = __builtin_amdgcn_readfirstlane(tid >> 6);
    unsigned char* ws = WSP();
    const int gw = blockIdx.x * NWAVES + wave, NGW = G * NWAVES;
    {
        float* MODP = (float*)(ws + WS_MODP);
        const float* cvec = INP(I_C); const float* cctx = INP(I_CCTX); const float* wmod = INP(I_WMOD);
        LAS float* st = (LAS float*)lds;
        for (int i = tid; i < 5 * D; i += NTHREADS) st[i] = silu_f(i < 4 * D ? cvec[i] : cctx[i - 4 * D]);
        __syncthreads();
        for (int u = gw; u < 2 * 64 * 48; u += NGW) {
            const int l = u / (64 * 48), r = u % (64 * 48), kc = r / 48, cg = r % 48;
            const int col = cg * 256 + lane * 4;
            const float* W = wmod + (size_t)l * D * 12288 + (size_t)(kc * 32) * 12288 + col;
            f32x4 acc[5];
#pragma unroll
            for (int v = 0; v < 5; ++v) acc[v] = (f32x4){0.f, 0.f, 0.f, 0.f};
#pragma unroll 1
            for (int k8 = 0; k8 < 32; k8 += 16) {
                f32x4 w[16];
#pragma unroll
                for (int kk = 0; kk < 16; ++kk) w[kk] = *(const f32x4*)(W + (size_t)(k8 + kk) * 12288);
#pragma unroll
                for (int kk = 0; kk < 16; ++kk) { const int k = kc * 32 + k8 + kk;
#pragma unroll
                    for (int v = 0; v < 5; ++v) acc[v] += st[v * D + k] * w[kk]; } }
#pragma unroll
            for (int v = 0; v < 5; ++v) *(f32x4*)(MODP + ((size_t)kc * 10 + l * 5 + v) * 12288 + col) = acc[v];
        }
        __syncthreads();
    }
    {
        f32x2* tabA = (f32x2*)(ws + WS_ROPE); f32x2* tabB = tabA + 64 * 32;
        for (int i = blockIdx.x * NTHREADS + tid; i < 64 * 32 + 64 * 16; i += G * NTHREADS) {
            if (i < 64 * 32) { const int pos = i >> 5, f = i & 31; const float inv = powf(10000.0f, -(float)f / 32.0f); const float ang = (float)pos * inv; tabA[i] = (f32x2){cosf(ang), sinf(ang)}; }
            else { const int q = i - 64 * 32; const int pos = q >> 4, f = q & 15; const float inv = powf(10000.0f, -(float)f / 16.0f); const float ang = (float)pos * inv; tabB[q] = (f32x2){cosf(ang), sinf(ang)}; }
        }
    }
    {
        const float* wr = INP(I_WR); bf16_t* WRS = (bf16_t*)(ws + WS_WRS);
        for (int i = blockIdx.x * NTHREADS + tid; i < 2 * D * NE; i += G * NTHREADS) {
            const int l = i / (D * NE), rem = i % (D * NE), k = rem >> 5, e = rem & 31;
            WRS[((size_t)l * NE + e) * D + k] = f2bf(wr[i]); }
    }
    {
        const float* win = INP(I_WIN); const float* wout = INP(I_WOUT); const float* w1 = INP(I_W1); const float* w2 = INP(I_W2);
        constexpr int TOT = 2 * 32 * (INW / 64);
        f32x4 va[16], vb[16]; TItem ta, tb;
        int it = gw;
        if (it < TOT) { ta = titem(it, win, wout, w1, w2, ws, lane); TI_LOAD(va, ta); }
        while (it < TOT) {
            const int i1 = it + NGW;
            if (i1 < TOT) { tb = titem(i1, win, wout, w1, w2, ws, lane); TI_LOAD(vb, tb); }
            TI_STORE(va, ta);
            if (i1 >= TOT) break;
            const int i2 = i1 + NGW;
            if (i2 < TOT) { ta = titem(i2, win, wout, w1, w2, ws, lane); TI_LOAD(va, ta); }
            TI_STORE(vb, tb);
            it = i2;
        }
    }
}

PHASE_FN phase_modreduce(LAS unsigned char* lds, int l_unused, int G) {
    lds = (LAS unsigned char*)__builtin_amdgcn_readfirstlane((int)(uintptr_t)lds); G = __builtin_amdgcn_readfirstlane(G);
    const int tid = tid_local();
    unsigned char* ws = WSP();
    const float* MODP = (const float*)(ws + WS_MODP); float* MOD = (float*)(ws + WS_MOD); const float* bmod = INP(I_BMOD); const float* g2 = INP(I_G2);
    for (int i = blockIdx.x * NTHREADS + tid; i < 10 * 12288 / 4; i += G * NTHREADS) {
        const int lv = i / 3072, col = (i % 3072) * 4, l = lv / 5;
        f32x4 s = *(const f32x4*)(bmod + (size_t)l * 12288 + col);
#pragma unroll 16
        for (int kc = 0; kc < 64; ++kc) s += *(const f32x4*)(MODP + ((size_t)kc * 10 + lv) * 12288 + col);
        if (col >= 4 * 2048 && col < 5 * 2048) s = *(const f32x4*)(g2 + (size_t)l * D + (col - 4 * 2048)) * (s + 1.0f);
        *(f32x4*)(MOD + (size_t)lv * 12288 + col) = s;
    }
}

__device__ __forceinline__ void norm_mod_store(const f32x4 (&v)[8], const f32x4 (&gg)[8], const f32x4 (&sh)[8], const f32x4 (&sc)[8], unsigned char* orow, int lane) {
    float ss = 0.f;
#pragma unroll
    for (int j = 0; j < 8; ++j) ss += (v[j].x * v[j].x + v[j].y * v[j].y) + (v[j].z * v[j].z + v[j].w * v[j].w);
    const float rs = rsqrtf(wave_sum(ss) * (1.0f / D) + EPS);
#pragma unroll
    for (int j = 0; j < 8; ++j) { const int col = 4 * (lane + 64 * j);
        const f32x4 y = (v[j] * rs) * gg[j]; const f32x4 n = y * (sc[j] + 1.0f) + sh[j];
        int w = 0; w = __builtin_amdgcn_cvt_pk_fp8_f32(n.x, n.y, w, false); w = __builtin_amdgcn_cvt_pk_fp8_f32(n.z, n.w, w, true);
        *(int*)(orow + col) = w; }
}

PHASE_FN phase_norm1_l0(LAS unsigned char* lds, int l_unused, int G) {
    lds = (LAS unsigned char*)__builtin_amdgcn_readfirstlane((int)(uintptr_t)lds); G = __builtin_amdgcn_readfirstlane(G);
    const int tid = tid_local(), lane = tid & 63, wave = __builtin_amdgcn_readfirstlane(tid >> 6);
    unsigned char* ws = WSP();
    const float* MOD = (const float*)(ws + WS_MOD);
    unsigned char* N = ws + WS_N;
    const float* x = INP(I_X); const float* ctx = INP(I_CTX); const float* g1 = INP(I_G1);
    f32x4 gg[8];
#pragma unroll
    for (int j = 0; j < 8; ++j) gg[j] = *(const f32x4*)(g1 + 4 * (lane + 64 * j));
    for (int row = blockIdx.x * NWAVES + wave; row < MT; row += G * NWAVES) {
        const float* src = row < ML ? x + (size_t)row * D : ctx + (size_t)(row - ML) * D;
        const int bidx = row < ML ? (row >> 12) : 4;
        const float* m = MOD + (size_t)bidx * 12288;
        f32x4 v[8], sh[8], sc[8];
#pragma unroll
        for (int j = 0; j < 8; ++j) { v[j] = *(const f32x4*)(src + 4 * (lane + 64 * j)); sh[j] = *(const f32x4*)(m + 4 * (lane + 64 * j)); sc[j] = *(const f32x4*)(m + 2048 + 4 * (lane + 64 * j)); }
        norm_mod_store(v, gg, sh, sc, N + (size_t)row * D, lane);
    }
}

PHASE_FN phase_inproj(LAS unsigned char* lds, int l, int G) {
    lds = (LAS unsigned char*)__builtin_amdgcn_readfirstlane((int)(uintptr_t)lds); l = __builtin_amdgcn_readfirstlane(l); G = __builtin_amdgcn_readfirstlane(G);
    unsigned char* ws = WSP();
    pg8::DenseSched<D, 1> S; S.init(ws + WS_N, ws + WS_WIN + (size_t)l * INW * D, MT, INW, G, (int)blockIdx.x);
    pg8::EpiProj E{(bf16_t*)(ws + WS_P), (bf16_t*)(ws + WS_VA), (bf16_t*)(ws + WS_VB)};
    pg8::gemm_phase(lds, S, E);
}

PHASE_FN phase_prep(LAS unsigned char* lds, int l, int G) {
    lds = (LAS unsigned char*)__builtin_amdgcn_readfirstlane((int)(uintptr_t)lds); l = __builtin_amdgcn_readfirstlane(l); G = __builtin_amdgcn_readfirstlane(G);
    const int tid = tid_local(), lane = tid & 63, wave = __builtin_amdgcn_readfirstlane(tid >> 6);
    unsigned char* ws = WSP();
    const bf16_t* P = (const bf16_t*)(ws + WS_P);
    unsigned* QA = (unsigned*)(ws + WS_QA); unsigned* KA = (unsigned*)(ws + WS_KA); unsigned* VA = (unsigned*)(ws + WS_VA);
    unsigned* QB = (unsigned*)(ws + WS_QB); unsigned* KB = (unsigned*)(ws + WS_KB); unsigned* VB = (unsigned*)(ws + WS_VB); unsigned char* CAT = ws + WS_CAT;
    const f32x2* tabA = (const f32x2*)(ws + WS_ROPE); const f32x2* tabB = tabA + 64 * 32;
    const f32x2 gq2 = *(const f32x2*)(INP(I_GQ) + l * 128 + 2 * lane), gk2 = *(const f32x2*)(INP(I_GK) + l * 128 + 2 * lane);
    const bool firstA = (lane & 16) == 0, firstB = (lane & 8) == 0;
    for (int unit = blockIdx.x; unit < MT / 8; unit += G) {
        const int ch = tid, hw = 1 << (ch >> 7);
        const int row0 = unit * 8; int base, s0, L;
        if (row0 < ML) { base = row0 & ~4095; s0 = row0 & 4095; L = SEQ; } else { const int r2 = row0 - ML; base = ML + (r2 & ~255); s0 = r2 & 255; L = CTX; }
        float pv_[23];
        { const bf16_t* pc = P + (size_t)base * INW + OFF_UC + ch;
#pragma unroll
            for (int j = 0; j < 23; ++j) { int sj = s0 - 8 + j; sj = sj < 0 ? 0 : (sj >= L ? L - 1 : sj);
                pv_[j] = bf2f(pc[(size_t)sj * INW]); } }
        {
            const int row = unit * 8 + wave;
            const bool lat = row < ML; int b, sq, trow;
            if (lat) { b = row >> 12; sq = row & 4095; trow = b * TK + CTX + sq; } else { const int r2 = row - ML; b = r2 >> 8; sq = r2 & 255; trow = b * TK + sq; }
            const unsigned* p = (const unsigned*)(P + (size_t)row * INW);
            unsigned ha[10], hb[8];
#pragma unroll
            for (int hh = 0; hh < 10; ++hh) ha[hh] = p[(hh < 8 ? hh * 64 : OFF_KA / 2 + (hh - 8) * 64) + lane];
#pragma unroll
            for (int jp = 0; jp < 8; ++jp) hb[jp] = p[(jp < 4 ? OFF_QB / 2 + jp * 64 : OFF_KB / 2 + (jp - 4) * 64) + lane];
            const int prow = sq >> 6, pcol = sq & 63;
            const f32x4 csA = *(const f32x4*)(tabA + (lane < 32 ? prow : pcol) * 32 + 2 * (lane & 15));
            const f32x4 csB = *(const f32x4*)(tabB + ((lane & 16) == 0 ? prow : pcol) * 16 + 2 * (lane & 7));
#pragma unroll
            for (int hh = 0; hh < 10; ++hh) {
                float e0 = __uint_as_float(ha[hh] << 16), e1 = __uint_as_float(ha[hh] & 0xffff0000u);
                const float ss = wave_sum(e0 * e0 + e1 * e1); const float r = rsqrtf(ss * (1.0f / 128.0f) + EPS);
                const f32x2 g = hh < 8 ? gq2 : gk2;
                e0 = e0 * r * g.x; e1 = e1 * r * g.y;
                if (lat) {
                    const float o0 = __shfl_xor(e0, 16), o1 = __shfl_xor(e1, 16);
                    e0 = firstA ? (e0 * csA.x - o0 * csA.y) : (o0 * csA.y + e0 * csA.x);
                    e1 = firstA ? (e1 * csA.z - o1 * csA.w) : (o1 * csA.w + e1 * csA.z);
                }
                unsigned* dst = hh < 8 ? QA + (size_t)row * 512 + hh * 64 : KA + (size_t)trow * 128 + (hh - 8) * 64;
                dst[lane] = cvt_pk_bf16(e0, e1);
            }
#pragma unroll
            for (int jp = 0; jp < 8; ++jp) {
                float e0 = __uint_as_float(hb[jp] << 16), e1 = __uint_as_float(hb[jp] & 0xffff0000u);
                if (lat) {
                    const float o0 = __shfl_xor(e0, 8), o1 = __shfl_xor(e1, 8);
                    e0 = firstB ? (e0 * csB.x - o0 * csB.y) : (o0 * csB.y + e0 * csB.x);
                    e1 = firstB ? (e1 * csB.z - o1 * csB.w) : (o1 * csB.w + e1 * csB.z);
                }
                unsigned* dst = jp < 4 ? QB + (size_t)row * 256 + jp * 64 : KB + (size_t)trow * 256 + (jp - 4) * 64;
                dst[lane] = cvt_pk_bf16(e0, e1);
            }
        }
        {
#pragma unroll
            for (int tk = 0; tk < 8; ++tk) { const int sq = s0 + tk;
                const int lo = (sq - hw) < 0 ? 0 : (sq - hw), hi = (sq + hw) > L ? L : (sq + hw);
                float sum = 0.f;
#pragma unroll
                for (int j = tk; j < tk + 16; ++j) { const int sj = s0 - 8 + j; sum += (sj >= lo && sj < hi) ? pv_[j] : 0.f; }
                CAT[(size_t)(row0 + tk) * D + 1536 + ch] = (unsigned char)(__builtin_amdgcn_cvt_pk_fp8_f32(sum / (float)(hi - lo) - pv_[tk + 8], 0.f, 0, false) & 0xff); }
        }
    }
}

constexpr int NCONV_WG = 40;
constexpr int CONV_BATCH = 128, CONV_E1 = 32 * 32 * 32, CONV_E2 = 32 * 16 * 32, CONV_ITEMS = CONV_E1 + CONV_E2  , CONV_FIRST = 2 * 32 * (INW / 64) + 2 * 24 * (D / 64);
constexpr int CONV_OUT0 = 2 * 32 * (INW / 64), CONV_OUT = 24 * (D / 64)  , NB_FOLD = 4 * 16 * 2048 / NTHREADS  , NB_OUT = CONV_OUT / CONV_BATCH, NB_EXP = CONV_ITEMS / CONV_BATCH;
static_assert(CONV_OUT % CONV_BATCH == 0, "w_out batches");
PHASE_FN phase_attention(LAS unsigned char* lds_, int l, int G) {
    lds_ = (LAS unsigned char*)__builtin_amdgcn_readfirstlane((int)(uintptr_t)lds_); l = __builtin_amdgcn_readfirstlane(l); G = __builtin_amdgcn_readfirstlane(G);
    LAS unsigned char* lds = lds_;
    unsigned char* ws = WSP();
    char* ldsg = (char*)lds_;
    const int tid = tid_local();
    const bf16_t* QA = (const bf16_t*)(ws + WS_QA); const bf16_t* KA = (const bf16_t*)(ws + WS_KA); const bf16_t* VA = (const bf16_t*)(ws + WS_VA);
    const bf16_t* QB = (const bf16_t*)(ws + WS_QB); const bf16_t* KB = (const bf16_t*)(ws + WS_KB); const bf16_t* VB = (const bf16_t*)(ws + WS_VB);
    unsigned char* CAT = ws + WS_CAT; bf16_t* OB = (bf16_t*)(ws + WS_OB);
    const int nA = 512 + (l == 0 ? 32 : 0), nB = 512 + (l == 0 ? 32 : 0);
    const bool dyn = (G > NCONV_WG);
    unsigned* qh = (unsigned*)(ws + WS_CTL) + CW_Q + l * 192;
    volatile LAS int* slot = (volatile LAS int*)(lds + MISC_OFF + 32);
    if (!dyn || (int)blockIdx.x < G - NCONV_WG) {
    for (int it = 0;; ++it) {
        int id;
        __syncthreads();
        if (dyn) { if (tid == 0) *slot = (int)atomicAdd(qh, 1u); __syncthreads(); id = __builtin_amdgcn_readfirstlane(*slot); } else id = (int)blockIdx.x + it * G;
        if (id >= nA) break;
        const bf16_t *q, *k, *v; unsigned char* o; int seq;
        if (id < 512) { int b, kvh, h, qb;
            if (dyn) { b = id >> 7; kvh = (id >> 6) & 1; h = kvh * 4 + ((id >> 4) & 3); qb = id & 15; }
            else { const int x = id & 7, i = id >> 8, j = (id >> 3) & 31; b = x >> 1; kvh = x & 1; h = kvh * 4 + 2 * i + (j >> 4); qb = j & 15; }
            const size_t r0 = (size_t)b * SEQ + qb * 256;
            q = QA + r0 * 1024 + h * 128; k = KA + (size_t)b * TK * 256 + kvh * 128; v = VA + (size_t)b * TK * 256 + kvh * 128; o = CAT + r0 * D + h * 128; seq = TK; }
        else { const int c = id - 512, b = c >> 3, h = c & 7; const size_t r0 = (size_t)ML + b * CTX;
            q = QA + r0 * 1024 + h * 128; k = KA + (size_t)b * TK * 256 + (h >> 2) * 128; v = VA + (size_t)b * TK * 256 + (h >> 2) * 128; o = CAT + r0 * D + h * 128; seq = CTX; }
        att::attn_body<128, 1024, 256, 256, D, true>(q, k, v, o, seq, ldsg);
    }
    for (int it = 0;; ++it) {
        int id;
        __syncthreads();
        if (dyn) { if (tid == 0) *slot = (int)atomicAdd(qh + 64, 1u); __syncthreads(); id = __builtin_amdgcn_readfirstlane(*slot); } else id = (int)blockIdx.x + it * G;
        if (id >= nB) break;
        const bf16_t *q, *k, *v; bf16_t* o; int seq;
        if (id < 512) { int b, h, comp, qb;
            if (dyn) { b = id >> 7; h = (id >> 5) & 3; comp = (id >> 4) & 1; qb = id & 15; }
            else { const int x = id & 7, i = id >> 8, j = (id >> 3) & 31; const int combo = 2 * x + i; b = combo >> 2; h = combo & 3; comp = j >> 4; qb = j & 15; }
            const int jj = comp * 4 + h; const size_t r0 = (size_t)b * SEQ + qb * 256;
            q = QB + r0 * 512 + jj * 64; k = KB + (size_t)b * TK * 512 + jj * 64; v = VB + (size_t)b * TK * 512 + h * 128; o = OB + r0 * 1024 + jj * 128; seq = TK; }
        else { const int c = id - 512, b = c >> 3, jj = c & 7, h = jj & 3; const size_t r0 = (size_t)ML + b * CTX;
            q = QB + r0 * 512 + jj * 64; k = KB + (size_t)b * TK * 512 + jj * 64; v = VB + (size_t)b * TK * 512 + h * 128; o = OB + r0 * 1024 + jj * 128; seq = CTX; }
        att::attn_body<64, 512, 512, 512, 1024, false>(q, k, v, o, seq, ldsg);
    }
    }
    {
        const int lane = tid & 63, wave = __builtin_amdgcn_readfirstlane(tid >> 6);
        int bt;
#define CONV_PULL() do { __syncthreads(); if (tid == 0) *slot = (int)atomicAdd(qh + 128, 1u); __syncthreads(); bt = __builtin_amdgcn_readfirstlane(*slot); } while (0)
        for (;;) {
            CONV_PULL();
            if (bt >= NB_FOLD) break;
            fold_item(l * (4 * 16 * 2048) + bt * NTHREADS + tid, INP(I_WPOOL), INP(I_PSCALE), INP(I_WOUT), ws + WS_WOUT);
        }
        const float* win = INP(I_WIN); const float* wout = INP(I_WOUT); const float* w1 = INP(I_W1); const float* w2 = INP(I_W2);
        for (;; ) {
            if (bt >= NB_FOLD + NB_OUT + NB_EXP) break;
            int base;
            if (bt < NB_FOLD + NB_OUT) base = CONV_OUT0 + l * CONV_OUT + (bt - NB_FOLD) * CONV_BATCH + wave * (CONV_BATCH / NWAVES);
            else { const int li = (bt - NB_FOLD - NB_OUT) * CONV_BATCH + wave * (CONV_BATCH / NWAVES);
                base = li < CONV_E1 ? CONV_FIRST + l * CONV_E1 + li : CONV_FIRST + 2 * CONV_E1 + l * CONV_E2 + (li - CONV_E1); }
            f32x4 va[16], vb[16], vc[16]; TItem ta, tb, tc;
            constexpr int NI = CONV_BATCH / NWAVES;
            ta = titem(base, win, wout, w1, w2, ws, lane); TI_LOAD(va, ta); tb = titem(base + 1, win, wout, w1, w2, ws, lane); TI_LOAD(vb, tb);
#pragma unroll 1
            for (int i = 0; i < NI; i += 3) {
                if (i + 2 < NI) { tc = titem(base + i + 2, win, wout, w1, w2, ws, lane); TI_LOAD(vc, tc); }
                TI_STORE(va, ta);
                if (i + 3 < NI) { ta = titem(base + i + 3, win, wout, w1, w2, ws, lane); TI_LOAD(va, ta); }
                if (i + 1 < NI) TI_STORE(vb, tb);
                if (i + 4 < NI) { tb = titem(base + i + 4, win, wout, w1, w2, ws, lane); TI_LOAD(vb, tb); }
                if (i + 2 < NI) TI_STORE(vc, tc);
            }
            CONV_PULL();
        }
#undef CONV_PULL
    }
}

PHASE_FN phase_fixup(LAS unsigned char* lds, int l, int G) {
    lds = (LAS unsigned char*)__builtin_amdgcn_readfirstlane((int)(uintptr_t)lds); l = __builtin_amdgcn_readfirstlane(l); G = __builtin_amdgcn_readfirstlane(G);
    const int tid = tid_local(), lane = tid & 63, wave = __builtin_amdgcn_readfirstlane(tid >> 6);
    unsigned char* ws = WSP();
    const float lam_init = 0.8f - 0.6f * expf(-0.3f * (float)l);
    float s1 = 0.f, s2 = 0.f;
    { const float* lq1 = INP(I_LQ1) + l * 64; const float* lk1 = INP(I_LK1) + l * 64; const float* lq2 = INP(I_LQ2) + l * 64; const float* lk2 = INP(I_LK2) + l * 64;
      s1 = wave_sum(lq1[lane] * lk1[lane]); s2 = wave_sum(lq2[lane] * lk2[lane]); }
    const float lam = expf(s1) - expf(s2) + lam_init;
    const unsigned* OB = (const unsigned*)(ws + WS_OB); unsigned char* CAT = ws + WS_CAT;
    const float* gs = INP(I_GSUB) + l * 128;
    const int nrows = (l == 0) ? MT : ML;
    const f32x2 g2 = *(const f32x2*)(gs + 2 * lane);
    unsigned w1[4], w2[4], n1[4], n2[4];
    int row = blockIdx.x * NWAVES + wave;
    if (row < nrows) {
#pragma unroll
        for (int h = 0; h < 4; ++h) { w1[h] = OB[(size_t)row * 512 + h * 64 + lane]; w2[h] = OB[(size_t)row * 512 + (4 + h) * 64 + lane]; } }
    for (; row < nrows; row += G * NWAVES) {
        const int nrow = row + G * NWAVES;
        if (nrow < nrows) {
#pragma unroll
            for (int h = 0; h < 4; ++h) { n1[h] = OB[(size_t)nrow * 512 + h * 64 + lane]; n2[h] = OB[(size_t)nrow * 512 + (4 + h) * 64 + lane]; } }
#pragma unroll
        for (int h = 0; h < 4; ++h) {
            const f32x2 o1 = (f32x2){__uint_as_float(w1[h] << 16), __uint_as_float(w1[h] & 0xffff0000u)}, o2 = (f32x2){__uint_as_float(w2[h] << 16), __uint_as_float(w2[h] & 0xffff0000u)};
            const f32x2 d = o1 - lam * o2;
            const float ss = wave_sum(d.x * d.x + d.y * d.y); const float r = rsqrtf(ss * (1.0f / 128.0f) + EPS) * (1.0f - lam_init);
            *(unsigned short*)(CAT + (size_t)row * D + 1024 + h * 128 + 2 * lane) = (unsigned short)(__builtin_amdgcn_cvt_pk_fp8_f32(d.x * r * g2.x, d.y * r * g2.y, 0, false) & 0xffff);
        }
#pragma unroll
        for (int h = 0; h < 4; ++h) { w1[h] = n1[h]; w2[h] = n2[h]; }
    }
}

PHASE_FN phase_outproj(LAS unsigned char* lds, int l, int G) {
    lds = (LAS unsigned char*)__builtin_amdgcn_readfirstlane((int)(uintptr_t)lds); l = __builtin_amdgcn_readfirstlane(l); G = __builtin_amdgcn_readfirstlane(G);
    unsigned char* ws = WSP();
    pg8::DenseSched<D, 1> S; S.init(ws + WS_CAT, ws + WS_WOUT + (size_t)l * D * D, (l == 0) ? MT : ML, D, G, (int)blockIdx.x);
    pg8::EpiResid E{INP(I_X), INP(I_CTX), (const bf16_t*)(ws + WS_XR), (bf16_t*)(ws + WS_XR), (const float*)(ws + WS_MOD) + (size_t)l * 5 * 12288, l};
    pg8::gemm_phase(lds, S, E);
}

PHASE_FN phase_router(LAS unsigned char* lds, int l, int G) {
    lds = (LAS unsigned char*)__builtin_amdgcn_readfirstlane((int)(uintptr_t)lds); l = __builtin_amdgcn_readfirstlane(l); G = __builtin_amdgcn_readfirstlane(G);
    const int tid = tid_local(), lane = tid & 63, wave = __builtin_amdgcn_readfirstlane(tid >> 6);
    unsigned char* ws = WSP();
    const bf16_t* XR = (const bf16_t*)(ws + WS_XR); unsigned char* NF8 = ws + WS_NF8;
    const float* MOD = (const float*)(ws + WS_MOD) + (size_t)l * 5 * 12288;
    int* eid = (int*)(ws + WS_ROUT + ROUT_EID); float* gate = (float*)(ws + WS_ROUT + ROUT_GATE); int* posb = (int*)(ws + WS_ROUT + ROUT_POS); int* list = (int*)(ws + WS_ROUT + ROUT_LIST);
    unsigned* cnt = (unsigned*)(ws + WS_CTL) + CW_CNT + l * 32 * 64;
    const float* br = INP(I_BR) + l * NE;
    const bf16_t* WRH = (const bf16_t*)(ws + WS_WRS) + (size_t)l * NE * D;
    constexpr int TST = 4112;
    LAS unsigned char* thi = lds; LAS unsigned char* tlo = lds + 16 * TST;
    static_assert(32 * TST <= MISC_OFF, "router token images");
    LAS float* fl = (LAS float*)lds;
    LAS float* lg = (LAS float*)(lds + MISC_OFF + 512);
    LAS float* tv = (LAS float*)(lds + MISC_OFF + 2560);
    LAS int* lc = (LAS int*)(lds + MISC_OFF + 2816); LAS int* lbase = (LAS int*)(lds + MISC_OFF + 2944);
    LAS int* selall = (LAS int*)(lds + MISC_OFF + 4096);
    const int ntok = (l == 0) ? MT : ML;
    if (tid < NE) lc[tid] = 0;
    const int fn = lane & 15, kg = lane >> 4;
    bf16x8 wh[8][2];
    { const char* bh = (const char*)uniform_ptr(WRH + wave * 256);
        const unsigned o0 = (unsigned)(fn * D + kg * 8) * 2u, o1 = o0 + 16u * D * 2u;
#pragma unroll
        for (int s = 0; s < 8; ++s) { wh[s][0] = *(const bf16x8*)(bh + o0 + s * 64); wh[s][1] = *(const bf16x8*)(bh + o1 + s * 64); } }
    int ui = 0;
    u32x2 ra[8], rb[8]; f32x4 psh, pg;
    LAS float* sg = (LAS float*)(lds + SG_OFF);
#define ROUTER_FETCH(u_) do { const int _row = (u_) * 16 + wave * 2; const int _b = _row < ML ? (_row >> 12) : 4; const float* _m = MOD + (size_t)_b * 12288; \
        const char* _x0 = (const char*)uniform_ptr(XR + (size_t)_row * D); const char* _x1 = (const char*)uniform_ptr(XR + (size_t)(_row + 1) * D); \
        const char* _ms = (const char*)uniform_ptr(_m + 3 * 2048); const char* _mg = (const char*)uniform_ptr(_m + 4 * 2048); \
        _Pragma("unroll") for (int j = 0; j < 8; ++j) { ra[j] = *(const u32x2*)(_x0 + lo8 + j * 512); rb[j] = *(const u32x2*)(_x1 + lo8 + j * 512); } \
        psh = *(const f32x4*)(_ms + (unsigned)tid * 16u); pg = *(const f32x4*)(_mg + (unsigned)tid * 16u); } while (0)
    const unsigned lo8 = (unsigned)lane * 8u, lo4 = (unsigned)lane * 4u, lo16 = (unsigned)lane * 16u;
    if ((int)blockIdx.x < ntok / 16) { ROUTER_FETCH((int)blockIdx.x); *(LAS f32x4*)(sg + 4 * tid) = psh; *(LAS f32x4*)(sg + 2048 + 4 * tid) = pg; }
    __syncthreads();
    for (int unit = blockIdx.x; unit < ntok / 16; unit += G) {
        LAS int* sel = selall + ui * 64;
        int tq = tid; asm volatile("" : "+v"(tq));
        const unsigned lq = (unsigned)(tq & 63);
        { const int tl = wave * 2, row = unit * 16 + tl;
            char* nfa = (char*)uniform_ptr(NF8 + (size_t)row * D); char* nfb = (char*)uniform_ptr(NF8 + (size_t)(row + 1) * D);
            float ssa = 0.f, ssb = 0.f;
#define UNPK4(w_) ((f32x4){__uint_as_float((w_).x << 16), __uint_as_float((w_).x & 0xffff0000u), __uint_as_float((w_).y << 16), __uint_as_float((w_).y & 0xffff0000u)})
#pragma unroll
            for (int j = 0; j < 8; ++j) { const f32x4 xa = UNPK4(ra[j]), xb = UNPK4(rb[j]);
                ssa += (xa.x * xa.x + xa.y * xa.y) + (xa.z * xa.z + xa.w * xa.w); ssb += (xb.x * xb.x + xb.y * xb.y) + (xb.z * xb.z + xb.w * xb.w); }
            const float rsa = rsqrtf(wave_sum(ssa) * (1.0f / D) + EPS), rsb = rsqrtf(wave_sum(ssb) * (1.0f / D) + EPS);
#pragma unroll
            for (int j = 0; j < 8; ++j) { const unsigned col = 4u * lq + 256u * j;
                const f32x4 shj = *(const LAS f32x4*)(sg + col), gj = *(const LAS f32x4*)(sg + 2048 + col);
                const f32x4 na = (UNPK4(ra[j]) * rsa) * gj + shj, nb = (UNPK4(rb[j]) * rsb) * gj + shj;
                int wa = 0, wb = 0; wa = __builtin_amdgcn_cvt_pk_fp8_f32(na.x, na.y, wa, false); wa = __builtin_amdgcn_cvt_pk_fp8_f32(na.z, na.w, wa, true);
                wb = __builtin_amdgcn_cvt_pk_fp8_f32(nb.x, nb.y, wb, false); wb = __builtin_amdgcn_cvt_pk_fp8_f32(nb.z, nb.w, wb, true);
                *(int*)(nfa + 4u * lq + j * 256) = wa; *(int*)(nfb + 4u * lq + j * 256) = wb;
                const unsigned ha0 = cvt_pk_bf16(na.x, na.y), ha1 = cvt_pk_bf16(na.z, na.w), hb0 = cvt_pk_bf16(nb.x, nb.y), hb1 = cvt_pk_bf16(nb.z, nb.w);
                const unsigned la0 = cvt_pk_bf16(na.x - __uint_as_float(ha0 << 16), na.y - __uint_as_float(ha0 & 0xffff0000u)), la1 = cvt_pk_bf16(na.z - __uint_as_float(ha1 << 16), na.w - __uint_as_float(ha1 & 0xffff0000u));
                const unsigned lb0 = cvt_pk_bf16(nb.x - __uint_as_float(hb0 << 16), nb.y - __uint_as_float(hb0 & 0xffff0000u)), lb1 = cvt_pk_bf16(nb.z - __uint_as_float(hb1 << 16), nb.w - __uint_as_float(hb1 & 0xffff0000u));
                *(LAS u32x2*)(thi + tl * TST + col * 2) = (u32x2){ha0, ha1}; *(LAS u32x2*)(tlo + tl * TST + col * 2) = (u32x2){la0, la1};
                *(LAS u32x2*)(thi + (tl + 1) * TST + col * 2) = (u32x2){hb0, hb1}; *(LAS u32x2*)(tlo + (tl + 1) * TST + col * 2) = (u32x2){lb0, lb1};
                }
            asm volatile("" ::: "memory");
            if (unit + G < ntok / 16) ROUTER_FETCH(unit + G);
        }
        __syncthreads();
        f32x4 acc0 = (f32x4){0.f, 0.f, 0.f, 0.f}, acc1 = (f32x4){0.f, 0.f, 0.f, 0.f};
#pragma unroll
        for (int s = 0; s < 8; ++s) { const int ko = (wave * 256 + s * 32 + kg * 8) * 2;
            const bf16x8 ah = *(const LAS bf16x8*)(thi + fn * TST + ko), al = *(const LAS bf16x8*)(tlo + fn * TST + ko);
            acc0 = __builtin_amdgcn_mfma_f32_16x16x32_bf16(ah, wh[s][0], acc0, 0, 0, 0); acc1 = __builtin_amdgcn_mfma_f32_16x16x32_bf16(ah, wh[s][1], acc1, 0, 0, 0);
            acc0 = __builtin_amdgcn_mfma_f32_16x16x32_bf16(al, wh[s][0], acc0, 0, 0, 0); acc1 = __builtin_amdgcn_mfma_f32_16x16x32_bf16(al, wh[s][1], acc1, 0, 0, 0); }
        __syncthreads();
        { LAS float* pw = fl + wave * 512;
#pragma unroll
            for (int r = 0; r < 4; ++r) { pw[(kg * 4 + r) * 32 + fn] = acc0[r]; pw[(kg * 4 + r) * 32 + 16 + fn] = acc1[r]; } }
        __syncthreads();
        { float sacc = br[tid & 31];
#pragma unroll
            for (int w = 0; w < 8; ++w) sacc += fl[w * 512 + tid];
            lg[tid] = sacc; }
        if (unit + G < ntok / 16) { *(LAS f32x4*)(sg + 4 * tid) = psh; *(LAS f32x4*)(sg + 2048 + 4 * tid) = pg; }
        __syncthreads();
        { const int t = tq >> 5, e = tq & 31; const float my = lg[tq]; int rank = 0;
#pragma unroll
            for (int q = 0; q < 8; ++q) { const f32x4 x = *(const LAS f32x4*)(lg + t * 32 + 4 * q);
#pragma unroll
                for (int c = 0; c < 4; ++c) rank += (x[c] > my || (x[c] == my && 4 * q + c < e)) ? 1 : 0; }
            if (rank < 4) { sel[t * 4 + rank] = e; tv[t * 4 + rank] = my; } }
        __syncthreads();
        if (tid < 16) { const int row = unit * 16 + tid; const f32x4 v = *(const LAS f32x4*)(tv + tid * 4);
            const float e1 = __expf(v[1] - v[0]), e2 = __expf(v[2] - v[0]), e3 = __expf(v[3] - v[0]); const float inv = 1.0f / (1.0f + e1 + e2 + e3);
            *(int4*)(eid + (size_t)row * 4) = make_int4(sel[tid * 4 + 0], sel[tid * 4 + 1], sel[tid * 4 + 2], sel[tid * 4 + 3]);
            *(f32x4*)(gate + (size_t)row * 4) = (f32x4){inv, e1 * inv, e2 * inv, e3 * inv}; }
        ++ui;
    }
    __syncthreads();
    const int nent = ui * 64; int ee = 0, rk = 0;
    if (tid < nent) { ee = selall[tid]; rk = __hip_atomic_fetch_add(lc + ee, 1, __ATOMIC_RELAXED, __HIP_MEMORY_SCOPE_WORKGROUP); }
    __syncthreads();
    if (tid < NE) { const int c = lc[tid]; if (c > 0) lbase[tid] = (int)atomicAdd(cnt + tid * 64, (unsigned)c); }
    __syncthreads();
    if (tid < nent) { const int p = lbase[ee] + rk; const int row = ((int)blockIdx.x + (tid >> 6) * G) * 16 + ((tid & 63) >> 2); list[(size_t)ee * MT + p] = row; posb[(size_t)row * 4 + (tid & 3)] = p; }
    __syncthreads();
#undef ROUTER_FETCH
#undef UNPK4
}

__device__ __forceinline__ void moe_tables(unsigned char* ws, int l, LAS unsigned char* lds) {
    LAS int* tp = (LAS int*)(lds + MISC_OFF + 64); LAS int* cn = (LAS int*)(lds + MISC_OFF + 256);
    const unsigned* cnt = (const unsigned*)(ws + WS_CTL) + CW_CNT + l * 32 * 64;
    __syncthreads();
    if (threadIdx.x < 64) { const int ln = threadIdx.x;
        const int c = (ln < NE) ? (int)__hip_atomic_load(cnt + ln * 64, __ATOMIC_RELAXED, __HIP_MEMORY_SCOPE_AGENT) : 0;
        const int t = (c + 255) >> 8; int incl = t;
#pragma unroll
        for (int o = 1; o < 32; o <<= 1) { const int u = __shfl_up(incl, o); if (ln >= o) incl += u; }
        if (ln < NE) { tp[ln] = incl - t; cn[ln] = c; }
        if (ln == NE - 1) tp[NE] = incl; }
    __syncthreads();
}

PHASE_FN phase_moe_up(LAS unsigned char* lds, int l, int G) {
    lds = (LAS unsigned char*)__builtin_amdgcn_readfirstlane((int)(uintptr_t)lds); l = __builtin_amdgcn_readfirstlane(l); G = __builtin_amdgcn_readfirstlane(G);
    unsigned char* ws = WSP();
    moe_tables(ws, l, lds);
    pg8::MoeSched<true, D, 1> S; S.init((const LAS int*)(lds + MISC_OFF + 64), (const LAS int*)(lds + MISC_OFF + 256), ws + WS_NF8, ws + WS_W1 + (size_t)l * 32 * 2048 * D,
                                  (const int*)(ws + WS_ROUT + ROUT_LIST), G, (int)blockIdx.x);
    pg8::EpiSwiglu E{ws + WS_ACT, INP(I_B1) + (size_t)l * 32 * 2048};
    pg8::gemm_phase(lds, S, E);
}

PHASE_FN phase_moe_down(LAS unsigned char* lds, int l, int G) {
    lds = (LAS unsigned char*)__builtin_amdgcn_readfirstlane((int)(uintptr_t)lds); l = __builtin_amdgcn_readfirstlane(l); G = __builtin_amdgcn_readfirstlane(G);
    unsigned char* ws = WSP();
    moe_tables(ws, l, lds);
    pg8::MoeSched<false, DE, 1> S; S.init((const LAS int*)(lds + MISC_OFF + 64), (const LAS int*)(lds + MISC_OFF + 256), ws + WS_ACT, ws + WS_W2 + (size_t)l * 32 * D * DE,
                                   nullptr, G, (int)blockIdx.x);
    pg8::EpiF8 E{ws + WS_Y, D, INP(I_B2) + (size_t)l * 32 * D, D};
    pg8::gemm_phase(lds, S, E);
}

PHASE_FN phase_combine(LAS unsigned char* lds, int l, int G) {
    lds = (LAS unsigned char*)__builtin_amdgcn_readfirstlane((int)(uintptr_t)lds); l = __builtin_amdgcn_readfirstlane(l); G = __builtin_amdgcn_readfirstlane(G);
    const int tid = tid_local(), lane = tid & 63, wave = __builtin_amdgcn_readfirstlane(tid >> 6);
    unsigned char* ws = WSP();
    moe_tables(ws, l, lds);
    bf16_t* XR = (bf16_t*)(ws + WS_XR); unsigned char* N = ws + WS_N; const unsigned char* Y = ws + WS_Y;
    const float* MOD = (const float*)(ws + WS_MOD);
    const int* eid = (const int*)(ws + WS_ROUT + ROUT_EID); const float* gate = (const float*)(ws + WS_ROUT + ROUT_GATE); const int* posb = (const int*)(ws + WS_ROUT + ROUT_POS);
    const LAS int* tp = (const LAS int*)(lds + MISC_OFF + 64);
    const float* g1n = INP(I_G1) + D; const float* gf = INP(I_GF); float* out = OUTP();
    const int ntok = (l == 0) ? MT : ML;
    for (int row = blockIdx.x * NWAVES + wave; row < ntok; row += G * NWAVES) {
        const int bidx = row < ML ? (row >> 12) : 4; const float* m = MOD + ((size_t)l * 5 + bidx) * 12288;
        const int4 ev = *(const int4*)(eid + (size_t)row * 4), pv = *(const int4*)(posb + (size_t)row * 4); const f32x4 gv = *(const f32x4*)(gate + (size_t)row * 4);
        const unsigned char* yr[4];
        yr[0] = Y + ((size_t)tp[ev.x] * 256 + pv.x) * D; yr[1] = Y + ((size_t)tp[ev.y] * 256 + pv.y) * D; yr[2] = Y + ((size_t)tp[ev.z] * 256 + pv.z) * D; yr[3] = Y + ((size_t)tp[ev.w] * 256 + pv.w) * D;
        u32x2 yv[4][4]; f32x4 xv[4][2]; u32x4 xw[4];
#pragma unroll
        for (int j = 0; j < 4; ++j) { const int col = 8 * (lane + 64 * j);
#pragma unroll
            for (int k = 0; k < 4; ++k) yv[j][k] = *(const u32x2*)(yr[k] + col);
            xw[j] = *(const u32x4*)(XR + (size_t)row * D + col); }
#pragma unroll
        for (int j = 0; j < 4; ++j) pg8::unpack_bf16x8(xw[j], xv[j][0], xv[j][1]);
        float ss = 0.f;
#pragma unroll
        for (int j = 0; j < 4; ++j) { const int col = 8 * (lane + 64 * j);
            f32x4 s0 = (f32x4){0.f, 0.f, 0.f, 0.f}, s1 = s0;
#pragma unroll
            for (int k = 0; k < 4; ++k) { const u32x2 w = yv[j][k];
                const f32x2 a0 = __builtin_amdgcn_cvt_pk_f32_fp8((int)w.x, false), a1 = __builtin_amdgcn_cvt_pk_f32_fp8((int)w.x, true), a2 = __builtin_amdgcn_cvt_pk_f32_fp8((int)w.y, false), a3 = __builtin_amdgcn_cvt_pk_f32_fp8((int)w.y, true);
                s0 += gv[k] * (f32x4){a0.x, a0.y, a1.x, a1.y};
                s1 += gv[k] * (f32x4){a2.x, a2.y, a3.x, a3.y}; }
            const f32x4 gt0 = *(const f32x4*)(m + 5 * 2048 + col), gt1 = *(const f32x4*)(m + 5 * 2048 + col + 4);
            xv[j][0] += gt0 * s0; xv[j][1] += gt1 * s1;
            ss += (xv[j][0].x * xv[j][0].x + xv[j][0].y * xv[j][0].y) + (xv[j][0].z * xv[j][0].z + xv[j][0].w * xv[j][0].w);
            ss += (xv[j][1].x * xv[j][1].x + xv[j][1].y * xv[j][1].y) + (xv[j][1].z * xv[j][1].z + xv[j][1].w * xv[j][1].w); }
        const float rs = rsqrtf(wave_sum(ss) * (1.0f / D) + EPS);
        if (l == 0) {
            const float* m1 = MOD + ((size_t)5 + bidx) * 12288;
#pragma unroll
            for (int j = 0; j < 4; ++j) { const int col = 8 * (lane + 64 * j);
                *(u32x4*)(XR + (size_t)row * D + col) = pg8::pack_bf16x8(xv[j][0], xv[j][1]);
                int w0 = 0, w1 = 0;
#pragma unroll
                for (int q = 0; q < 2; ++q) { const f32x4 gg = *(const f32x4*)(g1n + col + 4 * q), sh = *(const f32x4*)(m1 + col + 4 * q), sc = *(const f32x4*)(m1 + 2048 + col + 4 * q);
                    const f32x4 n = ((xv[j][q] * rs) * gg) * (sc + 1.0f) + sh;
                    if (q == 0) { w0 = __builtin_amdgcn_cvt_pk_fp8_f32(n.x, n.y, w0, false); w0 = __builtin_amdgcn_cvt_pk_fp8_f32(n.z, n.w, w0, true); }
                    else { w1 = __builtin_amdgcn_cvt_pk_fp8_f32(n.x, n.y, w1, false); w1 = __builtin_amdgcn_cvt_pk_fp8_f32(n.z, n.w, w1, true); } }
                *(u32x2*)(N + (size_t)row * D + col) = (u32x2){(unsigned)w0, (unsigned)w1}; }
        } else {
            f32x4 gfv[4][2];
#pragma unroll
            for (int j = 0; j < 4; ++j)
#pragma unroll
                for (int q = 0; q < 2; ++q) gfv[j][q] = *(const f32x4*)(gf + 8 * (lane + 64 * j) + 4 * q);
            asm volatile("" ::: "memory");
#pragma unroll
            for (int j = 0; j < 4; ++j) { const int col = 8 * (lane + 64 * j);
                *(f32x4*)(out + (size_t)row * D + col) = (xv[j][0] * rs) * gfv[j][0];
                *(f32x4*)(out + (size_t)row * D + col + 4) = (xv[j][1] * rs) * gfv[j][1]; }
        }
    }
}

__global__ void __launch_bounds__(NTHREADS, 2) mk_fwd(Args a) {
    extern __shared__ __attribute__((aligned(16))) unsigned char lds_raw[];
    LAS unsigned char* lds = (LAS unsigned char*)lds_raw;
    const int tid = threadIdx.x; const int G = gridDim.x;
    if (tid < 16) ((LAS unsigned*)(lds + MISC_OFF))[tid] = 0u;
    if (tid == 64) { LAS unsigned long long* pt = (LAS unsigned long long*)(lds + PT_OFF);
#pragma unroll
        for (int i = 0; i < 26; ++i) pt[i] = (unsigned long long)a.in[i];
        pt[PT_OUT] = (unsigned long long)a.out; pt[PT_WS] = (unsigned long long)a.ws; }
    __syncthreads();
    const bool multi = (a.ph_hi - a.ph_lo) > 1;
    if (multi) (void)xcd_barrier_post((unsigned*)(a.ws + WS_CTL) + CW_BAR, (volatile LAS unsigned*)(lds + MISC_OFF));
    const int lo = a.ph_lo, hi = a.ph_hi;
#define IN(k) (lo <= (k) && (k) < hi)
#define SEAM(k) do { if (IN((k) + 1)) { XcdBarrier _b; _b.bar = (unsigned*)(a.ws + WS_CTL) + CW_BAR; _b.x = xb_xcc_id(); _b.st = (volatile LAS unsigned*)(lds + MISC_OFF); xcd_barrier(_b); if ((MK_REPEAT >> 11) & 1) xcd_barrier(_b); } } while (0)

    if (IN(0)) { REP(0) phase_prologue(lds, 0, G); SEAM(0); }
    if (IN(1)) { phase_modreduce(lds, 0, G); SEAM(1); }
#define LAYER_BODY(l) { \
        const int pb = 2 + 10 * l; \
        if (l == 0 && IN(pb + 0)) { phase_norm1_l0(lds, 0, G); SEAM(pb + 0); } \
        if (IN(pb + 1)) { REP(2) phase_inproj(lds, l, G); SEAM(pb + 1); } \
        if (IN(pb + 2)) { REP(3) phase_prep(lds, l, G); SEAM(pb + 2); } \
        if (IN(pb + 3)) { REP(4) phase_attention(lds, l, G); SEAM(pb + 3); } \
        if (IN(pb + 4)) { REP(5) phase_fixup(lds, l, G); SEAM(pb + 4); } \
        if (IN(pb + 5)) { if (l == 0) { REP(6) phase_outproj(lds, l, G); } else phase_outproj(lds, l, G); SEAM(pb + 5); } \
        if (IN(pb + 6)) { phase_router(lds, l, G); SEAM(pb + 6); } \
        if (IN(pb + 7)) { REP(8) phase_moe_up(lds, l, G); SEAM(pb + 7); } \
        if (IN(pb + 8)) { REP(9) phase_moe_down(lds, l, G); SEAM(pb + 8); } \
        if (IN(pb + 9)) { if (l == 1) { REP(10) phase_combine(lds, l, G); } else phase_combine(lds, l, G); if (l == 0) SEAM(pb + 9); } \
    }
    LAYER_BODY(0)
    LAYER_BODY(1)
#undef LAYER_BODY
#undef IN
#undef SEAM
}

extern "C" void kernel_launch(void* const* d_in, const int* in_sizes, int n_in, void* d_out, int out_size, void* d_ws, size_t ws_size, hipStream_t stream) {
    static int grid = 0;
    if (grid == 0) {
        if (n_in != 26 || in_sizes[0] != ML * D || out_size != ML * D || ws_size < WS_END) {
            fprintf(stderr, "kernel_launch: shape mismatch (n_in %d, in0 %d, out %d, ws %zu need %zu); nothing launched\n", n_in, n_in > 0 ? in_sizes[0] : -1, out_size, ws_size, (size_t)WS_END); grid = -1; return; }
        int dev = 0, cus = 0, per_cu = 0;
        if (hipGetDevice(&dev) != hipSuccess || hipDeviceGetAttribute(&cus, hipDeviceAttributeMultiprocessorCount, dev) != hipSuccess) { grid = -1; return; }
        if (hipFuncSetAttribute((const void*)mk_fwd, hipFuncAttributeMaxDynamicSharedMemorySize, LDS_BYTES) != hipSuccess) { fprintf(stderr, "kernel_launch: hipFuncSetAttribute failed\n"); grid = -1; return; }
        if (hipOccupancyMaxActiveBlocksPerMultiprocessor(&per_cu, (const void*)mk_fwd, NTHREADS, LDS_BYTES) != hipSuccess || per_cu < 1)
            fprintf(stderr, "kernel_launch: note: occupancy query reports %d workgroups per CU\n", per_cu);
        (void)hipGetLastError();
        grid = cus;
    }
    if (grid < 0) return;
    if (hipMemsetAsync((char*)d_ws + WS_CTL, 0, CTL_ZERO_BYTES, stream) != hipSuccess) { fprintf(stderr, "kernel_launch: memset failed\n"); return; }
    Args a{};
    for (int i = 0; i < 26; ++i) a.in[i] = (const float*)d_in[i];
    a.out = (float*)d_out; a.ws = (unsigned char*)d_ws;
#if MK_PER_PHASE_LAUNCH
    for (int p = 0; p < NPHASE; ++p) {
        if (p == 12) continue;
        a.ph_lo = p; a.ph_hi = p + 1;
        hipLaunchKernelGGL(mk_fwd, dim3(grid), dim3(NTHREADS), LDS_BYTES, stream, a);
    }
#else
    a.ph_lo = 0; a.ph_hi = NPHASE;
    hipLaunchKernelGGL(mk_fwd, dim3(grid), dim3(NTHREADS), LDS_BYTES, stream, a);
#endif
    const hipError_t le = hipPeekAtLastError();
    if (le != hipSuccess) fprintf(stderr, "kernel_launch: launch failed: %s\n", hipGetErrorName(le));
}
```

```cpp
#include <hip/hip_runtime.h>
#include <cstdio>
#include <cstdint>

#ifndef MK_PER_PHASE_LAUNCH
#define MK_PER_PHASE_LAUNCH 0
#endif

#ifndef MK_REPEAT
#define MK_REPEAT 0
#endif
#define REP(k) for (int _rep = 0; _rep < 1 + ((MK_REPEAT >> (k)) & 1); ++_rep)
#define GAS __attribute__((address_space(1)))
#define LAS __attribute__((address_space(3)))
typedef unsigned short bf16_t;
typedef short bf16x8 __attribute__((ext_vector_type(8)));
typedef short s16x4 __attribute__((ext_vector_type(4)));
typedef float f32x4 __attribute__((ext_vector_type(4)));
typedef float f32x2 __attribute__((ext_vector_type(2)));
typedef float f32x16 __attribute__((ext_vector_type(16)));
typedef unsigned u32x4 __attribute__((ext_vector_type(4)));
typedef unsigned u32x2 __attribute__((ext_vector_type(2)));
typedef int v8i __attribute__((ext_vector_type(8)));

constexpr int D = 2048, NB = 4, SEQ = 4096, CTX = 256, TK = CTX + SEQ  , DEPTH = 2;
constexpr int ML = NB * SEQ  , MC = NB * CTX  , MT = ML + MC  ;
constexpr int INW = 3584, NE = 32, DE = 1024;
constexpr int OFF_QA = 0, OFF_KA = 1024, OFF_VA = 1280, OFF_QB = 1536, OFF_KB = 2048, OFF_VB = 2560, OFF_UC = 3072;
constexpr float EPS = 1e-6f;
constexpr int MAXROWS = 77824;
constexpr int NWAVES = 8, NTHREADS = 512;

constexpr size_t MiB = 1u << 20;
constexpr size_t WS_CTL = 0, CTL_ZERO_BYTES = 64 * 1024;
constexpr size_t WS_MOD = 1 * MiB;
constexpr size_t WS_ROPE = 2 * MiB;
constexpr size_t WS_ROUT = 3 * MiB;
constexpr size_t WS_WRS = 7 * MiB;
constexpr size_t WS_XR = 8 * MiB;
constexpr size_t WS_N = 144 * MiB;
constexpr size_t WS_P = 212 * MiB;
constexpr size_t WS_QA = 332 * MiB;
constexpr size_t WS_KA = 366 * MiB;
constexpr size_t WS_VA = 375 * MiB;
constexpr size_t WS_QB = 384 * MiB;
constexpr size_t WS_KB = 401 * MiB;
constexpr size_t WS_VB = 418 * MiB;
constexpr size_t WS_CAT = 435 * MiB;
constexpr size_t WS_OB = 503 * MiB;
constexpr size_t WS_ACT = 571 * MiB;
constexpr size_t WS_Y = 723 * MiB;
constexpr size_t WS_WIN = 1027 * MiB;
constexpr size_t WS_WOUT = 1055 * MiB;
constexpr size_t WS_W1 = 1071 * MiB;
constexpr size_t WS_W2 = 1583 * MiB;
constexpr size_t WS_MODP = 1839 * MiB;
constexpr size_t WS_NF8 = 1871 * MiB;
constexpr size_t WS_END = 1907 * MiB;
static_assert(WS_XR + (size_t)MT * D * 4 <= WS_N && WS_N + (size_t)MT * D * 2 <= WS_P && WS_P + (size_t)MT * INW * 2 <= WS_QA, "ws map 1");
static_assert(WS_QA + (size_t)MT * 1024 * 2 <= WS_KA && WS_KA + (size_t)MT * 256 * 2 <= WS_VA && WS_VA + (size_t)MT * 256 * 2 <= WS_QB, "ws map 2");
static_assert(WS_QB + (size_t)MT * 512 * 2 <= WS_KB && WS_KB + (size_t)MT * 512 * 2 <= WS_VB && WS_VB + (size_t)MT * 512 * 2 <= WS_CAT, "ws map 3");
static_assert(WS_CAT + (size_t)MT * D * 2 <= WS_OB && WS_OB + (size_t)MT * 1024 * 4 <= WS_ACT && WS_ACT + (size_t)MAXROWS * 1024 * 2 <= WS_Y, "ws map 4");
static_assert(WS_Y + (size_t)MAXROWS * 2048 * 2 <= WS_WIN && WS_WIN + (size_t)2 * INW * D * 2 <= WS_WOUT && WS_WOUT + (size_t)2 * D * D * 2 <= WS_W1, "ws map 5");
static_assert(WS_W1 + (size_t)2 * 32 * 2048 * 2048 * 2 <= WS_W2 && WS_W2 + (size_t)2 * 32 * 2048 * 1024 * 2 <= WS_MODP && WS_MODP + (size_t)64 * 10 * 12288 * 4 <= WS_NF8 && WS_NF8 + (size_t)MT * D <= WS_END, "ws map 6");
static_assert(NB * TK == MT, "K/V row count");
constexpr size_t ROUT_EID = 0, ROUT_GATE = (size_t)MT * 16, ROUT_POS = (size_t)MT * 32, ROUT_LIST = (size_t)MT * 48;
static_assert(WS_ROUT + ROUT_LIST + (size_t)32 * MT * 4 <= WS_WRS && WS_WRS + (size_t)2 * 2 * 32 * 2048 * 2 <= WS_XR, "router map");
constexpr int CW_BAR = 4096;
constexpr int CW_CNT = 8192;
constexpr int CW_Q = 12288;
static_assert((CW_Q + 512) * 4 <= (int)CTL_ZERO_BYTES && CTL_ZERO_BYTES <= WS_MOD && CW_CNT + 64 * 64 <= CW_Q, "ctl map");

constexpr int RING_BYTES = 131072;
constexpr int MISC_OFF = RING_BYTES + 1024;
constexpr int LDS_BYTES = 163840;
constexpr int SG_OFF = MISC_OFF + 6144;
constexpr int FLS = 2052;

#define VM_WAIT() asm volatile("s_waitcnt vmcnt(0)" ::: "memory")
#define LDS_WAIT() asm volatile("s_waitcnt lgkmcnt(0)" ::: "memory")
__device__ __forceinline__ unsigned cvt_pk_bf16(float lo, float hi) { unsigned r; asm volatile("v_cvt_pk_bf16_f32 %0, %1, %2" : "=v"(r) : "v"(lo), "v"(hi)); return r; }
__device__ __forceinline__ bf16_t f2bf(float f) { return (bf16_t)(cvt_pk_bf16(f, 0.f) & 0xffffu); }
__device__ __forceinline__ float bf2f(bf16_t b) { return __uint_as_float(((unsigned)b) << 16); }
__device__ __forceinline__ int tid_local() { int t = threadIdx.x; asm volatile("" : "+v"(t)); return t; }
template <class T> __device__ __forceinline__ T* uniform_ptr(T* p) {
    const unsigned long long v = (unsigned long long)p;
    const unsigned lo = __builtin_amdgcn_readfirstlane((unsigned)v), hi = __builtin_amdgcn_readfirstlane((unsigned)(v >> 32));
    return (T*)(GAS T*)(((unsigned long long)hi << 32) | lo);
}
__device__ __forceinline__ float wave_sum(float v) {
    v += __builtin_bit_cast(float, __builtin_amdgcn_update_dpp(0, __builtin_bit_cast(int, v), 0xB1, 0xF, 0xF, true));
    v += __builtin_bit_cast(float, __builtin_amdgcn_update_dpp(0, __builtin_bit_cast(int, v), 0x4E, 0xF, 0xF, true));
    v += __builtin_bit_cast(float, __builtin_amdgcn_update_dpp(0, __builtin_bit_cast(int, v), 0x141, 0xF, 0xF, true));
    v += __builtin_bit_cast(float, __builtin_amdgcn_update_dpp(0, __builtin_bit_cast(int, v), 0x140, 0xF, 0xF, true));
    const float a = __builtin_bit_cast(float, __builtin_amdgcn_readlane(__builtin_bit_cast(int, v), 0)), b = __builtin_bit_cast(float, __builtin_amdgcn_readlane(__builtin_bit_cast(int, v), 16));
    const float c = __builtin_bit_cast(float, __builtin_amdgcn_readlane(__builtin_bit_cast(int, v), 32)), d = __builtin_bit_cast(float, __builtin_amdgcn_readlane(__builtin_bit_cast(int, v), 48));
    return (a + b) + (c + d);
}

constexpr int PT_OFF = 131072 + 1024 + 3072;
constexpr int PT_OUT = 26, PT_WS = 27;
__device__ __forceinline__ unsigned long long ldp_raw(LAS unsigned char* lds, int i) {
    const u32x2 v = *(const LAS u32x2*)(lds + PT_OFF + 8 * i);
    const unsigned lo = __builtin_amdgcn_readfirstlane(v.x), hi = __builtin_amdgcn_readfirstlane(v.y);
    return ((unsigned long long)hi << 32) | lo;
}
#define INP(i) ((const float*)(const GAS float*)ldp_raw(lds, (i)))
#define WSP() ((unsigned char*)(GAS unsigned char*)ldp_raw(lds, PT_WS))
#define OUTP() ((float*)(GAS float*)ldp_raw(lds, PT_OUT))
#define PHASE_FN __device__ __forceinline__ void

#define XB_TMO      128
#define XB_XCNT(j)  (256  + 64 * (j))
#define XB_XSUB(j)  (1280 + 64 * (j))
#define XB_XGEN(j)  (2304 + 64 * (j))
#define XB_TOP      3328
#define XB_TOPGEN   3392
#define XCD_BAR_WORDS 3456
#define XB_SPIN_CAP (1u << 18)
__device__ __forceinline__ unsigned xb_ld(unsigned* p)              { return __hip_atomic_load(p, __ATOMIC_RELAXED, __HIP_MEMORY_SCOPE_AGENT); }
__device__ __forceinline__ unsigned xb_add(unsigned* p, unsigned v) { return __hip_atomic_fetch_add(p, v, __ATOMIC_RELAXED, __HIP_MEMORY_SCOPE_AGENT); }
__device__ __forceinline__ unsigned xb_xcc_id() { return (unsigned)__builtin_amdgcn_s_getreg((3 << 11) | 20) & 0xFu; }
#define XB_SPIN(cond, bar) do { unsigned _sp = 0; while (cond) { __builtin_amdgcn_s_sleep(1); \
    if ((++_sp & 255u) == 0u) { if (xb_ld(&(bar)[XB_TMO])) break; if (_sp > XB_SPIN_CAP) { atomicAdd(&(bar)[XB_TMO], 1u); break; } } } } while (0)
struct XcdBarrier { unsigned* bar; unsigned x; volatile LAS unsigned* st; };
__device__ __forceinline__ XcdBarrier xcd_barrier_post(unsigned* bar, volatile LAS unsigned* st) {
    XcdBarrier b; b.bar = bar; b.x = xb_xcc_id(); b.st = st;
    if (threadIdx.x == 0) (void)xb_add(&bar[XB_XCNT(b.x)], 1u);
    return b;
}
__device__ __forceinline__ void xcd_barrier_complete(unsigned* bar, unsigned x, unsigned& nloc, unsigned& nx) {
    const unsigned G = gridDim.x * gridDim.y * gridDim.z;
    unsigned sum, cnt, mine, sp = 0u;
    for (;;) {
        sum = 0u; cnt = 0u; mine = 0u;
#pragma unroll
        for (unsigned j = 0; j < 16; ++j) { const unsigned c = xb_ld(&bar[XB_XCNT(j)]); sum += c; cnt += (c > 0u) ? 1u : 0u; mine = (j == x) ? c : mine; }
        if (sum == G) break;
        __builtin_amdgcn_s_sleep(1);
        if ((++sp & 255u) == 0u) { if (xb_ld(&bar[XB_TMO])) break; if (sp > XB_SPIN_CAP) { atomicAdd(&bar[XB_TMO], 1u); break; } }
    }
    nloc = mine > 0u ? mine : 1u; nx = cnt > 0u ? cnt : 1u;
}
__device__ __forceinline__ void xcd_barrier(const XcdBarrier& b) {
    asm volatile("s_waitcnt vmcnt(0)" ::: "memory");
    __syncthreads();
    if (threadIdx.x == 0) {
        unsigned* bar = b.bar;
        __builtin_amdgcn_s_waitcnt(0);
        unsigned nloc = b.st[0], nx = b.st[1];
        if (nloc == 0u) { xcd_barrier_complete(bar, b.x, nloc, nx); b.st[0] = nloc; b.st[1] = nx; }
        const unsigned old = xb_add(&bar[XB_XSUB(b.x)], 1u);
        const unsigned gen = old / nloc;
        if (old + 1u == (gen + 1u) * nloc) {
            __builtin_amdgcn_fence(__ATOMIC_RELEASE, "agent");
            asm volatile("s_waitcnt vmcnt(0)" ::: "memory");
            const unsigned og = xb_add(&bar[XB_TOP], 1u);
            const unsigned tg = og / nx;
            if (og + 1u == (tg + 1u) * nx) xb_add(&bar[XB_TOPGEN], 1u);
            else XB_SPIN(xb_ld(&bar[XB_TOPGEN]) == tg, bar);
            __builtin_amdgcn_fence(__ATOMIC_ACQUIRE, "agent");
            xb_add(&bar[XB_XGEN(b.x)], 1u);
            asm volatile("s_waitcnt vmcnt(0)" ::: "memory");
        } else {
            XB_SPIN(xb_ld(&bar[XB_XGEN(b.x)]) == gen, bar);
            __builtin_amdgcn_fence(__ATOMIC_ACQUIRE, "agent");
            asm volatile("s_waitcnt vmcnt(0)" ::: "memory");
        }
    }
    __syncthreads();
}

namespace pg8 {
constexpr int BM = 256, BK = 64, HALF = 128, HTB = HALF * BK * 2, STAGE_BYTES = 8 * HTB, NXCD = 8, WGM = 8;
__host__ __device__ __forceinline__ int lds_byte(int r, int c) { const int st = (r >> 4) * 2 + (c >> 5), rr = r & 15, cc = c & 31, ob = rr * 64 + cc * 2; return st * 1024 + (ob ^ (((ob >> 9) & 1) << 5)); }
__host__ __device__ __forceinline__ void stage_rc(int b, int& R, int& C) { const int st = b / 1024, sb = b % 1024, swz = sb ^ (((sb >> 9) & 1) << 5); R = (st >> 1) * 16 + swz / 64; C = (st & 1) * 32 + (swz % 64) / 2; }
__host__ __device__ __forceinline__ int perm32(int rho) { const int n = rho >> 4, i = rho & 15; return 8 * (i >> 2) + 4 * n + (i & 3); }

__host__ __device__ __forceinline__ int f8_f(int rr) { return (0x9C >> (2 * (rr >> 2))) & 3; }
__host__ __device__ __forceinline__ int lds_byte8(int r, int b) { const int st = (r >> 4) * 2 + (b >> 6), rr = r & 15, q = (b >> 4) & 3; return st * 1024 + rr * 64 + ((q ^ f8_f(rr)) << 4) + (b & 15); }
__host__ __device__ __forceinline__ void stage_rc8(int o, int& R, int& Cb) { const int st = o / 1024, w = o % 1024, rr = w / 64, slot = (w % 64) / 16; R = (st >> 1) * 16 + rr; Cb = (st & 1) * 64 + ((slot ^ f8_f(rr)) << 4); }
template <int ESZ> __host__ __device__ __forceinline__ void stage_rcb(int o, int& R, int& Cb) { if constexpr (ESZ == 2) { int C; stage_rc(o, R, C); Cb = 2 * C; } else stage_rc8(o, R, Cb); }
struct Unit { int pm, pn, e; };

template <int K_, int ESZ_> struct DenseSched {
    static constexpr int K = K_, ESZ = ESZ_, SCALE_B = (ESZ_ == 1) ? 121 : 127;
    static constexpr bool GATHER_A = false;
    int nM, nN, nwg, G, c; const char* A; const char* Bt;
    __device__ void init(const void* A_, const void* Bt_, int M, int N, int G_, int c_) { A = (const char*)A_; Bt = (const char*)Bt_; nM = M / BM; nN = N / BM; nwg = nM * nN; G = G_; c = c_; }
    __device__ __forceinline__ bool next(int i, Unit& u) const {
        const long L = (long)i * G + c; if (L >= nwg) return false;
        int wgid = (int)L; { const int q = nwg / NXCD, r = nwg % NXCD, xcd = wgid % NXCD, off = wgid / NXCD; wgid = (xcd < r ? xcd * (q + 1) : r * (q + 1) + (xcd - r) * q) + off; }
        const int nig = WGM * nN, gid = wgid / nig, fm = gid * WGM, gsz = (nM - fm) < WGM ? (nM - fm) : WGM;
        u.pm = fm + ((wgid % nig) % gsz); u.pn = (wgid % nig) / gsz; u.e = 0; return true;
    }
    __device__ __forceinline__ int row0(const Unit& u) const { return u.pm * BM; }
    __device__ __forceinline__ const char* a_base() const { return A; }
    __device__ __forceinline__ const char* b_base(const Unit& u) const { return Bt + (size_t)u.pn * BM * K * ESZ; }
    __device__ __forceinline__ void a_voff(const Unit& u, int tid, unsigned (&v)[2][2]) const {
#pragma unroll
        for (int i = 0; i < 2; ++i) { int R, Cb; stage_rcb<ESZ>(tid * 16 + i * 8192, R, Cb);
#pragma unroll
            for (int h = 0; h < 2; ++h) v[h][i] = (unsigned)((u.pm * BM + h * HALF + R) * (K * ESZ) + Cb); }
    }
};
template <bool GATHER, int K_, int ESZ_> struct MoeSched {
    static constexpr int K = K_, ESZ = ESZ_, SCALE_B = (K_ == 2048) ? 121 : 122;
    static constexpr size_t BSTRIDE = (size_t)2048 * K * ESZ;
    static constexpr bool GATHER_A = GATHER;
    const LAS int* tp; const LAS int* cnt; int start, end, j, stride; const char* A; const char* Bt; const int* list;
    __device__ void init(const LAS int* tp_, const LAS int* cnt_, const void* A_, const void* Bt_, const int* list_, int G, int c) {
        tp = tp_; cnt = cnt_; A = (const char*)A_; Bt = (const char*)Bt_; list = list_;
        const int U = 8 * tp[NE];
        if (G == 256) { const int x = c & 7; j = c >> 3; stride = 32; start = (int)(((long)x * U) / 8); end = (int)(((long)(x + 1) * U) / 8); }
        else { start = 0; end = U; j = c; stride = G; }
    }
    __device__ __forceinline__ bool next(int i, Unit& u) const {
        const int idx = start + i * stride + j; if (idx >= end) return false;
        int e = 0;
        for (int q = 1; q < NE; ++q) e += (8 * tp[q] <= idx) ? 1 : 0;
        e = __builtin_amdgcn_readfirstlane(e);
        const int tiles = tp[e + 1] - tp[e], r = idx - 8 * tp[e];
        const int gi = r >> 5, fm = gi * 4, gsz = (tiles - fm) < 4 ? (tiles - fm) : 4, w = r - 32 * gi;
        u.e = e; u.pm = __builtin_amdgcn_readfirstlane(fm + (w % gsz)); u.pn = __builtin_amdgcn_readfirstlane(w / gsz); return true;
    }
    __device__ __forceinline__ int row0(const Unit& u) const { return __builtin_amdgcn_readfirstlane((tp[u.e] + u.pm) * BM); }
    __device__ __forceinline__ const char* a_base() const { return A; }
    __device__ __forceinline__ const char* b_base(const Unit& u) const { return Bt + (size_t)u.e * BSTRIDE + (size_t)u.pn * BM * K * ESZ; }
    __device__ __forceinline__ void a_voff(const Unit& u, int tid, unsigned (&v)[2][2]) const {
        if constexpr (GATHER) {
            const int* lp = list + (size_t)u.e * MT + u.pm * BM;
            const int nv = cnt[u.e] - u.pm * BM;
            int tok[2][2], Cc[2];
#pragma unroll
            for (int i = 0; i < 2; ++i) { int R; stage_rcb<ESZ>(tid * 16 + i * 8192, R, Cc[i]);
#pragma unroll
                for (int h = 0; h < 2; ++h) { const int lr = h * HALF + R; tok[h][i] = lp[lr < nv ? lr : 0]; } }
            asm volatile("s_waitcnt vmcnt(0)" ::: "memory");
#pragma unroll
            for (int h = 0; h < 2; ++h)
#pragma unroll
                for (int i = 0; i < 2; ++i) v[h][i] = (unsigned)(tok[h][i] * (K * ESZ) + Cc[i]);
        } else {
            const int r0 = row0(u);
#pragma unroll
            for (int i = 0; i < 2; ++i) { int R, Cb; stage_rcb<ESZ>(tid * 16 + i * 8192, R, Cb);
#pragma unroll
                for (int h = 0; h < 2; ++h) v[h][i] = (unsigned)((r0 + h * HALF + R) * (K * ESZ) + Cb); }
        }
    }
};

struct EpiProj {
    static constexpr bool PERM = true;
    bf16_t* P; bf16_t* VA; bf16_t* VB;
    __device__ __forceinline__ void operator()(const f32x4 (&acc)[2][2][4][2], const Unit& u, int urow0, int wr, int wc, int fr, int fq) const {
        bf16_t* O; int ldc; int rbase;
        const int kvrow0 = urow0 < ML ? (urow0 >> 12) * TK + CTX + (urow0 & 4095) : ((urow0 - ML) >> 8) * TK;
        if (u.pn == OFF_VA / BM) { O = VA; ldc = 256; rbase = kvrow0; }
        else if (u.pn == OFF_VB / BM || u.pn == OFF_VB / BM + 1) { O = VB + (u.pn - OFF_VB / BM) * BM; ldc = 512; rbase = kvrow0; }
        else { O = P + u.pn * BM; ldc = INW; rbase = urow0; }
        const int row0 = rbase + wr * 64 + fr; const int col0 = wc * 32 + 8 * fq;
#pragma unroll
        for (int ai = 0; ai < 2; ++ai)
#pragma unroll
            for (int m = 0; m < 4; ++m) { bf16_t* rowp = O + (size_t)(row0 + ai * HALF + m * 16) * ldc + col0;
#pragma unroll
                for (int bj = 0; bj < 2; ++bj) { const f32x4 v0 = acc[ai][bj][m][0], v1 = acc[ai][bj][m][1];
                    u32x4 w; w.x = cvt_pk_bf16(v0[0], v0[1]); w.y = cvt_pk_bf16(v0[2], v0[3]); w.z = cvt_pk_bf16(v1[0], v1[1]); w.w = cvt_pk_bf16(v1[2], v1[3]);
                    *(u32x4*)(rowp + bj * HALF) = w; } }
    }
};
static_assert(OFF_VA % BM == 0 && OFF_VB % BM == 0 && OFF_VB + 2 * BM == OFF_UC && OFF_VA + BM == OFF_QB, "value columns are whole unit columns");
struct EpiF8 {
    static constexpr bool PERM = true;
    unsigned char* O; int ldc; const float* bias; int bias_estride;
    __device__ __forceinline__ void operator()(const f32x4 (&acc)[2][2][4][2], const Unit& u, int urow0, int wr, int wc, int fr, int fq) const {
        const int row0 = urow0 + wr * 64 + fr; const int col0 = u.pn * BM + wc * 32 + 8 * fq;
        const float* bp = bias + (size_t)u.e * bias_estride + col0;
        f32x4 bv[2][2];
#pragma unroll
        for (int bj = 0; bj < 2; ++bj)
#pragma unroll
            for (int n = 0; n < 2; ++n) bv[bj][n] = *(const f32x4*)(bp + bj * HALF + 4 * n);
#pragma unroll
        for (int ai = 0; ai < 2; ++ai)
#pragma unroll
            for (int m = 0; m < 4; ++m) { unsigned char* rowp = O + (size_t)(row0 + ai * HALF + m * 16) * ldc + col0;
#pragma unroll
                for (int bj = 0; bj < 2; ++bj) { const f32x4 v0 = acc[ai][bj][m][0] + bv[bj][0], v1 = acc[ai][bj][m][1] + bv[bj][1];
                    int w0 = 0, w1 = 0; w0 = __builtin_amdgcn_cvt_pk_fp8_f32(v0[0], v0[1], w0, false); w0 = __builtin_amdgcn_cvt_pk_fp8_f32(v0[2], v0[3], w0, true);
                    w1 = __builtin_amdgcn_cvt_pk_fp8_f32(v1[0], v1[1], w1, false); w1 = __builtin_amdgcn_cvt_pk_fp8_f32(v1[2], v1[3], w1, true);
                    *(u32x2*)(rowp + bj * HALF) = (u32x2){(unsigned)w0, (unsigned)w1}; } }
    }
};
__device__ __forceinline__ float swiglu1(float g, float l) {
    g = fminf(g, 7.0f); l = fminf(fmaxf(l, -7.0f), 7.0f);
    const float sg = __builtin_amdgcn_rcpf(1.0f + __builtin_amdgcn_exp2f(-1.702f * 1.4426950408889634f * g));
    return g * sg * (l + 1.0f);
}
struct EpiSwiglu {
    static constexpr bool PERM = true;
    unsigned char* O; const float* bias;
    __device__ __forceinline__ void operator()(const f32x4 (&acc)[2][2][4][2], const Unit& u, int urow0, int wr, int wc, int fr, int fq) const {
        const int row0 = urow0 + wr * 64 + fr; const int col0 = u.pn * BM + wc * 32 + 8 * fq;
        const float* bp = bias + (size_t)u.e * 2048 + col0;
        f32x4 bv[2][2];
#pragma unroll
        for (int bj = 0; bj < 2; ++bj)
#pragma unroll
            for (int n = 0; n < 2; ++n) bv[bj][n] = *(const f32x4*)(bp + bj * HALF + 4 * n);
#pragma unroll
        for (int ai = 0; ai < 2; ++ai)
#pragma unroll
            for (int m = 0; m < 4; ++m) { unsigned char* rowp = O + (size_t)(row0 + ai * HALF + m * 16) * DE + (col0 >> 1);
#pragma unroll
                for (int bj = 0; bj < 2; ++bj) { const f32x4 v0 = acc[ai][bj][m][0] + bv[bj][0], v1 = acc[ai][bj][m][1] + bv[bj][1];
                    int w = 0; w = __builtin_amdgcn_cvt_pk_fp8_f32(swiglu1(v0[0], v0[1]), swiglu1(v0[2], v0[3]), w, false); w = __builtin_amdgcn_cvt_pk_fp8_f32(swiglu1(v1[0], v1[1]), swiglu1(v1[2], v1[3]), w, true);
                    *(int*)(rowp + bj * (HALF / 2)) = w; } }
    }
};
__device__ __forceinline__ void unpack_bf16x8(const u32x4 w, f32x4& lo, f32x4& hi) {
    lo = (f32x4){__uint_as_float(w.x << 16), __uint_as_float(w.x & 0xffff0000u), __uint_as_float(w.y << 16), __uint_as_float(w.y & 0xffff0000u)};
    hi = (f32x4){__uint_as_float(w.z << 16), __uint_as_float(w.z & 0xffff0000u), __uint_as_float(w.w << 16), __uint_as_float(w.w & 0xffff0000u)};
}
__device__ __forceinline__ u32x4 pack_bf16x8(const f32x4 lo, const f32x4 hi) {
    u32x4 w; w.x = cvt_pk_bf16(lo[0], lo[1]); w.y = cvt_pk_bf16(lo[2], lo[3]); w.z = cvt_pk_bf16(hi[0], hi[1]); w.w = cvt_pk_bf16(hi[2], hi[3]); return w;
}
struct EpiResid {
    static constexpr bool PERM = true;
    const float* xin; const float* cin; const bf16_t* xr_in; bf16_t* xr_out; const float* mod; int layer;
    __device__ __forceinline__ void operator()(const f32x4 (&acc)[2][2][4][2], const Unit& u, int urow0, int wr, int wc, int fr, int fq) const {
        const int row0 = urow0 + wr * 64 + fr, col0 = u.pn * BM + wc * 32 + 8 * fq;
        const int bidx = urow0 < ML ? (urow0 >> 12) : 4;
        const float* gp = mod + (size_t)bidx * 12288 + 2 * 2048 + col0;
        f32x4 g[2][2];
#pragma unroll
        for (int bj = 0; bj < 2; ++bj)
#pragma unroll
            for (int n = 0; n < 2; ++n) g[bj][n] = *(const f32x4*)(gp + bj * HALF + 4 * n);
        if (layer == 0) {
            const float* bbase = urow0 < ML ? xin : cin - (size_t)ML * D;
#pragma unroll
            for (int ai = 0; ai < 2; ++ai)
#pragma unroll
                for (int mp = 0; mp < 2; ++mp) {
                    f32x4 bs[2][2][2];
#pragma unroll
                    for (int mq = 0; mq < 2; ++mq) { const int row = row0 + ai * HALF + (2 * mp + mq) * 16; const float* bp = bbase + (size_t)row * D + col0;
#pragma unroll
                        for (int bj = 0; bj < 2; ++bj)
#pragma unroll
                            for (int n = 0; n < 2; ++n) bs[mq][bj][n] = *(const f32x4*)(bp + bj * HALF + 4 * n); }
#pragma unroll
                    for (int mq = 0; mq < 2; ++mq) { const int m = 2 * mp + mq; const int row = row0 + ai * HALF + m * 16; bf16_t* op = xr_out + (size_t)row * D + col0;
#pragma unroll
                        for (int bj = 0; bj < 2; ++bj) *(u32x4*)(op + bj * HALF) = pack_bf16x8(bs[mq][bj][0] + g[bj][0] * acc[ai][bj][m][0], bs[mq][bj][1] + g[bj][1] * acc[ai][bj][m][1]); }
                    asm volatile("" ::: "memory"); }
        } else {
#pragma unroll
            for (int ai = 0; ai < 2; ++ai) {
                u32x4 bw[4][2];
#pragma unroll
                for (int m = 0; m < 4; ++m) { const int row = row0 + ai * HALF + m * 16; const bf16_t* bp = xr_in + (size_t)row * D + col0;
#pragma unroll
                    for (int bj = 0; bj < 2; ++bj) bw[m][bj] = *(const u32x4*)(bp + bj * HALF); }
#pragma unroll
                for (int m = 0; m < 4; ++m) { const int row = row0 + ai * HALF + m * 16; bf16_t* op = xr_out + (size_t)row * D + col0;
#pragma unroll
                    for (int bj = 0; bj < 2; ++bj) { f32x4 b0, b1; unpack_bf16x8(bw[m][bj], b0, b1);
                        *(u32x4*)(op + bj * HALF) = pack_bf16x8(b0 + g[bj][0] * acc[ai][bj][m][0], b1 + g[bj][1] * acc[ai][bj][m][1]); } }
                asm volatile("" ::: "memory"); }
        }
    }
};

template <class Epi, class Sched>
__device__ __forceinline__ void gemm_phase(LAS unsigned char* lds, const Sched& S, const Epi& E) {
    constexpr int K = Sched::K, ESZ = Sched::ESZ;
    const int tid = tid_local(), wid = __builtin_amdgcn_readfirstlane(tid >> 6), lane = tid & 63, wr = wid >> 2, wc = wid & 3, fr = lane & 15, fq = lane >> 4;
    constexpr int nt = K * ESZ / 128;
    constexpr int SCALE_A = 127, SCALE_B = Sched::SCALE_B;
    unsigned voffB[2], voffA[2][2];
#pragma unroll
    for (int i = 0; i < 2; ++i) { int R, Cb; stage_rcb<ESZ>(tid * 16 + i * 8192, R, Cb); const int Rb = Epi::PERM ? ((R & ~31) + perm32(R & 31)) : R; voffB[i] = (unsigned)(Rb * (K * ESZ) + Cb); }
    constexpr size_t kstep = 128;
    constexpr size_t hstep = (size_t)HALF * K * ESZ;
    const unsigned ldsw = (unsigned)wid * 1024u;
    const int aoff = ESZ == 2 ? lds_byte(wr * 64 + fr, fq * 8) : lds_byte8(wr * 64 + fr, fq * 32), boff = ESZ == 2 ? lds_byte(wc * 32 + fr, fq * 8) : lds_byte8(wc * 32 + fr, fq * 32);
    const int aoff2 = aoff ^ 16, boff2 = boff ^ 16;
#define PG8_SA(b, h) (((b) * 2 + (h)) * HTB)
#define PG8_SB(b, h) ((4 + (b) * 2 + (h)) * HTB)
#define PG8_STAGE(bufoff, gbase, voff) do { _Pragma("unroll") for (int _i = 0; _i < 2; ++_i) \
        __builtin_amdgcn_global_load_lds((const unsigned*)((const char*)(gbase) + (voff)[_i]), (LAS unsigned*)(lds + (bufoff) + ldsw + _i * 8192), 16, 0, 0); } while (0)
#define PG8_LDA(dst, b, h) do { if constexpr (ESZ == 2) { _Pragma("unroll") for (int m = 0; m < 4; ++m) _Pragma("unroll") for (int k = 0; k < 2; ++k) dst[m][k] = *(const LAS bf16x8*)(lds + PG8_SA(b, h) + aoff + m * 2048 + k * 1024); } \
        else { _Pragma("unroll") for (int m = 0; m < 4; ++m) { const u32x4 _lo = *(const LAS u32x4*)(lds + PG8_SA(b, h) + aoff + m * 2048), _hi = *(const LAS u32x4*)(lds + PG8_SA(b, h) + aoff2 + m * 2048); \
            dst##8[m] = (v8i){(int)_lo.x, (int)_lo.y, (int)_lo.z, (int)_lo.w, (int)_hi.x, (int)_hi.y, (int)_hi.z, (int)_hi.w}; } } } while (0)
#define PG8_LDB(dst, b, h) do { if constexpr (ESZ == 2) { _Pragma("unroll") for (int n = 0; n < 2; ++n) _Pragma("unroll") for (int k = 0; k < 2; ++k) dst[n][k] = *(const LAS bf16x8*)(lds + PG8_SB(b, h) + boff + n * 2048 + k * 1024); } \
        else { _Pragma("unroll") for (int n = 0; n < 2; ++n) { const u32x4 _lo = *(const LAS u32x4*)(lds + PG8_SB(b, h) + boff + n * 2048), _hi = *(const LAS u32x4*)(lds + PG8_SB(b, h) + boff2 + n * 2048); \
            dst##8[n] = (v8i){(int)_lo.x, (int)_lo.y, (int)_lo.z, (int)_lo.w, (int)_hi.x, (int)_hi.y, (int)_hi.z, (int)_hi.w}; } } } while (0)
#define PG8_MMA(ai, bj, At, Bt) do { __builtin_amdgcn_s_setprio(1); if constexpr (ESZ == 2) { _Pragma("unroll") for (int m = 0; m < 4; ++m) _Pragma("unroll") for (int n = 0; n < 2; ++n) _Pragma("unroll") for (int k = 0; k < 2; ++k) \
        acc[ai][bj][m][n] = __builtin_amdgcn_mfma_f32_16x16x32_bf16(Bt[n][k], At[m][k], acc[ai][bj][m][n], 0, 0, 0); } \
        else { _Pragma("unroll") for (int m = 0; m < 4; ++m) _Pragma("unroll") for (int n = 0; n < 2; ++n) \
        acc[ai][bj][m][n] = __builtin_amdgcn_mfma_scale_f32_16x16x128_f8f6f4(Bt##8[n], At##8[m], acc[ai][bj][m][n], 0, 0, 0, SCALE_B, 0, SCALE_A); } __builtin_amdgcn_s_setprio(0); } while (0)
#define PG8_WAIT_V(n) asm volatile("s_waitcnt vmcnt(" #n ")" ::: "memory")
#define PG8_WAIT_L(n) asm volatile("s_waitcnt lgkmcnt(" #n ")" ::: "memory")
#define PG8_BAR __builtin_amdgcn_s_barrier()
#define PG8_SCHED __builtin_amdgcn_sched_barrier(0)
    Unit cur, nxt; int ui = 0;
    if (!S.next(0, cur)) return;
    f32x4 acc[2][2][4][2];
#pragma unroll
    for (int a = 0; a < 2; ++a)
#pragma unroll
        for (int b = 0; b < 2; ++b)
#pragma unroll
            for (int m = 0; m < 4; ++m)
#pragma unroll
                for (int n = 0; n < 2; ++n) acc[a][b][m][n] = (f32x4){0.f, 0.f, 0.f, 0.f};
    bf16x8 At[4][2], B0[2][2], B1[2][2];
    v8i At8[4], B08[2], B18[2];
    const char* const Ab = S.a_base();
    const char* cB = S.b_base(cur);
    S.a_voff(cur, tid, voffA);
    PG8_STAGE(PG8_SB(0, 0), cB, voffB); PG8_STAGE(PG8_SB(0, 1), cB + hstep, voffB); PG8_STAGE(PG8_SA(0, 0), Ab, voffA[0]); PG8_STAGE(PG8_SA(0, 1), Ab, voffA[1]);
    if (wr == 1) PG8_BAR;
    PG8_WAIT_V(2); PG8_BAR;
    PG8_STAGE(PG8_SB(1, 0), cB + kstep, voffB); PG8_STAGE(PG8_SA(1, 0), Ab + kstep, voffA[0]); PG8_STAGE(PG8_SB(1, 1), cB + hstep + kstep, voffB);
    PG8_WAIT_V(6); PG8_BAR;
    for (;;) {
        const bool has_next = S.next(ui + 1, nxt);
        const char* nB = has_next ? S.b_base(nxt) : cB;
        unsigned voffN[2][2];
        if constexpr (Sched::GATHER_A) { if (has_next) S.a_voff(nxt, tid, voffN); }
#pragma unroll 1
        for (int t = 0; t < nt; t += 2) {
            const bool last = (t == nt - 2);
            const char* a1 = Ab + (size_t)(t + 1) * kstep;
            const char* a2 = last ? Ab : Ab + (size_t)(t + 2) * kstep; const char* b2 = last ? nB : cB + (size_t)(t + 2) * kstep;
            const char* a3 = a2 + kstep; const char* b3 = b2 + kstep;
            PG8_LDB(B0, 0, 0); PG8_LDB(B1, 0, 1); PG8_SCHED; PG8_LDA(At, 0, 0); PG8_STAGE(PG8_SA(1, 1), a1, voffA[1]);
            if (last && has_next) {
                if constexpr (Sched::GATHER_A) { voffA[0][0] = voffN[0][0]; voffA[0][1] = voffN[0][1]; voffA[1][0] = voffN[1][0]; voffA[1][1] = voffN[1][1]; }
                else S.a_voff(nxt, tid, voffA); }
            PG8_WAIT_V(8); PG8_WAIT_L(0); PG8_BAR; PG8_MMA(0, 0, At, B0); PG8_MMA(0, 1, At, B1); PG8_BAR; PG8_SCHED;
            PG8_LDA(At, 0, 1); PG8_STAGE(PG8_SB(0, 0), b2, voffB); PG8_STAGE(PG8_SB(0, 1), b2 + hstep, voffB); PG8_STAGE(PG8_SA(0, 0), a2, voffA[0]);
            PG8_WAIT_V(8); PG8_WAIT_L(0); PG8_BAR; PG8_MMA(1, 0, At, B0); PG8_MMA(1, 1, At, B1); PG8_BAR; PG8_SCHED;
            PG8_LDB(B0, 1, 0); PG8_LDB(B1, 1, 1); PG8_SCHED; PG8_LDA(At, 1, 0); PG8_STAGE(PG8_SA(0, 1), a2, voffA[1]);
            PG8_WAIT_V(8); PG8_WAIT_L(0); PG8_BAR; PG8_MMA(0, 0, At, B0); PG8_MMA(0, 1, At, B1); PG8_BAR; PG8_SCHED;
            PG8_LDA(At, 1, 1); PG8_STAGE(PG8_SB(1, 0), b3, voffB); PG8_STAGE(PG8_SB(1, 1), b3 + hstep, voffB); PG8_STAGE(PG8_SA(1, 0), a3, voffA[0]);
            PG8_WAIT_V(8); PG8_WAIT_L(0); PG8_BAR; PG8_MMA(1, 0, At, B0); PG8_MMA(1, 1, At, B1); PG8_BAR; PG8_SCHED;
        }
        if (wr == 0) PG8_BAR;
        E(acc, cur, S.row0(cur), wr, wc, fr, fq);
        if constexpr (Epi::PERM) { if ((MK_REPEAT >> 12) & 1) E(acc, cur, S.row0(cur), wr, wc, fr, fq); }
        if (!has_next) break;
#pragma unroll
        for (int a = 0; a < 2; ++a)
#pragma unroll
            for (int b = 0; b < 2; ++b)
#pragma unroll
                for (int m = 0; m < 4; ++m)
#pragma unroll
                    for (int n = 0; n < 2; ++n) acc[a][b][m][n] = (f32x4){0.f, 0.f, 0.f, 0.f};
        cur = nxt; cB = nB; ++ui;
        if (wr == 1) PG8_BAR;
    }
    PG8_WAIT_V(0);
    PG8_BAR;
#undef PG8_SA
#undef PG8_SB
#undef PG8_STAGE
#undef PG8_LDA
#undef PG8_LDB
#undef PG8_MMA
#undef PG8_WAIT_V
#undef PG8_WAIT_L
#undef PG8_BAR
#undef PG8_SCHED
}
}

namespace att {
constexpr int NW = 8, QBLK = 32, KVBLK = 64, DV = 128;
constexpr float THR = 8.f;
constexpr int SHM_V = KVBLK * DV * 2, SHM_K = KVBLK * 128 * 2, SHM_ATTN = 2 * SHM_V + 2 * SHM_K + NW * 64 * 4;
#define SBAR() __builtin_amdgcn_sched_barrier(0)
__device__ __forceinline__ int crow(int r, int hi) { return (r & 3) + 8 * (r >> 2) + 4 * hi; }
template <int DQK> __device__ __forceinline__ int kswz(int row, int colB) {
    if constexpr (DQK == 128) return row * 256 + (colB ^ ((row & 15) << 4));
    else return row * 128 + (colB ^ (((row >> 1) & 7) << 4));
}
template <int DQK> __device__ __forceinline__ void partialSM(f32x16& p0, f32x16& p1, float& m_reg, float& mn, float& alpha) {
    constexpr float SCALE = (DQK == 128) ? 0.088388347648318440f : 0.125f;
    constexpr float Cc = SCALE * 1.4426950408889634f;
    float pmax = p0[0];
#pragma unroll
    for (int r = 1; r < 16; ++r) pmax = fmaxf(pmax, p0[r]);
#pragma unroll
    for (int r = 0; r < 16; ++r) pmax = fmaxf(pmax, p1[r]);
    { auto rr = __builtin_amdgcn_permlane32_swap(__float_as_uint(pmax), __float_as_uint(pmax), false, false);
      pmax = fmaxf(__uint_as_float(rr[0]), __uint_as_float(rr[1])); }
    if (__builtin_expect(__all(pmax - m_reg <= THR / SCALE), 1)) { mn = m_reg; alpha = 1.f; }
    else { mn = fmaxf(m_reg, pmax); alpha = __builtin_amdgcn_exp2f((m_reg - mn) * Cc); m_reg = mn; }
    const float mnC = -mn * Cc;
#pragma unroll
    for (int r = 0; r < 16; ++r) p0[r] = fmaf(p0[r], Cc, mnC);
#pragma unroll
    for (int r = 0; r < 16; ++r) p1[r] = fmaf(p1[r], Cc, mnC);
#pragma unroll
    for (int r = 0; r < 16; ++r) p0[r] = __builtin_amdgcn_exp2f(p0[r]);
}
__device__ __forceinline__ void finishSM(f32x16& p0, f32x16& p1, float alpha, float& l_reg, bf16x8& pa0, bf16x8& pa1, bf16x8& pa2, bf16x8& pa3) {
#pragma unroll
    for (int r = 0; r < 16; ++r) p1[r] = __builtin_amdgcn_exp2f(p1[r]);
    float ps = 0;
#pragma unroll
    for (int r = 0; r < 16; ++r) ps += p0[r];
#pragma unroll
    for (int r = 0; r < 16; ++r) ps += p1[r];
    { auto rr = __builtin_amdgcn_permlane32_swap(__float_as_uint(ps), __float_as_uint(ps), false, false);
      ps = __uint_as_float(rr[0]) + __uint_as_float(rr[1]); }
    l_reg = l_reg * alpha + ps;
#define PK4(P, BASE, OUT) do { unsigned a0 = cvt_pk_bf16(P[BASE + 0], P[BASE + 1]), a1 = cvt_pk_bf16(P[BASE + 2], P[BASE + 3]);   \
    unsigned b0 = cvt_pk_bf16(P[BASE + 4], P[BASE + 5]), b1 = cvt_pk_bf16(P[BASE + 6], P[BASE + 7]);                              \
    auto r0 = __builtin_amdgcn_permlane32_swap(a0, b0, false, false); auto r1 = __builtin_amdgcn_permlane32_swap(a1, b1, false, false); \
    u32x4 w = {r0[0], r1[0], r0[1], r1[1]}; OUT = *reinterpret_cast<bf16x8*>(&w); } while (0)
    PK4(p0, 0, pa0); PK4(p0, 8, pa1); PK4(p1, 0, pa2); PK4(p1, 8, pa3);
#undef PK4
}
template <int DQK> __device__ __forceinline__ void qkt(f32x16& p0, f32x16& p1, const char* Ks, const bf16x8* qr, int r32, int hi) {
    p0 = f32x16{}; p1 = f32x16{};
#pragma unroll
    for (int d0 = 0; d0 < DQK / 16; ++d0) { const int cb = (d0 * 16 + hi * 8) * 2;
        const bf16x8 b0 = *reinterpret_cast<const bf16x8*>(Ks + kswz<DQK>(r32, cb));
        const bf16x8 b1 = *reinterpret_cast<const bf16x8*>(Ks + kswz<DQK>(32 + r32, cb));
        p0 = __builtin_amdgcn_mfma_f32_32x32x16_bf16(b0, qr[d0], p0, 0, 0, 0);
        p1 = __builtin_amdgcn_mfma_f32_32x32x16_bf16(b1, qr[d0], p1, 0, 0, 0); }
}
__device__ __forceinline__ int v_st(int k, int c) { const int kk = (k & ~0xC) | ((k & 4) << 1) | ((k & 8) >> 1); return ((kk >> 3) * 4 + (c >> 5)) * 512 + ((kk & 7) * 32 + (c & 31)) * 2; }
__device__ __forceinline__ int v_rd_base(int lane) { return ((lane & 3) << 3) | (((lane >> 2) & 3) << 6) | (((lane >> 4) & 1) << 5) | (((lane >> 5) & 1) << 8); }
constexpr int v_rd_off(int d0, int ks, int half) { return d0 * 512 + ks * 4096 + half * 2048; }
template <int OFF> __device__ __forceinline__ s16x4 tr_read(int vb) {
    s16x4 r; asm volatile("ds_read_b64_tr_b16 %0, %1 offset:%2" : "=&v"(r) : "v"(vb), "i"(OFF) : "memory"); return r;
}
template <int KS> __device__ __forceinline__ void pv_step(f32x16* o, int vb, bf16x8 pa) {
    const s16x4 l0 = tr_read<v_rd_off(0, KS, 0)>(vb), h0 = tr_read<v_rd_off(0, KS, 1)>(vb), l1 = tr_read<v_rd_off(1, KS, 0)>(vb), h1 = tr_read<v_rd_off(1, KS, 1)>(vb);
    const s16x4 l2 = tr_read<v_rd_off(2, KS, 0)>(vb), h2 = tr_read<v_rd_off(2, KS, 1)>(vb), l3 = tr_read<v_rd_off(3, KS, 0)>(vb), h3 = tr_read<v_rd_off(3, KS, 1)>(vb);
    asm volatile("s_waitcnt lgkmcnt(0)" ::: "memory"); SBAR();
#define PK(L, H) (bf16x8){L[0], L[1], L[2], L[3], H[0], H[1], H[2], H[3]}
    o[0] = __builtin_amdgcn_mfma_f32_32x32x16_bf16(pa, PK(l0, h0), o[0], 0, 0, 0);
    o[1] = __builtin_amdgcn_mfma_f32_32x32x16_bf16(pa, PK(l1, h1), o[1], 0, 0, 0);
    o[2] = __builtin_amdgcn_mfma_f32_32x32x16_bf16(pa, PK(l2, h2), o[2], 0, 0, 0);
    o[3] = __builtin_amdgcn_mfma_f32_32x32x16_bf16(pa, PK(l3, h3), o[3], 0, 0, 0);
#undef PK
}
__device__ __forceinline__ void pv_d0(f32x16* o, int vb, bf16x8 pa0, bf16x8 pa1, bf16x8 pa2, bf16x8 pa3) {
    pv_step<0>(o, vb, pa0); pv_step<1>(o, vb, pa1); pv_step<2>(o, vb, pa2); pv_step<3>(o, vb, pa3);
}
template <int DQK, int LDQ, int LDK, int LDV, int LDO, bool OUT_BF16>
__device__ __forceinline__ void attn_body(const bf16_t* __restrict__ Qb, const bf16_t* __restrict__ Kh, const bf16_t* __restrict__ Vh, void* __restrict__ Ob, int seq, char* lds) {
    const int tid = tid_local(), wid = tid >> 6, lane = tid & 63, r32 = lane & 31, hi = lane >> 5;
    Qb = uniform_ptr(Qb); Kh = uniform_ptr(Kh); Vh = uniform_ptr(Vh); Ob = uniform_ptr(Ob);
    char* V_lds = lds; char* K_lds = lds + 2 * SHM_V;
    float* ws = (float*)(lds + 2 * SHM_V + 2 * SHM_K) + wid * 64; float* li_l = ws; float* al_l = ws + 32;
    float m_reg = -1e30f, l_reg = 0; f32x16 o[4] = {}; bf16x8 qr[DQK / 16];
    const unsigned qoff = (unsigned)((wid * QBLK + r32) * LDQ + hi * 8) * 2u;
#pragma unroll
    for (int d0 = 0; d0 < DQK / 16; ++d0) qr[d0] = *reinterpret_cast<const bf16x8*>((const char*)Qb + qoff + d0 * 32);
    const int sr = tid >> 4, sc = (tid & 15) * 8, vst0 = v_st(sr, sc), vst1 = v_st(32 + sr, sc);
    const int kr = (DQK == 128) ? sr : (tid >> 3), kc = (DQK == 128) ? sc : (tid & 7) * 8;
    const unsigned voffV = (unsigned)(sr * LDV + sc) * 2u, voffK = (unsigned)(kr * LDK + kc) * 2u;
    const int vb0 = (int)(uintptr_t)V_lds + v_rd_base(lane);
    struct { bf16x8 vs0, vs1, ks0, ks1; } sr_[2];
#define SLOAD(i, k0) do { const char* _vb = (const char*)Vh + (size_t)(k0) * (LDV * 2); const char* _kb = (const char*)Kh + (size_t)(k0) * (LDK * 2); \
    sr_[i].vs0 = *reinterpret_cast<const bf16x8*>(_vb + voffV); sr_[i].vs1 = *reinterpret_cast<const bf16x8*>(_vb + voffV + 32 * LDV * 2); \
    sr_[i].ks0 = *reinterpret_cast<const bf16x8*>(_kb + voffK); if constexpr (DQK == 128) sr_[i].ks1 = *reinterpret_cast<const bf16x8*>(_kb + voffK + 32 * LDK * 2); } while (0)
#define SWRITE(b, i) do { *(bf16x8*)(V_lds + (b) * SHM_V + vst0) = sr_[i].vs0;          \
    *(bf16x8*)(V_lds + (b) * SHM_V + vst1) = sr_[i].vs1;               \
    *(bf16x8*)(K_lds + (b) * SHM_K + kswz<DQK>(kr, kc * 2)) = sr_[i].ks0;                       \
    if constexpr (DQK == 128) *(bf16x8*)(K_lds + (b) * SHM_K + kswz<DQK>(32 + kr, kc * 2)) = sr_[i].ks1; } while (0)
#define SWAIT() do { if constexpr (DQK == 128) asm volatile("s_waitcnt vmcnt(4)" ::: "memory"); else asm volatile("s_waitcnt vmcnt(3)" ::: "memory"); } while (0)
#define RESC(a) do { if (__any((a) < 1.f)) { if (hi == 0) al_l[r32] = (a); asm volatile("s_waitcnt lgkmcnt(0)" ::: "memory"); \
    _Pragma("unroll") for (int d = 0; d < 4; ++d) _Pragma("unroll") for (int r = 0; r < 16; ++r) o[d][r] *= al_l[crow(r, hi)]; } } while (0)
    f32x16 pA0, pA1, pB0, pB1; float mnA, mnB, alA, alB; bf16x8 pa0, pa1, pa2, pa3; const int NT = seq / KVBLK;
    constexpr int SE = 0, SO = 1;
    SLOAD(SE, 0); asm volatile("s_waitcnt vmcnt(0)" ::: "memory"); SWRITE(0, SE); __syncthreads();
    qkt<DQK>(pA0, pA1, K_lds, qr, r32, hi); partialSM<DQK>(pA0, pA1, m_reg, mnA, alA);
    SLOAD(SO, KVBLK); if (2 < NT) SLOAD(SE, 2 * KVBLK);
    SWAIT(); SWRITE(1, SO); __syncthreads();
    for (int j = 1; j + 1 < NT; j += 2) {
        SBAR(); qkt<DQK>(pB0, pB1, K_lds + SHM_K, qr, r32, hi);
        finishSM(pA0, pA1, alA, l_reg, pa0, pa1, pa2, pa3); SBAR();
        SLOAD(SO, (j + 2) * KVBLK); SBAR();
        pv_d0(o, vb0, pa0, pa1, pa2, pa3); partialSM<DQK>(pB0, pB1, m_reg, mnB, alB);
        __syncthreads(); SWAIT(); SWRITE(0, SE);
        RESC(alB); __syncthreads();
        SBAR(); qkt<DQK>(pA0, pA1, K_lds, qr, r32, hi);
        finishSM(pB0, pB1, alB, l_reg, pa0, pa1, pa2, pa3); SBAR();
        if (j + 3 < NT) SLOAD(SE, (j + 3) * KVBLK); SBAR();
        pv_d0(o, vb0 + (int)SHM_V, pa0, pa1, pa2, pa3); partialSM<DQK>(pA0, pA1, m_reg, mnA, alA);
        __syncthreads(); SWAIT(); SWRITE(1, SO);
        RESC(alA); __syncthreads();
    }
    SBAR(); qkt<DQK>(pB0, pB1, K_lds + SHM_K, qr, r32, hi);
    finishSM(pA0, pA1, alA, l_reg, pa0, pa1, pa2, pa3); SBAR();
    pv_d0(o, vb0, pa0, pa1, pa2, pa3); partialSM<DQK>(pB0, pB1, m_reg, mnB, alB);
    __syncthreads(); RESC(alB);
    finishSM(pB0, pB1, alB, l_reg, pa0, pa1, pa2, pa3); SBAR();
    pv_d0(o, vb0 + (int)SHM_V, pa0, pa1, pa2, pa3);
    if (hi == 0) li_l[r32] = l_reg; asm volatile("s_waitcnt lgkmcnt(0)" ::: "memory");
    float rli[16];
#pragma unroll
    for (int r = 0; r < 16; ++r) rli[r] = __builtin_amdgcn_rcpf(li_l[crow(r, hi)]);
    if constexpr (OUT_BF16) {
#pragma unroll
        for (int r = 0; r < 16; ++r) { const unsigned ob = (unsigned)((wid * QBLK + crow(r, hi)) * LDO + r32); const float sc16 = rli[r] * 16.0f;
#pragma unroll
            for (int d0 = 0; d0 < 4; ++d0) *((unsigned char*)Ob + ob + d0 * 32) = (unsigned char)(__builtin_amdgcn_cvt_pk_fp8_f32(o[d0][r] * sc16, 0.f, 0, false) & 0xff); }
    } else {
#pragma unroll
        for (int r = 0; r < 16; ++r) { const unsigned ob = (unsigned)((wid * QBLK + crow(r, hi)) * LDO + r32) * 2u;
#pragma unroll
            for (int d0 = 0; d0 < 4; ++d0) *(bf16_t*)((char*)Ob + ob + d0 * 64) = f2bf(o[d0][r] * rli[r]); }
    }
#undef SLOAD
#undef SWRITE
#undef SWAIT
#undef RESC
}
}

struct Args { const float* in[26]; float* out; unsigned char* ws; int ph_lo, ph_hi; };
enum { I_X = 0, I_C, I_CTX, I_CCTX, I_WMOD, I_BMOD, I_G1, I_G2, I_WIN, I_GQ, I_GK, I_LQ1, I_LK1, I_LQ2, I_LK2, I_GSUB, I_WPOOL, I_PSCALE, I_WOUT, I_WR, I_BR, I_W1, I_B1, I_W2, I_B2, I_GF };
constexpr int NPHASE = 22;

struct TItem { const char* src; unsigned char* dst; unsigned soff, doff, nb4, ldb; float scale; };
__device__ __forceinline__ TItem titem(int it, const float* win, const float* wout, const float* w1, const float* w2, unsigned char* ws, int lane) {
    constexpr int I_IN = 32 * (INW / 64), I_OUT = 24 * (D / 64), I_E1 = 32 * 32, I_E2 = 16 * 32;
    constexpr int T_IN = 2 * I_IN, T_OUT = 2 * I_OUT, T_E1 = 64 * I_E1;
    const float* W; unsigned char* WT; int N, ldb, item; float scale; int r = it;
    if (r < T_IN) { const int l = r / I_IN; W = win + (size_t)l * D * INW; N = INW; WT = ws + WS_WIN + (size_t)l * INW * D; ldb = D; item = r % I_IN; scale = 64.0f; }
    else if ((r -= T_IN) < T_OUT) { const int l = r / I_OUT; W = wout + (size_t)l * D * D; N = D; WT = ws + WS_WOUT + (size_t)l * D * D; ldb = D; item = r % I_OUT; scale = (item / (D / 32) < 8) ? 4.0f : 64.0f; }
    else if ((r -= T_OUT) < T_E1) { const int le = r / I_E1; W = w1 + (size_t)le * D * 2048; N = 2048; WT = ws + WS_W1 + (size_t)le * 2048 * D; ldb = D; item = r % I_E1; scale = 64.0f; }
    else { r -= T_E1; const int le = r / I_E2; W = w2 + (size_t)le * DE * D; N = D; WT = ws + WS_W2 + (size_t)le * D * DE; ldb = DE; item = r % I_E2; scale = 32.0f; }
    const int nblk = N / 32, kb = item / nblk, nb = item % nblk, k0 = 128 * kb + 16 * (lane >> 3), n0 = 32 * nb + 4 * (lane & 7);
    TItem t; t.src = (const char*)uniform_ptr(W); t.dst = uniform_ptr(WT); t.soff = (unsigned)(k0 * N + n0) * 4u; t.doff = (unsigned)(n0 * ldb + k0); t.nb4 = (unsigned)N * 4u; t.ldb = (unsigned)ldb; t.scale = scale; return t;
}
#define TI_LOAD(v, t) do { _Pragma("unroll") for (int _i = 0; _i < 16; ++_i) v[_i] = *(const f32x4*)((t).src + ((t).soff + (unsigned)_i * (t).nb4)); } while (0)
#define TI_STORE(v, t) do { const float _sc = (t).scale; _Pragma("unroll") for (int _c = 0; _c < 4; ++_c) { int _w[4]; \
        _Pragma("unroll") for (int _q = 0; _q < 4; ++_q) { int _x = 0; _x = __builtin_amdgcn_cvt_pk_fp8_f32(v[4 * _q][_c] * _sc, v[4 * _q + 1][_c] * _sc, _x, false); \
            _x = __builtin_amdgcn_cvt_pk_fp8_f32(v[4 * _q + 2][_c] * _sc, v[4 * _q + 3][_c] * _sc, _x, true); _w[_q] = _x; } \
        *(u32x4*)((t).dst + ((t).doff + (unsigned)_c * (t).ldb)) = (u32x4){(unsigned)_w[0], (unsigned)_w[1], (unsigned)_w[2], (unsigned)_w[3]}; } } while (0)
__device__ __forceinline__ float silu_f(float x) { return x / (1.0f + __expf(-x)); }

__device__ __forceinline__ void fold_item(int it, const float* wpool, const float* pscale, const float* wout, unsigned char* WOUT) {
    const int n = it & 2047, cc = (it >> 11) & 15, g = (it >> 15) & 3, l = it >> 17;
    const float* wp = wpool + (((size_t)l * 4 + g) * 128 + cc * 8) * 128;
    const float* ps = pscale + (size_t)l * 512 + g * 128;
    const float* wo = wout + ((size_t)l * D + 1536 + g * 128) * D + n;
    float acc[8];
#pragma unroll
    for (int q = 0; q < 8; ++q) acc[q] = 0.f;
#pragma unroll 1
    for (int d0 = 0; d0 < 128; d0 += 32) { float av[32];
#pragma unroll
        for (int dd = 0; dd < 32; ++dd) av[dd] = wo[(size_t)(d0 + dd) * D];
#pragma unroll
        for (int dd = 0; dd < 32; ++dd) { const float x = ps[d0 + dd] * av[dd];
#pragma unroll
            for (int q = 0; q < 8; ++q) acc[q] = fmaf(wp[q * 128 + d0 + dd], x, acc[q]); } }
    int o0 = 0, o1 = 0; o0 = __builtin_amdgcn_cvt_pk_fp8_f32(acc[0] * 64.f, acc[1] * 64.f, o0, false); o0 = __builtin_amdgcn_cvt_pk_fp8_f32(acc[2] * 64.f, acc[3] * 64.f, o0, true);
    o1 = __builtin_amdgcn_cvt_pk_fp8_f32(acc[4] * 64.f, acc[5] * 64.f, o1, false); o1 = __builtin_amdgcn_cvt_pk_fp8_f32(acc[6] * 64.f, acc[7] * 64.f, o1, true);
    *(u32x2*)(WOUT + ((size_t)l * D + n) * D + 1536 + g * 128 + cc * 8) = (u32x2){(unsigned)o0, (unsigned)o1};
}

PHASE_FN phase_prologue(LAS unsigned char* lds, int l_unused, int G) {
    lds = (LAS unsigned char*)__builtin_amdgcn_readfirstlane((int)(uintptr_t)lds); G = __builtin_amdgcn_readfirstlane(G);
    const int tid = tid_local(), lane = tid & 63, wave = __builtin_amdgcn_readfirstlane(tid >> 6);
    unsigned char* ws = WSP();
    const int gw = blockIdx.x * NWAVES + wave, NGW = G * NWAVES;
    {
        float* MODP = (float*)(ws + WS_MODP);
        const float* cvec = INP(I_C); const float* cctx = INP(I_CCTX); const float* wmod = INP(I_WMOD);
        LAS float* st = (LAS float*)lds;
        for (int i = tid; i < 5 * D; i += NTHREADS) st[i] = silu_f(i < 4 * D ? cvec[i] : cctx[i - 4 * D]);
        __syncthreads();
        for (int u = gw; u < 2 * 64 * 48; u += NGW) {
            const int l = u / (64 * 48), r = u % (64 * 48), kc = r / 48, cg = r % 48;
            const int col = cg * 256 + lane * 4;
            const float* W = wmod + (size_t)l * D * 12288 + (size_t)(kc * 32) * 12288 + col;
            f32x4 acc[5];
#pragma unroll
            for (int v = 0; v < 5; ++v) acc[v] = (f32x4){0.f, 0.f, 0.f, 0.f};
#pragma unroll 1
            for (int k8 = 0; k8 < 32; k8 += 16) {
                f32x4 w[16];
#pragma unroll
                for (int kk = 0; kk < 16; ++kk) w[kk] = *(const f32x4*)(W + (size_t)(k8 + kk) * 12288);
#pragma unroll
                for (int kk = 0; kk < 16; ++kk) { const int k = kc * 32 + k8 + kk;
#pragma unroll
                    for (int v = 0; v < 5; ++v) acc[v] += st[v * D + k] * w[kk]; } }
#pragma unroll
            for (int v = 0; v < 5; ++v) *(f32x4*)(MODP + ((size_t)kc * 10 + l * 5 + v) * 12288 + col) = acc[v];
        }
        __syncthreads();
    }
    {
        f32x2* tabA = (f32x2*)(ws + WS_ROPE); f32x2* tabB = tabA + 64 * 32;
        for (int i = blockIdx.x * NTHREADS + tid; i < 64 * 32 + 64 * 16; i += G * NTHREADS) {
            if (i < 64 * 32) { const int pos = i >> 5, f = i & 31; const float inv = powf(10000.0f, -(float)f / 32.0f); const float ang = (float)pos * inv; tabA[i] = (f32x2){cosf(ang), sinf(ang)}; }
            else { const int q = i - 64 * 32; const int pos = q >> 4, f = q & 15; const float inv = powf(10000.0f, -(float)f / 16.0f); const float ang = (float)pos * inv; tabB[q] = (f32x2){cosf(ang), sinf(ang)}; }
        }
    }
    {
        const float* wr = INP(I_WR); bf16_t* WRS = (bf16_t*)(ws + WS_WRS);
        for (int i = blockIdx.x * NTHREADS + tid; i < 2 * D * NE; i += G * NTHREADS) {
            const int l = i / (D * NE), rem = i % (D * NE), k = rem >> 5, e = rem & 31;
            WRS[((size_t)l * NE + e) * D + k] = f2bf(wr[i]); }
    }
    {
        const float* win = INP(I_WIN); const float* wout = INP(I_WOUT); const float* w1 = INP(I_W1); const float* w2 = INP(I_W2);
        constexpr int TOT = 2 * 32 * (INW / 64);
        f32x4 va[16], vb[16]; TItem ta, tb;
        int it = gw;
        if (it < TOT) { ta = titem(it, win, wout, w1, w2, ws, lane); TI_LOAD(va, ta); }
        while (it < TOT) {
            const int i1 = it + NGW;
            if (i1 < TOT) { tb = titem(i1, win, wout, w1, w2, ws, lane); TI_LOAD(vb, tb); }
            TI_STORE(va, ta);
            if (i1 >= TOT) break;
            const int i2 = i1 + NGW;
            if (i2 < TOT) { ta = titem(i2, win, wout, w1, w2, ws, lane); TI_LOAD(va, ta); }
            TI_STORE(vb, tb);
            it = i2;
        }
    }
}

PHASE_FN phase_modreduce(LAS unsigned char* lds, int l_unused, int G) {
    lds = (LAS unsigned char*)__builtin_amdgcn_readfirstlane((int)(uintptr_t)lds); G = __builtin_amdgcn_readfirstlane(G);
    const int tid = tid_local();
    unsigned char* ws = WSP();
    const float* MODP = (const float*)(ws + WS_MODP); float* MOD = (float*)(ws + WS_MOD); const float* bmod = INP(I_BMOD); const float* g2 = INP(I_G2);
    for (int i = blockIdx.x * NTHREADS + tid; i < 10 * 12288 / 4; i += G * NTHREADS) {
        const int lv = i / 3072, col = (i % 3072) * 4, l = lv / 5;
        f32x4 s = *(const f32x4*)(bmod + (size_t)l * 12288 + col);
#pragma unroll 16
        for (int kc = 0; kc < 64; ++kc) s += *(const f32x4*)(MODP + ((size_t)kc * 10 + lv) * 12288 + col);
        if (col >= 4 * 2048 && col < 5 * 2048) s = *(const f32x4*)(g2 + (size_t)l * D + (col - 4 * 2048)) * (s + 1.0f);
        *(f32x4*)(MOD + (size_t)lv * 12288 + col) = s;
    }
}

__device__ __forceinline__ void norm_mod_store(const f32x4 (&v)[8], const f32x4 (&gg)[8], const f32x4 (&sh)[8], const f32x4 (&sc)[8], unsigned char* orow, int lane) {
    float ss = 0.f;
#pragma unroll
    for (int j = 0; j < 8; ++j) ss += (v[j].x * v[j].x + v[j].y * v[j].y) + (v[j].z * v[j].z + v[j].w * v[j].w);
    const float rs = rsqrtf(wave_sum(ss) * (1.0f / D) + EPS);
#pragma unroll
    for (int j = 0; j < 8; ++j) { const int col = 4 * (lane + 64 * j);
        const f32x4 y = (v[j] * rs) * gg[j]; const f32x4 n = y * (sc[j] + 1.0f) + sh[j];
        int w = 0; w = __builtin_amdgcn_cvt_pk_fp8_f32(n.x, n.y, w, false); w = __builtin_amdgcn_cvt_pk_fp8_f32(n.z, n.w, w, true);
        *(int*)(orow + col) = w; }
}

PHASE_FN phase_norm1_l0(LAS unsigned char* lds, int l_unused, int G) {
    lds = (LAS unsigned char*)__builtin_amdgcn_readfirstlane((int)(uintptr_t)lds); G = __builtin_amdgcn_readfirstlane(G);
    const int tid = tid_local(), lane = tid & 63, wave = __builtin_amdgcn_readfirstlane(tid >> 6);
    unsigned char* ws = WSP();
    const float* MOD = (const float*)(ws + WS_MOD);
    unsigned char* N = ws + WS_N;
    const float* x = INP(I_X); const float* ctx = INP(I_CTX); const float* g1 = INP(I_G1);
    f32x4 gg[8];
#pragma unroll
    for (int j = 0; j < 8; ++j) gg[j] = *(const f32x4*)(g1 + 4 * (lane + 64 * j));
    for (int row = blockIdx.x * NWAVES + wave; row < MT; row += G * NWAVES) {
        const float* src = row < ML ? x + (size_t)row * D : ctx + (size_t)(row - ML) * D;
        const int bidx = row < ML ? (row >> 12) : 4;
        const float* m = MOD + (size_t)bidx * 12288;
        f32x4 v[8], sh[8], sc[8];
#pragma unroll
        for (int j = 0; j < 8; ++j) { v[j] = *(const f32x4*)(src + 4 * (lane + 64 * j)); sh[j] = *(const f32x4*)(m + 4 * (lane + 64 * j)); sc[j] = *(const f32x4*)(m + 2048 + 4 * (lane + 64 * j)); }
        norm_mod_store(v, gg, sh, sc, N + (size_t)row * D, lane);
    }
}

PHASE_FN phase_inproj(LAS unsigned char* lds, int l, int G) {
    lds = (LAS unsigned char*)__builtin_amdgcn_readfirstlane((int)(uintptr_t)lds); l = __builtin_amdgcn_readfirstlane(l); G = __builtin_amdgcn_readfirstlane(G);
    unsigned char* ws = WSP();
    pg8::DenseSched<D, 1> S; S.init(ws + WS_N, ws + WS_WIN + (size_t)l * INW * D, MT, INW, G, (int)blockIdx.x);
    pg8::EpiProj E{(bf16_t*)(ws + WS_P), (bf16_t*)(ws + WS_VA), (bf16_t*)(ws + WS_VB)};
    pg8::gemm_phase(lds, S, E);
}

PHASE_FN phase_prep(LAS unsigned char* lds, int l, int G) {
    lds = (LAS unsigned char*)__builtin_amdgcn_readfirstlane((int)(uintptr_t)lds); l = __builtin_amdgcn_readfirstlane(l); G = __builtin_amdgcn_readfirstlane(G);
    const int tid = tid_local(), lane = tid & 63, wave = __builtin_amdgcn_readfirstlane(tid >> 6);
    unsigned char* ws = WSP();
    const bf16_t* P = (const bf16_t*)(ws + WS_P);
    unsigned* QA = (unsigned*)(ws + WS_QA); unsigned* KA = (unsigned*)(ws + WS_KA); unsigned* VA = (unsigned*)(ws + WS_VA);
    unsigned* QB = (unsigned*)(ws + WS_QB); unsigned* KB = (unsigned*)(ws + WS_KB); unsigned* VB = (unsigned*)(ws + WS_VB); unsigned char* CAT = ws + WS_CAT;
    const f32x2* tabA = (const f32x2*)(ws + WS_ROPE); const f32x2* tabB = tabA + 64 * 32;
    const f32x2 gq2 = *(const f32x2*)(INP(I_GQ) + l * 128 + 2 * lane), gk2 = *(const f32x2*)(INP(I_GK) + l * 128 + 2 * lane);
    const bool firstA = (lane & 16) == 0, firstB = (lane & 8) == 0;
    for (int unit = blockIdx.x; unit < MT / 8; unit += G) {
        const int ch = tid, hw = 1 << (ch >> 7);
        const int row0 = unit * 8; int base, s0, L;
        if (row0 < ML) { base = row0 & ~4095; s0 = row0 & 4095; L = SEQ; } else { const int r2 = row0 - ML; base = ML + (r2 & ~255); s0 = r2 & 255; L = CTX; }
        float pv_[23];
        { const bf16_t* pc = P + (size_t)base * INW + OFF_UC + ch;
#pragma unroll
            for (int j = 0; j < 23; ++j) { int sj = s0 - 8 + j; sj = sj < 0 ? 0 : (sj >= L ? L - 1 : sj);
                pv_[j] = bf2f(pc[(size_t)sj * INW]); } }
        {
            const int row = unit * 8 + wave;
            const bool lat = row < ML; int b, sq, trow;
            if (lat) { b = row >> 12; sq = row & 4095; trow = b * TK + CTX + sq; } else { const int r2 = row - ML; b = r2 >> 8; sq = r2 & 255; trow = b * TK + sq; }
            const unsigned* p = (const unsigned*)(P + (size_t)row * INW);
            unsigned ha[10], hb[8];
#pragma unroll
            for (int hh = 0; hh < 10; ++hh) ha[hh] = p[(hh < 8 ? hh * 64 : OFF_KA / 2 + (hh - 8) * 64) + lane];
#pragma unroll
            for (int jp = 0; jp < 8; ++jp) hb[jp] = p[(jp < 4 ? OFF_QB / 2 + jp * 64 : OFF_KB / 2 + (jp - 4) * 64) + lane];
            const int prow = sq >> 6, pcol = sq & 63;
            const f32x4 csA = *(const f32x4*)(tabA + (lane < 32 ? prow : pcol) * 32 + 2 * (lane & 15));
            const f32x4 csB = *(const f32x4*)(tabB + ((lane & 16) == 0 ? prow : pcol) * 16 + 2 * (lane & 7));
#pragma unroll
            for (int hh = 0; hh < 10; ++hh) {
                float e0 = __uint_as_float(ha[hh] << 16), e1 = __uint_as_float(ha[hh] & 0xffff0000u);
                const float ss = wave_sum(e0 * e0 + e1 * e1); const float r = rsqrtf(ss * (1.0f / 128.0f) + EPS);
                const f32x2 g = hh < 8 ? gq2 : gk2;
                e0 = e0 * r * g.x; e1 = e1 * r * g.y;
                if (lat) {
                    const float o0 = __shfl_xor(e0, 16), o1 = __shfl_xor(e1, 16);
                    e0 = firstA ? (e0 * csA.x - o0 * csA.y) : (o0 * csA.y + e0 * csA.x);
                    e1 = firstA ? (e1 * csA.z - o1 * csA.w) : (o1 * csA.w + e1 * csA.z);
                }
                unsigned* dst = hh < 8 ? QA + (size_t)row * 512 + hh * 64 : KA + (size_t)trow * 128 + (hh - 8) * 64;
                dst[lane] = cvt_pk_bf16(e0, e1);
            }
#pragma unroll
            for (int jp = 0; jp < 8; ++jp) {
                float e0 = __uint_as_float(hb[jp] << 16), e1 = __uint_as_float(hb[jp] & 0xffff0000u);
                if (lat) {
                    const float o0 = __shfl_xor(e0, 8), o1 = __shfl_xor(e1, 8);
                    e0 = firstB ? (e0 * csB.x - o0 * csB.y) : (o0 * csB.y + e0 * csB.x);
                    e1 = firstB ? (e1 * csB.z - o1 * csB.w) : (o1 * csB.w + e1 * csB.z);
                }
                unsigned* dst = jp < 4 ? QB + (size_t)row * 256 + jp * 64 : KB + (size_t)trow * 256 + (jp - 4) * 64;
                dst[lane] = cvt_pk_bf16(e0, e1);
            }
        }
        {
#pragma unroll
            for (int tk = 0; tk < 8; ++tk) { const int sq = s0 + tk;
                const int lo = (sq - hw) < 0 ? 0 : (sq - hw), hi = (sq + hw) > L ? L : (sq + hw);
                float sum = 0.f;
#pragma unroll
                for (int j = tk; j < tk + 16; ++j) { const int sj = s0 - 8 + j; sum += (sj >= lo && sj < hi) ? pv_[j] : 0.f; }
                CAT[(size_t)(row0 + tk) * D + 1536 + ch] = (unsigned char)(__builtin_amdgcn_cvt_pk_fp8_f32(sum / (float)(hi - lo) - pv_[tk + 8], 0.f, 0, false) & 0xff); }
        }
    }
}

constexpr int NCONV_WG = 40;
constexpr int CONV_BATCH = 128, CONV_E1 = 32 * 32 * 32, CONV_E2 = 32 * 16 * 32, CONV_ITEMS = CONV_E1 + CONV_E2  , CONV_FIRST = 2 * 32 * (INW / 64) + 2 * 24 * (D / 64);
constexpr int CONV_OUT0 = 2 * 32 * (INW / 64), CONV_OUT = 24 * (D / 64)  , NB_FOLD = 4 * 16 * 2048 / NTHREADS  , NB_OUT = CONV_OUT / CONV_BATCH, NB_EXP = CONV_ITEMS / CONV_BATCH;
static_assert(CONV_OUT % CONV_BATCH == 0, "w_out batches");
PHASE_FN phase_attention(LAS unsigned char* lds_, int l, int G) {
    lds_ = (LAS unsigned char*)__builtin_amdgcn_readfirstlane((int)(uintptr_t)lds_); l = __builtin_amdgcn_readfirstlane(l); G = __builtin_amdgcn_readfirstlane(G);
    LAS unsigned char* lds = lds_;
    unsigned char* ws = WSP();
    char* ldsg = (char*)lds_;
    const int tid = tid_local();
    const bf16_t* QA = (const bf16_t*)(ws + WS_QA); const bf16_t* KA = (const bf16_t*)(ws + WS_KA); const bf16_t* VA = (const bf16_t*)(ws + WS_VA);
    const bf16_t* QB = (const bf16_t*)(ws + WS_QB); const bf16_t* KB = (const bf16_t*)(ws + WS_KB); const bf16_t* VB = (const bf16_t*)(ws + WS_VB);
    unsigned char* CAT = ws + WS_CAT; bf16_t* OB = (bf16_t*)(ws + WS_OB);
    const int nA = 512 + (l == 0 ? 32 : 0), nB = 512 + (l == 0 ? 32 : 0);
    const bool dyn = (G > NCONV_WG);
    unsigned* qh = (unsigned*)(ws + WS_CTL) + CW_Q + l * 192;
    volatile LAS int* slot = (volatile LAS int*)(lds + MISC_OFF + 32);
    if (!dyn || (int)blockIdx.x < G - NCONV_WG) {
    for (int it = 0;; ++it) {
        int id;
        __syncthreads();
        if (dyn) { if (tid == 0) *slot = (int)atomicAdd(qh, 1u); __syncthreads(); id = __builtin_amdgcn_readfirstlane(*slot); } else id = (int)blockIdx.x + it * G;
        if (id >= nA) break;
        const bf16_t *q, *k, *v; unsigned char* o; int seq;
        if (id < 512) { int b, kvh, h, qb;
            if (dyn) { b = id >> 7; kvh = (id >> 6) & 1; h = kvh * 4 + ((id >> 4) & 3); qb = id & 15; }
            else { const int x = id & 7, i = id >> 8, j = (id >> 3) & 31; b = x >> 1; kvh = x & 1; h = kvh * 4 + 2 * i + (j >> 4); qb = j & 15; }
            const size_t r0 = (size_t)b * SEQ + qb * 256;
            q = QA + r0 * 1024 + h * 128; k = KA + (size_t)b * TK * 256 + kvh * 128; v = VA + (size_t)b * TK * 256 + kvh * 128; o = CAT + r0 * D + h * 128; seq = TK; }
        else { const int c = id - 512, b = c >> 3, h = c & 7; const size_t r0 = (size_t)ML + b * CTX;
            q = QA + r0 * 1024 + h * 128; k = KA + (size_t)b * TK * 256 + (h >> 2) * 128; v = VA + (size_t)b * TK * 256 + (h >> 2) * 128; o = CAT + r0 * D + h * 128; seq = CTX; }
        att::attn_body<128, 1024, 256, 256, D, true>(q, k, v, o, seq, ldsg);
    }
    for (int it = 0;; ++it) {
        int id;
        __syncthreads();
        if (dyn) { if (tid == 0) *slot = (int)atomicAdd(qh + 64, 1u); __syncthreads(); id = __builtin_amdgcn_readfirstlane(*slot); } else id = (int)blockIdx.x + it * G;
        if (id >= nB) break;
        const bf16_t *q, *k, *v; bf16_t* o; int seq;
        if (id < 512) { int b, h, comp, qb;
            if (dyn) { b = id >> 7; h = (id >> 5) & 3; comp = (id >> 4) & 1; qb = id & 15; }
            else { const int x = id & 7, i = id >> 8, j = (id >> 3) & 31; const int combo = 2 * x + i; b = combo >> 2; h = combo & 3; comp = j >> 4; qb = j & 15; }
            const int jj = comp * 4 + h; const size_t r0 = (size_t)b * SEQ + qb * 256;
            q = QB + r0 * 512 + jj * 64; k = KB + (size_t)b * TK * 512 + jj * 64; v = VB + (size_t)b * TK * 512 + h * 128; o = OB + r0 * 1024 + jj * 128; seq = TK; }
        else { const int c = id - 512, b = c >> 3, jj = c & 7, h = jj & 3; const size_t r0 = (size_t)ML + b * CTX;
            q = QB + r0 * 512 + jj * 64; k = KB + (size_t)b * TK * 512 + jj * 64; v = VB + (size_t)b * TK * 512 + h * 128; o = OB + r0 * 1024 + jj * 128; seq = CTX; }
        att::attn_body<64, 512, 512, 512, 1024, false>(q, k, v, o, seq, ldsg);
    }
    }
    {
        const int lane = tid & 63, wave = __builtin_amdgcn_readfirstlane(tid >> 6);
        int bt;
#define CONV_PULL() do { __syncthreads(); if (tid == 0) *slot = (int)atomicAdd(qh + 128, 1u); __syncthreads(); bt = __builtin_amdgcn_readfirstlane(*slot); } while (0)
        for (;;) {
            CONV_PULL();
            if (bt >= NB_FOLD) break;
            fold_item(l * (4 * 16 * 2048) + bt * NTHREADS + tid, INP(I_WPOOL), INP(I_PSCALE), INP(I_WOUT), ws + WS_WOUT);
        }
        const float* win = INP(I_WIN); const float* wout = INP(I_WOUT); const float* w1 = INP(I_W1); const float* w2 = INP(I_W2);
        for (;; ) {
            if (bt >= NB_FOLD + NB_OUT + NB_EXP) break;
            int base;
            if (bt < NB_FOLD + NB_OUT) base = CONV_OUT0 + l * CONV_OUT + (bt - NB_FOLD) * CONV_BATCH + wave * (CONV_BATCH / NWAVES);
            else { const int li = (bt - NB_FOLD - NB_OUT) * CONV_BATCH + wave * (CONV_BATCH / NWAVES);
                base = li < CONV_E1 ? CONV_FIRST + l * CONV_E1 + li : CONV_FIRST + 2 * CONV_E1 + l * CONV_E2 + (li - CONV_E1); }
            f32x4 va[16], vb[16], vc[16]; TItem ta, tb, tc;
            constexpr int NI = CONV_BATCH / NWAVES;
            ta = titem(base, win, wout, w1, w2, ws, lane); TI_LOAD(va, ta); tb = titem(base + 1, win, wout, w1, w2, ws, lane); TI_LOAD(vb, tb);
#pragma unroll 1
            for (int i = 0; i < NI; i += 3) {
                if (i + 2 < NI) { tc = titem(base + i + 2, win, wout, w1, w2, ws, lane); TI_LOAD(vc, tc); }
                TI_STORE(va, ta);
                if (i + 3 < NI) { ta = titem(base + i + 3, win, wout, w1, w2, ws, lane); TI_LOAD(va, ta); }
                if (i + 1 < NI) TI_STORE(vb, tb);
                if (i + 4 < NI) { tb = titem(base + i + 4, win, wout, w1, w2, ws, lane); TI_LOAD(vb, tb); }
                if (i + 2 < NI) TI_STORE(vc, tc);
            }
            CONV_PULL();
        }
#undef CONV_PULL
    }
}

PHASE_FN phase_fixup(LAS unsigned char* lds, int l, int G) {
    lds = (LAS unsigned char*)__builtin_amdgcn_readfirstlane((int)(uintptr_t)lds); l = __builtin_amdgcn_readfirstlane(l); G = __builtin_amdgcn_readfirstlane(G);
    const int tid = tid_local(), lane = tid & 63, wave = __builtin_amdgcn_readfirstlane(tid >> 6);
    unsigned char* ws = WSP();
    const float lam_init = 0.8f - 0.6f * expf(-0.3f * (float)l);
    float s1 = 0.f, s2 = 0.f;
    { const float* lq1 = INP(I_LQ1) + l * 64; const float* lk1 = INP(I_LK1) + l * 64; const float* lq2 = INP(I_LQ2) + l * 64; const float* lk2 = INP(I_LK2) + l * 64;
      s1 = wave_sum(lq1[lane] * lk1[lane]); s2 = wave_sum(lq2[lane] * lk2[lane]); }
    const float lam = expf(s1) - expf(s2) + lam_init;
    const unsigned* OB = (const unsigned*)(ws + WS_OB); unsigned char* CAT = ws + WS_CAT;
    const float* gs = INP(I_GSUB) + l * 128;
    const int nrows = (l == 0) ? MT : ML;
    const f32x2 g2 = *(const f32x2*)(gs + 2 * lane);
    unsigned w1[4], w2[4], n1[4], n2[4];
    int row = blockIdx.x * NWAVES + wave;
    if (row < nrows) {
#pragma unroll
        for (int h = 0; h < 4; ++h) { w1[h] = OB[(size_t)row * 512 + h * 64 + lane]; w2[h] = OB[(size_t)row * 512 + (4 + h) * 64 + lane]; } }
    for (; row < nrows; row += G * NWAVES) {
        const int nrow = row + G * NWAVES;
        if (nrow < nrows) {
#pragma unroll
            for (int h = 0; h < 4; ++h) { n1[h] = OB[(size_t)nrow * 512 + h * 64 + lane]; n2[h] = OB[(size_t)nrow * 512 + (4 + h) * 64 + lane]; } }
#pragma unroll
        for (int h = 0; h < 4; ++h) {
            const f32x2 o1 = (f32x2){__uint_as_float(w1[h] << 16), __uint_as_float(w1[h] & 0xffff0000u)}, o2 = (f32x2){__uint_as_float(w2[h] << 16), __uint_as_float(w2[h] & 0xffff0000u)};
            const f32x2 d = o1 - lam * o2;
            const float ss = wave_sum(d.x * d.x + d.y * d.y); const float r = rsqrtf(ss * (1.0f / 128.0f) + EPS) * (1.0f - lam_init);
            *(unsigned short*)(CAT + (size_t)row * D + 1024 + h * 128 + 2 * lane) = (unsigned short)(__builtin_amdgcn_cvt_pk_fp8_f32(d.x * r * g2.x, d.y * r * g2.y, 0, false) & 0xffff);
        }
#pragma unroll
        for (int h = 0; h < 4; ++h) { w1[h] = n1[h]; w2[h] = n2[h]; }
    }
}

PHASE_FN phase_outproj(LAS unsigned char* lds, int l, int G) {
    lds = (LAS unsigned char*)__builtin_amdgcn_readfirstlane((int)(uintptr_t)lds); l = __builtin_amdgcn_readfirstlane(l); G = __builtin_amdgcn_readfirstlane(G);
    unsigned char* ws = WSP();
    pg8::DenseSched<D, 1> S; S.init(ws + WS_CAT, ws + WS_WOUT + (size_t)l * D * D, (l == 0) ? MT : ML, D, G, (int)blockIdx.x);
    pg8::EpiResid E{INP(I_X), INP(I_CTX), (const bf16_t*)(ws + WS_XR), (bf16_t*)(ws + WS_XR), (const float*)(ws + WS_MOD) + (size_t)l * 5 * 12288, l};
    pg8::gemm_phase(lds, S, E);
}

PHASE_FN phase_router(LAS unsigned char* lds, int l, int G) {
    lds = (LAS unsigned char*)__builtin_amdgcn_readfirstlane((int)(uintptr_t)lds); l = __builtin_amdgcn_readfirstlane(l); G = __builtin_amdgcn_readfirstlane(G);
    const int tid = tid_local(), lane = tid & 63, wave = __builtin_amdgcn_readfirstlane(tid >> 6);
    unsigned char* ws = WSP();
    const bf16_t* XR = (const bf16_t*)(ws + WS_XR); unsigned char* NF8 = ws + WS_NF8;
    const float* MOD = (const float*)(ws + WS_MOD) + (size_t)l * 5 * 12288;
    int* eid = (int*)(ws + WS_ROUT + ROUT_EID); float* gate = (float*)(ws + WS_ROUT + ROUT_GATE); int* posb = (int*)(ws + WS_ROUT + ROUT_POS); int* list = (int*)(ws + WS_ROUT + ROUT_LIST);
    unsigned* cnt = (unsigned*)(ws + WS_CTL) + CW_CNT + l * 32 * 64;
    const float* br = INP(I_BR) + l * NE;
    const bf16_t* WRH = (const bf16_t*)(ws + WS_WRS) + (size_t)l * NE * D;
    constexpr int TST = 4112;
    LAS unsigned char* thi = lds; LAS unsigned char* tlo = lds + 16 * TST;
    static_assert(32 * TST <= MISC_OFF, "router token images");
    LAS float* fl = (LAS float*)lds;
    LAS float* lg = (LAS float*)(lds + MISC_OFF + 512);
    LAS float* tv = (LAS float*)(lds + MISC_OFF + 2560);
    LAS int* lc = (LAS int*)(lds + MISC_OFF + 2816); LAS int* lbase = (LAS int*)(lds + MISC_OFF + 2944);
    LAS int* selall = (LAS int*)(lds + MISC_OFF + 4096);
    const int ntok = (l == 0) ? MT : ML;
    if (tid < NE) lc[tid] = 0;
    const int fn = lane & 15, kg = lane >> 4;
    bf16x8 wh[8][2];
    { const char* bh = (const char*)uniform_ptr(WRH + wave * 256);
        const unsigned o0 = (unsigned)(fn * D + kg * 8) * 2u, o1 = o0 + 16u * D * 2u;
#pragma unroll
        for (int s = 0; s < 8; ++s) { wh[s][0] = *(const bf16x8*)(bh + o0 + s * 64); wh[s][1] = *(const bf16x8*)(bh + o1 + s * 64); } }
    int ui = 0;
    u32x2 ra[8], rb[8]; f32x4 psh, pg;
    LAS float* sg = (LAS float*)(lds + SG_OFF);
#define ROUTER_FETCH(u_) do { const int _row = (u_) * 16 + wave * 2; const int _b = _row < ML ? (_row >> 12) : 4; const float* _m = MOD + (size_t)_b * 12288; \
        const char* _x0 = (const char*)uniform_ptr(XR + (size_t)_row * D); const char* _x1 = (const char*)uniform_ptr(XR + (size_t)(_row + 1) * D); \
        const char* _ms = (const char*)uniform_ptr(_m + 3 * 2048); const char* _mg = (const char*)uniform_ptr(_m + 4 * 2048); \
        _Pragma("unroll") for (int j = 0; j < 8; ++j) { ra[j] = *(const u32x2*)(_x0 + lo8 + j * 512); rb[j] = *(const u32x2*)(_x1 + lo8 + j * 512); } \
        psh = *(const f32x4*)(_ms + (unsigned)tid * 16u); pg = *(const f32x4*)(_mg + (unsigned)tid * 16u); } while (0)
    const unsigned lo8 = (unsigned)lane * 8u, lo4 = (unsigned)lane * 4u, lo16 = (unsigned)lane * 16u;
    if ((int)blockIdx.x < ntok / 16) { ROUTER_FETCH((int)blockIdx.x); *(LAS f32x4*)(sg + 4 * tid) = psh; *(LAS f32x4*)(sg + 2048 + 4 * tid) = pg; }
    __syncthreads();
    for (int unit = blockIdx.x; unit < ntok / 16; unit += G) {
        LAS int* sel = selall + ui * 64;
        int tq = tid; asm volatile("" : "+v"(tq));
        const unsigned lq = (unsigned)(tq & 63);
        { const int tl = wave * 2, row = unit * 16 + tl;
            char* nfa = (char*)uniform_ptr(NF8 + (size_t)row * D); char* nfb = (char*)uniform_ptr(NF8 + (size_t)(row + 1) * D);
            float ssa = 0.f, ssb = 0.f;
#define UNPK4(w_) ((f32x4){__uint_as_float((w_).x << 16), __uint_as_float((w_).x & 0xffff0000u), __uint_as_float((w_).y << 16), __uint_as_float((w_).y & 0xffff0000u)})
#pragma unroll
            for (int j = 0; j < 8; ++j) { const f32x4 xa = UNPK4(ra[j]), xb = UNPK4(rb[j]);
                ssa += (xa.x * xa.x + xa.y * xa.y) + (xa.z * xa.z + xa.w * xa.w); ssb += (xb.x * xb.x + xb.y * xb.y) + (xb.z * xb.z + xb.w * xb.w); }
            const float rsa = rsqrtf(wave_sum(ssa) * (1.0f / D) + EPS), rsb = rsqrtf(wave_sum(ssb) * (1.0f / D) + EPS);
#pragma unroll
            for (int j = 0; j < 8; ++j) { const unsigned col = 4u * lq + 256u * j;
                const f32x4 shj = *(const LAS f32x4*)(sg + col), gj = *(const LAS f32x4*)(sg + 2048 + col);
                const f32x4 na = (UNPK4(ra[j]) * rsa) * gj + shj, nb = (UNPK4(rb[j]) * rsb) * gj + shj;
                int wa = 0, wb = 0; wa = __builtin_amdgcn_cvt_pk_fp8_f32(na.x, na.y, wa, false); wa = __builtin_amdgcn_cvt_pk_fp8_f32(na.z, na.w, wa, true);
                wb = __builtin_amdgcn_cvt_pk_fp8_f32(nb.x, nb.y, wb, false); wb = __builtin_amdgcn_cvt_pk_fp8_f32(nb.z, nb.w, wb, true);
                *(int*)(nfa + 4u * lq + j * 256) = wa; *(int*)(nfb + 4u * lq + j * 256) = wb;
                const unsigned ha0 = cvt_pk_bf16(na.x, na.y), ha1 = cvt_pk_bf16(na.z, na.w), hb0 = cvt_pk_bf16(nb.x, nb.y), hb1 = cvt_pk_bf16(nb.z, nb.w);
                const unsigned la0 = cvt_pk_bf16(na.x - __uint_as_float(ha0 << 16), na.y - __uint_as_float(ha0 & 0xffff0000u)), la1 = cvt_pk_bf16(na.z - __uint_as_float(ha1 << 16), na.w - __uint_as_float(ha1 & 0xffff0000u));
                const unsigned lb0 = cvt_pk_bf16(nb.x - __uint_as_float(hb0 << 16), nb.y - __uint_as_float(hb0 & 0xffff0000u)), lb1 = cvt_pk_bf16(nb.z - __uint_as_float(hb1 << 16), nb.w - __uint_as_float(hb1 & 0xffff0000u));
                *(LAS u32x2*)(thi + tl * TST + col * 2) = (u32x2){ha0, ha1}; *(LAS u32x2*)(tlo + tl * TST + col * 2) = (u32x2){la0, la1};
                *(LAS u32x2*)(thi + (tl + 1) * TST + col * 2) = (u32x2){hb0, hb1}; *(LAS u32x2*)(tlo + (tl + 1) * TST + col * 2) = (u32x2){lb0, lb1};
                }
            asm volatile("" ::: "memory");
            if (unit + G < ntok / 16) ROUTER_FETCH(unit + G);
        }
        __syncthreads();
        f32x4 acc0 = (f32x4){0.f, 0.f, 0.f, 0.f}, acc1 = (f32x4){0.f, 0.f, 0.f, 0.f};
#pragma unroll
        for (int s = 0; s < 8; ++s) { const int ko = (wave * 256 + s * 32 + kg * 8) * 2;
            const bf16x8 ah = *(const LAS bf16x8*)(thi + fn * TST + ko), al = *(const LAS bf16x8*)(tlo + fn * TST + ko);
            acc0 = __builtin_amdgcn_mfma_f32_16x16x32_bf16(ah, wh[s][0], acc0, 0, 0, 0); acc1 = __builtin_amdgcn_mfma_f32_16x16x32_bf16(ah, wh[s][1], acc1, 0, 0, 0);
            acc0 = __builtin_amdgcn_mfma_f32_16x16x32_bf16(al, wh[s][0], acc0, 0, 0, 0); acc1 = __builtin_amdgcn_mfma_f32_16x16x32_bf16(al, wh[s][1], acc1, 0, 0, 0); }
        __syncthreads();
        { LAS float* pw = fl + wave * 512;
#pragma unroll
            for (int r = 0; r < 4; ++r) { pw[(kg * 4 + r) * 32 + fn] = acc0[r]; pw[(kg * 4 + r) * 32 + 16 + fn] = acc1[r]; } }
        __syncthreads();
        { float sacc = br[tid & 31];
#pragma unroll
            for (int w = 0; w < 8; ++w) sacc += fl[w * 512 + tid];
            lg[tid] = sacc; }
        if (unit + G < ntok / 16) { *(LAS f32x4*)(sg + 4 * tid) = psh; *(LAS f32x4*)(sg + 2048 + 4 * tid) = pg; }
        __syncthreads();
        { const int t = tq >> 5, e = tq & 31; const float my = lg[tq]; int rank = 0;
#pragma unroll
            for (int q = 0; q < 8; ++q) { const f32x4 x = *(const LAS f32x4*)(lg + t * 32 + 4 * q);
#pragma unroll
                for (int c = 0; c < 4; ++c) rank += (x[c] > my || (x[c] == my && 4 * q + c < e)) ? 1 : 0; }
            if (rank < 4) { sel[t * 4 + rank] = e; tv[t * 4 + rank] = my; } }
        __syncthreads();
        if (tid < 16) { const int row = unit * 16 + tid; const f32x4 v = *(const LAS f32x4*)(tv + tid * 4);
            const float e1 = __expf(v[1] - v[0]), e2 = __expf(v[2] - v[0]), e3 = __expf(v[3] - v[0]); const float inv = 1.0f / (1.0f + e1 + e2 + e3);
            *(int4*)(eid + (size_t)row * 4) = make_int4(sel[tid * 4 + 0], sel[tid * 4 + 1], sel[tid * 4 + 2], sel[tid * 4 + 3]);
            *(f32x4*)(gate + (size_t)row * 4) = (f32x4){inv, e1 * inv, e2 * inv, e3 * inv}; }
        ++ui;
    }
    __syncthreads();
    const int nent = ui * 64; int ee = 0, rk = 0;
    if (tid < nent) { ee = selall[tid]; rk = __hip_atomic_fetch_add(lc + ee, 1, __ATOMIC_RELAXED, __HIP_MEMORY_SCOPE_WORKGROUP); }
    __syncthreads();
    if (tid < NE) { const int c = lc[tid]; if (c > 0) lbase[tid] = (int)atomicAdd(cnt + tid * 64, (unsigned)c); }
    __syncthreads();
    if (tid < nent) { const int p = lbase[ee] + rk; const int row = ((int)blockIdx.x + (tid >> 6) * G) * 16 + ((tid & 63) >> 2); list[(size_t)ee * MT + p] = row; posb[(size_t)row * 4 + (tid & 3)] = p; }
    __syncthreads();
#undef ROUTER_FETCH
#undef UNPK4
}

__device__ __forceinline__ void moe_tables(unsigned char* ws, int l, LAS unsigned char* lds) {
    LAS int* tp = (LAS int*)(lds + MISC_OFF + 64); LAS int* cn = (LAS int*)(lds + MISC_OFF + 256);
    const unsigned* cnt = (const unsigned*)(ws + WS_CTL) + CW_CNT + l * 32 * 64;
    __syncthreads();
    if (threadIdx.x < 64) { const int ln = threadIdx.x;
        const int c = (ln < NE) ? (int)__hip_atomic_load(cnt + ln * 64, __ATOMIC_RELAXED, __HIP_MEMORY_SCOPE_AGENT) : 0;
        const int t = (c + 255) >> 8; int incl = t;
#pragma unroll
        for (int o = 1; o < 32; o <<= 1) { const int u = __shfl_up(incl, o); if (ln >= o) incl += u; }
        if (ln < NE) { tp[ln] = incl - t; cn[ln] = c; }
        if (ln == NE - 1) tp[NE] = incl; }
    __syncthreads();
}

PHASE_FN phase_moe_up(LAS unsigned char* lds, int l, int G) {
    lds = (LAS unsigned char*)__builtin_amdgcn_readfirstlane((int)(uintptr_t)lds); l = __builtin_amdgcn_readfirstlane(l); G = __builtin_amdgcn_readfirstlane(G);
    unsigned char* ws = WSP();
    moe_tables(ws, l, lds);
    pg8::MoeSched<true, D, 1> S; S.init((const LAS int*)(lds + MISC_OFF + 64), (const LAS int*)(lds + MISC_OFF + 256), ws + WS_NF8, ws + WS_W1 + (size_t)l * 32 * 2048 * D,
                                  (const int*)(ws + WS_ROUT + ROUT_LIST), G, (int)blockIdx.x);
    pg8::EpiSwiglu E{ws + WS_ACT, INP(I_B1) + (size_t)l * 32 * 2048};
    pg8::gemm_phase(lds, S, E);
}

PHASE_FN phase_moe_down(LAS unsigned char* lds, int l, int G) {
    lds = (LAS unsigned char*)__builtin_amdgcn_readfirstlane((int)(uintptr_t)lds); l = __builtin_amdgcn_readfirstlane(l); G = __builtin_amdgcn_readfirstlane(G);
    unsigned char* ws = WSP();
    moe_tables(ws, l, lds);
    pg8::MoeSched<false, DE, 1> S; S.init((const LAS int*)(lds + MISC_OFF + 64), (const LAS int*)(lds + MISC_OFF + 256), ws + WS_ACT, ws + WS_W2 + (size_t)l * 32 * D * DE,
                                   nullptr, G, (int)blockIdx.x);
    pg8::EpiF8 E{ws + WS_Y, D, INP(I_B2) + (size_t)l * 32 * D, D};
    pg8::gemm_phase(lds, S, E);
}

PHASE_FN phase_combine(LAS unsigned char* lds, int l, int G) {
    lds = (LAS unsigned char*)__builtin_amdgcn_readfirstlane((int)(uintptr_t)lds); l = __builtin_amdgcn_readfirstlane(l); G = __builtin_amdgcn_readfirstlane(G);
    const int tid = tid_local(), lane = tid & 63, wave = __builtin_amdgcn_readfirstlane(tid >> 6);
    unsigned char* ws = WSP();
    moe_tables(ws, l, lds);
    bf16_t* XR = (bf16_t*)(ws + WS_XR); unsigned char* N = ws + WS_N; const unsigned char* Y = ws + WS_Y;
    const float* MOD = (const float*)(ws + WS_MOD);
    const int* eid = (const int*)(ws + WS_ROUT + ROUT_EID); const float* gate = (const float*)(ws + WS_ROUT + ROUT_GATE); const int* posb = (const int*)(ws + WS_ROUT + ROUT_POS);
    const LAS int* tp = (const LAS int*)(lds + MISC_OFF + 64);
    const float* g1n = INP(I_G1) + D; const float* gf = INP(I_GF); float* out = OUTP();
    const int ntok = (l == 0) ? MT : ML;
    for (int row = blockIdx.x * NWAVES + wave; row < ntok; row += G * NWAVES) {
        const int bidx = row < ML ? (row >> 12) : 4; const float* m = MOD + ((size_t)l * 5 + bidx) * 12288;
        const int4 ev = *(const int4*)(eid + (size_t)row * 4), pv = *(const int4*)(posb + (size_t)row * 4); const f32x4 gv = *(const f32x4*)(gate + (size_t)row * 4);
        const unsigned char* yr[4];
        yr[0] = Y + ((size_t)tp[ev.x] * 256 + pv.x) * D; yr[1] = Y + ((size_t)tp[ev.y] * 256 + pv.y) * D; yr[2] = Y + ((size_t)tp[ev.z] * 256 + pv.z) * D; yr[3] = Y + ((size_t)tp[ev.w] * 256 + pv.w) * D;
        u32x2 yv[4][4]; f32x4 xv[4][2]; u32x4 xw[4];
#pragma unroll
        for (int j = 0; j < 4; ++j) { const int col = 8 * (lane + 64 * j);
#pragma unroll
            for (int k = 0; k < 4; ++k) yv[j][k] = *(const u32x2*)(yr[k] + col);
            xw[j] = *(const u32x4*)(XR + (size_t)row * D + col); }
#pragma unroll
        for (int j = 0; j < 4; ++j) pg8::unpack_bf16x8(xw[j], xv[j][0], xv[j][1]);
        float ss = 0.f;
#pragma unroll
        for (int j = 0; j < 4; ++j) { const int col = 8 * (lane + 64 * j);
            f32x4 s0 = (f32x4){0.f, 0.f, 0.f, 0.f}, s1 = s0;
#pragma unroll
            for (int k = 0; k < 4; ++k) { const u32x2 w = yv[j][k];
                const f32x2 a0 = __builtin_amdgcn_cvt_pk_f32_fp8((int)w.x, false), a1 = __builtin_amdgcn_cvt_pk_f32_fp8((int)w.x, true), a2 = __builtin_amdgcn_cvt_pk_f32_fp8((int)w.y, false), a3 = __builtin_amdgcn_cvt_pk_f32_fp8((int)w.y, true);
                s0 += gv[k] * (f32x4){a0.x, a0.y, a1.x, a1.y};
                s1 += gv[k] * (f32x4){a2.x, a2.y, a3.x, a3.y}; }
            const f32x4 gt0 = *(const f32x4*)(m + 5 * 2048 + col), gt1 = *(const f32x4*)(m + 5 * 2048 + col + 4);
            xv[j][0] += gt0 * s0; xv[j][1] += gt1 * s1;
            ss += (xv[j][0].x * xv[j][0].x + xv[j][0].y * xv[j][0].y) + (xv[j][0].z * xv[j][0].z + xv[j][0].w * xv[j][0].w);
            ss += (xv[j][1].x * xv[j][1].x + xv[j][1].y * xv[j][1].y) + (xv[j][1].z * xv[j][1].z + xv[j][1].w * xv[j][1].w); }
        const float rs = rsqrtf(wave_sum(ss) * (1.0f / D) + EPS);
        if (l == 0) {
            const float* m1 = MOD + ((size_t)5 + bidx) * 12288;
#pragma unroll
            for (int j = 0; j < 4; ++j) { const int col = 8 * (lane + 64 * j);
                *(u32x4*)(XR + (size_t)row * D + col) = pg8::pack_bf16x8(xv[j][0], xv[j][1]);
                int w0 = 0, w1 = 0;
#pragma unroll
                for (int q = 0; q < 2; ++q) { const f32x4 gg = *(const f32x4*)(g1n + col + 4 * q), sh = *(const f32x4*)(m1 + col + 4 * q), sc = *(const f32x4*)(m1 + 2048 + col + 4 * q);
                    const f32x4 n = ((xv[j][q] * rs) * gg) * (sc + 1.0f) + sh;
                    if (q == 0) { w0 = __builtin_amdgcn_cvt_pk_fp8_f32(n.x, n.y, w0, false); w0 = __builtin_amdgcn_cvt_pk_fp8_f32(n.z, n.w, w0, true); }
                    else { w1 = __builtin_amdgcn_cvt_pk_fp8_f32(n.x, n.y, w1, false); w1 = __builtin_amdgcn_cvt_pk_fp8_f32(n.z, n.w, w1, true); } }
                *(u32x2*)(N + (size_t)row * D + col) = (u32x2){(unsigned)w0, (unsigned)w1}; }
        } else {
            f32x4 gfv[4][2];
#pragma unroll
            for (int j = 0; j < 4; ++j)
#pragma unroll
                for (int q = 0; q < 2; ++q) gfv[j][q] = *(const f32x4*)(gf + 8 * (lane + 64 * j) + 4 * q);
            asm volatile("" ::: "memory");
#pragma unroll
            for (int j = 0; j < 4; ++j) { const int col = 8 * (lane + 64 * j);
                *(f32x4*)(out + (size_t)row * D + col) = (xv[j][0] * rs) * gfv[j][0];
                *(f32x4*)(out + (size_t)row * D + col + 4) = (xv[j][1] * rs) * gfv[j][1]; }
        }
    }
}

__global__ void __launch_bounds__(NTHREADS, 2) mk_fwd(Args a) {
    extern __shared__ __attribute__((aligned(16))) unsigned char lds_raw[];
    LAS unsigned char* lds = (LAS unsigned char*)lds_raw;
    const int tid = threadIdx.x; const int G = gridDim.x;
    if (tid < 16) ((LAS unsigned*)(lds + MISC_OFF))[tid] = 0u;
    if (tid == 64) { LAS unsigned long long* pt = (LAS unsigned long long*)(lds + PT_OFF);
#pragma unroll
        for (int i = 0; i < 26; ++i) pt[i] = (unsigned long long)a.in[i];
        pt[PT_OUT] = (unsigned long long)a.out; pt[PT_WS] = (unsigned long long)a.ws; }
    __syncthreads();
    const bool multi = (a.ph_hi - a.ph_lo) > 1;
    if (multi) (void)xcd_barrier_post((unsigned*)(a.ws + WS_CTL) + CW_BAR, (volatile LAS unsigned*)(lds + MISC_OFF));
    const int lo = a.ph_lo, hi = a.ph_hi;
#define IN(k) (lo <= (k) && (k) < hi)
#define SEAM(k) do { if (IN((k) + 1)) { XcdBarrier _b; _b.bar = (unsigned*)(a.ws + WS_CTL) + CW_BAR; _b.x = xb_xcc_id(); _b.st = (volatile LAS unsigned*)(lds + MISC_OFF); xcd_barrier(_b); if ((MK_REPEAT >> 11) & 1) xcd_barrier(_b); } } while (0)

    if (IN(0)) { REP(0) phase_prologue(lds, 0, G); SEAM(0); }
    if (IN(1)) { phase_modreduce(lds, 0, G); SEAM(1); }
#define LAYER_BODY(l) { \
        const int pb = 2 + 10 * l; \
        if (l == 0 && IN(pb + 0)) { phase_norm1_l0(lds, 0, G); SEAM(pb + 0); } \
        if (IN(pb + 1)) { REP(2) phase_inproj(lds, l, G); SEAM(pb + 1); } \
        if (IN(pb + 2)) { REP(3) phase_prep(lds, l, G); SEAM(pb + 2); } \
        if (IN(pb + 3)) { REP(4) phase_attention(lds, l, G); SEAM(pb + 3); } \
        if (IN(pb + 4)) { REP(5) phase_fixup(lds, l, G); SEAM(pb + 4); } \
        if (IN(pb + 5)) { if (l == 0) { REP(6) phase_outproj(lds, l, G); } else phase_outproj(lds, l, G); SEAM(pb + 5); } \
        if (IN(pb + 6)) { phase_router(lds, l, G); SEAM(pb + 6); } \
        if (IN(pb + 7)) { REP(8) phase_moe_up(lds, l, G); SEAM(pb + 7); } \
        if (IN(pb + 8)) { REP(9) phase_moe_down(lds, l, G); SEAM(pb + 8); } \
        if (IN(pb + 9)) { if (l == 1) { REP(10) phase_combine(lds, l, G); } else phase_combine(lds, l, G); if (l == 0) SEAM(pb + 9); } \
    }
    LAYER_BODY(0)
    LAYER_BODY(1)
#undef LAYER_BODY
#undef IN
#undef SEAM
}

extern "C" void kernel_launch(void* const* d_in, const int* in_sizes, int n_in, void* d_out, int out_size, void* d_ws, size_t ws_size, hipStream_t stream) {
    static int grid = 0;
    if (grid == 0) {
        if (n_in != 26 || in_sizes[0] != ML * D || out_size != ML * D || ws_size < WS_END) {
            fprintf(stderr, "kernel_launch: shape mismatch (n_in %d, in0 %d, out %d, ws %zu need %zu); nothing launched\n", n_in, n_in > 0 ? in_sizes[0] : -1, out_size, ws_size, (size_t)WS_END); grid = -1; return; }
        int dev = 0, cus = 0, per_cu = 0;
        if (hipGetDevice(&dev) != hipSuccess || hipDeviceGetAttribute(&cus, hipDeviceAttributeMultiprocessorCount, dev) != hipSuccess) { grid = -1; return; }
        if (hipFuncSetAttribute((const void*)mk_fwd, hipFuncAttributeMaxDynamicSharedMemorySize, LDS_BYTES) != hipSuccess) { fprintf(stderr, "kernel_launch: hipFuncSetAttribute failed\n"); grid = -1; return; }
        if (hipOccupancyMaxActiveBlocksPerMultiprocessor(&per_cu, (const void*)mk_fwd, NTHREADS, LDS_BYTES) != hipSuccess || per_cu < 1)
            fprintf(stderr, "kernel_launch: note: occupancy query reports %d workgroups per CU\n", per_cu);
        (void)hipGetLastError();
        grid = cus;
    }
    if (grid < 0) return;
    if (hipMemsetAsync((char*)d_ws + WS_CTL, 0, CTL_ZERO_BYTES, stream) != hipSuccess) { fprintf(stderr, "kernel_launch: memset failed\n"); return; }
    Args a{};
    for (int i = 0; i < 26; ++i) a.in[i] = (const float*)d_in[i];
    a.out = (float*)d_out; a.ws = (unsigned char*)d_ws;
#if MK_PER_PHASE_LAUNCH
    for (int p = 0; p < NPHASE; ++p) {
        if (p == 12) continue;
        a.ph_lo = p; a.ph_hi = p + 1;
        hipLaunchKernelGGL(mk_fwd, dim3(grid), dim3(NTHREADS), LDS_BYTES, stream, a);
    }
#else
    a.ph_lo = 0; a.ph_hi = NPHASE;
    hipLaunchKernelGGL(mk_fwd, dim3(grid), dim3(NTHREADS), LDS_BYTES, stream, a);
#endif
    const hipError_t le = hipPeekAtLastError();
    if (le != hipSuccess) fprintf(stderr, "kernel_launch: launch failed: %s\n", hipGetErrorName(le));
}
```
